# Optimizing an MI355X kernel written in HIP

```python
import math
import jax
import jax.numpy as jnp
from jax import lax
import numpy as np

D_MODEL = 1024
BATCH = 8
SEQ = 4096
DEPTH = 2

GRID_W = 64
CTX_LEN = 256
HEAD_DIM = 64
D_HY = 3 * D_MODEL // 8
D_NA = 3 * D_MODEL // 8
D_GA = D_MODEL - D_HY - D_NA
N_NA = D_NA // HEAD_DIM
N_GA = D_GA // HEAD_DIM
KH_MAX = 8
KW = 16
HY_EMB = 33
HY_ORDER = 64
HY_INNER = 2
HY_FAST_DECAY = 0.3
HY_SLOW_DECAY = 1.5
HY_TARGET = 1e-2
SHORT_K = 3
D_FF = 2816
N_EXPERTS = 8
TOP_K = 2
D_FF_E = 3584
ROPE_BASE = 10000.0
Q_BLOCK = 128
N_MOD = 6
EPS = 1e-6

kernel_name = "hybrid_hyena_natten_global_moe_dit"


def rms_norm(x, g):
    xf = x.astype(jnp.float32)
    y = xf * lax.rsqrt(jnp.mean(xf * xf, axis=-1, keepdims=True) + EPS)
    return (y * g.astype(jnp.float32)).astype(x.dtype)


def modulate(x, g, shift, scale):
    return rms_norm(x, g) * (1.0 + scale) + shift


def split_proj(p):
    B, L, _ = p.shape
    hy = p[..., :3 * D_HY]
    na = p[..., 3 * D_HY:3 * (D_HY + D_NA)].reshape(B, L, 3, N_NA, HEAD_DIM)
    ga = p[..., 3 * (D_HY + D_NA):].reshape(B, L, 3, N_GA, HEAD_DIM)
    return hy, na[:, :, 0], na[:, :, 1], na[:, :, 2], ga[:, :, 0], ga[:, :, 1], ga[:, :, 2]


def short_conv(u, w, b):
    L = u.shape[1]
    pad = SHORT_K // 2
    up = jnp.pad(u, ((0, 0), (pad, SHORT_K - 1 - pad), (0, 0)))
    y = b
    for j in range(SHORT_K):
        y = y + up[:, j:j + L] * w[j]
    return y


def hyena_filter(L, w1, b1, freq, w2, b2, w3):
    f32 = jnp.float32
    bands = (HY_EMB - 1) // 2
    t = jnp.linspace(0.0, 1.0, L, dtype=f32)[:, None]
    ang = 2.0 * math.pi * jnp.arange(L, dtype=f32)[:, None] / L
    fr = jnp.linspace(1e-4, bands - 1, bands, dtype=f32)[None, :]
    z = jnp.concatenate([t, jnp.cos(fr * ang), -jnp.sin(fr * ang)], axis=-1)
    w = freq.astype(f32)
    h = jnp.sin(w * (z @ w1.astype(f32) + b1.astype(f32)))
    for i in range(HY_INNER):
        h = jnp.sin(w * (h @ w2[i].astype(f32) + b2[i].astype(f32)))
    h = h @ w3.astype(f32)
    deltas = jnp.linspace(math.log(HY_TARGET) / HY_SLOW_DECAY,
                          math.log(HY_TARGET) / HY_FAST_DECAY, D_HY, dtype=f32)
    deltas = jnp.concatenate([deltas, deltas])
    return h * jnp.exp(-t * jnp.abs(deltas))


def bidir_long_conv(u, h, skip):
    L, C = u.shape[1], u.shape[2]
    h_fwd, h_bwd = h[:, :C], h[:, C:]
    k_circ = jnp.concatenate([h_fwd, jnp.zeros((1, C), jnp.float32), h_bwd[1:][::-1]], axis=0)
    uf = jnp.fft.rfft(u.astype(jnp.float32), n=2 * L, axis=1)
    kf = jnp.fft.rfft(k_circ, n=2 * L, axis=0)
    y = jnp.fft.irfft(uf * kf[None], n=2 * L, axis=1)[:, :L]
    return (y + u.astype(jnp.float32) * skip.astype(jnp.float32)).astype(u.dtype)


def hyena_mixer(p, conv_w, conv_b, filt, skip):
    u = short_conv(p, conv_w, conv_b)
    x0, x1, v = jnp.split(u, 3, axis=-1)
    v = bidir_long_conv(v * x1, filt, skip)
    return v * x0


def context_attention(q, k, v):
    B, Lc, H, Dh = q.shape
    s = jnp.einsum('bqhd,bkhd->bhqk', q, k).astype(jnp.float32) * (Dh ** -0.5)
    p = jax.nn.softmax(s, axis=-1).astype(v.dtype)
    return jnp.einsum('bhqk,bkhd->bqhd', p, v).reshape(B, Lc, H * Dh)


def neighbourhood_attention(q, k, v, k_ctx, v_ctx, rpb):
    B, S, H, Dh = q.shape
    rows = S // GRID_W
    kh = min(KH_MAX, rows)
    r = jnp.arange(rows)
    cidx = jnp.arange(GRID_W)
    row_idx = jnp.clip(r - kh // 2, 0, rows - kh)[:, None] + jnp.arange(kh)[None, :]
    col_start = jnp.clip(cidx - KW // 2, 0, GRID_W - KW)
    col_mask = (cidx[None, :] >= col_start[:, None]) & (cidx[None, :] < col_start[:, None] + KW)
    qg = q.reshape(B, rows, GRID_W, H, Dh)
    kb = k.reshape(B, rows, GRID_W, H, Dh)[:, row_idx]
    vb = v.reshape(B, rows, GRID_W, H, Dh)[:, row_idx]
    scale = Dh ** -0.5
    s_lat = jnp.einsum('brqhd,brkwhd->bhrqkw', qg, kb).astype(jnp.float32) * scale
    dr = row_idx - r[:, None] + (KH_MAX - 1)
    dc = jnp.clip(cidx[None, :] - cidx[:, None], -(KW - 1), KW - 1) + (KW - 1)
    bias = rpb[:, dr[:, None, :, None], dc[None, :, None, :]]
    s_lat = jnp.where(col_mask[:, None, :], s_lat + bias.astype(jnp.float32), -jnp.inf)
    s_ctx = jnp.einsum('brqhd,bchd->bhrqc', qg, k_ctx).astype(jnp.float32) * scale
    n_lat = kh * GRID_W
    s = jnp.concatenate([s_lat.reshape(B, H, rows, GRID_W, n_lat), s_ctx], axis=-1)
    p = jax.nn.softmax(s, axis=-1).astype(v.dtype)
    p_lat = p[..., :n_lat].reshape(B, H, rows, GRID_W, kh, GRID_W)
    o = (jnp.einsum('bhrqkw,brkwhd->brqhd', p_lat, vb)
         + jnp.einsum('bhrqc,bchd->brqhd', p[..., n_lat:], v_ctx))
    return o.reshape(B, S, H * Dh)


def global_attention(q, k, v, k_ctx, v_ctx):
    B, S, H, Dh = q.shape
    nb = S // Q_BLOCK
    scale = Dh ** -0.5
    qb = q.reshape(B, nb, Q_BLOCK, H, Dh).transpose(1, 0, 2, 3, 4)

    def block(qi):
        s = jnp.concatenate([jnp.einsum('bqhd,bkhd->bhqk', qi, k),
                             jnp.einsum('bqhd,bchd->bhqc', qi, k_ctx)], axis=-1).astype(jnp.float32) * scale
        p = jax.nn.softmax(s, axis=-1).astype(v.dtype)
        return (jnp.einsum('bhqk,bkhd->bqhd', p[..., :S], v)
                + jnp.einsum('bhqc,bchd->bqhd', p[..., S:], v_ctx))

    o = lax.map(block, qb)
    return o.transpose(1, 0, 2, 3, 4).reshape(B, S, H * Dh)


def rope_1d(x, pos):
    n = x.shape[-1] // 2
    inv = jnp.power(ROPE_BASE, -jnp.arange(n, dtype=jnp.float32) / n)
    ang = pos[:, None] * inv[None, :]
    cos = jnp.cos(ang)[None, :, None, :]
    sin = jnp.sin(ang)[None, :, None, :]
    x1, x2 = x[..., :n], x[..., n:]
    return jnp.concatenate([x1 * cos - x2 * sin, x1 * sin + x2 * cos], axis=-1)


def axial_rope(x, pos_row, pos_col):
    xf = x.astype(jnp.float32)
    half = x.shape[-1] // 2
    return jnp.concatenate([rope_1d(xf[..., :half], pos_row),
                            rope_1d(xf[..., half:], pos_col)], axis=-1).astype(x.dtype)


def swiglu(h, w_gate, w_up, w_down):
    return (jax.nn.silu(h @ w_gate) * (h @ w_up)) @ w_down


def moe_ffn(h, w_router, w_gate, w_up, w_down):
    logits = (h @ w_router).astype(jnp.float32)
    top_v, top_i = lax.top_k(logits, TOP_K)
    top_w = jax.nn.softmax(top_v, axis=-1)
    combine = jnp.sum(jax.nn.one_hot(top_i, N_EXPERTS, dtype=jnp.float32) * top_w[..., None], axis=-2)
    combine = combine.astype(h.dtype)
    out = jnp.zeros_like(h)
    for e in range(N_EXPERTS):
        out = out + combine[..., e:e + 1] * swiglu(h, w_gate[e], w_up[e], w_down[e])
    return out


def setup_inputs(seed: int = 0) -> dict:
    key = jax.random.key(seed)
    ks = iter(jax.random.split(key, 40))
    f32 = jnp.float32

    def nrm(shape, scale):
        return jax.random.normal(next(ks), shape, f32) * scale

    def gain(shape):
        return 1.0 + nrm(shape, 0.02)

    L = DEPTH
    nd = (DEPTH + 1) // 2
    nm = DEPTH // 2
    return {
        "x": nrm((BATCH, SEQ, D_MODEL), 1.0),
        "c": nrm((BATCH, D_MODEL), 1.0),
        "ctx": nrm((BATCH, CTX_LEN, D_MODEL), 1.0),
        "c_ctx": nrm((D_MODEL,), 1.0),
        "w_mod": nrm((L, D_MODEL, N_MOD * D_MODEL), 0.3 * D_MODEL ** -0.5),
        "b_mod": nrm((L, N_MOD * D_MODEL), 0.02),
        "norm_mix": gain((L, D_MODEL)),
        "norm_ffn": gain((L, D_MODEL)),
        "w_in": nrm((L, D_MODEL, 3 * D_MODEL), D_MODEL ** -0.5),
        "hy_conv_w": nrm((L, SHORT_K, 3 * D_HY), SHORT_K ** -0.5),
        "hy_conv_b": nrm((L, 3 * D_HY), 0.02),
        "hy_w1": nrm((L, HY_EMB, HY_ORDER), HY_EMB ** -0.5),
        "hy_b1": nrm((L, HY_ORDER), 0.2),
        "hy_freq": gain((L, HY_ORDER)),
        "hy_w2": nrm((L, HY_INNER, HY_ORDER, HY_ORDER), HY_ORDER ** -0.5),
        "hy_b2": nrm((L, HY_INNER, HY_ORDER), 0.2),
        "hy_w3": nrm((L, HY_ORDER, 2 * D_HY), HY_ORDER ** -0.5),
        "hy_skip": nrm((L, D_HY), 1.0),
        "na_q_norm": gain((L, HEAD_DIM)),
        "na_k_norm": gain((L, HEAD_DIM)),
        "na_rpb": nrm((L, N_NA, 2 * KH_MAX - 1, 2 * KW - 1), 0.02),
        "ga_q_norm": gain((L, HEAD_DIM)),
        "ga_k_norm": gain((L, HEAD_DIM)),
        "out_norm_hy": gain((L, D_HY)),
        "out_norm_na": gain((L, D_NA)),
        "out_norm_ga": gain((L, D_GA)),
        "w_out": nrm((L, D_MODEL, D_MODEL), D_MODEL ** -0.5),
        "ffn_w_gate": nrm((nd, D_MODEL, D_FF), D_MODEL ** -0.5),
        "ffn_w_up": nrm((nd, D_MODEL, D_FF), D_MODEL ** -0.5),
        "ffn_w_down": nrm((nd, D_FF, D_MODEL), D_FF ** -0.5),
        "moe_router": nrm((nm, D_MODEL, N_EXPERTS), D_MODEL ** -0.5),
        "moe_w_gate": nrm((nm, N_EXPERTS, D_MODEL, D_FF_E), D_MODEL ** -0.5),
        "moe_w_up": nrm((nm, N_EXPERTS, D_MODEL, D_FF_E), D_MODEL ** -0.5),
        "moe_w_down": nrm((nm, N_EXPERTS, D_FF_E, D_MODEL), D_FF_E ** -0.5),
    }


def reference(x, c, ctx, c_ctx, w_mod, b_mod, norm_mix, norm_ffn, w_in,
              hy_conv_w, hy_conv_b, hy_w1, hy_b1, hy_freq, hy_w2, hy_b2, hy_w3, hy_skip,
              na_q_norm, na_k_norm, na_rpb, ga_q_norm, ga_k_norm,
              out_norm_hy, out_norm_na, out_norm_ga, w_out,
              ffn_w_gate, ffn_w_up, ffn_w_down,
              moe_router, moe_w_gate, moe_w_up, moe_w_down):
    S = x.shape[1]
    Lc = ctx.shape[1]
    t = jnp.arange(S)
    pos_row = (t // GRID_W).astype(jnp.float32)
    pos_col = (t % GRID_W).astype(jnp.float32)

    for l in range(DEPTH):
        last = l == DEPTH - 1
        mod_x = jnp.split((jax.nn.silu(c) @ w_mod[l] + b_mod[l])[:, None, :], N_MOD, axis=-1)
        mod_c = jnp.split((jax.nn.silu(c_ctx) @ w_mod[l] + b_mod[l])[None, None, :], N_MOD, axis=-1)

        hx = modulate(x, norm_mix[l], mod_x[0], mod_x[1])
        hc = modulate(ctx, norm_mix[l], mod_c[0], mod_c[1])
        hy_x, qn_x, kn_x, vn_x, qg_x, kg_x, vg_x = split_proj(hx @ w_in[l])
        hy_c, qn_c, kn_c, vn_c, qg_c, kg_c, vg_c = split_proj(hc @ w_in[l])
        qn_x, kn_x = rms_norm(qn_x, na_q_norm[l]), rms_norm(kn_x, na_k_norm[l])
        qn_c, kn_c = rms_norm(qn_c, na_q_norm[l]), rms_norm(kn_c, na_k_norm[l])
        qg_x, kg_x = rms_norm(qg_x, ga_q_norm[l]), rms_norm(kg_x, ga_k_norm[l])
        qg_c, kg_c = rms_norm(qg_c, ga_q_norm[l]), rms_norm(kg_c, ga_k_norm[l])
        qg_x = axial_rope(qg_x, pos_row, pos_col)
        kg_x = axial_rope(kg_x, pos_row, pos_col)

        filt_x = hyena_filter(S, hy_w1[l], hy_b1[l], hy_freq[l], hy_w2[l], hy_b2[l], hy_w3[l])
        y_hy = hyena_mixer(hy_x, hy_conv_w[l], hy_conv_b[l], filt_x, hy_skip[l])
        y_na = neighbourhood_attention(qn_x, kn_x, vn_x, kn_c, vn_c, na_rpb[l])
        y_ga = global_attention(qg_x, kg_x, vg_x, kg_c, vg_c)
        y = jnp.concatenate([rms_norm(y_hy, out_norm_hy[l]), rms_norm(y_na, out_norm_na[l]),
                             rms_norm(y_ga, out_norm_ga[l])], axis=-1) @ w_out[l]
        x = x + mod_x[2] * y

        if not last:
            filt_c = hyena_filter(Lc, hy_w1[l], hy_b1[l], hy_freq[l], hy_w2[l], hy_b2[l], hy_w3[l])
            yc_hy = hyena_mixer(hy_c, hy_conv_w[l], hy_conv_b[l], filt_c, hy_skip[l])
            yc_na = context_attention(qn_c, kn_c, vn_c)
            yc_ga = context_attention(qg_c, kg_c, vg_c)
            yc = jnp.concatenate([rms_norm(yc_hy, out_norm_hy[l]), rms_norm(yc_na, out_norm_na[l]),
                                  rms_norm(yc_ga, out_norm_ga[l])], axis=-1) @ w_out[l]
            ctx = ctx + mod_c[2] * yc

        if l % 2 == 0:
            i = l // 2
            ffn = functools_partial_dense(ffn_w_gate[i], ffn_w_up[i], ffn_w_down[i])
        else:
            i = l // 2
            ffn = functools_partial_moe(moe_router[i], moe_w_gate[i], moe_w_up[i], moe_w_down[i])
        x = x + mod_x[5] * ffn(modulate(x, norm_ffn[l], mod_x[3], mod_x[4]))
        if not last:
            ctx = ctx + mod_c[5] * ffn(modulate(ctx, norm_ffn[l], mod_c[3], mod_c[4]))

    return x


def functools_partial_dense(w_gate, w_up, w_down):
    def f(h):
        return swiglu(h, w_gate, w_up, w_down)
    return f


def functools_partial_moe(w_router, w_gate, w_up, w_down):
    def f(h):
        return moe_ffn(h, w_router, w_gate, w_up, w_down)
    return f
```

```cpp
#ifdef CPU_EMU
#include <cmath>
#include <cstdio>
#include <cstdlib>
#include <cstring>
#include <cstdint>
#define __device__
#define __global__
#define __host__
#define __forceinline__ inline
static inline int atomicAdd(int* p, int v) { int o = *p; *p += v; return o; }
#else
#include <hip/hip_runtime.h>
#include <cstdio>
#include <cstdint>
#endif

#ifdef CFG_SMALL
constexpr int D = 512, NB = 2, S = 1024, LC = 64, DFF = 256, DFE = 256;
#else
constexpr int D = 1024, NB = 8, S = 4096, LC = 256, DFF = 2816, DFE = 3584;
#endif
constexpr int NL = 2;
constexpr int DHY = 3 * D / 8, DNA = 3 * D / 8, DGA = D - DHY - DNA, NNA = DNA / 64, NGA = DGA / 64, HD = 64;
constexpr int GW = 64, ROWS = S / GW, KH = 8, KWIN = 16;
constexpr int MX = NB * S, MC = NB * LC, M = MX + MC;
constexpr int NE = 8;
constexpr int NP = 3 * D;
constexpr int PC_HY = 0, PC_NAQ = 3 * DHY, PC_NAK = PC_NAQ + DNA, PC_NAV = PC_NAK + DNA, PC_GAQ = 3 * (DHY + DNA), PC_GAK = PC_GAQ + DGA, PC_GAV = PC_GAK + DGA;
constexpr int MPAD = ((MX + NE * 255 + 255) / 256) * 256;
constexpr float EPS = 1e-6f;
constexpr float LOG2E = 1.4426950408889634f;
constexpr float QSCALE = 0.125f * LOG2E;

typedef unsigned short bf16;
__host__ __device__ __forceinline__ unsigned f2bf_u(float f) { unsigned u; __builtin_memcpy(&u, &f, 4); return (u + 0x7fffu + ((u >> 16) & 1u)) >> 16; }
__host__ __device__ __forceinline__ bf16 f2bf(float f) { return (bf16)f2bf_u(f); }
__host__ __device__ __forceinline__ float bf2f(bf16 h) { unsigned u = ((unsigned)h) << 16; float f; __builtin_memcpy(&f, &u, 4); return f; }
__host__ __device__ __forceinline__ float silu_f(float v) { return v / (1.0f + expf(-v)); }

struct Prm {
    const float *x, *c, *ctx, *c_ctx, *w_mod, *b_mod, *norm_mix, *norm_ffn, *w_in, *hy_conv_w, *hy_conv_b, *hy_w1, *hy_b1, *hy_freq, *hy_w2, *hy_b2, *hy_w3, *hy_skip;
    const float *na_q_norm, *na_k_norm, *na_rpb, *ga_q_norm, *ga_k_norm, *out_norm_hy, *out_norm_na, *out_norm_ga, *w_out;
    const float *ffn_w_gate, *ffn_w_up, *ffn_w_down, *moe_router, *moe_w_gate, *moe_w_up, *moe_w_down;
    float* out;
    int* ctl;
    float* MOD;
    float *FHA, *FHB;
    bf16* FT;
    bf16* FTC;
    bf16 *WinT, *WoutT;
    bf16 *WguT, *WdT;
    bf16 *WguTe, *WdTe;
    float* CX;
    int* TOPI; float* TOPW; int* LIST;
    bf16* HX;
    bf16* P;
    bf16 *VT, *VTC;
    float *YC, *YCC;
    bf16* HID;
};

__device__ __forceinline__ void conv_T(const float* W, int K, int N, bf16* dst, long gtid, long gsz) {
    for (long i = gtid; i < (long)N * K; i += gsz) { const int n = (int)(i / K), k = (int)(i % K); dst[i] = f2bf(W[(size_t)k * N + n]); }
}
__device__ __forceinline__ void conv_gu(const float* Wg, const float* Wu, int K, int F, bf16* dst, long gtid, long gsz) {
    for (long i = gtid; i < (long)2 * F * K; i += gsz) {
        const int n = (int)(i / K), k = (int)(i % K), p = n / 256, j = n % 256;
        const float* src = j < 128 ? Wg : Wu; const int col = 128 * p + (j & 127);
        dst[i] = f2bf(src[(size_t)k * F + col]);
    }
}
__device__ void ph_wconv(const Prm& p, long gtid, long gsz) {
    for (int l = 0; l < NL; ++l) {
        conv_T(p.w_in + (size_t)l * D * NP, D, NP, p.WinT + (size_t)l * NP * D, gtid, gsz);
        conv_T(p.w_out + (size_t)l * D * D, D, D, p.WoutT + (size_t)l * D * D, gtid, gsz);
    }
    conv_gu(p.ffn_w_gate, p.ffn_w_up, D, DFF, p.WguT, gtid, gsz);
    conv_T(p.ffn_w_down, DFF, D, p.WdT, gtid, gsz);
    for (int e = 0; e < NE; ++e) {
        conv_gu(p.moe_w_gate + (size_t)e * D * DFE, p.moe_w_up + (size_t)e * D * DFE, D, DFE, p.WguTe + (size_t)e * 2 * DFE * D, gtid, gsz);
        conv_T(p.moe_w_down + (size_t)e * DFE * D, DFE, D, p.WdTe + (size_t)e * D * DFE, gtid, gsz);
    }
}
__device__ void ph_mod(const Prm& p, long gtid, long gsz) {
    for (long i = gtid; i < (long)NL * 9 * 6 * D; i += gsz) {
        const int n = (int)(i % (6 * D)), r = (int)((i / (6 * D)) % 9), l = (int)(i / (6 * D * 9));
        const float* cv = r < 8 ? p.c + (size_t)(r % NB) * D : p.c_ctx;
        const float* w = p.w_mod + (size_t)l * D * 6 * D;
        float acc = p.b_mod[(size_t)l * 6 * D + n];
        for (int k = 0; k < D; ++k) acc += silu_f(cv[k]) * w[(size_t)k * 6 * D + n];
        p.MOD[i] = acc;
    }
}
__device__ __forceinline__ int fset_len(int s) { return s < 2 ? S : LC; }
__device__ __forceinline__ int fset_layer(int s) { return s == 1 ? 1 : 0; }
__device__ void ph_filt1(const Prm& p, long gtid, long gsz) {
    for (long i = gtid; i < (long)3 * S * 64; i += gsz) {
        const int u = (int)(i % 64), t = (int)((i / 64) % S), s = (int)(i / (64 * S));
        const int Len = fset_len(s), l = fset_layer(s);
        if (t >= Len) continue;
        const float* w1 = p.hy_w1 + (size_t)l * 33 * 64;
        const float tn = (float)t / (float)(Len - 1);
        const float ang = 6.283185307179586f * (float)t / (float)Len;
        float pre = p.hy_b1[l * 64 + u] + tn * w1[u];
        for (int j = 0; j < 16; ++j) {
            const float fr = 1e-4f + (float)j * ((15.0f - 1e-4f) / 15.0f);
            pre += cosf(fr * ang) * w1[(1 + j) * 64 + u] - sinf(fr * ang) * w1[(17 + j) * 64 + u];
        }
        p.FHA[i] = sinf(p.hy_freq[l * 64 + u] * pre);
    }
}
__device__ void ph_filt2(const Prm& p, int inner, const float* src, float* dst, long gtid, long gsz) {
    for (long i = gtid; i < (long)3 * S * 64; i += gsz) {
        const int u = (int)(i % 64), t = (int)((i / 64) % S), s = (int)(i / (64 * S));
        const int Len = fset_len(s), l = fset_layer(s);
        if (t >= Len) continue;
        const float* w2 = p.hy_w2 + ((size_t)l * 2 + inner) * 64 * 64;
        const float* h = src + (i - u);
        float pre = p.hy_b2[(l * 2 + inner) * 64 + u];
        for (int k = 0; k < 64; ++k) pre += h[k] * w2[k * 64 + u];
        dst[i] = sinf(p.hy_freq[l * 64 + u] * pre);
    }
}
__device__ void ph_filt3(const Prm& p, const float* src, long gtid, long gsz) {
    for (long i = gtid; i < (long)3 * S * 2 * DHY; i += gsz) {
        const int n = (int)(i % (2 * DHY)), t = (int)((i / (2 * DHY)) % S), s = (int)(i / ((long)2 * DHY * S));
        const int Len = fset_len(s), l = fset_layer(s);
        if (t >= Len) continue;
        const float* w3 = p.hy_w3 + (size_t)l * 64 * 2 * DHY;
        const float* h = src + ((size_t)s * S + t) * 64;
        float acc = 0.f;
        for (int k = 0; k < 64; ++k) acc += h[k] * w3[(size_t)k * 2 * DHY + n];
        const int cch = n % DHY;
        const float d0 = logf(1e-2f) / 1.5f, d1 = logf(1e-2f) / 0.3f;
        const float delta = fabsf(d0 + (float)cch * ((d1 - d0) / (float)(DHY - 1)));
        const float tn = (float)t / (float)(Len - 1);
        const float val = acc * expf(-tn * delta);
        bf16* ft = (s < 2 ? p.FT + (size_t)s * DHY * 2 * S : p.FTC) + (size_t)cch * 2 * Len;
        if (n < DHY) ft[Len + t] = f2bf(val);
        else if (t > 0) ft[Len - t] = f2bf(val);
        else ft[0] = 0;
    }
}

__device__ __forceinline__ int row_modrow(int row) { return row < MX ? row / S : 8; }
__device__ __forceinline__ int row_batch(int row) { return row < MX ? row / S : (row - MX) / LC; }

__device__ void ph_modnorm(const Prm& p, int l, const float* xs, const float* cs, const float* gain, int off_shift, int off_scale, int nrows, bool router, long gtid, long gsz) {
    for (long row = gtid; row < nrows; row += gsz) {
        const float* src = row < MX ? xs + (size_t)row * D : cs + (size_t)(row - MX) * D;
        const float* mod = p.MOD + ((size_t)l * 9 + row_modrow((int)row)) * 6 * D;
        float ss = 0.f;
        for (int k = 0; k < D; ++k) ss += src[k] * src[k];
        const float rstd = 1.0f / sqrtf(ss / (float)D + EPS);
        float lg[NE];
#pragma unroll
        for (int e = 0; e < NE; ++e) lg[e] = 0.f;
        for (int k = 0; k < D; ++k) {
            const float h = src[k] * rstd * gain[k] * (1.0f + mod[off_scale + k]) + mod[off_shift + k];
            p.HX[(size_t)row * D + k] = f2bf(h);
            if (router) {
#pragma unroll
                for (int e = 0; e < NE; ++e) lg[e] += h * p.moe_router[(size_t)k * NE + e]; }
        }
        if (router && row < MX) {
            float b1 = -INFINITY, b2 = -INFINITY; int i1 = 0, i2 = 0;
#pragma unroll
            for (int e = 0; e < NE; ++e) { const float v = lg[e]; if (v > b1) { b2 = b1; i2 = i1; b1 = v; i1 = e; } else if (v > b2) { b2 = v; i2 = e; } }
            const float w1 = 1.0f / (1.0f + expf(b2 - b1));
            p.TOPI[row * 2] = i1; p.TOPI[row * 2 + 1] = i2; p.TOPW[row * 2] = w1; p.TOPW[row * 2 + 1] = 1.0f - w1;
        }
    }
}
struct U4 { unsigned x, y, z, w; };
__device__ __forceinline__ float dot_bf(const bf16* a, const bf16* b, int K) {
    float acc = 0.f;
    for (int k = 0; k < K; k += 8) {
        U4 va, vb; __builtin_memcpy(&va, a + k, 16); __builtin_memcpy(&vb, b + k, 16);
        const unsigned ua[4] = {va.x, va.y, va.z, va.w}, ub[4] = {vb.x, vb.y, vb.z, vb.w};
#pragma unroll
        for (int j = 0; j < 4; ++j) acc += bf2f((bf16)(ua[j] & 0xffffu)) * bf2f((bf16)(ub[j] & 0xffffu)) + bf2f((bf16)(ua[j] >> 16)) * bf2f((bf16)(ub[j] >> 16));
    }
    return acc;
}

__device__ void ph_inproj(const Prm& p, int l, long gtid, long gsz) {
    const bf16* Bt = p.WinT + (size_t)l * NP * D;
    for (long i = gtid; i < (long)M * NP; i += gsz) { const int m = (int)(i / NP), n = (int)(i % NP); p.P[i] = f2bf(dot_bf(p.HX + (size_t)m * D, Bt + (size_t)n * D, D)); }
}
__device__ __forceinline__ float sconv(const Prm& p, int l, int row, int col) {
    int t, Len; if (row < MX) { t = row % S; Len = S; } else { t = (row - MX) % LC; Len = LC; }
    const float* w = p.hy_conv_w + (size_t)l * 3 * 3 * DHY;
    float y = p.hy_conv_b[(size_t)l * 3 * DHY + col] + w[3 * DHY + col] * bf2f(p.P[(size_t)row * NP + col]);
    if (t > 0) y += w[col] * bf2f(p.P[(size_t)(row - 1) * NP + col]);
    if (t < Len - 1) y += w[2 * 3 * DHY + col] * bf2f(p.P[(size_t)(row + 1) * NP + col]);
    return y;
}
__device__ void ph_prep_hy(const Prm& p, int l, long gtid, long gsz) {
    for (long i = gtid; i < (long)M * DHY; i += gsz) {
        const int row = (int)(i / DHY), c = (int)(i % DHY);
        const float v = sconv(p, l, row, 2 * DHY + c) * sconv(p, l, row, DHY + c);
        if (row < MX) p.VT[((size_t)c * NB + row / S) * S + row % S] = f2bf(v);
        else { const int rr = row - MX; p.VTC[((size_t)c * NB + rr / LC) * LC + rr % LC] = f2bf(v); }
    }
}
__device__ void ph_prep_qk(const Prm& p, int l, long gtid, long gsz) {
    constexpr int NS = 2 * NNA + 2 * NGA;
    for (long i = gtid; i < (long)M * NS; i += gsz) {
        const int row = (int)(i / NS), hs = (int)(i % NS);
        int col; const float* g; bool isq, rope;
        if (hs < NNA) { col = PC_NAQ + 64 * hs; g = p.na_q_norm + l * 64; isq = true; rope = false; }
        else if (hs < 2 * NNA) { col = PC_NAK + 64 * (hs - NNA); g = p.na_k_norm + l * 64; isq = false; rope = false; }
        else if (hs < 2 * NNA + NGA) { col = PC_GAQ + 64 * (hs - 2 * NNA); g = p.ga_q_norm + l * 64; isq = true; rope = row < MX; }
        else { col = PC_GAK + 64 * (hs - 2 * NNA - NGA); g = p.ga_k_norm + l * 64; isq = false; rope = row < MX; }
        bf16* v = p.P + (size_t)row * NP + col;
        float ss = 0.f;
        for (int d = 0; d < 64; ++d) { const float a = bf2f(v[d]); ss += a * a; }
        const float rstd = 1.0f / sqrtf(ss / 64.0f + EPS), sc = isq ? QSCALE : 1.0f;
        if (!rope) { for (int d = 0; d < 64; ++d) v[d] = f2bf(bf2f(v[d]) * rstd * g[d] * sc); }
        else {
            const int t = row % S; const float pr = (float)(t / GW), pc = (float)(t % GW);
            for (int hf = 0; hf < 2; ++hf) {
                const float pos = hf == 0 ? pr : pc;
                for (int j = 0; j < 16; ++j) {
                    const float inv = powf(10000.0f, -(float)j / 16.0f), ang = pos * inv, cs = cosf(ang), sn = sinf(ang);
                    const int d1 = 32 * hf + j, d2 = d1 + 16;
                    const float a = bf2f(v[d1]) * rstd * g[d1], b = bf2f(v[d2]) * rstd * g[d2];
                    v[d1] = f2bf((a * cs - b * sn) * sc); v[d2] = f2bf((a * sn + b * cs) * sc);
                }
            }
        }
    }
}
__device__ void ph_hyena_naive(const Prm& p, int l, bool with_ctx, long gtid, long gsz) {
    const bf16* FTl = p.FT + (size_t)l * DHY * 2 * S;
    for (long i = gtid; i < (long)DHY * NB * S; i += gsz) {
        const int t = (int)(i % S), cb = (int)(i / S), c = cb / NB;
        const bf16* ft = FTl + (size_t)c * 2 * S + S + t; const bf16* v = p.VT + (size_t)cb * S;
        float acc = 0.f;
        for (int s = 0; s < S; ++s) acc += bf2f(ft[-s]) * bf2f(v[s]);
        p.YC[i] = acc;
    }
    if (with_ctx) for (long i = gtid; i < (long)DHY * NB * LC; i += gsz) {
        const int t = (int)(i % LC), cb = (int)(i / LC), c = cb / NB;
        const bf16* ft = p.FTC + (size_t)c * 2 * LC + LC + t; const bf16* v = p.VTC + (size_t)cb * LC;
        float acc = 0.f;
        for (int s = 0; s < LC; ++s) acc += bf2f(ft[-s]) * bf2f(v[s]);
        p.YCC[i] = acc;
    }
}
struct OnlineSm { float m, l, o[64]; };
__device__ __forceinline__ void osm_init(OnlineSm& st) { st.m = -INFINITY; st.l = 0.f;
_Pragma("unroll") for (int d = 0; d < 64; ++d) st.o[d] = 0.f; }
__device__ __forceinline__ void osm_step(OnlineSm& st, const float* q, const bf16* k, const bf16* v, float bias) {
    float sc = bias;
_Pragma("unroll") for (int d = 0; d < 64; ++d) sc += q[d] * bf2f(k[d]);
    if (sc > st.m) { const float a = exp2f(st.m - sc); st.l *= a;
_Pragma("unroll") for (int d = 0; d < 64; ++d) st.o[d] *= a;
 st.m = sc; }
    const float pe = exp2f(sc - st.m); st.l += pe;
_Pragma("unroll") for (int d = 0; d < 64; ++d) st.o[d] += pe * bf2f(v[d]);
}
__device__ void ph_ga_naive(const Prm& p, long gtid, long gsz) {
    for (long i = gtid; i < (long)NB * NGA * S; i += gsz) {
        const int t = (int)(i % S), h = (int)((i / S) % NGA), b = (int)(i / ((long)S * NGA));
        bf16* qp = p.P + ((size_t)b * S + t) * NP + PC_GAQ + 64 * h;
        float q[64];
_Pragma("unroll") for (int d = 0; d < 64; ++d) q[d] = bf2f(qp[d]);
        OnlineSm st; osm_init(st);
        for (int s = 0; s < S; ++s) { const bf16* kr = p.P + ((size_t)b * S + s) * NP; osm_step(st, q, kr + PC_GAK + 64 * h, kr + PC_GAV + 64 * h, 0.f); }
        for (int s = 0; s < LC; ++s) { const bf16* kr = p.P + ((size_t)MX + b * LC + s) * NP; osm_step(st, q, kr + PC_GAK + 64 * h, kr + PC_GAV + 64 * h, 0.f); }
        const float il = 1.0f / st.l;
_Pragma("unroll") for (int d = 0; d < 64; ++d) qp[d] = f2bf(st.o[d] * il);
    }
}
__device__ void ph_na_naive(const Prm& p, int l, long gtid, long gsz) {
    for (long i = gtid; i < (long)NB * NNA * S; i += gsz) {
        const int t = (int)(i % S), h = (int)((i / S) % NNA), b = (int)(i / ((long)S * NNA));
        const int r = t / GW, qc = t % GW;
        int r0 = r - KH / 2; r0 = r0 < 0 ? 0 : (r0 > ROWS - KH ? ROWS - KH : r0);
        int c0 = qc - KWIN / 2; c0 = c0 < 0 ? 0 : (c0 > GW - KWIN ? GW - KWIN : c0);
        bf16* qp = p.P + ((size_t)b * S + t) * NP + PC_NAQ + 64 * h;
        float q[64];
_Pragma("unroll") for (int d = 0; d < 64; ++d) q[d] = bf2f(qp[d]);
        const float* rpb = p.na_rpb + ((size_t)l * NNA + h) * (2 * KH - 1) * (2 * KWIN - 1);
        OnlineSm st; osm_init(st);
        for (int kr = 0; kr < KH; ++kr) for (int kc = c0; kc < c0 + KWIN; ++kc) {
            const int krow = r0 + kr, dr = krow - r + (KH - 1); int dc = kc - qc; dc = dc < -(KWIN - 1) ? -(KWIN - 1) : (dc > KWIN - 1 ? KWIN - 1 : dc); dc += KWIN - 1;
            const bf16* kp = p.P + ((size_t)b * S + krow * GW + kc) * NP;
            osm_step(st, q, kp + PC_NAK + 64 * h, kp + PC_NAV + 64 * h, rpb[dr * (2 * KWIN - 1) + dc] * LOG2E);
        }
        for (int s = 0; s < LC; ++s) { const bf16* kp = p.P + ((size_t)MX + b * LC + s) * NP; osm_step(st, q, kp + PC_NAK + 64 * h, kp + PC_NAV + 64 * h, 0.f); }
        const float il = 1.0f / st.l;
_Pragma("unroll") for (int d = 0; d < 64; ++d) qp[d] = f2bf(st.o[d] * il);
    }
}
__device__ void ph_ctxattn_naive(const Prm& p, long gtid, long gsz) {
    for (long i = gtid; i < (long)NB * (NNA + NGA) * LC; i += gsz) {
        const int t = (int)(i % LC), hh = (int)((i / LC) % (NNA + NGA)), b = (int)(i / ((long)LC * (NNA + NGA)));
        const int qo = hh < NNA ? PC_NAQ + 64 * hh : PC_GAQ + 64 * (hh - NNA), ko = hh < NNA ? PC_NAK + 64 * hh : PC_GAK + 64 * (hh - NNA), vo = hh < NNA ? PC_NAV + 64 * hh : PC_GAV + 64 * (hh - NNA);
        bf16* qp = p.P + ((size_t)MX + b * LC + t) * NP + qo;
        float q[64];
_Pragma("unroll") for (int d = 0; d < 64; ++d) q[d] = bf2f(qp[d]);
        OnlineSm st; osm_init(st);
        for (int s = 0; s < LC; ++s) { const bf16* kp = p.P + ((size_t)MX + b * LC + s) * NP; osm_step(st, q, kp + ko, kp + vo, 0.f); }
        const float il = 1.0f / st.l;
_Pragma("unroll") for (int d = 0; d < 64; ++d) qp[d] = f2bf(st.o[d] * il);
    }
}
__device__ void ph_final(const Prm& p, int l, int nrows, long gtid, long gsz) {
    for (long row = gtid; row < nrows; row += gsz) {
        const int r = (int)row; int b, t; const float* yc;
        if (r < MX) { b = r / S; t = r % S; } else { b = (r - MX) / LC; t = (r - MX) % LC; }
        float ss = 0.f;
        for (int pass = 0; pass < 2; ++pass) {
            const float rstd = pass ? 1.0f / sqrtf(ss / (float)DHY + EPS) : 0.f;
            for (int c = 0; c < DHY; ++c) {
                const float x0 = sconv(p, l, r, c), vp = sconv(p, l, r, 2 * DHY + c) * sconv(p, l, r, DHY + c);
                const float conv = r < MX ? p.YC[((size_t)c * NB + b) * S + t] : p.YCC[((size_t)c * NB + b) * LC + t];
                const float y = (conv + p.hy_skip[l * DHY + c] * vp) * x0;
                if (!pass) ss += y * y; else p.HX[(size_t)r * D + c] = f2bf(y * rstd * p.out_norm_hy[l * DHY + c]);
            }
        }
        { const bf16* o = p.P + (size_t)r * NP + PC_NAQ; float s2 = 0.f; for (int j = 0; j < DNA; ++j) { const float a = bf2f(o[j]); s2 += a * a; }
          const float rstd = 1.0f / sqrtf(s2 / (float)DNA + EPS); for (int j = 0; j < DNA; ++j) p.HX[(size_t)r * D + DHY + j] = f2bf(bf2f(o[j]) * rstd * p.out_norm_na[l * DNA + j]); }
        { const bf16* o = p.P + (size_t)r * NP + PC_GAQ; float s2 = 0.f; for (int j = 0; j < DGA; ++j) { const float a = bf2f(o[j]); s2 += a * a; }
          const float rstd = 1.0f / sqrtf(s2 / (float)DGA + EPS); for (int j = 0; j < DGA; ++j) p.HX[(size_t)r * D + DHY + DNA + j] = f2bf(bf2f(o[j]) * rstd * p.out_norm_ga[l * DGA + j]); }
        (void)yc;
    }
}
__device__ void ph_outproj(const Prm& p, int l, const float* xs, const float* cs, int nrows, long gtid, long gsz) {
    const bf16* Bt = p.WoutT + (size_t)l * D * D;
    for (long i = gtid; i < (long)nrows * D; i += gsz) {
        const int m = (int)(i / D), n = (int)(i % D);
        const float acc = dot_bf(p.HX + (size_t)m * D, Bt + (size_t)n * D, D);
        const float gate = p.MOD[((size_t)l * 9 + row_modrow(m)) * 6 * D + 2 * D + n];
        if (m < MX) p.out[i] = xs[i] + gate * acc; else p.CX[i - (size_t)MX * D] = cs[i - (size_t)MX * D] + gate * acc;
    }
}
__device__ void ph_ffn_up(const Prm& p, int nrows, long gtid, long gsz) {
    for (long i = gtid; i < (long)nrows * DFF; i += gsz) {
        const int m = (int)(i / DFF), j = (int)(i % DFF), n = 256 * (j / 128) + (j % 128);
        const float g = dot_bf(p.HX + (size_t)m * D, p.WguT + (size_t)n * D, D), u = dot_bf(p.HX + (size_t)m * D, p.WguT + (size_t)(n + 128) * D, D);
        p.HID[i] = f2bf(silu_f(g) * u);
    }
}
__device__ void ph_ffn_down(const Prm& p, int l, int nrows, long gtid, long gsz) {
    for (long i = gtid; i < (long)nrows * D; i += gsz) {
        const int m = (int)(i / D), n = (int)(i % D);
        const float acc = dot_bf(p.HID + (size_t)m * DFF, p.WdT + (size_t)n * DFF, DFF);
        const float gate = p.MOD[((size_t)l * 9 + row_modrow(m)) * 6 * D + 5 * D + n];
        if (m < MX) p.out[i] += gate * acc; else p.CX[i - (size_t)MX * D] += gate * acc;
    }
}
__device__ void ph_moe_count(const Prm& p, long gtid, long gsz) {
    for (long i = gtid; i < (long)2 * MPAD; i += gsz) p.LIST[i] = -1;
    for (long m = gtid; m < MX; m += gsz) { atomicAdd(p.ctl + p.TOPI[m * 2], 1); atomicAdd(p.ctl + 8 + p.TOPI[m * 2 + 1], 1); }
}
__device__ __forceinline__ int moe_off(const Prm& p, int pass, int e) {
    int o = 0;
#pragma unroll
    for (int k = 0; k < NE; ++k) if (k < e) o += (p.ctl[pass * 8 + k] + 255) / 256 * 256;
    return o;
}
__device__ void ph_moe_assign(const Prm& p, long gtid, long gsz) {
    for (long m = gtid; m < MX; m += gsz) {
        for (int c = 0; c < 2; ++c) { const int e = p.TOPI[m * 2 + c]; const int slot = moe_off(p, c, e) + atomicAdd(p.ctl + 16 + c * 8 + e, 1); p.LIST[(size_t)c * MPAD + slot] = (int)m; }
    }
}
__device__ __forceinline__ int moe_slot_expert(const Prm& p, int pass, int slot) {
    int e = 0, o = 0;
#pragma unroll
    for (int k = 0; k < NE - 1; ++k) { o += (p.ctl[pass * 8 + k] + 255) / 256 * 256; if (slot >= o) e = k + 1; }
    return e;
}
__device__ void ph_moe_up(const Prm& p, int pass, long gtid, long gsz) {
    const int tot = moe_off(p, pass, NE);
    for (long i = gtid; i < (long)tot * DFE; i += gsz) {
        const int slot = (int)(i / DFE), j = (int)(i % DFE), tok = p.LIST[(size_t)pass * MPAD + slot];
        if (tok < 0) continue;
        const int e = moe_slot_expert(p, pass, slot), n = 256 * (j / 128) + (j % 128);
        const bf16* W = p.WguTe + (size_t)e * 2 * DFE * D;
        const float g = dot_bf(p.HX + (size_t)tok * D, W + (size_t)n * D, D), u = dot_bf(p.HX + (size_t)tok * D, W + (size_t)(n + 128) * D, D);
        p.HID[i] = f2bf(silu_f(g) * u);
    }
}
__device__ void ph_moe_down(const Prm& p, int l, int pass, long gtid, long gsz) {
    const int tot = moe_off(p, pass, NE);
    for (long i = gtid; i < (long)tot * D; i += gsz) {
        const int slot = (int)(i / D), n = (int)(i % D), tok = p.LIST[(size_t)pass * MPAD + slot];
        if (tok < 0) continue;
        const int e = moe_slot_expert(p, pass, slot);
        const float acc = dot_bf(p.HID + (size_t)slot * DFE, p.WdTe + ((size_t)e * D + n) * DFE, DFE);
        const float gate = p.MOD[((size_t)l * 9 + tok / S) * 6 * D + 5 * D + n];
        p.out[(size_t)tok * D + n] += gate * p.TOPW[tok * 2 + pass] * acc;
    }
}

enum { PH_WCONV, PH_MOD, PH_F1, PH_F2A, PH_F2B, PH_F3, PH_MODNORM1, PH_INPROJ, PH_PREP_HY, PH_PREP_QK, PH_HYENA, PH_GA, PH_NA, PH_CTXATTN, PH_FINAL, PH_OUTPROJ, PH_MODNORM2,
       PH_FFN_UP, PH_FFN_DOWN, PH_MOE_COUNT, PH_MOE_ASSIGN, PH_MOE_UP, PH_MOE_DOWN };
__device__ __forceinline__ void run_phase(const Prm& p, int ph, int l, int arg, long gtid, long gsz) {
    const bool first = l == 0, last = l == NL - 1;
    const float* xs = first ? p.x : p.out; const float* cs = first ? p.ctx : p.CX;
    const int nact = last ? MX : M;
    switch (ph) {
        case PH_WCONV: ph_wconv(p, gtid, gsz); break;
        case PH_MOD: ph_mod(p, gtid, gsz); break;
        case PH_F1: ph_filt1(p, gtid, gsz); break;
        case PH_F2A: ph_filt2(p, 0, p.FHA, p.FHB, gtid, gsz); break;
        case PH_F2B: ph_filt2(p, 1, p.FHB, p.FHA, gtid, gsz); break;
        case PH_F3: ph_filt3(p, p.FHA, gtid, gsz); break;
        case PH_MODNORM1: ph_modnorm(p, l, xs, cs, p.norm_mix + l * D, 0, D, M, false, gtid, gsz); break;
        case PH_INPROJ: ph_inproj(p, l, gtid, gsz); break;
        case PH_PREP_HY: ph_prep_hy(p, l, gtid, gsz); break;
        case PH_PREP_QK: ph_prep_qk(p, l, gtid, gsz); break;
        case PH_HYENA: ph_hyena_naive(p, l, !last, gtid, gsz); break;
        case PH_GA: ph_ga_naive(p, gtid, gsz); break;
        case PH_NA: ph_na_naive(p, l, gtid, gsz); break;
        case PH_CTXATTN: ph_ctxattn_naive(p, gtid, gsz); break;
        case PH_FINAL: ph_final(p, l, nact, gtid, gsz); break;
        case PH_OUTPROJ: ph_outproj(p, l, xs, cs, nact, gtid, gsz); break;
        case PH_MODNORM2: ph_modnorm(p, l, p.out, p.CX, p.norm_ffn + l * D, 3 * D, 4 * D, nact, (l & 1) != 0, gtid, gsz); break;
        case PH_FFN_UP: ph_ffn_up(p, nact, gtid, gsz); break;
        case PH_FFN_DOWN: ph_ffn_down(p, l, nact, gtid, gsz); break;
        case PH_MOE_COUNT: ph_moe_count(p, gtid, gsz); break;
        case PH_MOE_ASSIGN: ph_moe_assign(p, gtid, gsz); break;
        case PH_MOE_UP: ph_moe_up(p, arg, gtid, gsz); break;
        case PH_MOE_DOWN: ph_moe_down(p, l, arg, gtid, gsz); break;
    }
}

struct WsMap { size_t off; size_t take(size_t bytes) { const size_t o = off; off = (off + bytes + 255) & ~(size_t)255; return o; } };
constexpr size_t CTL_BYTES = 1u << 20;
static void build_prm(Prm& p, void* const* d_in, void* d_out, void* d_ws) {
    const float** f = (const float**)&p;
    for (int i = 0; i < 34; ++i) f[i] = (const float*)d_in[i];
    p.out = (float*)d_out;
    unsigned char* ws = (unsigned char*)d_ws; WsMap w{0};
    p.ctl = (int*)(ws + w.take(CTL_BYTES));
    p.MOD = (float*)(ws + w.take((size_t)NL * 9 * 6 * D * 4));
    p.FHA = (float*)(ws + w.take((size_t)3 * S * 64 * 4)); p.FHB = (float*)(ws + w.take((size_t)3 * S * 64 * 4));
    p.FT = (bf16*)(ws + w.take((size_t)NL * DHY * 2 * S * 2)); p.FTC = (bf16*)(ws + w.take((size_t)DHY * 2 * LC * 2));
    p.WinT = (bf16*)(ws + w.take((size_t)NL * NP * D * 2)); p.WoutT = (bf16*)(ws + w.take((size_t)NL * D * D * 2));
    p.WguT = (bf16*)(ws + w.take((size_t)2 * DFF * D * 2)); p.WdT = (bf16*)(ws + w.take((size_t)D * DFF * 2));
    p.WguTe = (bf16*)(ws + w.take((size_t)NE * 2 * DFE * D * 2)); p.WdTe = (bf16*)(ws + w.take((size_t)NE * D * DFE * 2));
    p.CX = (float*)(ws + w.take((size_t)MC * D * 4));
    p.TOPI = (int*)(ws + w.take((size_t)MX * 2 * 4)); p.TOPW = (float*)(ws + w.take((size_t)MX * 2 * 4)); p.LIST = (int*)(ws + w.take((size_t)2 * MPAD * 4));
    p.HX = (bf16*)(ws + w.take((size_t)M * D * 2));
    const size_t rbase = w.off;
    p.P = (bf16*)(ws + w.take((size_t)M * NP * 2));
    p.VT = (bf16*)(ws + w.take((size_t)DHY * NB * S * 2)); p.VTC = (bf16*)(ws + w.take((size_t)DHY * NB * LC * 2));
    p.YC = (float*)(ws + w.take((size_t)DHY * NB * S * 4)); p.YCC = (float*)(ws + w.take((size_t)DHY * NB * LC * 4));
    p.HID = (bf16*)(ws + rbase);
}
static size_t ws_needed() {
    const size_t hid = (size_t)M * DFF * 2 > (size_t)MPAD * DFE * 2 ? (size_t)M * DFF * 2 : (size_t)MPAD * DFE * 2;
    Prm p; unsigned char* base = (unsigned char*)0x1000; void* din[34] = {}; build_prm(p, din, nullptr, base);
    const size_t endR = (size_t)((unsigned char*)p.YCC - base) + (size_t)DHY * NB * LC * 4, endH = (size_t)((unsigned char*)p.HID - base) + hid;
    return endR > endH ? endR : endH;
}

#ifndef CPU_EMU
template <int PH> __global__ void __launch_bounds__(256) k_phase(Prm p, int l, int arg) {
    run_phase(p, PH, l, arg, (long)blockIdx.x * blockDim.x + threadIdx.x, (long)gridDim.x * blockDim.x);
}
#define RUN(ph, l, arg) hipLaunchKernelGGL(k_phase<ph>, dim3(grid), dim3(256), 0, stream, p, (int)(l), (int)(arg))
#else
#define RUN(ph, l, arg) run_phase(p, (ph), (l), (arg), 0, 1)
#endif

#ifndef CPU_EMU
extern "C" void kernel_launch(void* const* d_in, const int* in_sizes, int n_in, void* d_out, int out_size, void* d_ws, size_t ws_size, hipStream_t stream) {
    if (n_in != 34 || out_size != MX * D || ws_size < ws_needed()) { fprintf(stderr, "kernel_launch: unexpected shapes (n_in %d out %d ws %zu need %zu)\n", n_in, out_size, ws_size, ws_needed()); return; }
    (void)in_sizes;
    (void)hipMemsetAsync(d_ws, 0, CTL_BYTES, stream);
    const int grid = 256 * 16;
#else
static void forward_emu(void* const* d_in, void* d_out, void* d_ws) {
    memset(d_ws, 0, CTL_BYTES);
#endif
    Prm p; __builtin_memset((void*)&p, 0, sizeof(p)); build_prm(p, d_in, d_out, d_ws);
    RUN(PH_WCONV, 0, 0); RUN(PH_MOD, 0, 0); RUN(PH_F1, 0, 0); RUN(PH_F2A, 0, 0); RUN(PH_F2B, 0, 0); RUN(PH_F3, 0, 0);
    for (int l = 0; l < NL; ++l) {
        const bool last = l == NL - 1;
        RUN(PH_MODNORM1, l, 0); RUN(PH_INPROJ, l, 0); RUN(PH_PREP_HY, l, 0); RUN(PH_PREP_QK, l, 0);
        RUN(PH_HYENA, l, 0); RUN(PH_GA, l, 0); RUN(PH_NA, l, 0); if (!last) RUN(PH_CTXATTN, l, 0);
        RUN(PH_FINAL, l, 0); RUN(PH_OUTPROJ, l, 0); RUN(PH_MODNORM2, l, 0);
        if ((l & 1) == 0) { RUN(PH_FFN_UP, l, 0); RUN(PH_FFN_DOWN, l, 0); }
        else { RUN(PH_MOE_COUNT, l, 0); RUN(PH_MOE_ASSIGN, l, 0); for (int c = 0; c < 2; ++c) { RUN(PH_MOE_UP, l, c); RUN(PH_MOE_DOWN, l, c); } }
    }
}
```

```cpp
#ifdef CPU_EMU
#include <cmath>
#include <cstdio>
#include <cstdlib>
#include <cstring>
#include <cstdint>
#define __device__
#define __global__
#define __host__
#define __forceinline__ inline
static inline int atomicAdd(int* p, int v) { int o = *p; *p += v; return o; }
#else
#include <hip/hip_runtime.h>
#include <cstdio>
#include <cstdint>
#endif

#ifdef CFG_SMALL
constexpr int D = 512, NB = 2, S = 1024, LC = 64, DFF = 256, DFE = 256;
#else
constexpr int D = 1024, NB = 8, S = 4096, LC = 256, DFF = 2816, DFE = 3584;
#endif
constexpr int NL = 2;
constexpr int DHY = 3 * D / 8, DNA = 3 * D / 8, DGA = D - DHY - DNA, NNA = DNA / 64, NGA = DGA / 64, HD = 64;
constexpr int GW = 64, ROWS = S / GW, KH = 8, KWIN = 16;
constexpr int MX = NB * S, MC = NB * LC, M = MX + MC;
constexpr int NE = 8;
constexpr int NP = 3 * D;
constexpr int PC_HY = 0, PC_NAQ = 3 * DHY, PC_NAK = PC_NAQ + DNA, PC_NAV = PC_NAK + DNA, PC_GAQ = 3 * (DHY + DNA), PC_GAK = PC_GAQ + DGA, PC_GAV = PC_GAK + DGA;
constexpr int MPAD = ((MX + NE * 255 + 255) / 256) * 256;
constexpr float EPS = 1e-6f;
constexpr float LOG2E = 1.4426950408889634f;
constexpr float QSCALE = 0.125f * LOG2E;

typedef unsigned short bf16;
__host__ __device__ __forceinline__ unsigned f2bf_u(float f) { unsigned u; __builtin_memcpy(&u, &f, 4); return (u + 0x7fffu + ((u >> 16) & 1u)) >> 16; }
__host__ __device__ __forceinline__ bf16 f2bf(float f) { return (bf16)f2bf_u(f); }
__host__ __device__ __forceinline__ float bf2f(bf16 h) { unsigned u = ((unsigned)h) << 16; float f; __builtin_memcpy(&f, &u, 4); return f; }
__host__ __device__ __forceinline__ float silu_f(float v) { return v / (1.0f + expf(-v)); }

struct Prm {
    const float *x, *c, *ctx, *c_ctx, *w_mod, *b_mod, *norm_mix, *norm_ffn, *w_in, *hy_conv_w, *hy_conv_b, *hy_w1, *hy_b1, *hy_freq, *hy_w2, *hy_b2, *hy_w3, *hy_skip;
    const float *na_q_norm, *na_k_norm, *na_rpb, *ga_q_norm, *ga_k_norm, *out_norm_hy, *out_norm_na, *out_norm_ga, *w_out;
    const float *ffn_w_gate, *ffn_w_up, *ffn_w_down, *moe_router, *moe_w_gate, *moe_w_up, *moe_w_down;
    float* out;
    int* ctl;
    float* MOD;
    float *FHA, *FHB;
    bf16* FT;
    bf16* FTC;
    bf16 *WinT, *WoutT;
    bf16 *WguT, *WdT;
    bf16 *WguTe, *WdTe;
    float* CX;
    int* TOPI; float* TOPW; int* LIST;
    bf16* HX;
    bf16* P;
    bf16 *VT, *VTC;
    float *YC, *YCC;
    bf16* HID;
};

__device__ __forceinline__ void conv_T(const float* W, int K, int N, bf16* dst, long gtid, long gsz) {
    for (long i = gtid; i < (long)N * K; i += gsz) { const int n = (int)(i / K), k = (int)(i % K); dst[i] = f2bf(W[(size_t)k * N + n]); }
}
__device__ __forceinline__ void conv_gu(const float* Wg, const float* Wu, int K, int F, bf16* dst, long gtid, long gsz) {
    for (long i = gtid; i < (long)2 * F * K; i += gsz) {
        const int n = (int)(i / K), k = (int)(i % K), p = n / 256, j = n % 256;
        const float* src = j < 128 ? Wg : Wu; const int col = 128 * p + (j & 127);
        dst[i] = f2bf(src[(size_t)k * F + col]);
    }
}
__device__ __forceinline__ void ph_wconv(const Prm& p, long gtid, long gsz) {
    for (int l = 0; l < NL; ++l) {
        conv_T(p.w_in + (size_t)l * D * NP, D, NP, p.WinT + (size_t)l * NP * D, gtid, gsz);
        conv_T(p.w_out + (size_t)l * D * D, D, D, p.WoutT + (size_t)l * D * D, gtid, gsz);
    }
    conv_gu(p.ffn_w_gate, p.ffn_w_up, D, DFF, p.WguT, gtid, gsz);
    conv_T(p.ffn_w_down, DFF, D, p.WdT, gtid, gsz);
    for (int e = 0; e < NE; ++e) {
        conv_gu(p.moe_w_gate + (size_t)e * D * DFE, p.moe_w_up + (size_t)e * D * DFE, D, DFE, p.WguTe + (size_t)e * 2 * DFE * D, gtid, gsz);
        conv_T(p.moe_w_down + (size_t)e * DFE * D, DFE, D, p.WdTe + (size_t)e * D * DFE, gtid, gsz);
    }
}
__device__ __forceinline__ void ph_mod(const Prm& p, long gtid, long gsz) {
    for (long i = gtid; i < (long)NL * 9 * 6 * D; i += gsz) {
        const int n = (int)(i % (6 * D)), r = (int)((i / (6 * D)) % 9), l = (int)(i / (6 * D * 9));
        const float* cv = r < 8 ? p.c + (size_t)(r % NB) * D : p.c_ctx;
        const float* w = p.w_mod + (size_t)l * D * 6 * D;
        float acc = p.b_mod[(size_t)l * 6 * D + n];
        for (int k = 0; k < D; ++k) acc += silu_f(cv[k]) * w[(size_t)k * 6 * D + n];
        p.MOD[i] = acc;
    }
}
__device__ __forceinline__ int fset_len(int s) { return s < 2 ? S : LC; }
__device__ __forceinline__ int fset_layer(int s) { return s == 1 ? 1 : 0; }
__device__ __forceinline__ void ph_filt1(const Prm& p, long gtid, long gsz) {
    for (long i = gtid; i < (long)3 * S * 64; i += gsz) {
        const int u = (int)(i % 64), t = (int)((i / 64) % S), s = (int)(i / (64 * S));
        const int Len = fset_len(s), l = fset_layer(s);
        if (t >= Len) continue;
        const float* w1 = p.hy_w1 + (size_t)l * 33 * 64;
        const float tn = (float)t / (float)(Len - 1);
        const float ang = 6.283185307179586f * (float)t / (float)Len;
        float pre = p.hy_b1[l * 64 + u] + tn * w1[u];
        for (int j = 0; j < 16; ++j) {
            const float fr = 1e-4f + (float)j * ((15.0f - 1e-4f) / 15.0f);
            pre += cosf(fr * ang) * w1[(1 + j) * 64 + u] - sinf(fr * ang) * w1[(17 + j) * 64 + u];
        }
        p.FHA[i] = sinf(p.hy_freq[l * 64 + u] * pre);
    }
}
__device__ __forceinline__ void ph_filt2(const Prm& p, int inner, const float* src, float* dst, long gtid, long gsz) {
    for (long i = gtid; i < (long)3 * S * 64; i += gsz) {
        const int u = (int)(i % 64), t = (int)((i / 64) % S), s = (int)(i / (64 * S));
        const int Len = fset_len(s), l = fset_layer(s);
        if (t >= Len) continue;
        const float* w2 = p.hy_w2 + ((size_t)l * 2 + inner) * 64 * 64;
        const float* h = src + (i - u);
        float pre = p.hy_b2[(l * 2 + inner) * 64 + u];
        for (int k = 0; k < 64; ++k) pre += h[k] * w2[k * 64 + u];
        dst[i] = sinf(p.hy_freq[l * 64 + u] * pre);
    }
}
__device__ __forceinline__ void ph_filt3(const Prm& p, const float* src, long gtid, long gsz) {
    for (long i = gtid; i < (long)3 * S * 2 * DHY; i += gsz) {
        const int n = (int)(i % (2 * DHY)), t = (int)((i / (2 * DHY)) % S), s = (int)(i / ((long)2 * DHY * S));
        const int Len = fset_len(s), l = fset_layer(s);
        if (t >= Len) continue;
        const float* w3 = p.hy_w3 + (size_t)l * 64 * 2 * DHY;
        const float* h = src + ((size_t)s * S + t) * 64;
        float acc = 0.f;
        for (int k = 0; k < 64; ++k) acc += h[k] * w3[(size_t)k * 2 * DHY + n];
        const int cch = n % DHY;
        const float d0 = logf(1e-2f) / 1.5f, d1 = logf(1e-2f) / 0.3f;
        const float delta = fabsf(d0 + (float)cch * ((d1 - d0) / (float)(DHY - 1)));
        const float tn = (float)t / (float)(Len - 1);
        const float val = acc * expf(-tn * delta);
        bf16* ft = (s < 2 ? p.FT + (size_t)s * DHY * 2 * S : p.FTC) + (size_t)cch * 2 * Len;
        if (n < DHY) ft[Len + t] = f2bf(val);
        else if (t > 0) ft[Len - t] = f2bf(val);
        else ft[0] = 0;
    }
}

__device__ __forceinline__ int row_modrow(int row) { return row < MX ? row / S : 8; }
__device__ __forceinline__ int row_batch(int row) { return row < MX ? row / S : (row - MX) / LC; }

__device__ __forceinline__ void ph_modnorm(const Prm& p, int l, const float* xs, const float* cs, const float* gain, int off_shift, int off_scale, int nrows, bool router, long gtid, long gsz) {
    for (long row = gtid; row < nrows; row += gsz) {
        const float* src = row < MX ? xs + (size_t)row * D : cs + (size_t)(row - MX) * D;
        const float* mod = p.MOD + ((size_t)l * 9 + row_modrow((int)row)) * 6 * D;
        float ss = 0.f;
        for (int k = 0; k < D; ++k) ss += src[k] * src[k];
        const float rstd = 1.0f / sqrtf(ss / (float)D + EPS);
        float lg[NE];
#pragma unroll
        for (int e = 0; e < NE; ++e) lg[e] = 0.f;
        for (int k = 0; k < D; ++k) {
            const float h = src[k] * rstd * gain[k] * (1.0f + mod[off_scale + k]) + mod[off_shift + k];
            p.HX[(size_t)row * D + k] = f2bf(h);
            if (router) {
#pragma unroll
                for (int e = 0; e < NE; ++e) lg[e] += h * p.moe_router[(size_t)k * NE + e]; }
        }
        if (router && row < MX) {
            float b1 = -INFINITY, b2 = -INFINITY; int i1 = 0, i2 = 0;
#pragma unroll
            for (int e = 0; e < NE; ++e) { const float v = lg[e]; if (v > b1) { b2 = b1; i2 = i1; b1 = v; i1 = e; } else if (v > b2) { b2 = v; i2 = e; } }
            const float w1 = 1.0f / (1.0f + expf(b2 - b1));
            p.TOPI[row * 2] = i1; p.TOPI[row * 2 + 1] = i2; p.TOPW[row * 2] = w1; p.TOPW[row * 2 + 1] = 1.0f - w1;
        }
    }
}
struct U4 { unsigned x, y, z, w; };
__device__ __forceinline__ float dot_bf(const bf16* a, const bf16* b, int K) {
    float acc = 0.f;
    for (int k = 0; k < K; k += 8) {
        U4 va, vb; __builtin_memcpy(&va, a + k, 16); __builtin_memcpy(&vb, b + k, 16);
        const unsigned ua[4] = {va.x, va.y, va.z, va.w}, ub[4] = {vb.x, vb.y, vb.z, vb.w};
#pragma unroll
        for (int j = 0; j < 4; ++j) acc += bf2f((bf16)(ua[j] & 0xffffu)) * bf2f((bf16)(ub[j] & 0xffffu)) + bf2f((bf16)(ua[j] >> 16)) * bf2f((bf16)(ub[j] >> 16));
    }
    return acc;
}

__device__ __forceinline__ void ph_inproj(const Prm& p, int l, long gtid, long gsz) {
    const bf16* Bt = p.WinT + (size_t)l * NP * D;
    for (long i = gtid; i < (long)M * NP; i += gsz) { const int m = (int)(i / NP), n = (int)(i % NP); p.P[i] = f2bf(dot_bf(p.HX + (size_t)m * D, Bt + (size_t)n * D, D)); }
}
__device__ __forceinline__ float sconv(const Prm& p, int l, int row, int col) {
    int t, Len; if (row < MX) { t = row % S; Len = S; } else { t = (row - MX) % LC; Len = LC; }
    const float* w = p.hy_conv_w + (size_t)l * 3 * 3 * DHY;
    float y = p.hy_conv_b[(size_t)l * 3 * DHY + col] + w[3 * DHY + col] * bf2f(p.P[(size_t)row * NP + col]);
    if (t > 0) y += w[col] * bf2f(p.P[(size_t)(row - 1) * NP + col]);
    if (t < Len - 1) y += w[2 * 3 * DHY + col] * bf2f(p.P[(size_t)(row + 1) * NP + col]);
    return y;
}
__device__ __forceinline__ void ph_prep_hy(const Prm& p, int l, long gtid, long gsz) {
    for (long i = gtid; i < (long)M * DHY; i += gsz) {
        const int row = (int)(i / DHY), c = (int)(i % DHY);
        const float v = sconv(p, l, row, 2 * DHY + c) * sconv(p, l, row, DHY + c);
        if (row < MX) p.VT[((size_t)c * NB + row / S) * S + row % S] = f2bf(v);
        else { const int rr = row - MX; p.VTC[((size_t)c * NB + rr / LC) * LC + rr % LC] = f2bf(v); }
    }
}
__device__ __forceinline__ void ph_prep_qk(const Prm& p, int l, long gtid, long gsz) {
    constexpr int NS = 2 * NNA + 2 * NGA;
    for (long i = gtid; i < (long)M * NS; i += gsz) {
        const int row = (int)(i / NS), hs = (int)(i % NS);
        int col; const float* g; bool isq, rope;
        if (hs < NNA) { col = PC_NAQ + 64 * hs; g = p.na_q_norm + l * 64; isq = true; rope = false; }
        else if (hs < 2 * NNA) { col = PC_NAK + 64 * (hs - NNA); g = p.na_k_norm + l * 64; isq = false; rope = false; }
        else if (hs < 2 * NNA + NGA) { col = PC_GAQ + 64 * (hs - 2 * NNA); g = p.ga_q_norm + l * 64; isq = true; rope = row < MX; }
        else { col = PC_GAK + 64 * (hs - 2 * NNA - NGA); g = p.ga_k_norm + l * 64; isq = false; rope = row < MX; }
        bf16* v = p.P + (size_t)row * NP + col;
        float ss = 0.f;
        for (int d = 0; d < 64; ++d) { const float a = bf2f(v[d]); ss += a * a; }
        const float rstd = 1.0f / sqrtf(ss / 64.0f + EPS), sc = isq ? QSCALE : 1.0f;
        if (!rope) { for (int d = 0; d < 64; ++d) v[d] = f2bf(bf2f(v[d]) * rstd * g[d] * sc); }
        else {
            const int t = row % S; const float pr = (float)(t / GW), pc = (float)(t % GW);
            for (int hf = 0; hf < 2; ++hf) {
                const float pos = hf == 0 ? pr : pc;
                for (int j = 0; j < 16; ++j) {
                    const float inv = powf(10000.0f, -(float)j / 16.0f), ang = pos * inv, cs = cosf(ang), sn = sinf(ang);
                    const int d1 = 32 * hf + j, d2 = d1 + 16;
                    const float a = bf2f(v[d1]) * rstd * g[d1], b = bf2f(v[d2]) * rstd * g[d2];
                    v[d1] = f2bf((a * cs - b * sn) * sc); v[d2] = f2bf((a * sn + b * cs) * sc);
                }
            }
        }
    }
}
__device__ __forceinline__ void ph_hyena_naive(const Prm& p, int l, bool with_ctx, long gtid, long gsz) {
    const bf16* FTl = p.FT + (size_t)l * DHY * 2 * S;
    for (long i = gtid; i < (long)DHY * NB * S; i += gsz) {
        const int t = (int)(i % S), cb = (int)(i / S), c = cb / NB;
        const bf16* ft = FTl + (size_t)c * 2 * S + S + t; const bf16* v = p.VT + (size_t)cb * S;
        float acc = 0.f;
        for (int s = 0; s < S; ++s) acc += bf2f(ft[-s]) * bf2f(v[s]);
        p.YC[i] = acc;
    }
    if (with_ctx) for (long i = gtid; i < (long)DHY * NB * LC; i += gsz) {
        const int t = (int)(i % LC), cb = (int)(i / LC), c = cb / NB;
        const bf16* ft = p.FTC + (size_t)c * 2 * LC + LC + t; const bf16* v = p.VTC + (size_t)cb * LC;
        float acc = 0.f;
        for (int s = 0; s < LC; ++s) acc += bf2f(ft[-s]) * bf2f(v[s]);
        p.YCC[i] = acc;
    }
}
struct OnlineSm { float m, l, o[64]; };
__device__ __forceinline__ void osm_init(OnlineSm& st) { st.m = -INFINITY; st.l = 0.f;
_Pragma("unroll") for (int d = 0; d < 64; ++d) st.o[d] = 0.f; }
__device__ __forceinline__ void osm_step(OnlineSm& st, const float* q, const bf16* k, const bf16* v, float bias) {
    float sc = bias;
_Pragma("unroll") for (int d = 0; d < 64; ++d) sc += q[d] * bf2f(k[d]);
    if (sc > st.m) { const float a = exp2f(st.m - sc); st.l *= a;
_Pragma("unroll") for (int d = 0; d < 64; ++d) st.o[d] *= a;
 st.m = sc; }
    const float pe = exp2f(sc - st.m); st.l += pe;
_Pragma("unroll") for (int d = 0; d < 64; ++d) st.o[d] += pe * bf2f(v[d]);
}
__device__ __forceinline__ void ph_ga_naive(const Prm& p, long gtid, long gsz) {
    for (long i = gtid; i < (long)NB * NGA * S; i += gsz) {
        const int t = (int)(i % S), h = (int)((i / S) % NGA), b = (int)(i / ((long)S * NGA));
        bf16* qp = p.P + ((size_t)b * S + t) * NP + PC_GAQ + 64 * h;
        float q[64];
_Pragma("unroll") for (int d = 0; d < 64; ++d) q[d] = bf2f(qp[d]);
        OnlineSm st; osm_init(st);
        for (int s = 0; s < S; ++s) { const bf16* kr = p.P + ((size_t)b * S + s) * NP; osm_step(st, q, kr + PC_GAK + 64 * h, kr + PC_GAV + 64 * h, 0.f); }
        for (int s = 0; s < LC; ++s) { const bf16* kr = p.P + ((size_t)MX + b * LC + s) * NP; osm_step(st, q, kr + PC_GAK + 64 * h, kr + PC_GAV + 64 * h, 0.f); }
        const float il = 1.0f / st.l;
_Pragma("unroll") for (int d = 0; d < 64; ++d) qp[d] = f2bf(st.o[d] * il);
    }
}
__device__ __forceinline__ void ph_na_naive(const Prm& p, int l, long gtid, long gsz) {
    for (long i = gtid; i < (long)NB * NNA * S; i += gsz) {
        const int t = (int)(i % S), h = (int)((i / S) % NNA), b = (int)(i / ((long)S * NNA));
        const int r = t / GW, qc = t % GW;
        int r0 = r - KH / 2; r0 = r0 < 0 ? 0 : (r0 > ROWS - KH ? ROWS - KH : r0);
        int c0 = qc - KWIN / 2; c0 = c0 < 0 ? 0 : (c0 > GW - KWIN ? GW - KWIN : c0);
        bf16* qp = p.P + ((size_t)b * S + t) * NP + PC_NAQ + 64 * h;
        float q[64];
_Pragma("unroll") for (int d = 0; d < 64; ++d) q[d] = bf2f(qp[d]);
        const float* rpb = p.na_rpb + ((size_t)l * NNA + h) * (2 * KH - 1) * (2 * KWIN - 1);
        OnlineSm st; osm_init(st);
        for (int kr = 0; kr < KH; ++kr) for (int kc = c0; kc < c0 + KWIN; ++kc) {
            const int krow = r0 + kr, dr = krow - r + (KH - 1); int dc = kc - qc; dc = dc < -(KWIN - 1) ? -(KWIN - 1) : (dc > KWIN - 1 ? KWIN - 1 : dc); dc += KWIN - 1;
            const bf16* kp = p.P + ((size_t)b * S + krow * GW + kc) * NP;
            osm_step(st, q, kp + PC_NAK + 64 * h, kp + PC_NAV + 64 * h, rpb[dr * (2 * KWIN - 1) + dc] * LOG2E);
        }
        for (int s = 0; s < LC; ++s) { const bf16* kp = p.P + ((size_t)MX + b * LC + s) * NP; osm_step(st, q, kp + PC_NAK + 64 * h, kp + PC_NAV + 64 * h, 0.f); }
        const float il = 1.0f / st.l;
_Pragma("unroll") for (int d = 0; d < 64; ++d) qp[d] = f2bf(st.o[d] * il);
    }
}
__device__ __forceinline__ void ph_ctxattn_naive(const Prm& p, long gtid, long gsz) {
    for (long i = gtid; i < (long)NB * (NNA + NGA) * LC; i += gsz) {
        const int t = (int)(i % LC), hh = (int)((i / LC) % (NNA + NGA)), b = (int)(i / ((long)LC * (NNA + NGA)));
        const int qo = hh < NNA ? PC_NAQ + 64 * hh : PC_GAQ + 64 * (hh - NNA), ko = hh < NNA ? PC_NAK + 64 * hh : PC_GAK + 64 * (hh - NNA), vo = hh < NNA ? PC_NAV + 64 * hh : PC_GAV + 64 * (hh - NNA);
        bf16* qp = p.P + ((size_t)MX + b * LC + t) * NP + qo;
        float q[64];
_Pragma("unroll") for (int d = 0; d < 64; ++d) q[d] = bf2f(qp[d]);
        OnlineSm st; osm_init(st);
        for (int s = 0; s < LC; ++s) { const bf16* kp = p.P + ((size_t)MX + b * LC + s) * NP; osm_step(st, q, kp + ko, kp + vo, 0.f); }
        const float il = 1.0f / st.l;
_Pragma("unroll") for (int d = 0; d < 64; ++d) qp[d] = f2bf(st.o[d] * il);
    }
}
__device__ __forceinline__ void ph_final(const Prm& p, int l, int nrows, long gtid, long gsz) {
    for (long row = gtid; row < nrows; row += gsz) {
        const int r = (int)row; int b, t; const float* yc;
        if (r < MX) { b = r / S; t = r % S; } else { b = (r - MX) / LC; t = (r - MX) % LC; }
        float ss = 0.f;
        for (int pass = 0; pass < 2; ++pass) {
            const float rstd = pass ? 1.0f / sqrtf(ss / (float)DHY + EPS) : 0.f;
            for (int c = 0; c < DHY; ++c) {
                const float x0 = sconv(p, l, r, c), vp = sconv(p, l, r, 2 * DHY + c) * sconv(p, l, r, DHY + c);
                const float conv = r < MX ? p.YC[((size_t)c * NB + b) * S + t] : p.YCC[((size_t)c * NB + b) * LC + t];
                const float y = (conv + p.hy_skip[l * DHY + c] * vp) * x0;
                if (!pass) ss += y * y; else p.HX[(size_t)r * D + c] = f2bf(y * rstd * p.out_norm_hy[l * DHY + c]);
            }
        }
        { const bf16* o = p.P + (size_t)r * NP + PC_NAQ; float s2 = 0.f; for (int j = 0; j < DNA; ++j) { const float a = bf2f(o[j]); s2 += a * a; }
          const float rstd = 1.0f / sqrtf(s2 / (float)DNA + EPS); for (int j = 0; j < DNA; ++j) p.HX[(size_t)r * D + DHY + j] = f2bf(bf2f(o[j]) * rstd * p.out_norm_na[l * DNA + j]); }
        { const bf16* o = p.P + (size_t)r * NP + PC_GAQ; float s2 = 0.f; for (int j = 0; j < DGA; ++j) { const float a = bf2f(o[j]); s2 += a * a; }
          const float rstd = 1.0f / sqrtf(s2 / (float)DGA + EPS); for (int j = 0; j < DGA; ++j) p.HX[(size_t)r * D + DHY + DNA + j] = f2bf(bf2f(o[j]) * rstd * p.out_norm_ga[l * DGA + j]); }
        (void)yc;
    }
}
__device__ __forceinline__ void ph_outproj(const Prm& p, int l, const float* xs, const float* cs, int nrows, long gtid, long gsz) {
    const bf16* Bt = p.WoutT + (size_t)l * D * D;
    for (long i = gtid; i < (long)nrows * D; i += gsz) {
        const int m = (int)(i / D), n = (int)(i % D);
        const float acc = dot_bf(p.HX + (size_t)m * D, Bt + (size_t)n * D, D);
        const float gate = p.MOD[((size_t)l * 9 + row_modrow(m)) * 6 * D + 2 * D + n];
        if (m < MX) p.out[i] = xs[i] + gate * acc; else p.CX[i - (size_t)MX * D] = cs[i - (size_t)MX * D] + gate * acc;
    }
}
__device__ __forceinline__ void ph_ffn_up(const Prm& p, int nrows, long gtid, long gsz) {
    for (long i = gtid; i < (long)nrows * DFF; i += gsz) {
        const int m = (int)(i / DFF), j = (int)(i % DFF), n = 256 * (j / 128) + (j % 128);
        const float g = dot_bf(p.HX + (size_t)m * D, p.WguT + (size_t)n * D, D), u = dot_bf(p.HX + (size_t)m * D, p.WguT + (size_t)(n + 128) * D, D);
        p.HID[i] = f2bf(silu_f(g) * u);
    }
}
__device__ __forceinline__ void ph_ffn_down(const Prm& p, int l, int nrows, long gtid, long gsz) {
    for (long i = gtid; i < (long)nrows * D; i += gsz) {
        const int m = (int)(i / D), n = (int)(i % D);
        const float acc = dot_bf(p.HID + (size_t)m * DFF, p.WdT + (size_t)n * DFF, DFF);
        const float gate = p.MOD[((size_t)l * 9 + row_modrow(m)) * 6 * D + 5 * D + n];
        if (m < MX) p.out[i] += gate * acc; else p.CX[i - (size_t)MX * D] += gate * acc;
    }
}
__device__ __forceinline__ void ph_moe_count(const Prm& p, long gtid, long gsz) {
    for (long i = gtid; i < (long)2 * MPAD; i += gsz) p.LIST[i] = -1;
    for (long m = gtid; m < MX; m += gsz) { atomicAdd(p.ctl + p.TOPI[m * 2], 1); atomicAdd(p.ctl + 8 + p.TOPI[m * 2 + 1], 1); }
}
__device__ __forceinline__ int moe_off(const Prm& p, int pass, int e) {
    int o = 0;
#pragma unroll
    for (int k = 0; k < NE; ++k) if (k < e) o += (p.ctl[pass * 8 + k] + 255) / 256 * 256;
    return o;
}
__device__ __forceinline__ void ph_moe_assign(const Prm& p, long gtid, long gsz) {
    for (long m = gtid; m < MX; m += gsz) {
        for (int c = 0; c < 2; ++c) { const int e = p.TOPI[m * 2 + c]; const int slot = moe_off(p, c, e) + atomicAdd(p.ctl + 16 + c * 8 + e, 1); p.LIST[(size_t)c * MPAD + slot] = (int)m; }
    }
}
__device__ __forceinline__ int moe_slot_expert(const Prm& p, int pass, int slot) {
    int e = 0, o = 0;
#pragma unroll
    for (int k = 0; k < NE - 1; ++k) { o += (p.ctl[pass * 8 + k] + 255) / 256 * 256; if (slot >= o) e = k + 1; }
    return e;
}
__device__ __forceinline__ void ph_moe_up(const Prm& p, int pass, long gtid, long gsz) {
    const int tot = moe_off(p, pass, NE);
    for (long i = gtid; i < (long)tot * DFE; i += gsz) {
        const int slot = (int)(i / DFE), j = (int)(i % DFE), tok = p.LIST[(size_t)pass * MPAD + slot];
        if (tok < 0) continue;
        const int e = moe_slot_expert(p, pass, slot), n = 256 * (j / 128) + (j % 128);
        const bf16* W = p.WguTe + (size_t)e * 2 * DFE * D;
        const float g = dot_bf(p.HX + (size_t)tok * D, W + (size_t)n * D, D), u = dot_bf(p.HX + (size_t)tok * D, W + (size_t)(n + 128) * D, D);
        p.HID[i] = f2bf(silu_f(g) * u);
    }
}
__device__ __forceinline__ void ph_moe_down(const Prm& p, int l, int pass, long gtid, long gsz) {
    const int tot = moe_off(p, pass, NE);
    for (long i = gtid; i < (long)tot * D; i += gsz) {
        const int slot = (int)(i / D), n = (int)(i % D), tok = p.LIST[(size_t)pass * MPAD + slot];
        if (tok < 0) continue;
        const int e = moe_slot_expert(p, pass, slot);
        const float acc = dot_bf(p.HID + (size_t)slot * DFE, p.WdTe + ((size_t)e * D + n) * DFE, DFE);
        const float gate = p.MOD[((size_t)l * 9 + tok / S) * 6 * D + 5 * D + n];
        p.out[(size_t)tok * D + n] += gate * p.TOPW[tok * 2 + pass] * acc;
    }
}

enum { PH_WCONV, PH_MOD, PH_F1, PH_F2A, PH_F2B, PH_F3, PH_MODNORM1, PH_INPROJ, PH_PREP_HY, PH_PREP_QK, PH_HYENA, PH_GA, PH_NA, PH_CTXATTN, PH_FINAL, PH_OUTPROJ, PH_MODNORM2,
       PH_FFN_UP, PH_FFN_DOWN, PH_MOE_COUNT, PH_MOE_ASSIGN, PH_MOE_UP, PH_MOE_DOWN };
__device__ __forceinline__ void run_phase(const Prm& p, int ph, int l, int arg, long gtid, long gsz) {
    const bool first = l == 0, last = l == NL - 1;
    const float* xs = first ? p.x : p.out; const float* cs = first ? p.ctx : p.CX;
    const int nact = last ? MX : M;
    switch (ph) {
        case PH_WCONV: ph_wconv(p, gtid, gsz); break;
        case PH_MOD: ph_mod(p, gtid, gsz); break;
        case PH_F1: ph_filt1(p, gtid, gsz); break;
        case PH_F2A: ph_filt2(p, 0, p.FHA, p.FHB, gtid, gsz); break;
        case PH_F2B: ph_filt2(p, 1, p.FHB, p.FHA, gtid, gsz); break;
        case PH_F3: ph_filt3(p, p.FHA, gtid, gsz); break;
        case PH_MODNORM1: ph_modnorm(p, l, xs, cs, p.norm_mix + l * D, 0, D, M, false, gtid, gsz); break;
        case PH_INPROJ: ph_inproj(p, l, gtid, gsz); break;
        case PH_PREP_HY: ph_prep_hy(p, l, gtid, gsz); break;
        case PH_PREP_QK: ph_prep_qk(p, l, gtid, gsz); break;
        case PH_HYENA: ph_hyena_naive(p, l, !last, gtid, gsz); break;
        case PH_GA: ph_ga_naive(p, gtid, gsz); break;
        case PH_NA: ph_na_naive(p, l, gtid, gsz); break;
        case PH_CTXATTN: ph_ctxattn_naive(p, gtid, gsz); break;
        case PH_FINAL: ph_final(p, l, nact, gtid, gsz); break;
        case PH_OUTPROJ: ph_outproj(p, l, xs, cs, nact, gtid, gsz); break;
        case PH_MODNORM2: ph_modnorm(p, l, p.out, p.CX, p.norm_ffn + l * D, 3 * D, 4 * D, nact, (l & 1) != 0, gtid, gsz); break;
        case PH_FFN_UP: ph_ffn_up(p, nact, gtid, gsz); break;
        case PH_FFN_DOWN: ph_ffn_down(p, l, nact, gtid, gsz); break;
        case PH_MOE_COUNT: ph_moe_count(p, gtid, gsz); break;
        case PH_MOE_ASSIGN: ph_moe_assign(p, gtid, gsz); break;
        case PH_MOE_UP: ph_moe_up(p, arg, gtid, gsz); break;
        case PH_MOE_DOWN: ph_moe_down(p, l, arg, gtid, gsz); break;
    }
}

struct WsMap { size_t off; size_t take(size_t bytes) { const size_t o = off; off = (off + bytes + 255) & ~(size_t)255; return o; } };
constexpr size_t CTL_BYTES = 1u << 20;
static void build_prm(Prm& p, void* const* d_in, void* d_out, void* d_ws) {
    const float** f = (const float**)&p;
    for (int i = 0; i < 34; ++i) f[i] = (const float*)d_in[i];
    p.out = (float*)d_out;
    unsigned char* ws = (unsigned char*)d_ws; WsMap w{0};
    p.ctl = (int*)(ws + w.take(CTL_BYTES));
    p.MOD = (float*)(ws + w.take((size_t)NL * 9 * 6 * D * 4));
    p.FHA = (float*)(ws + w.take((size_t)3 * S * 64 * 4)); p.FHB = (float*)(ws + w.take((size_t)3 * S * 64 * 4));
    p.FT = (bf16*)(ws + w.take((size_t)NL * DHY * 2 * S * 2)); p.FTC = (bf16*)(ws + w.take((size_t)DHY * 2 * LC * 2));
    p.WinT = (bf16*)(ws + w.take((size_t)NL * NP * D * 2)); p.WoutT = (bf16*)(ws + w.take((size_t)NL * D * D * 2));
    p.WguT = (bf16*)(ws + w.take((size_t)2 * DFF * D * 2)); p.WdT = (bf16*)(ws + w.take((size_t)D * DFF * 2));
    p.WguTe = (bf16*)(ws + w.take((size_t)NE * 2 * DFE * D * 2)); p.WdTe = (bf16*)(ws + w.take((size_t)NE * D * DFE * 2));
    p.CX = (float*)(ws + w.take((size_t)MC * D * 4));
    p.TOPI = (int*)(ws + w.take((size_t)MX * 2 * 4)); p.TOPW = (float*)(ws + w.take((size_t)MX * 2 * 4)); p.LIST = (int*)(ws + w.take((size_t)2 * MPAD * 4));
    p.HX = (bf16*)(ws + w.take((size_t)M * D * 2));
    const size_t rbase = w.off;
    p.P = (bf16*)(ws + w.take((size_t)M * NP * 2));
    p.VT = (bf16*)(ws + w.take((size_t)DHY * NB * S * 2)); p.VTC = (bf16*)(ws + w.take((size_t)DHY * NB * LC * 2));
    p.YC = (float*)(ws + w.take((size_t)DHY * NB * S * 4)); p.YCC = (float*)(ws + w.take((size_t)DHY * NB * LC * 4));
    p.HID = (bf16*)(ws + rbase);
}
static size_t ws_needed() {
    const size_t hid = (size_t)M * DFF * 2 > (size_t)MPAD * DFE * 2 ? (size_t)M * DFF * 2 : (size_t)MPAD * DFE * 2;
    Prm p; unsigned char* base = (unsigned char*)0x1000; void* din[34] = {}; build_prm(p, din, nullptr, base);
    const size_t endR = (size_t)((unsigned char*)p.YCC - base) + (size_t)DHY * NB * LC * 4, endH = (size_t)((unsigned char*)p.HID - base) + hid;
    return endR > endH ? endR : endH;
}


#ifndef CPU_EMU
namespace pg8 {
#define PG8_LAS __attribute__((address_space(3)))
typedef unsigned short bf16_t;
typedef short bf16x8 __attribute__((ext_vector_type(8)));
typedef float f32x4 __attribute__((ext_vector_type(4)));
typedef unsigned u32x4 __attribute__((ext_vector_type(4)));
constexpr int BM = 256, BK = 64, HALF = 128, HTB = HALF * BK * 2  , STAGE_BYTES = 8 * HTB, NXCD = 8, WGM = 8;
__host__ __device__ __forceinline__ int lds_byte(int r, int c) { const int st = (r >> 4) * 2 + (c >> 5), rr = r & 15, cc = c & 31, ob = rr * 64 + cc * 2; return st * 1024 + (ob ^ (((ob >> 9) & 1) << 5)); }
__host__ __device__ __forceinline__ void stage_rc(int b, int& R, int& C) { const int st = b / 1024, sb = b % 1024, swz = sb ^ (((sb >> 9) & 1) << 5); R = (st >> 1) * 16 + swz / 64; C = (st & 1) * 32 + (swz % 64) / 2; }
__host__ __device__ __forceinline__ int perm32(int rho) { const int n = rho >> 4, i = rho & 15; return 8 * (i >> 2) + 4 * n + (i & 3); }
struct Unit { int pm, pn; };
struct Order {
    int nM, nN, nwg, G, c;
    const bf16_t* Bt; size_t bt_group_stride; int pend[8];
    const int* rows;
    __device__ void init(int nM_, int nN_, int G_, int c_, const bf16_t* Bt_) { nM = nM_; nN = nN_; nwg = nM * nN; G = G_; c = c_; Bt = Bt_; bt_group_stride = 0; rows = nullptr;
#pragma unroll
        for (int k = 0; k < 8; ++k) pend[k] = 0x7fffffff; }
    __device__ bool next(int i, Unit& u) const {
        const long L = (long)i * G + c; if (L >= nwg) return false;
        int wgid = (int)L; { const int q = nwg / NXCD, r = nwg % NXCD, xcd = wgid % NXCD, off = wgid / NXCD; wgid = (xcd < r ? xcd * (q + 1) : r * (q + 1) + (xcd - r) * q) + off; }
        const int nig = WGM * nN, gid = wgid / nig, fm = gid * WGM, gsz = (nM - fm) < WGM ? (nM - fm) : WGM;
        u.pm = fm + ((wgid % nig) % gsz); u.pn = (wgid % nig) / gsz; return true;
    }
    __device__ __forceinline__ int group(int pm) const { int e = 0;
#pragma unroll
        for (int k = 0; k < 7; ++k) e += (pm >= pend[k]) ? 1 : 0; return e; }
    __device__ __forceinline__ const bf16_t* bt(const Unit& u) const { return Bt + (size_t)group(u.pm) * bt_group_stride; }
    __device__ __forceinline__ int row(const Unit& u, int r) const { const int t = rows[(size_t)u.pm * BM + r]; return t < 0 ? 0 : t; }
};
__device__ __forceinline__ unsigned cvt_pk_bf16(float lo, float hi) { unsigned r; asm volatile("v_cvt_pk_bf16_f32 %0, %1, %2" : "=v"(r) : "v"(lo), "v"(hi)); return r; }

struct EpiBf16 {
    static constexpr bool PERM = true;
    bf16_t* O; int ldc;
    __device__ __forceinline__ void operator()(const f32x4 (&acc)[2][2][4][2], const Unit& u, int wr, int wc, int fr, int fq) const {
        const int row0 = u.pm * BM + wr * 64 + fr, col0 = u.pn * BM + wc * 32 + 8 * fq;
#pragma unroll
        for (int ai = 0; ai < 2; ++ai)
#pragma unroll
            for (int m = 0; m < 4; ++m) { bf16_t* rowp = O + (size_t)(row0 + ai * HALF + m * 16) * ldc + col0;
#pragma unroll
                for (int bj = 0; bj < 2; ++bj) { const f32x4 v0 = acc[ai][bj][m][0], v1 = acc[ai][bj][m][1];
                    u32x4 w; w.x = cvt_pk_bf16(v0[0], v0[1]); w.y = cvt_pk_bf16(v0[2], v0[3]); w.z = cvt_pk_bf16(v1[0], v1[1]); w.w = cvt_pk_bf16(v1[2], v1[3]);
                    *(u32x4*)(rowp + bj * HALF) = w; } }
    }
};
__device__ __forceinline__ float silu_fast(float v) { return v * __builtin_amdgcn_rcpf(1.0f + __builtin_amdgcn_exp2f(-1.4426950408889634f * v)); }
struct EpiSwiGLU {
    static constexpr bool PERM = true;
    bf16_t* H; int ldc;
    __device__ __forceinline__ void operator()(const f32x4 (&acc)[2][2][4][2], const Unit& u, int wr, int wc, int fr, int fq) const {
        const int row0 = u.pm * BM + wr * 64 + fr, col0 = u.pn * HALF + wc * 32 + 8 * fq;
#pragma unroll
        for (int ai = 0; ai < 2; ++ai)
#pragma unroll
            for (int m = 0; m < 4; ++m) { bf16_t* rowp = H + (size_t)(row0 + ai * HALF + m * 16) * ldc + col0;
                const f32x4 g0 = acc[ai][0][m][0], g1 = acc[ai][0][m][1], u0 = acc[ai][1][m][0], u1 = acc[ai][1][m][1];
                u32x4 w; w.x = cvt_pk_bf16(silu_fast(g0[0]) * u0[0], silu_fast(g0[1]) * u0[1]); w.y = cvt_pk_bf16(silu_fast(g0[2]) * u0[2], silu_fast(g0[3]) * u0[3]);
                w.z = cvt_pk_bf16(silu_fast(g1[0]) * u1[0], silu_fast(g1[1]) * u1[1]); w.w = cvt_pk_bf16(silu_fast(g1[2]) * u1[2], silu_fast(g1[3]) * u1[3]);
                *(u32x4*)rowp = w; }
    }
};
struct EpiResGate {
    static constexpr bool PERM = false;
    const float *xs, *cs; float *xd, *cd; const float* gate;
    __device__ __forceinline__ void operator()(const f32x4 (&acc)[2][2][4][2], const Unit& u, int wr, int wc, int fr, int fq) const {
        const bool lat = u.pm < MX / BM; const int prow = (lat ? u.pm : u.pm - MX / BM) * BM + wr * 64 + fr, col0 = u.pn * BM + wc * 32 + 4 * fq;
        const float* s = lat ? xs : cs; float* d = lat ? xd : cd; const float* g = gate + (size_t)(lat ? u.pm / (S / BM) : 8) * 6 * D + col0;
        f32x4 gv[2][2];
#pragma unroll
        for (int bj = 0; bj < 2; ++bj)
#pragma unroll
            for (int n = 0; n < 2; ++n) gv[bj][n] = *(const f32x4*)(g + bj * HALF + n * 16);
#pragma unroll
        for (int ai = 0; ai < 2; ++ai)
#pragma unroll
            for (int m = 0; m < 4; ++m) { const size_t off = (size_t)(prow + ai * HALF + m * 16) * D + col0;
#pragma unroll
                for (int bj = 0; bj < 2; ++bj)
#pragma unroll
                    for (int n = 0; n < 2; ++n) *(f32x4*)(d + off + bj * HALF + n * 16) = *(const f32x4*)(s + off + bj * HALF + n * 16) + gv[bj][n] * acc[ai][bj][m][n]; }
    }
};
struct EpiMoeDown {
    static constexpr bool PERM = false;
    const int* list; const float* topw; int pass; float* x; const float* gate;
    __device__ __forceinline__ void operator()(const f32x4 (&acc)[2][2][4][2], const Unit& u, int wr, int wc, int fr, int fq) const {
        const int slot0 = u.pm * BM + wr * 64 + fr, col0 = u.pn * BM + wc * 32 + 4 * fq;
#pragma unroll
        for (int ai = 0; ai < 2; ++ai)
#pragma unroll
            for (int m = 0; m < 4; ++m) { const int tok = list[slot0 + ai * HALF + m * 16];
                if (tok >= 0) { const float w = topw[tok * 2 + pass]; const float* g = gate + (size_t)(tok / S) * 6 * D + col0; float* xr = x + (size_t)tok * D + col0;
#pragma unroll
                    for (int bj = 0; bj < 2; ++bj)
#pragma unroll
                        for (int n = 0; n < 2; ++n) { const f32x4 gv = *(const f32x4*)(g + bj * HALF + n * 16); f32x4* xp = (f32x4*)(xr + bj * HALF + n * 16); *xp = *xp + gv * w * acc[ai][bj][m][n]; } } }
    }
};

template <class Epi, bool ALIGN_EPI, bool GATHER>
__device__ __forceinline__ void gemm_phase(PG8_LAS unsigned char* lds, const bf16_t* A, int K, const Order& S, const Epi& E) {
    int tid_ = threadIdx.x; asm volatile("" : "+v"(tid_));
    const int tid = tid_, wid = __builtin_amdgcn_readfirstlane(tid >> 6), lane = tid & 63, wr = wid >> 2, wc = wid & 3, fr = lane & 15, fq = lane >> 4;
    const int nt = K / BK;
    unsigned voffB[2]; int RA[2], CA[2];
#pragma unroll
    for (int i = 0; i < 2; ++i) { int R, C; stage_rc(tid * 16 + i * 8192, R, C); const int Rb = Epi::PERM ? ((R & ~31) + perm32(R & 31)) : R; RA[i] = R; CA[i] = C; voffB[i] = (unsigned)(Rb * K + C) * 2u; }
    const size_t kstep = (size_t)(BK * 2);
    const size_t hstep = (size_t)HALF * K * 2;
    const size_t tstep = 2 * hstep;
    const unsigned ldsw = (unsigned)wid * 1024u;
    const int aoff = lds_byte(wr * 64 + fr, fq * 8), boff = lds_byte(wc * 32 + fr, fq * 8);
#define PG8_SA(b, h) (((b) * 2 + (h)) * HTB)
#define PG8_SB(b, h) ((4 + (b) * 2 + (h)) * HTB)
#define PG8_STAGE_B(bufoff, gbase) do { _Pragma("unroll") for (int _i = 0; _i < 2; ++_i) \
        __builtin_amdgcn_global_load_lds((const unsigned*)((const char*)(gbase) + voffB[_i]), (PG8_LAS unsigned*)(lds + (bufoff) + ldsw + _i * 8192), 16, 0, 0); } while (0)
#define PG8_STAGE_A(bufoff, gbase, o0, o1) do { \
        __builtin_amdgcn_global_load_lds((const unsigned*)((const char*)(gbase) + (o0)), (PG8_LAS unsigned*)(lds + (bufoff) + ldsw), 16, 0, 0); \
        __builtin_amdgcn_global_load_lds((const unsigned*)((const char*)(gbase) + (o1)), (PG8_LAS unsigned*)(lds + (bufoff) + ldsw + 8192), 16, 0, 0); } while (0)
#define PG8_LDA(dst, b, h) do { _Pragma("unroll") for (int m = 0; m < 4; ++m) _Pragma("unroll") for (int k = 0; k < 2; ++k) dst[m][k] = *(const PG8_LAS bf16x8*)(lds + PG8_SA(b, h) + aoff + m * 2048 + k * 1024); } while (0)
#define PG8_LDB(dst, b, h) do { _Pragma("unroll") for (int n = 0; n < 2; ++n) _Pragma("unroll") for (int k = 0; k < 2; ++k) dst[n][k] = *(const PG8_LAS bf16x8*)(lds + PG8_SB(b, h) + boff + n * 2048 + k * 1024); } while (0)
#define PG8_MMA(ai, bj, At, Bt) do { __builtin_amdgcn_s_setprio(1); _Pragma("unroll") for (int m = 0; m < 4; ++m) _Pragma("unroll") for (int n = 0; n < 2; ++n) _Pragma("unroll") for (int k = 0; k < 2; ++k) \
        acc[ai][bj][m][n] = __builtin_amdgcn_mfma_f32_16x16x32_bf16(Bt[n][k], At[m][k], acc[ai][bj][m][n], 0, 0, 0); __builtin_amdgcn_s_setprio(0); } while (0)
#define PG8_WAIT_V(n) asm volatile("s_waitcnt vmcnt(" #n ")" ::: "memory")
#define PG8_WAIT_L(n) asm volatile("s_waitcnt lgkmcnt(" #n ")" ::: "memory")
#define PG8_BAR __builtin_amdgcn_s_barrier()
#define PG8_SCHED __builtin_amdgcn_sched_barrier(0)
    Unit cur, nxt, nx2; int ui = 0;
    if (!S.next(0, cur)) return;
    f32x4 acc[2][2][4][2];
#pragma unroll
    for (int a = 0; a < 2; ++a)
#pragma unroll
        for (int b = 0; b < 2; ++b)
#pragma unroll
            for (int m = 0; m < 4; ++m)
#pragma unroll
                for (int n = 0; n < 2; ++n) acc[a][b][m][n] = (f32x4){0.f, 0.f, 0.f, 0.f};
    bf16x8 At[4][2], B0[2][2], B1[2][2];
    unsigned oc00, oc01, oc10, oc11, on00, on01, on10, on11, o200 = 0, o201 = 0, o210 = 0, o211 = 0;
    const char* cA; const char* cB = (const char*)S.bt(cur) + (size_t)cur.pn * tstep;
    bool has_next = S.next(1, nxt), has_nx2 = false;
    if constexpr (GATHER) {
        cA = (const char*)A;
        oc00 = (unsigned)(S.row(cur, RA[0]) * K + CA[0]) * 2u; oc01 = (unsigned)(S.row(cur, RA[1]) * K + CA[1]) * 2u;
        oc10 = (unsigned)(S.row(cur, HALF + RA[0]) * K + CA[0]) * 2u; oc11 = (unsigned)(S.row(cur, HALF + RA[1]) * K + CA[1]) * 2u;
        if (has_next) { on00 = (unsigned)(S.row(nxt, RA[0]) * K + CA[0]) * 2u; on01 = (unsigned)(S.row(nxt, RA[1]) * K + CA[1]) * 2u;
                        on10 = (unsigned)(S.row(nxt, HALF + RA[0]) * K + CA[0]) * 2u; on11 = (unsigned)(S.row(nxt, HALF + RA[1]) * K + CA[1]) * 2u; }
        else { on00 = oc00; on01 = oc01; on10 = oc10; on11 = oc11; }
    } else {
        cA = (const char*)A + (size_t)cur.pm * tstep;
        oc00 = on00 = (unsigned)(RA[0] * K + CA[0]) * 2u; oc01 = on01 = (unsigned)(RA[1] * K + CA[1]) * 2u; oc10 = on10 = oc00 + (unsigned)hstep; oc11 = on11 = oc01 + (unsigned)hstep;
    }
    PG8_STAGE_B(PG8_SB(0, 0), cB); PG8_STAGE_B(PG8_SB(0, 1), cB + hstep); PG8_STAGE_A(PG8_SA(0, 0), cA, oc00, oc01); PG8_STAGE_A(PG8_SA(0, 1), cA, oc10, oc11);
    if (wr == 1) PG8_BAR;
    PG8_WAIT_V(2); PG8_BAR;
    PG8_STAGE_B(PG8_SB(1, 0), cB + kstep); PG8_STAGE_A(PG8_SA(1, 0), cA + kstep, oc00, oc01); PG8_STAGE_B(PG8_SB(1, 1), cB + hstep + kstep);
    PG8_WAIT_V(6); PG8_BAR;
    for (;;) {
        if constexpr (GATHER) {
            has_nx2 = has_next && S.next(ui + 2, nx2);
            if (has_nx2) { o200 = (unsigned)(S.row(nx2, RA[0]) * K + CA[0]) * 2u; o201 = (unsigned)(S.row(nx2, RA[1]) * K + CA[1]) * 2u;
                           o210 = (unsigned)(S.row(nx2, HALF + RA[0]) * K + CA[0]) * 2u; o211 = (unsigned)(S.row(nx2, HALF + RA[1]) * K + CA[1]) * 2u; }
        }
        const char* nA = GATHER ? cA : (has_next ? (const char*)A + (size_t)nxt.pm * tstep : cA);
        const char* nB = has_next ? (const char*)S.bt(nxt) + (size_t)nxt.pn * tstep : cB;
        for (int t = 0; t < nt; t += 2) {
            const bool last = (t == nt - 2);
            const char* a1 = cA + (size_t)(t + 1) * kstep;
            const char* a2 = last ? nA : cA + (size_t)(t + 2) * kstep; const char* b2 = last ? nB : cB + (size_t)(t + 2) * kstep;
            const char* a3 = a2 + kstep; const char* b3 = b2 + kstep;
            unsigned s00 = oc00, s01 = oc01, s10 = oc10, s11 = oc11;
            if constexpr (GATHER) { if (last) { s00 = on00; s01 = on01; s10 = on10; s11 = on11; } }
            PG8_LDB(B0, 0, 0); PG8_LDB(B1, 0, 1); PG8_SCHED; PG8_LDA(At, 0, 0); PG8_STAGE_A(PG8_SA(1, 1), a1, oc10, oc11);
            PG8_WAIT_V(8); PG8_WAIT_L(0); PG8_BAR; PG8_MMA(0, 0, At, B0); PG8_MMA(0, 1, At, B1); PG8_BAR; PG8_SCHED;
            PG8_LDA(At, 0, 1); PG8_STAGE_B(PG8_SB(0, 0), b2); PG8_STAGE_B(PG8_SB(0, 1), b2 + hstep); PG8_STAGE_A(PG8_SA(0, 0), a2, s00, s01);
            PG8_WAIT_V(8); PG8_WAIT_L(0); PG8_BAR; PG8_MMA(1, 0, At, B0); PG8_MMA(1, 1, At, B1); PG8_BAR; PG8_SCHED;
            PG8_LDB(B0, 1, 0); PG8_LDB(B1, 1, 1); PG8_SCHED; PG8_LDA(At, 1, 0); PG8_STAGE_A(PG8_SA(0, 1), a2, s10, s11);
            PG8_WAIT_V(8); PG8_WAIT_L(0); PG8_BAR; PG8_MMA(0, 0, At, B0); PG8_MMA(0, 1, At, B1); PG8_BAR; PG8_SCHED;
            PG8_LDA(At, 1, 1); PG8_STAGE_B(PG8_SB(1, 0), b3); PG8_STAGE_B(PG8_SB(1, 1), b3 + hstep); PG8_STAGE_A(PG8_SA(1, 0), a3, s00, s01);
            PG8_WAIT_V(8); PG8_WAIT_L(0); PG8_BAR; PG8_MMA(1, 0, At, B0); PG8_MMA(1, 1, At, B1); PG8_BAR; PG8_SCHED;
        }
        if constexpr (ALIGN_EPI) { if (wr == 0) PG8_BAR; }
        E(acc, cur, wr, wc, fr, fq);
        if (!has_next) break;
#pragma unroll
        for (int a = 0; a < 2; ++a)
#pragma unroll
            for (int b = 0; b < 2; ++b)
#pragma unroll
                for (int m = 0; m < 4; ++m)
#pragma unroll
                    for (int n = 0; n < 2; ++n) acc[a][b][m][n] = (f32x4){0.f, 0.f, 0.f, 0.f};
        cur = nxt; cA = nA; cB = nB; ++ui;
        if constexpr (GATHER) { oc00 = on00; oc01 = on01; oc10 = on10; oc11 = on11; nxt = nx2; has_next = has_nx2; if (has_nx2) { on00 = o200; on01 = o201; on10 = o210; on11 = o211; } }
        else has_next = S.next(ui + 1, nxt);
        if constexpr (ALIGN_EPI) { if (wr == 1) PG8_BAR; }
    }
    PG8_WAIT_V(0);
    if constexpr (!ALIGN_EPI) { if (wr == 0) PG8_BAR; }
    PG8_BAR;
#undef PG8_SA
#undef PG8_SB
#undef PG8_STAGE_A
#undef PG8_STAGE_B
#undef PG8_LDA
#undef PG8_LDB
#undef PG8_MMA
#undef PG8_WAIT_V
#undef PG8_WAIT_L
#undef PG8_BAR
#undef PG8_SCHED
}
}

#define LAS __attribute__((address_space(3)))
#define XB_TMO      128
#define XB_XCNT(j)  (256  + 64 * (j))
#define XB_XSUB(j)  (1280 + 64 * (j))
#define XB_XGEN(j)  (2304 + 64 * (j))
#define XB_TOP      3328
#define XB_TOPGEN   3392
#define XCD_BAR_WORDS 3456
#define XB_SPIN_CAP (1u << 23)

__device__ __forceinline__ unsigned xb_ld(unsigned* p)              { return __hip_atomic_load(p, __ATOMIC_RELAXED, __HIP_MEMORY_SCOPE_AGENT); }
__device__ __forceinline__ unsigned xb_add(unsigned* p, unsigned v) { return __hip_atomic_fetch_add(p, v, __ATOMIC_RELAXED, __HIP_MEMORY_SCOPE_AGENT); }
__device__ __forceinline__ unsigned xb_xcc_id() { return (unsigned)__builtin_amdgcn_s_getreg((3 << 11) | 20) & 0xFu; }
#define XB_SPIN(cond, bar) do { unsigned _sp = 0; while (cond) { __builtin_amdgcn_s_sleep(1); \
    if ((++_sp & 255u) == 0u) { if (xb_ld(&(bar)[XB_TMO])) break; if (_sp > XB_SPIN_CAP) { atomicAdd(&(bar)[XB_TMO], 1u); break; } } } } while (0)

struct XcdBarrier {
    unsigned* bar; unsigned x;
    volatile LAS unsigned* st;
};

__device__ __forceinline__ XcdBarrier xcd_barrier_post(unsigned* bar, volatile LAS unsigned* st) {
    XcdBarrier b; b.bar = bar; b.x = xb_xcc_id(); b.st = st;
    if (threadIdx.x == 0) (void)xb_add(&bar[XB_XCNT(b.x)], 1u);
    return b;
}
__device__ __forceinline__ void xcd_barrier_complete(unsigned* bar, unsigned x, unsigned& nloc, unsigned& nx) {
    const unsigned G = gridDim.x * gridDim.y * gridDim.z;
    unsigned sum, cnt, mine, sp = 0u;
    for (;;) {
        sum = 0u; cnt = 0u; mine = 0u;
#pragma unroll
        for (unsigned j = 0; j < 16; ++j) { const unsigned c = xb_ld(&bar[XB_XCNT(j)]); sum += c; cnt += (c > 0u) ? 1u : 0u; mine = (j == x) ? c : mine; }
        if (sum == G) break;
        __builtin_amdgcn_s_sleep(1);
        if ((++sp & 255u) == 0u) { if (xb_ld(&bar[XB_TMO])) break; if (sp > XB_SPIN_CAP) { atomicAdd(&bar[XB_TMO], 1u); break; } }
    }
    nloc = mine > 0u ? mine : 1u; nx = cnt > 0u ? cnt : 1u;
}

__device__ __forceinline__ void xcd_barrier(const XcdBarrier& b) {
    asm volatile("s_waitcnt vmcnt(0)" ::: "memory");
    __syncthreads();
    if (threadIdx.x == 0) {
        unsigned* bar = b.bar;
        __builtin_amdgcn_s_waitcnt(0);
        unsigned nloc = b.st[0], nx = b.st[1];
        if (nloc == 0u) { xcd_barrier_complete(bar, b.x, nloc, nx); b.st[0] = nloc; b.st[1] = nx; }
        const unsigned old = xb_add(&bar[XB_XSUB(b.x)], 1u);
        const unsigned gen = old / nloc;
        if (old + 1u == (gen + 1u) * nloc) {
            __builtin_amdgcn_fence(__ATOMIC_RELEASE, "agent");
            asm volatile("s_waitcnt vmcnt(0)" ::: "memory");
            const unsigned og = xb_add(&bar[XB_TOP], 1u);
            const unsigned tg = og / nx;
            if (og + 1u == (tg + 1u) * nx) xb_add(&bar[XB_TOPGEN], 1u);
            else XB_SPIN(xb_ld(&bar[XB_TOPGEN]) == tg, bar);
            __builtin_amdgcn_fence(__ATOMIC_ACQUIRE, "agent");
            xb_add(&bar[XB_XGEN(b.x)], 1u);
            asm volatile("s_waitcnt vmcnt(0)" ::: "memory");
        } else {
            XB_SPIN(xb_ld(&bar[XB_XGEN(b.x)]) == gen, bar);
            __builtin_amdgcn_fence(__ATOMIC_ACQUIRE, "agent");
            asm volatile("s_waitcnt vmcnt(0)" ::: "memory");
        }
    }
    __syncthreads();
}

constexpr int NWAVES = 8, NTHR = NWAVES * 64;
constexpr int RING_BYTES = 131072, LDSCTL_OFF = RING_BYTES, MISC_OFF = LDSCTL_OFF + 320, LDS_BYTES = 147456;
constexpr int CW_BAR = 4096;

__device__ __forceinline__ long opaque_gtid() { int t = threadIdx.x; asm volatile("" : "+v"(t)); return (long)blockIdx.x * 512 + t; }
typedef const __attribute__((address_space(4))) Prm* KPrm;
__device__ __forceinline__ KPrm opaque_kp() { KPrm q = (KPrm)__builtin_amdgcn_kernarg_segment_ptr(); asm volatile("" : "+s"(q)); return q; }
typedef const __attribute__((address_space(4))) unsigned long long* KWords;
__device__ __forceinline__ void load_prm(Prm& p) {
    static_assert(sizeof(Prm) % 8 == 0, "Prm is a pack of pointers");
    KWords src = (KWords)opaque_kp(); unsigned long long* dst = (unsigned long long*)&p;
#pragma unroll
    for (int i = 0; i < (int)(sizeof(Prm) / 8); ++i) dst[i] = src[i];
}
#define LP() Prm p; load_prm(p)
#define GT opaque_gtid()
#define GRID_BAR() xcd_barrier(bar)

template <int L> __device__ __forceinline__ void layer_fwd(LAS unsigned char* lds, const XcdBarrier& bar, const long gsz, const int G) {
    constexpr bool first = L == 0, last = L == NL - 1; constexpr int l = L;
    constexpr int nact = last ? MX : M;
    { LP(); ph_modnorm(p, l, first ? p.x : p.out, first ? p.ctx : p.CX, p.norm_mix + l * D, 0, D, M, false, GT, gsz); }
    GRID_BAR();
    {
        LP(); pg8::Order O; O.init(M / 256, NP / 256, G, (int)blockIdx.x, p.WinT + (size_t)l * NP * D);
        pg8::EpiBf16 E{p.P, NP};
        pg8::gemm_phase<pg8::EpiBf16, true, false>(lds, p.HX, D, O, E);
    }
    GRID_BAR();
    { LP(); ph_prep_hy(p, l, GT, gsz); }
    { LP(); ph_prep_qk(p, l, GT, gsz); }
    GRID_BAR();
    { LP(); ph_hyena_naive(p, l, !last, GT, gsz); }
    { LP(); ph_ga_naive(p, GT, gsz); }
    { LP(); ph_na_naive(p, l, GT, gsz); }
    if (!last) { LP(); ph_ctxattn_naive(p, GT, gsz); }
    GRID_BAR();
    { LP(); ph_final(p, l, nact, GT, gsz); }
    GRID_BAR();
    {
        LP(); pg8::Order O; O.init(nact / 256, D / 256, G, (int)blockIdx.x, p.WoutT + (size_t)l * D * D);
        pg8::EpiResGate E{first ? p.x : p.out, first ? p.ctx : p.CX, p.out, p.CX, p.MOD + (size_t)l * 9 * 6 * D + 2 * D};
        pg8::gemm_phase<pg8::EpiResGate, true, false>(lds, p.HX, D, O, E);
    }
    GRID_BAR();
    { LP(); ph_modnorm(p, l, p.out, p.CX, p.norm_ffn + l * D, 3 * D, 4 * D, nact, (l & 1) != 0, GT, gsz); }
    GRID_BAR();
    if constexpr ((L & 1) == 0) {
        {   LP(); pg8::Order O; O.init(nact / 256, 2 * DFF / 256, G, (int)blockIdx.x, p.WguT);
            pg8::EpiSwiGLU E{p.HID, DFF};
            pg8::gemm_phase<pg8::EpiSwiGLU, true, false>(lds, p.HX, D, O, E); }
        GRID_BAR();
        {   LP(); pg8::Order O; O.init(nact / 256, D / 256, G, (int)blockIdx.x, p.WdT);
            pg8::EpiResGate E{p.out, p.CX, p.out, p.CX, p.MOD + (size_t)l * 9 * 6 * D + 5 * D};
            pg8::gemm_phase<pg8::EpiResGate, true, false>(lds, p.HID, DFF, O, E); }
        GRID_BAR();
    } else {
        { LP(); ph_moe_count(p, GT, gsz); }
        GRID_BAR();
        { LP(); ph_moe_assign(p, GT, gsz); }
        GRID_BAR();
#pragma unroll
        for (int pass = 0; pass < 2; ++pass) {
            {   LP(); pg8::Order O; int o = 0;
#pragma unroll
                for (int k = 0; k < 8; ++k) { o += (__builtin_amdgcn_readfirstlane(p.ctl[pass * 8 + k]) + 255) / 256; O.pend[k] = o; }
                const int npan = o; O.nM = npan; O.nN = 2 * DFE / 256; O.nwg = O.nM * O.nN; O.G = G; O.c = (int)blockIdx.x; O.Bt = p.WguTe; O.bt_group_stride = (size_t)2 * DFE * D; O.rows = p.LIST + (size_t)pass * MPAD;
                pg8::EpiSwiGLU E{p.HID, DFE};
                pg8::gemm_phase<pg8::EpiSwiGLU, true, true>(lds, p.HX, D, O, E); }
            GRID_BAR();
            {   LP(); pg8::Order O; int o = 0;
#pragma unroll
                for (int k = 0; k < 8; ++k) { o += (__builtin_amdgcn_readfirstlane(p.ctl[pass * 8 + k]) + 255) / 256; O.pend[k] = o; }
                O.nM = o; O.nN = D / 256; O.nwg = O.nM * O.nN; O.G = G; O.c = (int)blockIdx.x; O.Bt = p.WdTe; O.bt_group_stride = (size_t)D * DFE; O.rows = nullptr;
                pg8::EpiMoeDown E{p.LIST + (size_t)pass * MPAD, p.TOPW, pass, p.out, p.MOD + (size_t)l * 9 * 6 * D + 5 * D};
                pg8::gemm_phase<pg8::EpiMoeDown, true, false>(lds, p.HID, DFE, O, E); }
            GRID_BAR();
        }
    }
}

__global__ void __launch_bounds__(NTHR, 2) mega_fwd(Prm p_in) {
    extern __shared__ __attribute__((aligned(16))) unsigned char lds_raw[];
    LAS unsigned char* lds = (LAS unsigned char*)lds_raw;
    volatile LAS unsigned* MISC = (volatile LAS unsigned*)(lds + MISC_OFF);
    const int tid = threadIdx.x;
    for (int u = tid; u < (LDS_BYTES - LDSCTL_OFF) / 4; u += NTHR) ((LAS unsigned*)(lds + LDSCTL_OFF))[u] = 0u;
    __syncthreads();
    XcdBarrier bar = xcd_barrier_post((unsigned*)p_in.ctl + CW_BAR, MISC + 8);
    const int G = gridDim.x;
    const long gsz = (long)G * NTHR;
    { LP(); ph_wconv(p, GT, gsz); }
    { LP(); ph_mod(p, GT, gsz); }
    { LP(); ph_filt1(p, GT, gsz); }
    GRID_BAR();
    { LP(); ph_filt2(p, 0, p.FHA, p.FHB, GT, gsz); }
    GRID_BAR();
    { LP(); ph_filt2(p, 1, p.FHB, p.FHA, GT, gsz); }
    GRID_BAR();
    { LP(); ph_filt3(p, p.FHA, GT, gsz); }
    GRID_BAR();
    layer_fwd<0>(lds, bar, gsz, G);
    layer_fwd<1>(lds, bar, gsz, G);
}

extern "C" void kernel_launch(void* const* d_in, const int* in_sizes, int n_in, void* d_out, int out_size, void* d_ws, size_t ws_size, hipStream_t stream) {
    static int grid = 0;
    if (grid == 0) {
        if (n_in != 34 || out_size != MX * D || ws_size < ws_needed()) { fprintf(stderr, "kernel_launch: unexpected shapes (n_in %d out %d ws %zu need %zu)\n", n_in, out_size, ws_size, ws_needed()); grid = -1; return; }
        int dev = 0, cus = 0, per_cu = 0;
        if (hipGetDevice(&dev) != hipSuccess || hipDeviceGetAttribute(&cus, hipDeviceAttributeMultiprocessorCount, dev) != hipSuccess) { grid = -1; return; }
        if (hipFuncSetAttribute((const void*)mega_fwd, hipFuncAttributeMaxDynamicSharedMemorySize, LDS_BYTES) != hipSuccess) { fprintf(stderr, "kernel_launch: hipFuncSetAttribute failed\n"); grid = -1; return; }
        if (hipOccupancyMaxActiveBlocksPerMultiprocessor(&per_cu, (const void*)mega_fwd, NTHR, LDS_BYTES) != hipSuccess || per_cu < 1) { fprintf(stderr, "kernel_launch: occupancy query reports %d\n", per_cu); }
        (void)hipGetLastError();
        grid = cus;
    }
    if (grid < 0) return;
    (void)in_sizes;
    (void)hipMemsetAsync(d_ws, 0, CTL_BYTES, stream);
    Prm p; __builtin_memset((void*)&p, 0, sizeof(p)); build_prm(p, d_in, d_out, d_ws);
    hipLaunchKernelGGL(mega_fwd, dim3(grid), dim3(NTHR), LDS_BYTES, stream, p);
}
#else
static void forward_emu(void* const* d_in, void* d_out, void* d_ws) {
    memset(d_ws, 0, CTL_BYTES);
    Prm p; memset(&p, 0, sizeof(p)); build_prm(p, d_in, d_out, d_ws);
#define RUN(ph, l, arg) run_phase(p, (ph), (l), (arg), 0, 1)
    RUN(PH_WCONV, 0, 0); RUN(PH_MOD, 0, 0); RUN(PH_F1, 0, 0); RUN(PH_F2A, 0, 0); RUN(PH_F2B, 0, 0); RUN(PH_F3, 0, 0);
    for (int l = 0; l < NL; ++l) {
        const bool last = l == NL - 1;
        RUN(PH_MODNORM1, l, 0); RUN(PH_INPROJ, l, 0); RUN(PH_PREP_HY, l, 0); RUN(PH_PREP_QK, l, 0);
        RUN(PH_HYENA, l, 0); RUN(PH_GA, l, 0); RUN(PH_NA, l, 0); if (!last) RUN(PH_CTXATTN, l, 0);
        RUN(PH_FINAL, l, 0); RUN(PH_OUTPROJ, l, 0); RUN(PH_MODNORM2, l, 0);
        if ((l & 1) == 0) { RUN(PH_FFN_UP, l, 0); RUN(PH_FFN_DOWN, l, 0); }
        else { RUN(PH_MOE_COUNT, l, 0); RUN(PH_MOE_ASSIGN, l, 0); for (int c = 0; c < 2; ++c) { RUN(PH_MOE_UP, l, c); RUN(PH_MOE_DOWN, l, c); } }
    }
}
#endif
```

```cpp
#ifdef CPU_EMU
#include <cmath>
#include <cstdio>
#include <cstdlib>
#include <cstring>
#include <cstdint>
#define __device__
#define __global__
#define __host__
#define __forceinline__ inline
static inline int atomicAdd(int* p, int v) { int o = *p; *p += v; return o; }
#else
#include <hip/hip_runtime.h>
#include <cstdio>
#include <cstdint>
#endif

#ifdef CFG_SMALL
constexpr int D = 512, NB = 2, S = 1024, LC = 64, DFF = 256, DFE = 256;
#else
constexpr int D = 1024, NB = 8, S = 4096, LC = 256, DFF = 2816, DFE = 3584;
#endif
constexpr int NL = 2;
constexpr int DHY = 3 * D / 8, DNA = 3 * D / 8, DGA = D - DHY - DNA, NNA = DNA / 64, NGA = DGA / 64, HD = 64;
constexpr int GW = 64, ROWS = S / GW, KH = 8, KWIN = 16;
constexpr int MX = NB * S, MC = NB * LC, M = MX + MC;
constexpr int NE = 8;
constexpr int NP = 3 * D;
constexpr int PC_HY = 0, PC_NAQ = 3 * DHY, PC_NAK = PC_NAQ + DNA, PC_NAV = PC_NAK + DNA, PC_GAQ = 3 * (DHY + DNA), PC_GAK = PC_GAQ + DGA, PC_GAV = PC_GAK + DGA;
constexpr int MPAD = ((MX + NE * 255 + 255) / 256) * 256;
constexpr float EPS = 1e-6f;
constexpr float LOG2E = 1.4426950408889634f;
constexpr float QSCALE = 0.125f * LOG2E;

typedef unsigned short bf16;
__host__ __device__ __forceinline__ unsigned f2bf_u(float f) { unsigned u; __builtin_memcpy(&u, &f, 4); return (u + 0x7fffu + ((u >> 16) & 1u)) >> 16; }
__host__ __device__ __forceinline__ bf16 f2bf(float f) { return (bf16)f2bf_u(f); }
__host__ __device__ __forceinline__ float bf2f(bf16 h) { unsigned u = ((unsigned)h) << 16; float f; __builtin_memcpy(&f, &u, 4); return f; }
__host__ __device__ __forceinline__ float silu_f(float v) { return v / (1.0f + expf(-v)); }

struct Prm {
    const float *x, *c, *ctx, *c_ctx, *w_mod, *b_mod, *norm_mix, *norm_ffn, *w_in, *hy_conv_w, *hy_conv_b, *hy_w1, *hy_b1, *hy_freq, *hy_w2, *hy_b2, *hy_w3, *hy_skip;
    const float *na_q_norm, *na_k_norm, *na_rpb, *ga_q_norm, *ga_k_norm, *out_norm_hy, *out_norm_na, *out_norm_ga, *w_out;
    const float *ffn_w_gate, *ffn_w_up, *ffn_w_down, *moe_router, *moe_w_gate, *moe_w_up, *moe_w_down;
    float* out;
    int* ctl;
    float* MOD;
    float *FHA, *FHB;
    bf16* FT;
    bf16* FTC;
    bf16 *WinT, *WoutT;
    bf16 *WguT, *WdT;
    bf16 *WguTe, *WdTe;
    float* CX;
    int* TOPI; float* TOPW; int* LIST;
    bf16* HX;
    bf16* P;
    bf16 *VT, *VTC;
    float *YC, *YCC;
    bf16* HID;
};

__device__ __forceinline__ void conv_T(const float* W, int K, int N, bf16* dst, long gtid, long gsz) {
    for (long i = gtid; i < (long)N * K; i += gsz) { const int n = (int)(i / K), k = (int)(i % K); dst[i] = f2bf(W[(size_t)k * N + n]); }
}
__device__ __forceinline__ void conv_gu(const float* Wg, const float* Wu, int K, int F, bf16* dst, long gtid, long gsz) {
    for (long i = gtid; i < (long)2 * F * K; i += gsz) {
        const int n = (int)(i / K), k = (int)(i % K), p = n / 256, j = n % 256;
        const float* src = j < 128 ? Wg : Wu; const int col = 128 * p + (j & 127);
        dst[i] = f2bf(src[(size_t)k * F + col]);
    }
}
__device__ __forceinline__ void ph_wconv(const Prm& p, long gtid, long gsz) {
    for (int l = 0; l < NL; ++l) {
        conv_T(p.w_in + (size_t)l * D * NP, D, NP, p.WinT + (size_t)l * NP * D, gtid, gsz);
        conv_T(p.w_out + (size_t)l * D * D, D, D, p.WoutT + (size_t)l * D * D, gtid, gsz);
    }
    conv_gu(p.ffn_w_gate, p.ffn_w_up, D, DFF, p.WguT, gtid, gsz);
    conv_T(p.ffn_w_down, DFF, D, p.WdT, gtid, gsz);
    for (int e = 0; e < NE; ++e) {
        conv_gu(p.moe_w_gate + (size_t)e * D * DFE, p.moe_w_up + (size_t)e * D * DFE, D, DFE, p.WguTe + (size_t)e * 2 * DFE * D, gtid, gsz);
        conv_T(p.moe_w_down + (size_t)e * DFE * D, DFE, D, p.WdTe + (size_t)e * D * DFE, gtid, gsz);
    }
}
__device__ __forceinline__ void ph_mod(const Prm& p, long gtid, long gsz) {
    for (long i = gtid; i < (long)NL * 9 * 6 * D; i += gsz) {
        const int n = (int)(i % (6 * D)), r = (int)((i / (6 * D)) % 9), l = (int)(i / (6 * D * 9));
        const float* cv = r < 8 ? p.c + (size_t)(r % NB) * D : p.c_ctx;
        const float* w = p.w_mod + (size_t)l * D * 6 * D;
        float acc = p.b_mod[(size_t)l * 6 * D + n];
        for (int k = 0; k < D; ++k) acc += silu_f(cv[k]) * w[(size_t)k * 6 * D + n];
        p.MOD[i] = acc;
    }
}
__device__ __forceinline__ int fset_len(int s) { return s < 2 ? S : LC; }
__device__ __forceinline__ int fset_layer(int s) { return s == 1 ? 1 : 0; }
__device__ __forceinline__ void ph_filt1(const Prm& p, long gtid, long gsz) {
    for (long i = gtid; i < (long)3 * S * 64; i += gsz) {
        const int u = (int)(i % 64), t = (int)((i / 64) % S), s = (int)(i / (64 * S));
        const int Len = fset_len(s), l = fset_layer(s);
        if (t >= Len) continue;
        const float* w1 = p.hy_w1 + (size_t)l * 33 * 64;
        const float tn = (float)t / (float)(Len - 1);
        const float ang = 6.283185307179586f * (float)t / (float)Len;
        float pre = p.hy_b1[l * 64 + u] + tn * w1[u];
        for (int j = 0; j < 16; ++j) {
            const float fr = 1e-4f + (float)j * ((15.0f - 1e-4f) / 15.0f);
            pre += cosf(fr * ang) * w1[(1 + j) * 64 + u] - sinf(fr * ang) * w1[(17 + j) * 64 + u];
        }
        p.FHA[i] = sinf(p.hy_freq[l * 64 + u] * pre);
    }
}
__device__ __forceinline__ void ph_filt2(const Prm& p, int inner, const float* src, float* dst, long gtid, long gsz) {
    for (long i = gtid; i < (long)3 * S * 64; i += gsz) {
        const int u = (int)(i % 64), t = (int)((i / 64) % S), s = (int)(i / (64 * S));
        const int Len = fset_len(s), l = fset_layer(s);
        if (t >= Len) continue;
        const float* w2 = p.hy_w2 + ((size_t)l * 2 + inner) * 64 * 64;
        const float* h = src + (i - u);
        float pre = p.hy_b2[(l * 2 + inner) * 64 + u];
        for (int k = 0; k < 64; ++k) pre += h[k] * w2[k * 64 + u];
        dst[i] = sinf(p.hy_freq[l * 64 + u] * pre);
    }
}
__device__ __forceinline__ void ph_filt3(const Prm& p, const float* src, long gtid, long gsz) {
    for (long i = gtid; i < (long)3 * S * 2 * DHY; i += gsz) {
        const int n = (int)(i % (2 * DHY)), t = (int)((i / (2 * DHY)) % S), s = (int)(i / ((long)2 * DHY * S));
        const int Len = fset_len(s), l = fset_layer(s);
        if (t >= Len) continue;
        const float* w3 = p.hy_w3 + (size_t)l * 64 * 2 * DHY;
        const float* h = src + ((size_t)s * S + t) * 64;
        float acc = 0.f;
        for (int k = 0; k < 64; ++k) acc += h[k] * w3[(size_t)k * 2 * DHY + n];
        const int cch = n % DHY;
        const float d0 = logf(1e-2f) / 1.5f, d1 = logf(1e-2f) / 0.3f;
        const float delta = fabsf(d0 + (float)cch * ((d1 - d0) / (float)(DHY - 1)));
        const float tn = (float)t / (float)(Len - 1);
        const float val = acc * expf(-tn * delta);
        bf16* ft = (s < 2 ? p.FT + (size_t)s * DHY * (2 * S + 8) : p.FTC) + (size_t)cch * (2 * Len + 8);
        if (n < DHY) ft[Len - t] = f2bf(val);
        else if (t > 0) ft[Len + t] = f2bf(val);
        else { ft[0] = 0; for (int k = 0; k < 8; ++k) ft[2 * Len + k] = 0; }
    }
}

__device__ __forceinline__ int row_modrow(int row) { return row < MX ? row / S : 8; }
__device__ __forceinline__ int row_batch(int row) { return row < MX ? row / S : (row - MX) / LC; }

__device__ __forceinline__ void ph_modnorm(const Prm& p, int l, const float* xs, const float* cs, const float* gain, int off_shift, int off_scale, int nrows, bool router, long gtid, long gsz) {
    for (long row = gtid; row < nrows; row += gsz) {
        const float* src = row < MX ? xs + (size_t)row * D : cs + (size_t)(row - MX) * D;
        const float* mod = p.MOD + ((size_t)l * 9 + row_modrow((int)row)) * 6 * D;
        float ss = 0.f;
        for (int k = 0; k < D; ++k) ss += src[k] * src[k];
        const float rstd = 1.0f / sqrtf(ss / (float)D + EPS);
        float lg[NE];
#pragma unroll
        for (int e = 0; e < NE; ++e) lg[e] = 0.f;
        for (int k = 0; k < D; ++k) {
            const float h = src[k] * rstd * gain[k] * (1.0f + mod[off_scale + k]) + mod[off_shift + k];
            p.HX[(size_t)row * D + k] = f2bf(h);
            if (router) {
#pragma unroll
                for (int e = 0; e < NE; ++e) lg[e] += h * p.moe_router[(size_t)k * NE + e]; }
        }
        if (router && row < MX) {
            float b1 = -INFINITY, b2 = -INFINITY; int i1 = 0, i2 = 0;
#pragma unroll
            for (int e = 0; e < NE; ++e) { const float v = lg[e]; if (v > b1) { b2 = b1; i2 = i1; b1 = v; i1 = e; } else if (v > b2) { b2 = v; i2 = e; } }
            const float w1 = 1.0f / (1.0f + expf(b2 - b1));
            p.TOPI[row * 2] = i1; p.TOPI[row * 2 + 1] = i2; p.TOPW[row * 2] = w1; p.TOPW[row * 2 + 1] = 1.0f - w1;
        }
    }
}
struct U4 { unsigned x, y, z, w; };
__device__ __forceinline__ float dot_bf(const bf16* a, const bf16* b, int K) {
    float acc = 0.f;
    for (int k = 0; k < K; k += 8) {
        U4 va, vb; __builtin_memcpy(&va, a + k, 16); __builtin_memcpy(&vb, b + k, 16);
        const unsigned ua[4] = {va.x, va.y, va.z, va.w}, ub[4] = {vb.x, vb.y, vb.z, vb.w};
#pragma unroll
        for (int j = 0; j < 4; ++j) acc += bf2f((bf16)(ua[j] & 0xffffu)) * bf2f((bf16)(ub[j] & 0xffffu)) + bf2f((bf16)(ua[j] >> 16)) * bf2f((bf16)(ub[j] >> 16));
    }
    return acc;
}

__device__ __forceinline__ void ph_inproj(const Prm& p, int l, long gtid, long gsz) {
    const bf16* Bt = p.WinT + (size_t)l * NP * D;
    for (long i = gtid; i < (long)M * NP; i += gsz) { const int m = (int)(i / NP), n = (int)(i % NP); p.P[i] = f2bf(dot_bf(p.HX + (size_t)m * D, Bt + (size_t)n * D, D)); }
}
__device__ __forceinline__ float sconv(const Prm& p, int l, int row, int col) {
    int t, Len; if (row < MX) { t = row % S; Len = S; } else { t = (row - MX) % LC; Len = LC; }
    const float* w = p.hy_conv_w + (size_t)l * 3 * 3 * DHY;
    float y = p.hy_conv_b[(size_t)l * 3 * DHY + col] + w[3 * DHY + col] * bf2f(p.P[(size_t)row * NP + col]);
    if (t > 0) y += w[col] * bf2f(p.P[(size_t)(row - 1) * NP + col]);
    if (t < Len - 1) y += w[2 * 3 * DHY + col] * bf2f(p.P[(size_t)(row + 1) * NP + col]);
    return y;
}
__device__ __forceinline__ void ph_prep_hy(const Prm& p, int l, long gtid, long gsz) {
    for (long i = gtid; i < (long)M * DHY; i += gsz) {
        const int row = (int)(i / DHY), c = (int)(i % DHY);
        const float v = sconv(p, l, row, 2 * DHY + c) * sconv(p, l, row, DHY + c);
        if (row < MX) p.VT[((size_t)c * NB + row / S) * S + row % S] = f2bf(v);
        else { const int rr = row - MX; p.VTC[((size_t)c * NB + rr / LC) * LC + rr % LC] = f2bf(v); }
    }
}
__device__ __forceinline__ void ph_prep_qk(const Prm& p, int l, long gtid, long gsz) {
    constexpr int NS = 2 * NNA + 2 * NGA;
    for (long i = gtid; i < (long)M * NS; i += gsz) {
        const int row = (int)(i / NS), hs = (int)(i % NS);
        int col; const float* g; bool isq, rope;
        if (hs < NNA) { col = PC_NAQ + 64 * hs; g = p.na_q_norm + l * 64; isq = true; rope = false; }
        else if (hs < 2 * NNA) { col = PC_NAK + 64 * (hs - NNA); g = p.na_k_norm + l * 64; isq = false; rope = false; }
        else if (hs < 2 * NNA + NGA) { col = PC_GAQ + 64 * (hs - 2 * NNA); g = p.ga_q_norm + l * 64; isq = true; rope = row < MX; }
        else { col = PC_GAK + 64 * (hs - 2 * NNA - NGA); g = p.ga_k_norm + l * 64; isq = false; rope = row < MX; }
        bf16* v = p.P + (size_t)row * NP + col;
        float ss = 0.f;
        for (int d = 0; d < 64; ++d) { const float a = bf2f(v[d]); ss += a * a; }
        const float rstd = 1.0f / sqrtf(ss / 64.0f + EPS), sc = isq ? QSCALE : 1.0f;
        if (!rope) { for (int d = 0; d < 64; ++d) v[d] = f2bf(bf2f(v[d]) * rstd * g[d] * sc); }
        else {
            const int t = row % S; const float pr = (float)(t / GW), pc = (float)(t % GW);
            for (int hf = 0; hf < 2; ++hf) {
                const float pos = hf == 0 ? pr : pc;
                for (int j = 0; j < 16; ++j) {
                    const float inv = powf(10000.0f, -(float)j / 16.0f), ang = pos * inv, cs = cosf(ang), sn = sinf(ang);
                    const int d1 = 32 * hf + j, d2 = d1 + 16;
                    const float a = bf2f(v[d1]) * rstd * g[d1], b = bf2f(v[d2]) * rstd * g[d2];
                    v[d1] = f2bf((a * cs - b * sn) * sc); v[d2] = f2bf((a * sn + b * cs) * sc);
                }
            }
        }
    }
}
__device__ __forceinline__ void ph_hyena_naive(const Prm& p, int l, bool with_lat, bool with_ctx, long gtid, long gsz) {
    const bf16* FTl = p.FT + (size_t)l * DHY * (2 * S + 8);
    if (with_lat) for (long i = gtid; i < (long)DHY * NB * S; i += gsz) {
        const int t = (int)(i % S), cb = (int)(i / S), c = cb / NB;
        const bf16* ft = FTl + (size_t)c * (2 * S + 8) + S - t; const bf16* v = p.VT + (size_t)cb * S;
        float acc = 0.f;
        for (int s = 0; s < S; ++s) acc += bf2f(ft[s]) * bf2f(v[s]);
        p.YC[i] = acc;
    }
    if (with_ctx) for (long i = gtid; i < (long)DHY * NB * LC; i += gsz) {
        const int t = (int)(i % LC), cb = (int)(i / LC), c = cb / NB;
        const bf16* ft = p.FTC + (size_t)c * (2 * LC + 8) + LC - t; const bf16* v = p.VTC + (size_t)cb * LC;
        float acc = 0.f;
        for (int s = 0; s < LC; ++s) acc += bf2f(ft[s]) * bf2f(v[s]);
        p.YCC[i] = acc;
    }
}
struct OnlineSm { float m, l, o[64]; };
__device__ __forceinline__ void osm_init(OnlineSm& st) { st.m = -INFINITY; st.l = 0.f;
_Pragma("unroll") for (int d = 0; d < 64; ++d) st.o[d] = 0.f; }
__device__ __forceinline__ void osm_step(OnlineSm& st, const float* q, const bf16* k, const bf16* v, float bias) {
    float sc = bias;
_Pragma("unroll") for (int d = 0; d < 64; ++d) sc += q[d] * bf2f(k[d]);
    if (sc > st.m) { const float a = exp2f(st.m - sc); st.l *= a;
_Pragma("unroll") for (int d = 0; d < 64; ++d) st.o[d] *= a;
 st.m = sc; }
    const float pe = exp2f(sc - st.m); st.l += pe;
_Pragma("unroll") for (int d = 0; d < 64; ++d) st.o[d] += pe * bf2f(v[d]);
}
__device__ __forceinline__ void ph_ga_naive(const Prm& p, long gtid, long gsz) {
    for (long i = gtid; i < (long)NB * NGA * S; i += gsz) {
        const int t = (int)(i % S), h = (int)((i / S) % NGA), b = (int)(i / ((long)S * NGA));
        bf16* qp = p.P + ((size_t)b * S + t) * NP + PC_GAQ + 64 * h;
        float q[64];
_Pragma("unroll") for (int d = 0; d < 64; ++d) q[d] = bf2f(qp[d]);
        OnlineSm st; osm_init(st);
        for (int s = 0; s < S; ++s) { const bf16* kr = p.P + ((size_t)b * S + s) * NP; osm_step(st, q, kr + PC_GAK + 64 * h, kr + PC_GAV + 64 * h, 0.f); }
        for (int s = 0; s < LC; ++s) { const bf16* kr = p.P + ((size_t)MX + b * LC + s) * NP; osm_step(st, q, kr + PC_GAK + 64 * h, kr + PC_GAV + 64 * h, 0.f); }
        const float il = 1.0f / st.l;
_Pragma("unroll") for (int d = 0; d < 64; ++d) qp[d] = f2bf(st.o[d] * il);
    }
}
__device__ __forceinline__ void ph_na_naive(const Prm& p, int l, long gtid, long gsz) {
    for (long i = gtid; i < (long)NB * NNA * S; i += gsz) {
        const int t = (int)(i % S), h = (int)((i / S) % NNA), b = (int)(i / ((long)S * NNA));
        const int r = t / GW, qc = t % GW;
        int r0 = r - KH / 2; r0 = r0 < 0 ? 0 : (r0 > ROWS - KH ? ROWS - KH : r0);
        int c0 = qc - KWIN / 2; c0 = c0 < 0 ? 0 : (c0 > GW - KWIN ? GW - KWIN : c0);
        bf16* qp = p.P + ((size_t)b * S + t) * NP + PC_NAQ + 64 * h;
        float q[64];
_Pragma("unroll") for (int d = 0; d < 64; ++d) q[d] = bf2f(qp[d]);
        const float* rpb = p.na_rpb + ((size_t)l * NNA + h) * (2 * KH - 1) * (2 * KWIN - 1);
        OnlineSm st; osm_init(st);
        for (int kr = 0; kr < KH; ++kr) for (int kc = c0; kc < c0 + KWIN; ++kc) {
            const int krow = r0 + kr, dr = krow - r + (KH - 1); int dc = kc - qc; dc = dc < -(KWIN - 1) ? -(KWIN - 1) : (dc > KWIN - 1 ? KWIN - 1 : dc); dc += KWIN - 1;
            const bf16* kp = p.P + ((size_t)b * S + krow * GW + kc) * NP;
            osm_step(st, q, kp + PC_NAK + 64 * h, kp + PC_NAV + 64 * h, rpb[dr * (2 * KWIN - 1) + dc] * LOG2E);
        }
        for (int s = 0; s < LC; ++s) { const bf16* kp = p.P + ((size_t)MX + b * LC + s) * NP; osm_step(st, q, kp + PC_NAK + 64 * h, kp + PC_NAV + 64 * h, 0.f); }
        const float il = 1.0f / st.l;
_Pragma("unroll") for (int d = 0; d < 64; ++d) qp[d] = f2bf(st.o[d] * il);
    }
}
__device__ __forceinline__ void ph_ctxattn_naive(const Prm& p, long gtid, long gsz) {
    for (long i = gtid; i < (long)NB * (NNA + NGA) * LC; i += gsz) {
        const int t = (int)(i % LC), hh = (int)((i / LC) % (NNA + NGA)), b = (int)(i / ((long)LC * (NNA + NGA)));
        const int qo = hh < NNA ? PC_NAQ + 64 * hh : PC_GAQ + 64 * (hh - NNA), ko = hh < NNA ? PC_NAK + 64 * hh : PC_GAK + 64 * (hh - NNA), vo = hh < NNA ? PC_NAV + 64 * hh : PC_GAV + 64 * (hh - NNA);
        bf16* qp = p.P + ((size_t)MX + b * LC + t) * NP + qo;
        float q[64];
_Pragma("unroll") for (int d = 0; d < 64; ++d) q[d] = bf2f(qp[d]);
        OnlineSm st; osm_init(st);
        for (int s = 0; s < LC; ++s) { const bf16* kp = p.P + ((size_t)MX + b * LC + s) * NP; osm_step(st, q, kp + ko, kp + vo, 0.f); }
        const float il = 1.0f / st.l;
_Pragma("unroll") for (int d = 0; d < 64; ++d) qp[d] = f2bf(st.o[d] * il);
    }
}
__device__ __forceinline__ void ph_final(const Prm& p, int l, int nrows, long gtid, long gsz) {
    for (long row = gtid; row < nrows; row += gsz) {
        const int r = (int)row; int b, t; const float* yc;
        if (r < MX) { b = r / S; t = r % S; } else { b = (r - MX) / LC; t = (r - MX) % LC; }
        float ss = 0.f;
        for (int pass = 0; pass < 2; ++pass) {
            const float rstd = pass ? 1.0f / sqrtf(ss / (float)DHY + EPS) : 0.f;
            for (int c = 0; c < DHY; ++c) {
                const float x0 = sconv(p, l, r, c), vp = sconv(p, l, r, 2 * DHY + c) * sconv(p, l, r, DHY + c);
                const float conv = r < MX ? p.YC[((size_t)c * NB + b) * S + t] : p.YCC[((size_t)c * NB + b) * LC + t];
                const float y = (conv + p.hy_skip[l * DHY + c] * vp) * x0;
                if (!pass) ss += y * y; else p.HX[(size_t)r * D + c] = f2bf(y * rstd * p.out_norm_hy[l * DHY + c]);
            }
        }
        { const bf16* o = p.P + (size_t)r * NP + PC_NAQ; float s2 = 0.f; for (int j = 0; j < DNA; ++j) { const float a = bf2f(o[j]); s2 += a * a; }
          const float rstd = 1.0f / sqrtf(s2 / (float)DNA + EPS); for (int j = 0; j < DNA; ++j) p.HX[(size_t)r * D + DHY + j] = f2bf(bf2f(o[j]) * rstd * p.out_norm_na[l * DNA + j]); }
        { const bf16* o = p.P + (size_t)r * NP + PC_GAQ; float s2 = 0.f; for (int j = 0; j < DGA; ++j) { const float a = bf2f(o[j]); s2 += a * a; }
          const float rstd = 1.0f / sqrtf(s2 / (float)DGA + EPS); for (int j = 0; j < DGA; ++j) p.HX[(size_t)r * D + DHY + DNA + j] = f2bf(bf2f(o[j]) * rstd * p.out_norm_ga[l * DGA + j]); }
        (void)yc;
    }
}
__device__ __forceinline__ void ph_outproj(const Prm& p, int l, const float* xs, const float* cs, int nrows, long gtid, long gsz) {
    const bf16* Bt = p.WoutT + (size_t)l * D * D;
    for (long i = gtid; i < (long)nrows * D; i += gsz) {
        const int m = (int)(i / D), n = (int)(i % D);
        const float acc = dot_bf(p.HX + (size_t)m * D, Bt + (size_t)n * D, D);
        const float gate = p.MOD[((size_t)l * 9 + row_modrow(m)) * 6 * D + 2 * D + n];
        if (m < MX) p.out[i] = xs[i] + gate * acc; else p.CX[i - (size_t)MX * D] = cs[i - (size_t)MX * D] + gate * acc;
    }
}
__device__ __forceinline__ void ph_ffn_up(const Prm& p, int nrows, long gtid, long gsz) {
    for (long i = gtid; i < (long)nrows * DFF; i += gsz) {
        const int m = (int)(i / DFF), j = (int)(i % DFF), n = 256 * (j / 128) + (j % 128);
        const float g = dot_bf(p.HX + (size_t)m * D, p.WguT + (size_t)n * D, D), u = dot_bf(p.HX + (size_t)m * D, p.WguT + (size_t)(n + 128) * D, D);
        p.HID[i] = f2bf(silu_f(g) * u);
    }
}
__device__ __forceinline__ void ph_ffn_down(const Prm& p, int l, int nrows, long gtid, long gsz) {
    for (long i = gtid; i < (long)nrows * D; i += gsz) {
        const int m = (int)(i / D), n = (int)(i % D);
        const float acc = dot_bf(p.HID + (size_t)m * DFF, p.WdT + (size_t)n * DFF, DFF);
        const float gate = p.MOD[((size_t)l * 9 + row_modrow(m)) * 6 * D + 5 * D + n];
        if (m < MX) p.out[i] += gate * acc; else p.CX[i - (size_t)MX * D] += gate * acc;
    }
}
__device__ __forceinline__ void ph_moe_count(const Prm& p, long gtid, long gsz) {
    for (long i = gtid; i < (long)2 * MPAD; i += gsz) p.LIST[i] = -1;
    for (long m = gtid; m < MX; m += gsz) { atomicAdd(p.ctl + p.TOPI[m * 2], 1); atomicAdd(p.ctl + 8 + p.TOPI[m * 2 + 1], 1); }
}
__device__ __forceinline__ int moe_off(const Prm& p, int pass, int e) {
    int o = 0;
#pragma unroll
    for (int k = 0; k < NE; ++k) if (k < e) o += (p.ctl[pass * 8 + k] + 255) / 256 * 256;
    return o;
}
__device__ __forceinline__ void ph_moe_assign(const Prm& p, long gtid, long gsz) {
    for (long m = gtid; m < MX; m += gsz) {
        for (int c = 0; c < 2; ++c) { const int e = p.TOPI[m * 2 + c]; const int slot = moe_off(p, c, e) + atomicAdd(p.ctl + 16 + c * 8 + e, 1); p.LIST[(size_t)c * MPAD + slot] = (int)m; }
    }
}
__device__ __forceinline__ int moe_slot_expert(const Prm& p, int pass, int slot) {
    int e = 0, o = 0;
#pragma unroll
    for (int k = 0; k < NE - 1; ++k) { o += (p.ctl[pass * 8 + k] + 255) / 256 * 256; if (slot >= o) e = k + 1; }
    return e;
}
__device__ __forceinline__ void ph_moe_up(const Prm& p, int pass, long gtid, long gsz) {
    const int tot = moe_off(p, pass, NE);
    for (long i = gtid; i < (long)tot * DFE; i += gsz) {
        const int slot = (int)(i / DFE), j = (int)(i % DFE), tok = p.LIST[(size_t)pass * MPAD + slot];
        if (tok < 0) continue;
        const int e = moe_slot_expert(p, pass, slot), n = 256 * (j / 128) + (j % 128);
        const bf16* W = p.WguTe + (size_t)e * 2 * DFE * D;
        const float g = dot_bf(p.HX + (size_t)tok * D, W + (size_t)n * D, D), u = dot_bf(p.HX + (size_t)tok * D, W + (size_t)(n + 128) * D, D);
        p.HID[i] = f2bf(silu_f(g) * u);
    }
}
__device__ __forceinline__ void ph_moe_down(const Prm& p, int l, int pass, long gtid, long gsz) {
    const int tot = moe_off(p, pass, NE);
    for (long i = gtid; i < (long)tot * D; i += gsz) {
        const int slot = (int)(i / D), n = (int)(i % D), tok = p.LIST[(size_t)pass * MPAD + slot];
        if (tok < 0) continue;
        const int e = moe_slot_expert(p, pass, slot);
        const float acc = dot_bf(p.HID + (size_t)slot * DFE, p.WdTe + ((size_t)e * D + n) * DFE, DFE);
        const float gate = p.MOD[((size_t)l * 9 + tok / S) * 6 * D + 5 * D + n];
        p.out[(size_t)tok * D + n] += gate * p.TOPW[tok * 2 + pass] * acc;
    }
}

enum { PH_WCONV, PH_MOD, PH_F1, PH_F2A, PH_F2B, PH_F3, PH_MODNORM1, PH_INPROJ, PH_PREP_HY, PH_PREP_QK, PH_HYENA, PH_GA, PH_NA, PH_CTXATTN, PH_FINAL, PH_OUTPROJ, PH_MODNORM2,
       PH_FFN_UP, PH_FFN_DOWN, PH_MOE_COUNT, PH_MOE_ASSIGN, PH_MOE_UP, PH_MOE_DOWN };
__device__ __forceinline__ void run_phase(const Prm& p, int ph, int l, int arg, long gtid, long gsz) {
    const bool first = l == 0, last = l == NL - 1;
    const float* xs = first ? p.x : p.out; const float* cs = first ? p.ctx : p.CX;
    const int nact = last ? MX : M;
    switch (ph) {
        case PH_WCONV: ph_wconv(p, gtid, gsz); break;
        case PH_MOD: ph_mod(p, gtid, gsz); break;
        case PH_F1: ph_filt1(p, gtid, gsz); break;
        case PH_F2A: ph_filt2(p, 0, p.FHA, p.FHB, gtid, gsz); break;
        case PH_F2B: ph_filt2(p, 1, p.FHB, p.FHA, gtid, gsz); break;
        case PH_F3: ph_filt3(p, p.FHA, gtid, gsz); break;
        case PH_MODNORM1: ph_modnorm(p, l, xs, cs, p.norm_mix + l * D, 0, D, M, false, gtid, gsz); break;
        case PH_INPROJ: ph_inproj(p, l, gtid, gsz); break;
        case PH_PREP_HY: ph_prep_hy(p, l, gtid, gsz); break;
        case PH_PREP_QK: ph_prep_qk(p, l, gtid, gsz); break;
        case PH_HYENA: ph_hyena_naive(p, l, true, !last, gtid, gsz); break;
        case PH_GA: ph_ga_naive(p, gtid, gsz); break;
        case PH_NA: ph_na_naive(p, l, gtid, gsz); break;
        case PH_CTXATTN: ph_ctxattn_naive(p, gtid, gsz); break;
        case PH_FINAL: ph_final(p, l, nact, gtid, gsz); break;
        case PH_OUTPROJ: ph_outproj(p, l, xs, cs, nact, gtid, gsz); break;
        case PH_MODNORM2: ph_modnorm(p, l, p.out, p.CX, p.norm_ffn + l * D, 3 * D, 4 * D, nact, (l & 1) != 0, gtid, gsz); break;
        case PH_FFN_UP: ph_ffn_up(p, nact, gtid, gsz); break;
        case PH_FFN_DOWN: ph_ffn_down(p, l, nact, gtid, gsz); break;
        case PH_MOE_COUNT: ph_moe_count(p, gtid, gsz); break;
        case PH_MOE_ASSIGN: ph_moe_assign(p, gtid, gsz); break;
        case PH_MOE_UP: ph_moe_up(p, arg, gtid, gsz); break;
        case PH_MOE_DOWN: ph_moe_down(p, l, arg, gtid, gsz); break;
    }
}

struct WsMap { size_t off; size_t take(size_t bytes) { const size_t o = off; off = (off + bytes + 255) & ~(size_t)255; return o; } };
constexpr size_t CTL_BYTES = 1u << 20;
static void build_prm(Prm& p, void* const* d_in, void* d_out, void* d_ws) {
    const float** f = (const float**)&p;
    for (int i = 0; i < 34; ++i) f[i] = (const float*)d_in[i];
    p.out = (float*)d_out;
    unsigned char* ws = (unsigned char*)d_ws; WsMap w{0};
    p.ctl = (int*)(ws + w.take(CTL_BYTES));
    p.MOD = (float*)(ws + w.take((size_t)NL * 9 * 6 * D * 4));
    p.FHA = (float*)(ws + w.take((size_t)3 * S * 64 * 4)); p.FHB = (float*)(ws + w.take((size_t)3 * S * 64 * 4));
    p.FT = (bf16*)(ws + w.take((size_t)NL * DHY * (2 * S + 8) * 2)); p.FTC = (bf16*)(ws + w.take((size_t)DHY * (2 * LC + 8) * 2));
    p.WinT = (bf16*)(ws + w.take((size_t)NL * NP * D * 2)); p.WoutT = (bf16*)(ws + w.take((size_t)NL * D * D * 2));
    p.WguT = (bf16*)(ws + w.take((size_t)2 * DFF * D * 2)); p.WdT = (bf16*)(ws + w.take((size_t)D * DFF * 2));
    p.WguTe = (bf16*)(ws + w.take((size_t)NE * 2 * DFE * D * 2)); p.WdTe = (bf16*)(ws + w.take((size_t)NE * D * DFE * 2));
    p.CX = (float*)(ws + w.take((size_t)MC * D * 4));
    p.TOPI = (int*)(ws + w.take((size_t)MX * 2 * 4)); p.TOPW = (float*)(ws + w.take((size_t)MX * 2 * 4)); p.LIST = (int*)(ws + w.take((size_t)2 * MPAD * 4));
    p.HX = (bf16*)(ws + w.take((size_t)M * D * 2));
    const size_t rbase = w.off;
    p.P = (bf16*)(ws + w.take((size_t)M * NP * 2));
    p.VT = (bf16*)(ws + w.take((size_t)DHY * NB * S * 2)); p.VTC = (bf16*)(ws + w.take((size_t)DHY * NB * LC * 2));
    p.YC = (float*)(ws + w.take((size_t)DHY * NB * S * 4)); p.YCC = (float*)(ws + w.take((size_t)DHY * NB * LC * 4));
    p.HID = (bf16*)(ws + rbase);
}
static size_t ws_needed() {
    const size_t hid = (size_t)M * DFF * 2 > (size_t)MPAD * DFE * 2 ? (size_t)M * DFF * 2 : (size_t)MPAD * DFE * 2;
    Prm p; unsigned char* base = (unsigned char*)0x1000; void* din[34] = {}; build_prm(p, din, nullptr, base);
    const size_t endR = (size_t)((unsigned char*)p.YCC - base) + (size_t)DHY * NB * LC * 4, endH = (size_t)((unsigned char*)p.HID - base) + hid;
    return endR > endH ? endR : endH;
}


#ifndef CPU_EMU
#define LAS __attribute__((address_space(3)))
namespace pg8 {
#define PG8_LAS __attribute__((address_space(3)))
typedef unsigned short bf16_t;
typedef short bf16x8 __attribute__((ext_vector_type(8)));
typedef float f32x4 __attribute__((ext_vector_type(4)));
typedef unsigned u32x4 __attribute__((ext_vector_type(4)));
constexpr int BM = 256, BK = 64, HALF = 128, HTB = HALF * BK * 2  , STAGE_BYTES = 8 * HTB, NXCD = 8, WGM = 8;
__host__ __device__ __forceinline__ int lds_byte(int r, int c) { const int st = (r >> 4) * 2 + (c >> 5), rr = r & 15, cc = c & 31, ob = rr * 64 + cc * 2; return st * 1024 + (ob ^ (((ob >> 9) & 1) << 5)); }
__host__ __device__ __forceinline__ void stage_rc(int b, int& R, int& C) { const int st = b / 1024, sb = b % 1024, swz = sb ^ (((sb >> 9) & 1) << 5); R = (st >> 1) * 16 + swz / 64; C = (st & 1) * 32 + (swz % 64) / 2; }
__host__ __device__ __forceinline__ int perm32(int rho) { const int n = rho >> 4, i = rho & 15; return 8 * (i >> 2) + 4 * n + (i & 3); }
struct Unit { int pm, pn; };
struct Order {
    int nM, nN, nwg, G, c;
    const bf16_t* Bt; size_t bt_group_stride; int pend[8];
    const int* rows;
    __device__ void init(int nM_, int nN_, int G_, int c_, const bf16_t* Bt_) { nM = nM_; nN = nN_; nwg = nM * nN; G = G_; c = c_; Bt = Bt_; bt_group_stride = 0; rows = nullptr;
#pragma unroll
        for (int k = 0; k < 8; ++k) pend[k] = 0x7fffffff; }
    __device__ bool next(int i, Unit& u) const {
        const long L = (long)i * G + c; if (L >= nwg) return false;
        int wgid = (int)L; { const int q = nwg / NXCD, r = nwg % NXCD, xcd = wgid % NXCD, off = wgid / NXCD; wgid = (xcd < r ? xcd * (q + 1) : r * (q + 1) + (xcd - r) * q) + off; }
        const int nig = WGM * nN, gid = wgid / nig, fm = gid * WGM, gsz = (nM - fm) < WGM ? (nM - fm) : WGM;
        u.pm = fm + ((wgid % nig) % gsz); u.pn = (wgid % nig) / gsz; return true;
    }
    __device__ __forceinline__ int group(int pm) const { int e = 0;
#pragma unroll
        for (int k = 0; k < 7; ++k) e += (pm >= pend[k]) ? 1 : 0; return e; }
    __device__ __forceinline__ const bf16_t* bt(const Unit& u) const { return Bt + (size_t)group(u.pm) * bt_group_stride; }
    __device__ __forceinline__ int row(const Unit& u, int r) const { const int t = rows[(size_t)u.pm * BM + r]; return t < 0 ? 0 : t; }
};
__device__ __forceinline__ unsigned cvt_pk_bf16(float lo, float hi) { unsigned r; asm volatile("v_cvt_pk_bf16_f32 %0, %1, %2" : "=v"(r) : "v"(lo), "v"(hi)); return r; }

struct EpiBf16 {
    static constexpr bool PERM = true;
    bf16_t* O; int ldc;
    __device__ __forceinline__ void operator()(const f32x4 (&acc)[2][2][4][2], const Unit& u, int wr, int wc, int fr, int fq) const {
        const int row0 = u.pm * BM + wr * 64 + fr, col0 = u.pn * BM + wc * 32 + 8 * fq;
#pragma unroll
        for (int ai = 0; ai < 2; ++ai)
#pragma unroll
            for (int m = 0; m < 4; ++m) { bf16_t* rowp = O + (size_t)(row0 + ai * HALF + m * 16) * ldc + col0;
#pragma unroll
                for (int bj = 0; bj < 2; ++bj) { const f32x4 v0 = acc[ai][bj][m][0], v1 = acc[ai][bj][m][1];
                    u32x4 w; w.x = cvt_pk_bf16(v0[0], v0[1]); w.y = cvt_pk_bf16(v0[2], v0[3]); w.z = cvt_pk_bf16(v1[0], v1[1]); w.w = cvt_pk_bf16(v1[2], v1[3]);
                    *(u32x4*)(rowp + bj * HALF) = w; } }
    }
};
__device__ __forceinline__ float silu_fast(float v) { return v * __builtin_amdgcn_rcpf(1.0f + __builtin_amdgcn_exp2f(-1.4426950408889634f * v)); }
struct EpiSwiGLU {
    static constexpr bool PERM = true;
    bf16_t* H; int ldc;
    __device__ __forceinline__ void operator()(const f32x4 (&acc)[2][2][4][2], const Unit& u, int wr, int wc, int fr, int fq) const {
        const int row0 = u.pm * BM + wr * 64 + fr, col0 = u.pn * HALF + wc * 32 + 8 * fq;
#pragma unroll
        for (int ai = 0; ai < 2; ++ai)
#pragma unroll
            for (int m = 0; m < 4; ++m) { bf16_t* rowp = H + (size_t)(row0 + ai * HALF + m * 16) * ldc + col0;
                const f32x4 g0 = acc[ai][0][m][0], g1 = acc[ai][0][m][1], u0 = acc[ai][1][m][0], u1 = acc[ai][1][m][1];
                u32x4 w; w.x = cvt_pk_bf16(silu_fast(g0[0]) * u0[0], silu_fast(g0[1]) * u0[1]); w.y = cvt_pk_bf16(silu_fast(g0[2]) * u0[2], silu_fast(g0[3]) * u0[3]);
                w.z = cvt_pk_bf16(silu_fast(g1[0]) * u1[0], silu_fast(g1[1]) * u1[1]); w.w = cvt_pk_bf16(silu_fast(g1[2]) * u1[2], silu_fast(g1[3]) * u1[3]);
                *(u32x4*)rowp = w; }
    }
};
struct EpiResGate {
    static constexpr bool PERM = false;
    const float *xs, *cs; float *xd, *cd; const float* gate;
    __device__ __forceinline__ void operator()(const f32x4 (&acc)[2][2][4][2], const Unit& u, int wr, int wc, int fr, int fq) const {
        const bool lat = u.pm < MX / BM; const int prow = (lat ? u.pm : u.pm - MX / BM) * BM + wr * 64 + fr, col0 = u.pn * BM + wc * 32 + 4 * fq;
        const float* s = lat ? xs : cs; float* d = lat ? xd : cd; const float* g = gate + (size_t)(lat ? u.pm / (S / BM) : 8) * 6 * D + col0;
        f32x4 gv[2][2];
#pragma unroll
        for (int bj = 0; bj < 2; ++bj)
#pragma unroll
            for (int n = 0; n < 2; ++n) gv[bj][n] = *(const f32x4*)(g + bj * HALF + n * 16);
#pragma unroll
        for (int ai = 0; ai < 2; ++ai)
#pragma unroll
            for (int m = 0; m < 4; ++m) { const size_t off = (size_t)(prow + ai * HALF + m * 16) * D + col0;
#pragma unroll
                for (int bj = 0; bj < 2; ++bj)
#pragma unroll
                    for (int n = 0; n < 2; ++n) *(f32x4*)(d + off + bj * HALF + n * 16) = *(const f32x4*)(s + off + bj * HALF + n * 16) + gv[bj][n] * acc[ai][bj][m][n]; }
    }
};
struct EpiMoeDown {
    static constexpr bool PERM = false;
    const int* list; const float* topw; int pass; float* x; const float* gate;
    __device__ __forceinline__ void operator()(const f32x4 (&acc)[2][2][4][2], const Unit& u, int wr, int wc, int fr, int fq) const {
        const int slot0 = u.pm * BM + wr * 64 + fr, col0 = u.pn * BM + wc * 32 + 4 * fq;
#pragma unroll
        for (int ai = 0; ai < 2; ++ai)
#pragma unroll
            for (int m = 0; m < 4; ++m) { const int tok = list[slot0 + ai * HALF + m * 16];
                if (tok >= 0) { const float w = topw[tok * 2 + pass]; const float* g = gate + (size_t)(tok / S) * 6 * D + col0; float* xr = x + (size_t)tok * D + col0;
#pragma unroll
                    for (int bj = 0; bj < 2; ++bj)
#pragma unroll
                        for (int n = 0; n < 2; ++n) { const f32x4 gv = *(const f32x4*)(g + bj * HALF + n * 16); f32x4* xp = (f32x4*)(xr + bj * HALF + n * 16); *xp = *xp + gv * w * acc[ai][bj][m][n]; } } }
    }
};

template <class Epi, bool ALIGN_EPI, bool GATHER>
__device__ __forceinline__ void gemm_phase(PG8_LAS unsigned char* lds, const bf16_t* A, int K, const Order& S, const Epi& E) {
    int tid_ = threadIdx.x; asm volatile("" : "+v"(tid_));
    const int tid = tid_, wid = __builtin_amdgcn_readfirstlane(tid >> 6), lane = tid & 63, wr = wid >> 2, wc = wid & 3, fr = lane & 15, fq = lane >> 4;
    const int nt = K / BK;
    unsigned voffB[2]; int RA[2], CA[2];
#pragma unroll
    for (int i = 0; i < 2; ++i) { int R, C; stage_rc(tid * 16 + i * 8192, R, C); const int Rb = Epi::PERM ? ((R & ~31) + perm32(R & 31)) : R; RA[i] = R; CA[i] = C; voffB[i] = (unsigned)(Rb * K + C) * 2u; }
    const size_t kstep = (size_t)(BK * 2);
    const size_t hstep = (size_t)HALF * K * 2;
    const size_t tstep = 2 * hstep;
    const unsigned ldsw = (unsigned)wid * 1024u;
    const int aoff = lds_byte(wr * 64 + fr, fq * 8), boff = lds_byte(wc * 32 + fr, fq * 8);
#define PG8_SA(b, h) (((b) * 2 + (h)) * HTB)
#define PG8_SB(b, h) ((4 + (b) * 2 + (h)) * HTB)
#define PG8_STAGE_B(bufoff, gbase) do { _Pragma("unroll") for (int _i = 0; _i < 2; ++_i) \
        __builtin_amdgcn_global_load_lds((const unsigned*)((const char*)(gbase) + voffB[_i]), (PG8_LAS unsigned*)(lds + (bufoff) + ldsw + _i * 8192), 16, 0, 0); } while (0)
#define PG8_STAGE_A(bufoff, gbase, o0, o1) do { \
        __builtin_amdgcn_global_load_lds((const unsigned*)((const char*)(gbase) + (o0)), (PG8_LAS unsigned*)(lds + (bufoff) + ldsw), 16, 0, 0); \
        __builtin_amdgcn_global_load_lds((const unsigned*)((const char*)(gbase) + (o1)), (PG8_LAS unsigned*)(lds + (bufoff) + ldsw + 8192), 16, 0, 0); } while (0)
#define PG8_LDA(dst, b, h) do { _Pragma("unroll") for (int m = 0; m < 4; ++m) _Pragma("unroll") for (int k = 0; k < 2; ++k) dst[m][k] = *(const PG8_LAS bf16x8*)(lds + PG8_SA(b, h) + aoff + m * 2048 + k * 1024); } while (0)
#define PG8_LDB(dst, b, h) do { _Pragma("unroll") for (int n = 0; n < 2; ++n) _Pragma("unroll") for (int k = 0; k < 2; ++k) dst[n][k] = *(const PG8_LAS bf16x8*)(lds + PG8_SB(b, h) + boff + n * 2048 + k * 1024); } while (0)
#define PG8_MMA(ai, bj, At, Bt) do { __builtin_amdgcn_s_setprio(1); _Pragma("unroll") for (int m = 0; m < 4; ++m) _Pragma("unroll") for (int n = 0; n < 2; ++n) _Pragma("unroll") for (int k = 0; k < 2; ++k) \
        acc[ai][bj][m][n] = __builtin_amdgcn_mfma_f32_16x16x32_bf16(Bt[n][k], At[m][k], acc[ai][bj][m][n], 0, 0, 0); __builtin_amdgcn_s_setprio(0); } while (0)
#define PG8_WAIT_V(n) asm volatile("s_waitcnt vmcnt(" #n ")" ::: "memory")
#define PG8_WAIT_L(n) asm volatile("s_waitcnt lgkmcnt(" #n ")" ::: "memory")
#define PG8_BAR __builtin_amdgcn_s_barrier()
#define PG8_SCHED __builtin_amdgcn_sched_barrier(0)
    Unit cur, nxt, nx2; int ui = 0;
    if (!S.next(0, cur)) return;
    f32x4 acc[2][2][4][2];
#pragma unroll
    for (int a = 0; a < 2; ++a)
#pragma unroll
        for (int b = 0; b < 2; ++b)
#pragma unroll
            for (int m = 0; m < 4; ++m)
#pragma unroll
                for (int n = 0; n < 2; ++n) acc[a][b][m][n] = (f32x4){0.f, 0.f, 0.f, 0.f};
    bf16x8 At[4][2], B0[2][2], B1[2][2];
    unsigned oc00, oc01, oc10, oc11, on00, on01, on10, on11, o200 = 0, o201 = 0, o210 = 0, o211 = 0;
    const char* cA; const char* cB = (const char*)S.bt(cur) + (size_t)cur.pn * tstep;
    bool has_next = S.next(1, nxt), has_nx2 = false;
    if constexpr (GATHER) {
        cA = (const char*)A;
        oc00 = (unsigned)(S.row(cur, RA[0]) * K + CA[0]) * 2u; oc01 = (unsigned)(S.row(cur, RA[1]) * K + CA[1]) * 2u;
        oc10 = (unsigned)(S.row(cur, HALF + RA[0]) * K + CA[0]) * 2u; oc11 = (unsigned)(S.row(cur, HALF + RA[1]) * K + CA[1]) * 2u;
        if (has_next) { on00 = (unsigned)(S.row(nxt, RA[0]) * K + CA[0]) * 2u; on01 = (unsigned)(S.row(nxt, RA[1]) * K + CA[1]) * 2u;
                        on10 = (unsigned)(S.row(nxt, HALF + RA[0]) * K + CA[0]) * 2u; on11 = (unsigned)(S.row(nxt, HALF + RA[1]) * K + CA[1]) * 2u; }
        else { on00 = oc00; on01 = oc01; on10 = oc10; on11 = oc11; }
    } else {
        cA = (const char*)A + (size_t)cur.pm * tstep;
        oc00 = on00 = (unsigned)(RA[0] * K + CA[0]) * 2u; oc01 = on01 = (unsigned)(RA[1] * K + CA[1]) * 2u; oc10 = on10 = oc00 + (unsigned)hstep; oc11 = on11 = oc01 + (unsigned)hstep;
    }
    PG8_STAGE_B(PG8_SB(0, 0), cB); PG8_STAGE_B(PG8_SB(0, 1), cB + hstep); PG8_STAGE_A(PG8_SA(0, 0), cA, oc00, oc01); PG8_STAGE_A(PG8_SA(0, 1), cA, oc10, oc11);
    if (wr == 1) PG8_BAR;
    PG8_WAIT_V(2); PG8_BAR;
    PG8_STAGE_B(PG8_SB(1, 0), cB + kstep); PG8_STAGE_A(PG8_SA(1, 0), cA + kstep, oc00, oc01); PG8_STAGE_B(PG8_SB(1, 1), cB + hstep + kstep);
    PG8_WAIT_V(6); PG8_BAR;
    for (;;) {
        if constexpr (GATHER) {
            has_nx2 = has_next && S.next(ui + 2, nx2);
            if (has_nx2) { o200 = (unsigned)(S.row(nx2, RA[0]) * K + CA[0]) * 2u; o201 = (unsigned)(S.row(nx2, RA[1]) * K + CA[1]) * 2u;
                           o210 = (unsigned)(S.row(nx2, HALF + RA[0]) * K + CA[0]) * 2u; o211 = (unsigned)(S.row(nx2, HALF + RA[1]) * K + CA[1]) * 2u; }
        }
        const char* nA = GATHER ? cA : (has_next ? (const char*)A + (size_t)nxt.pm * tstep : cA);
        const char* nB = has_next ? (const char*)S.bt(nxt) + (size_t)nxt.pn * tstep : cB;
        for (int t = 0; t < nt; t += 2) {
            const bool last = (t == nt - 2);
            const char* a1 = cA + (size_t)(t + 1) * kstep;
            const char* a2 = last ? nA : cA + (size_t)(t + 2) * kstep; const char* b2 = last ? nB : cB + (size_t)(t + 2) * kstep;
            const char* a3 = a2 + kstep; const char* b3 = b2 + kstep;
            unsigned s00 = oc00, s01 = oc01, s10 = oc10, s11 = oc11;
            if constexpr (GATHER) { if (last) { s00 = on00; s01 = on01; s10 = on10; s11 = on11; } }
            PG8_LDB(B0, 0, 0); PG8_LDB(B1, 0, 1); PG8_SCHED; PG8_LDA(At, 0, 0); PG8_STAGE_A(PG8_SA(1, 1), a1, oc10, oc11);
            PG8_WAIT_V(8); PG8_WAIT_L(0); PG8_BAR; PG8_MMA(0, 0, At, B0); PG8_MMA(0, 1, At, B1); PG8_BAR; PG8_SCHED;
            PG8_LDA(At, 0, 1); PG8_STAGE_B(PG8_SB(0, 0), b2); PG8_STAGE_B(PG8_SB(0, 1), b2 + hstep); PG8_STAGE_A(PG8_SA(0, 0), a2, s00, s01);
            PG8_WAIT_V(8); PG8_WAIT_L(0); PG8_BAR; PG8_MMA(1, 0, At, B0); PG8_MMA(1, 1, At, B1); PG8_BAR; PG8_SCHED;
            PG8_LDB(B0, 1, 0); PG8_LDB(B1, 1, 1); PG8_SCHED; PG8_LDA(At, 1, 0); PG8_STAGE_A(PG8_SA(0, 1), a2, s10, s11);
            PG8_WAIT_V(8); PG8_WAIT_L(0); PG8_BAR; PG8_MMA(0, 0, At, B0); PG8_MMA(0, 1, At, B1); PG8_BAR; PG8_SCHED;
            PG8_LDA(At, 1, 1); PG8_STAGE_B(PG8_SB(1, 0), b3); PG8_STAGE_B(PG8_SB(1, 1), b3 + hstep); PG8_STAGE_A(PG8_SA(1, 0), a3, s00, s01);
            PG8_WAIT_V(8); PG8_WAIT_L(0); PG8_BAR; PG8_MMA(1, 0, At, B0); PG8_MMA(1, 1, At, B1); PG8_BAR; PG8_SCHED;
        }
        if constexpr (ALIGN_EPI) { if (wr == 0) PG8_BAR; }
        E(acc, cur, wr, wc, fr, fq);
        if (!has_next) break;
#pragma unroll
        for (int a = 0; a < 2; ++a)
#pragma unroll
            for (int b = 0; b < 2; ++b)
#pragma unroll
                for (int m = 0; m < 4; ++m)
#pragma unroll
                    for (int n = 0; n < 2; ++n) acc[a][b][m][n] = (f32x4){0.f, 0.f, 0.f, 0.f};
        cur = nxt; cA = nA; cB = nB; ++ui;
        if constexpr (GATHER) { oc00 = on00; oc01 = on01; oc10 = on10; oc11 = on11; nxt = nx2; has_next = has_nx2; if (has_nx2) { on00 = o200; on01 = o201; on10 = o210; on11 = o211; } }
        else has_next = S.next(ui + 1, nxt);
        if constexpr (ALIGN_EPI) { if (wr == 1) PG8_BAR; }
    }
    PG8_WAIT_V(0);
    if constexpr (!ALIGN_EPI) { if (wr == 0) PG8_BAR; }
    PG8_BAR;
#undef PG8_SA
#undef PG8_SB
#undef PG8_STAGE_A
#undef PG8_STAGE_B
#undef PG8_LDA
#undef PG8_LDB
#undef PG8_MMA
#undef PG8_WAIT_V
#undef PG8_WAIT_L
#undef PG8_BAR
#undef PG8_SCHED
}
}


#include <hip/hip_bf16.h>
namespace attn_body {
using bf16=__hip_bfloat16;
using bf16x8=__attribute__((ext_vector_type(8)))short;
using s16x4=__attribute__((ext_vector_type(4)))short;
using f32x16=__attribute__((ext_vector_type(16)))float;
using u32x4=__attribute__((ext_vector_type(4)))unsigned;
constexpr int D=64,DM=NP;
constexpr int NW=8,QBLK=32,QB=QBLK*NW,KVBLK=64;
__device__ __forceinline__ int crow(int r,int hi){return (r&3)+8*(r>>2)+4*hi;}
#define SBAR() __builtin_amdgcn_sched_barrier(0)
constexpr int NSLOT=3, SLOTB=8192;
constexpr int LDS_K=0, LDS_V=NSLOT*SLOTB, LDS_WS=2*NSLOT*SLOTB, LDS_OST=LDS_WS+NW*64*4, LDS_TAB=LDS_OST+NW*4096, LDS_BYTES=LDS_TAB+2048;
constexpr float C2=0.125f*1.4426950408889634f;
__device__ __forceinline__ void glds16(const void*gsrc,unsigned lds_dst){unsigned keep;
  asm volatile("s_mov_b32 %0, m0\n\ts_mov_b32 m0, %2\n\ts_nop 0\n\tglobal_load_lds_dwordx4 %1, off\n\ts_mov_b32 m0, %0":"=&s"(keep):"v"(gsrc),"s"(lds_dst):"memory");}
__device__ __forceinline__ float max3f(float a,float b,float c){float r;asm("v_max3_f32 %0, %1, %2, %3":"=v"(r):"v"(a),"v"(b),"v"(c));return r;}
__device__ __forceinline__ float max2f(float a,float b){float r;asm("v_max_f32_e32 %0, %1, %2":"=v"(r):"v"(a),"v"(b));return r;}
__device__ __forceinline__ float fadd_s(float a,float b){float r;asm("v_add_f32_e32 %0, %1, %2":"=v"(r):"v"(a),"v"(b));return r;}
__device__ __forceinline__ float fsub_s(float a,float b){float r;asm("v_sub_f32_e32 %0, %1, %2":"=v"(r):"v"(a),"v"(b));return r;}
typedef float f32x2_t __attribute__((ext_vector_type(2))); typedef __bf16 bf16x2_t __attribute__((ext_vector_type(2)));
__device__ __forceinline__ unsigned cvtpk_s(float lo,float hi){f32x2_t v={lo,hi};bf16x2_t b=__builtin_convertvector(v,bf16x2_t);return __builtin_bit_cast(unsigned,b);}
#define WAIT_BAR(N) asm volatile("s_waitcnt vmcnt(" #N ") lgkmcnt(0)\n\ts_barrier":::"memory")

__device__ __forceinline__ void qkt(f32x16&p0,f32x16&p1,const char*Kslot,const bf16x8*qr,const f32x16&negm,int r32,int hi){
  const char*kb=Kslot+hi*1024+r32*16;
  #pragma unroll
  for(int d0=0;d0<4;++d0){
    const bf16x8 b0=*reinterpret_cast<const bf16x8*>(kb+d0*2048);
    const bf16x8 b1=*reinterpret_cast<const bf16x8*>(kb+d0*2048+512);
    if(d0==0){p0=__builtin_amdgcn_mfma_f32_32x32x16_bf16(b0,qr[0],negm,0,0,0);p1=__builtin_amdgcn_mfma_f32_32x32x16_bf16(b1,qr[0],negm,0,0,0);}
    else{p0=__builtin_amdgcn_mfma_f32_32x32x16_bf16(b0,qr[d0],p0,0,0,0);p1=__builtin_amdgcn_mfma_f32_32x32x16_bf16(b1,qr[d0],p1,0,0,0);}}
}
typedef __attribute__((address_space(3))) const char* lds_cptr;
typedef short v4i16_t __attribute__((ext_vector_type(4)));
__device__ __forceinline__ void kload8(bf16x8*kf,lds_cptr kp){
  kf[0]=*(const __attribute__((address_space(3))) bf16x8*)(kp);      kf[1]=*(const __attribute__((address_space(3))) bf16x8*)(kp+512);
  kf[2]=*(const __attribute__((address_space(3))) bf16x8*)(kp+2048); kf[3]=*(const __attribute__((address_space(3))) bf16x8*)(kp+2560);
  kf[4]=*(const __attribute__((address_space(3))) bf16x8*)(kp+4096); kf[5]=*(const __attribute__((address_space(3))) bf16x8*)(kp+4608);
  kf[6]=*(const __attribute__((address_space(3))) bf16x8*)(kp+6144); kf[7]=*(const __attribute__((address_space(3))) bf16x8*)(kp+6656);
}
__device__ __forceinline__ void kload2(bf16x8*kf,lds_cptr kp,int j){ kf[2*j]=*(const __attribute__((address_space(3))) bf16x8*)(kp+j*2048); kf[2*j+1]=*(const __attribute__((address_space(3))) bf16x8*)(kp+j*2048+512); }
__device__ __forceinline__ s16x4 vtr(lds_cptr p){ return __builtin_bit_cast(s16x4,__builtin_amdgcn_ds_read_tr16_b64_v4i16((__attribute__((address_space(3))) v4i16_t*)p)); }
__device__ __forceinline__ float rowmax(const f32x16&p0,const f32x16&p1){
  float a=max3f(p0[0],p0[1],p1[0]),b=max3f(p0[2],p0[3],p1[1]);a=max3f(a,p1[2],p1[3]);
  #pragma unroll
  for(int r=4;r<16;r+=4){a=max3f(a,p0[r],p0[r+1]);b=max3f(b,p0[r+2],p0[r+3]);a=max3f(a,p1[r],p1[r+1]);b=max3f(b,p1[r+2],p1[r+3]);}
  const float m=max2f(a,b);
  auto rr=__builtin_amdgcn_permlane32_swap(__float_as_uint(m),__float_as_uint(m),false,false);
  return max2f(__uint_as_float(rr[0]),__uint_as_float(rr[1]));
}
__device__ __forceinline__ void pv(f32x16*o,int vb,bf16x8 pa0,bf16x8 pa1,bf16x8 pa2,bf16x8 pa3){
  #pragma unroll
  for(int d0=0;d0<2;++d0){s16x4 lo[4],hi[4];
    #pragma unroll
    for(int ks=0;ks<4;++ks){
      asm volatile("ds_read_b64_tr_b16 %0,%1 offset:%c2":"=&v"(lo[ks]):"v"(vb),"i"(d0*4096+ks*1024):"memory");
      asm volatile("ds_read_b64_tr_b16 %0,%1 offset:%c2":"=&v"(hi[ks]):"v"(vb),"i"(d0*4096+ks*1024+512):"memory");}
    asm volatile("s_waitcnt lgkmcnt(0)":::"memory");SBAR();
    #define PK(k) (bf16x8){lo[k][0],lo[k][1],lo[k][2],lo[k][3],hi[k][0],hi[k][1],hi[k][2],hi[k][3]}
    o[d0]=__builtin_amdgcn_mfma_f32_32x32x16_bf16(pa0,PK(0),o[d0],0,0,0);
    o[d0]=__builtin_amdgcn_mfma_f32_32x32x16_bf16(pa1,PK(1),o[d0],0,0,0);
    o[d0]=__builtin_amdgcn_mfma_f32_32x32x16_bf16(pa2,PK(2),o[d0],0,0,0);
    o[d0]=__builtin_amdgcn_mfma_f32_32x32x16_bf16(pa3,PK(3),o[d0],0,0,0);
    #undef PK
  }
}

#ifndef ATTN_STORE16
#define ATTN_STORE16(p,v) (*(u32x4*)(p)=(v))
#endif
__device__ __forceinline__ void na_mask(f32x16&P0,f32x16&P1,int tl,int klo,int nlat,int wr0,int qgr,int qcol,int cs,int hi,float mhat,const float*tab){
  if(tl<0){
    #pragma unroll
    for(int r=0;r<16;++r){P0[r]-=mhat;P1[r]-=mhat;}
    return; }
  const int krow=klo+tl; const bool rv=(tl<nlat)&&(krow>=wr0)&&(krow<wr0+8);
  if(!rv){
    #pragma unroll
    for(int r=0;r<16;++r){P0[r]=-INFINITY;P1[r]=-INFINITY;}
    return; }
  int hio=hi; asm volatile("":"+v"(hio));
  const float*tb=tab+(krow-qgr+7)*31+15-qcol+4*hio; const int kb=4*hio-cs;
  #pragma unroll
  for(int r=0;r<16;++r){ const int c0=(r&3)+8*(r>>2);
    const bool v0=(unsigned)(c0+kb)<16u, v1=(unsigned)(c0+32+kb)<16u;
    const float b0=tb[c0], b1=tb[c0+32];
    P0[r]=v0?(P0[r]-mhat)+b0:-INFINITY; P1[r]=v1?(P1[r]-mhat)+b1:-INFINITY; }
}
template<int THRL,int MODE> __device__ __forceinline__ void attn_unit(const int b,const int qrow0,const int klo,const int NT,const int nlat,const bf16*Qg,const bf16*__restrict__ Kg,const bf16*__restrict__ Vg,bf16*Og,const float*rpb,char*shm){
  const int tid=threadIdx.x,lane=tid&63,r32=lane&31,hi=lane>>5; const int wid=__builtin_amdgcn_readfirstlane(tid>>6);
  const bf16*Qw=Qg+((long)qrow0+wid*QBLK)*DM;
  #define TROW(t) ((long)(MODE==0 ? ((t)<S/64 ? (long)b*S+64*(t) : (long)MX+(long)b*LC+64*((t)-S/64)) : MODE==1 ? ((t)<LC/64 ? (long)MX+(long)b*LC+64*(t) : (long)b*S+64*(klo+((t)-LC/64<nlat?(t)-LC/64:nlat-1))) : (long)MX+(long)b*LC+64*(t)))
  const unsigned lds0=(unsigned)(uintptr_t)shm;
  float*wsf=(float*)(shm+LDS_WS)+wid*64;
  const bf16*ksrc=Kg+(long)lane*DM+wid*8;
  const bf16*vsrc=Vg+(long)(16*(wid&3)+(lane>>2))*DM+(wid>>2)*32+(lane&3)*8;
  const unsigned kdst=lds0+LDS_K+wid*1024, vdst=lds0+LDS_V+wid*1024;
  #define DMA_K(t,slot) glds16(ksrc+TROW(t)*DM,(unsigned)__builtin_amdgcn_readfirstlane(kdst+(slot)))
  #define DMA_V(t,slot) glds16(vsrc+TROW(t)*DM,(unsigned)__builtin_amdgcn_readfirstlane(vdst+(slot)))
  const int vb0=(int)(lds0+LDS_V)+((lane>>4)&1)*32+(lane&3)*8+(4*hi+((lane&15)>>2))*64;
  const char*Kbase=shm+LDS_K; bf16x8 kf[8];
  const lds_cptr shm3=(lds_cptr)shm; const lds_cptr kp0=shm3+LDS_K+hi*1024+r32*16; const lds_cptr vp0=shm3+LDS_V+((lane>>4)&1)*32+(lane&3)*8+(4*hi+((lane&15)>>2))*64;
  DMA_K(0,0);DMA_V(0,0);DMA_K(1,SLOTB);
  bf16x8 qr[4];
  #pragma unroll
  for(int d0=0;d0<4;++d0)qr[d0]=*reinterpret_cast<const bf16x8*>(&Qw[(long)r32*DM+d0*16+hi*8]);
  float mhat=0.f,l_reg=0.f;f32x16 o[2];o[0]=f32x16{};o[1]=f32x16{};f32x16 negm=f32x16{}; if(MODE!=1){asm volatile("":"+v"(negm));} const f32x16 zero16_=f32x16{};
  #define NEGM_ (MODE==1?zero16_:negm)
  const int qcol=32*(wid&1)+r32, qgr=(qrow0%S)/64+(wid>>1); int cs_=qcol-8; cs_=cs_<0?0:(cs_>48?48:cs_); int wr0_=qgr-4; wr0_=wr0_<0?0:(wr0_>S/64-8?S/64-8:wr0_);
  const float*tab=(const float*)(shm+LDS_TAB);
  if(MODE==1){ for(int i_=tid;i_<15*31;i_+=512)((float*)(shm+LDS_TAB))[i_]=rpb[i_]*1.4426950408889634f; }
  #define CMASK(P0,P1,t) do{ if(MODE==1){ na_mask(P0,P1,(t)-LC/64,klo,nlat,wr0_,qgr,qcol,cs_,hi,mhat,tab); } }while(0)
  bool resc=false;
  #define START(P0,P1) do{ const float rm=rowmax(P0,P1); resc=false; \
    { const float dl=rm; mhat=fadd_s(mhat,dl); \
      _Pragma("unroll") for(int r=0;r<16;++r){P0[r]=fsub_s(P0[r],dl);P1[r]=fsub_s(P1[r],dl);} \
      if(MODE!=1){ _Pragma("unroll") for(int r=0;r<16;++r)negm[r]=-mhat; asm volatile("":"+v"(negm)); } } \
    _Pragma("unroll") for(int r=0;r<16;++r)P0[r]=__builtin_amdgcn_exp2f(P0[r]); }while(0)
  #define RESC() do{ if(resc){ asm volatile("s_waitcnt lgkmcnt(0)":::"memory"); \
      _Pragma("unroll") for(int d_=0;d_<2;++d_) _Pragma("unroll") for(int r=0;r<16;++r)o[d_][r]*=wsf[crow(r,hi)]; } }while(0)
  f32x16 pA0,pA1,pB0,pB1;
  int sl_prev=0,sl_cur=0,sl_next=SLOTB;
  #define ROT() do{sl_prev=sl_cur;sl_cur=sl_next;sl_next=(sl_next==(NSLOT-1)*SLOTB)?0:sl_next+SLOTB;}while(0)
  DMA_K(2,2*SLOTB);
  WAIT_BAR(3);
  qkt(pA0,pA1,Kbase,qr,NEGM_,r32,hi);asm volatile("s_nop 15\n\ts_nop 7":"+v"(pA0),"+v"(pA1));CMASK(pA0,pA1,0);
  START(pA0,pA1);
  _Pragma("unroll") for(int r=0;r<16;++r)pA1[r]=__builtin_amdgcn_exp2f(pA1[r]);
  WAIT_BAR(0);
  DMA_K(3,0);DMA_V(1,SLOTB);
  ROT();
  kload8(kf,kp0+sl_cur);
  WAIT_BAR(2);
  s16x4 vlo[8],vhi[8]; u32x4 pw0,pw1,pw2,pw3;
  #define PKW(P,B) cvtpk_s(P[B],P[B+1])
  #define PAF(k) __builtin_bit_cast(bf16x8,pw##k)
  #define VFR(i) (bf16x8){vlo[i][0],vlo[i][1],vlo[i][2],vlo[i][3],vhi[i][0],vhi[i][1],vhi[i][2],vhi[i][3]}
  #define PIN(x) asm volatile("":"+v"(x))
  #define MX3(a,b,c) __builtin_fmaxf(__builtin_fmaxf((a),(b)),(c))
  #define GAPA(MF,A0,A1,A2,A3,W0,W1,PW) do{ MF; sacc+=A0; sacc+=A1; sacc+=A2; sacc+=A3; PIN(sacc); W0; W1; PIN(PW); SBAR(); }while(0)
  #define EX(v) __builtin_amdgcn_exp2f(v)
  #define GAPB(MF,X,B) do{ MF; X[B]=EX(X[B]); X[B+1]=EX(X[B+1]); X[B+2]=EX(X[B+2]); X[B+3]=EX(X[B+3]); PIN(X); SBAR(); }while(0)
  #define VRD(i) do{ vlo[i]=vtr(vp_+(((i)>>2)*4096+((i)&3)*1024)); vhi[i]=vtr(vp_+(((i)>>2)*4096+((i)&3)*1024+512)); }while(0)
  #define KRD(G,j) do{ if(G){ kload2(kf,kp0+sl_next,j); SBAR(); } }while(0)
  #define STEP(C0,C1,P0,P1,t,GK,GV,GL) do{ SBAR(); \
    const lds_cptr vp_=vp0+sl_prev; \
    VRD(0); SBAR(); float sacc=(P0[0]+P0[1]); \
    GAPA(C0=__builtin_amdgcn_mfma_f32_32x32x16_bf16(kf[0],qr[0],NEGM_,0,0,0), P0[2],P0[3],P0[4],P0[5],     pw0[0]=PKW(P0,0), pw0[1]=PKW(P0,2), pw0); \
    VRD(4); SBAR(); GAPA(C1=__builtin_amdgcn_mfma_f32_32x32x16_bf16(kf[1],qr[0],NEGM_,0,0,0), P0[6],P0[7],P0[8],P0[9],     pw0[2]=PKW(P0,4), pw0[3]=PKW(P0,6), pw0); \
    VRD(1); SBAR(); GAPA(C0=__builtin_amdgcn_mfma_f32_32x32x16_bf16(kf[2],qr[1],C0,0,0,0),   P0[10],P0[11],P0[12],P0[13], pw1[0]=PKW(P0,8), pw1[1]=PKW(P0,10), pw1); \
    VRD(5); SBAR(); GAPA(C1=__builtin_amdgcn_mfma_f32_32x32x16_bf16(kf[3],qr[1],C1,0,0,0),   P0[14],P0[15],P1[0],P1[1],   pw1[2]=PKW(P0,12),pw1[3]=PKW(P0,14), pw1); \
    VRD(2); SBAR(); GAPA(C0=__builtin_amdgcn_mfma_f32_32x32x16_bf16(kf[4],qr[2],C0,0,0,0),   P1[2],P1[3],P1[4],P1[5],     pw2[0]=PKW(P1,0), pw2[1]=PKW(P1,2), pw2); \
    VRD(6); SBAR(); GAPA(C1=__builtin_amdgcn_mfma_f32_32x32x16_bf16(kf[5],qr[2],C1,0,0,0),   P1[6],P1[7],P1[8],P1[9],     pw2[2]=PKW(P1,4), pw2[3]=PKW(P1,6), pw2); \
    VRD(3); SBAR(); GAPA(C0=__builtin_amdgcn_mfma_f32_32x32x16_bf16(kf[6],qr[3],C0,0,0,0),   P1[10],P1[11],P1[12],P1[13], pw3[0]=PKW(P1,8), pw3[1]=PKW(P1,10), pw3); \
    VRD(7); SBAR(); GAPA(C1=__builtin_amdgcn_mfma_f32_32x32x16_bf16(kf[7],qr[3],C1,0,0,0),   P1[14],P1[15],0.f,0.f,       pw3[2]=PKW(P1,12),pw3[3]=PKW(P1,14), pw3); \
    l_reg+=sacc; \
    if(GK){DMA_K((t)+3,sl_cur);} if(GV){DMA_V((t)+1,sl_next);} \
    CMASK(C0,C1,t); \
    { float a=MX3(C0[0],C0[1],C1[0]),b=MX3(C0[2],C0[3],C1[1]); a=MX3(a,C1[2],C1[3]); \
      _Pragma("unroll") for(int r=4;r<16;r+=4){a=MX3(a,C0[r],C0[r+1]);b=MX3(b,C0[r+2],C0[r+3]);a=MX3(a,C1[r],C1[r+1]);b=MX3(b,C1[r+2],C1[r+3]);} \
      float rm=__builtin_fmaxf(a,b); { auto rr=__builtin_amdgcn_permlane32_swap(__float_as_uint(rm),__float_as_uint(rm),false,false); rm=__builtin_fmaxf(__uint_as_float(rr[0]),__uint_as_float(rr[1])); } \
      resc=false; \
      if(__builtin_expect(__any(rm>(float)THRL),0)){ const float dl=__builtin_fmaxf(rm,0.f); mhat+=dl; \
        _Pragma("unroll") for(int r=0;r<16;++r){C0[r]-=dl;C1[r]-=dl;} \
        if(MODE!=1){ _Pragma("unroll") for(int r=0;r<16;++r)negm[r]=-mhat; asm volatile("":"+v"(negm)); } \
        const float f=__builtin_amdgcn_exp2f(-dl); l_reg*=f; if(hi==0)wsf[r32]=f; resc=true; } } \
    SBAR(); \
    GAPB(o[0]=__builtin_amdgcn_mfma_f32_32x32x16_bf16(PAF(0),VFR(0),o[0],0,0,0), C0,0); \
    GAPB(o[1]=__builtin_amdgcn_mfma_f32_32x32x16_bf16(PAF(0),VFR(4),o[1],0,0,0), C0,4); \
    KRD(GL,0); GAPB(o[0]=__builtin_amdgcn_mfma_f32_32x32x16_bf16(PAF(1),VFR(1),o[0],0,0,0), C0,8); \
    KRD(GL,1); GAPB(o[1]=__builtin_amdgcn_mfma_f32_32x32x16_bf16(PAF(1),VFR(5),o[1],0,0,0), C0,12); \
    KRD(GL,2); GAPB(o[0]=__builtin_amdgcn_mfma_f32_32x32x16_bf16(PAF(2),VFR(2),o[0],0,0,0), C1,0); \
    KRD(GL,3); GAPB(o[1]=__builtin_amdgcn_mfma_f32_32x32x16_bf16(PAF(2),VFR(6),o[1],0,0,0), C1,4); \
    GAPB(o[0]=__builtin_amdgcn_mfma_f32_32x32x16_bf16(PAF(3),VFR(3),o[0],0,0,0), C1,8); \
    GAPB(o[1]=__builtin_amdgcn_mfma_f32_32x32x16_bf16(PAF(3),VFR(7),o[1],0,0,0), C1,12); \
    }while(0)
  int t=1;
  #undef CMASK
  #define CMASK(P0,P1,t) do{ if(MODE==1){ na_mask(P0,P1,(t)-LC/64,klo,nlat,wr0_,qgr,qcol,cs_,hi,mhat,tab); } }while(0)
  for(;t+5<NT;t+=2){
    STEP(pB0,pB1,pA0,pA1,t,true,true,true);     WAIT_BAR(2); RESC(); ROT();
    STEP(pA0,pA1,pB0,pB1,t+1,true,true,true);   WAIT_BAR(2); RESC(); ROT();
  }
  #undef CMASK
  #define CMASK(P0,P1,t) do{ if(MODE==1){ na_mask(P0,P1,(t)-LC/64,klo,nlat,wr0_,qgr,qcol,cs_,hi,mhat,tab); } }while(0)
  #define ENDW(tt) do{ if((tt)+3<NT){WAIT_BAR(2);} else if((tt)+2<NT){WAIT_BAR(1);} else {WAIT_BAR(0);} }while(0)
  for(;t+1<NT;t+=2){
    STEP(pB0,pB1,pA0,pA1,t,(t+3<NT),(t+1<NT),(t+1<NT));       ENDW(t);   RESC(); ROT();
    STEP(pA0,pA1,pB0,pB1,t+1,(t+4<NT),(t+2<NT),(t+2<NT));     ENDW(t+1); RESC(); ROT();
  }
  STEP(pB0,pB1,pA0,pA1,NT-1,false,false,false); RESC();
  { float sacc=pB0[0]+pB0[1]; _Pragma("unroll") for(int r=2;r<16;++r)sacc+=pB0[r]; _Pragma("unroll") for(int r=0;r<16;++r)sacc+=pB1[r]; l_reg+=sacc;
    pw0=(u32x4){PKW(pB0,0),PKW(pB0,2),PKW(pB0,4),PKW(pB0,6)};pw1=(u32x4){PKW(pB0,8),PKW(pB0,10),PKW(pB0,12),PKW(pB0,14)};pw2=(u32x4){PKW(pB1,0),PKW(pB1,2),PKW(pB1,4),PKW(pB1,6)};pw3=(u32x4){PKW(pB1,8),PKW(pB1,10),PKW(pB1,12),PKW(pB1,14)};
    SBAR(); pv(o,vb0+sl_cur,PAF(0),PAF(1),PAF(2),PAF(3)); }
  #undef PKW
  #undef PAF
  #undef VFR
  #undef PIN
  #undef MX3
  #undef GAPA
  #undef GAPB
  #undef EX
  #undef VRD
  #undef KRD
  #undef STEP
  #undef ENDW
  {auto rr=__builtin_amdgcn_permlane32_swap(__float_as_uint(l_reg),__float_as_uint(l_reg),false,false);l_reg=__uint_as_float(rr[0])+__uint_as_float(rr[1]);}
  if(hi==0)wsf[32+r32]=l_reg;asm volatile("s_waitcnt lgkmcnt(0)":::"memory");
  float rli[16];
  #pragma unroll
  for(int r=0;r<16;++r)rli[r]=__builtin_amdgcn_rcpf(wsf[32+crow(r,hi)]);
  bf16*Ow=Og+((long)qrow0+wid*QBLK)*DM;
  { bf16*stg=(bf16*)(shm+LDS_OST)+wid*2048;
    #pragma unroll
    for(int r=0;r<16;++r){const int orow=crow(r,hi);
      #pragma unroll
      for(int d0=0;d0<2;++d0)stg[orow*64+d0*32+r32]=__float2bfloat16(o[d0][r]*rli[r]);}
    asm volatile("s_waitcnt lgkmcnt(0)":::"memory");
    #pragma unroll
    for(int i=0;i<4;++i){const int row=i*8+(lane>>3),ch=lane&7; const u32x4 v=*(const u32x4*)(stg+row*64+ch*8); ATTN_STORE16(Ow+(long)row*DM+ch*8,v);} }
  asm volatile("s_waitcnt lgkmcnt(0)\n\ts_barrier":::"memory");
  #undef DMA_K
  #undef NEGM_
  #undef TROW
  #undef DMA_V
  #undef CMASK
  #undef START
  #undef RESC
  #undef ROT
}
constexpr int ATTN_LDS_BYTES=LDS_BYTES;
#undef SBAR
#undef WAIT_BAR
}
template <bool WITH_CTX> __device__ __forceinline__ void attn_phase(const Prm& p, int l, char* shm, int G) {
    using namespace attn_body;
    const int bx = blockIdx.x, vcu = (G % 8 == 0) ? (bx % 8) * (G / 8) + bx / 8 : bx;
    const attn_body::bf16* Pb = (const attn_body::bf16*)p.P;
    constexpr int NQB = S / 256;
    for (int u = vcu * 2; u < NB * NGA * NQB; u += 2 * G) {
#pragma unroll 1
        for (int j = 0; j < 2; ++j) { const int uu = u + j; if (uu >= NB * NGA * NQB) break; const int qb = uu % NQB, h = (uu / NQB) % NGA, b = uu / (NQB * NGA);
            attn_unit<8, 0>(b, b * S + 256 * qb, 0, S / 64 + LC / 64, 0, Pb + PC_GAQ + 64 * h, Pb + PC_GAK + 64 * h, Pb + PC_GAV + 64 * h, (attn_body::bf16*)Pb + PC_GAQ + 64 * h, nullptr, shm); }
    }
    for (int u = vcu * 3; u < NB * NNA * NQB; u += 3 * G) {
#pragma unroll 1
        for (int j = 0; j < 3; ++j) { const int uu = u + j; if (uu >= NB * NNA * NQB) break; const int qb = uu % NQB, h = (uu / NQB) % NNA, b = uu / (NQB * NNA);
            const int r0 = 4 * qb; int klo = r0 - 4; klo = klo < 0 ? 0 : (klo > ROWS - 8 ? ROWS - 8 : klo); int khi = r0 + 3 - 4; khi = (khi < 0 ? 0 : (khi > ROWS - 8 ? ROWS - 8 : khi)) + 7;
            const int nlat = khi - klo + 1, NT = (LC / 64 + nlat + 1) & ~1;
            attn_unit<8, 1>(b, b * S + 256 * qb, klo, NT, nlat, Pb + PC_NAQ + 64 * h, Pb + PC_NAK + 64 * h, Pb + PC_NAV + 64 * h, (attn_body::bf16*)Pb + PC_NAQ + 64 * h, p.na_rpb + ((size_t)l * NNA + h) * 15 * 31, shm); }
    }
    if constexpr (WITH_CTX) {
        static_assert(LC == 256, "context unit = one 256-row query block");
        for (int u = vcu; u < NB * (NNA + NGA); u += G) { const int hh = u % (NNA + NGA), b = u / (NNA + NGA);
            const int qo = hh < NNA ? PC_NAQ + 64 * hh : PC_GAQ + 64 * (hh - NNA), ko = hh < NNA ? PC_NAK + 64 * hh : PC_GAK + 64 * (hh - NNA), vo = hh < NNA ? PC_NAV + 64 * hh : PC_GAV + 64 * (hh - NNA);
            attn_unit<8, 2>(b, MX + b * LC, 0, LC / 64, 0, Pb + qo, Pb + ko, Pb + vo, (attn_body::bf16*)Pb + qo, nullptr, shm); }
    }
}


namespace hy {
typedef short bf16x8 __attribute__((ext_vector_type(8)));
typedef short s16x4 __attribute__((ext_vector_type(4)));
typedef float f32x16 __attribute__((ext_vector_type(16)));
typedef float f32x4 __attribute__((ext_vector_type(4)));
typedef unsigned u32x4 __attribute__((ext_vector_type(4)));
constexpr int NBLK = S / 128, FTP = 2 * S + 8, L_V = 0, L_F = NB * S * 2, FCOPY = 2 * S * 2 + 64, L_END = L_F + 3 * FCOPY + 2 * S * 2;
static_assert(NBLK == 32 && NB == 8, "hyena unit geometry: 32 sequence blocks of 128, 8 batches");
__device__ __forceinline__ void hyena_unit(const bf16* vg, const bf16* fg, float* yg, LAS unsigned char* lds) {
    int tid_ = threadIdx.x; asm volatile("" : "+v"(tid_));
    const int tid = tid_, wid = __builtin_amdgcn_readfirstlane(tid >> 6), lane = tid & 63, n = lane & 31, hi = lane >> 5;
#pragma unroll
    for (int i = 0; i < 8; ++i) { const int q = i * 512 + tid, rowg = q >> 4, ch = q & 15, rowL = (rowg & 31) * 8 + (rowg >> 5);
        const u32x4 v = *(const u32x4*)(vg + (size_t)q * 8); *(LAS u32x4*)(lds + L_V + rowL * 256 + ((ch ^ (rowL & 15)) << 4)) = v; }
#pragma unroll
    for (int i = 0; i < 2; ++i) { const int g = i * 512 + tid; const u32x4 a = *(const u32x4*)(fg + 8 * g), b = *(const u32x4*)(fg + 8 * g + 8);
        const unsigned w[8] = {a.x, a.y, a.z, a.w, b.x, b.y, b.z, b.w};
        u32x4 c1, c3;
#pragma unroll
        for (int k = 0; k < 4; ++k) { c1[k] = __builtin_amdgcn_alignbit(w[k + 1], w[k], 16); c3[k] = __builtin_amdgcn_alignbit(w[k + 2], w[k + 1], 16); }
        *(LAS u32x4*)(lds + L_F + 0 * FCOPY + g * 16) = a; *(LAS u32x4*)(lds + L_F + 1 * FCOPY + g * 16) = c1;
        *(LAS u32x4*)(lds + L_F + 2 * FCOPY + g * 16) = (u32x4){a.y, a.z, a.w, b.x}; *(LAS u32x4*)(lds + L_F + 3 * FCOPY + g * 16) = c3; }
    __syncthreads();
    f32x16 acc[4];
#pragma unroll
    for (int m = 0; m < 4; ++m) acc[m] = f32x16{};
    const int I0 = 4 * wid, I = I0 + (n >> 3), bb = n & 7;
#pragma unroll 1
    for (int cs = 0; cs < NBLK; ++cs) {
        const int rowL = ((I - cs) & 31) * 8 + bb;
        bf16x8 Bf[8];
#pragma unroll
        for (int s = 0; s < 8; ++s) Bf[s] = *(const LAS bf16x8*)(lds + L_V + rowL * 256 + (((2 * s + hi) ^ (rowL & 15)) << 4));
#pragma unroll 1
        for (int pass = 0; pass < 2; ++pass) {
            const bool any = pass == 0 ? (I0 + 3 >= cs) : (I0 < cs);
            if (!any) continue;
            const bool valid = pass == 0 ? (I >= cs) : (I < cs); const int d = pass == 0 ? cs : cs - NBLK;
            const int xb = S - 128 * d - 96 - n + 8 * hi, rho = xb & 3;
            const LAS unsigned char* fa = lds + L_F + rho * FCOPY + 2 * (xb - rho);
            bf16x8 Af[14];
#pragma unroll
            for (int o = 0; o < 14; ++o) { const s16x4 lo = *(const LAS s16x4*)(fa + (13 - o) * 32), hh = *(const LAS s16x4*)(fa + (13 - o) * 32 + 8);
                Af[o] = (bf16x8){lo[0], lo[1], lo[2], lo[3], hh[0], hh[1], hh[2], hh[3]}; }
            bf16x8 Bm[8];
#pragma unroll
            for (int s = 0; s < 8; ++s) Bm[s] = valid ? Bf[s] : (bf16x8){0, 0, 0, 0, 0, 0, 0, 0};
#pragma unroll
            for (int s = 0; s < 8; ++s)
#pragma unroll
                for (int m = 0; m < 4; ++m) acc[m] = __builtin_amdgcn_mfma_f32_32x32x16_bf16(Af[2 * m - s + 7], Bm[s], acc[m], 0, 0, 0);
        }
    }
    __syncthreads();
    LAS unsigned char* st = lds + wid * 16384;
#pragma unroll
    for (int m = 0; m < 4; ++m)
#pragma unroll
        for (int g = 0; g < 4; ++g) { const int q = 8 * m + 2 * g + hi; *(LAS f32x4*)(st + n * 512 + ((q ^ n) << 4)) = (f32x4){acc[m][4 * g], acc[m][4 * g + 1], acc[m][4 * g + 2], acc[m][4 * g + 3]}; }
    asm volatile("s_waitcnt lgkmcnt(0)" ::: "memory");
#pragma unroll
    for (int i = 0; i < 16; ++i) { const int rn = 2 * i + hi, q = n; const f32x4 v = *(const LAS f32x4*)(st + rn * 512 + ((q ^ rn) << 4));
        *(f32x4*)(yg + (size_t)(rn & 7) * S + (I0 + (rn >> 3)) * 128 + 4 * q) = v; }
    __syncthreads();
}
}
__device__ __forceinline__ void hyena_phase(const Prm& p, int l, LAS unsigned char* lds, int G) {
    const int bx = blockIdx.x;
    for (int c = bx; c < DHY; c += G)
        hy::hyena_unit(p.VT + (size_t)c * NB * S, p.FT + ((size_t)l * DHY + c) * hy::FTP, p.YC + (size_t)c * NB * S, lds);
}

#define XB_TMO      128
#define XB_XCNT(j)  (256  + 64 * (j))
#define XB_XSUB(j)  (1280 + 64 * (j))
#define XB_XGEN(j)  (2304 + 64 * (j))
#define XB_TOP      3328
#define XB_TOPGEN   3392
#define XCD_BAR_WORDS 3456
#define XB_SPIN_CAP (1u << 23)

__device__ __forceinline__ unsigned xb_ld(unsigned* p)              { return __hip_atomic_load(p, __ATOMIC_RELAXED, __HIP_MEMORY_SCOPE_AGENT); }
__device__ __forceinline__ unsigned xb_add(unsigned* p, unsigned v) { return __hip_atomic_fetch_add(p, v, __ATOMIC_RELAXED, __HIP_MEMORY_SCOPE_AGENT); }
__device__ __forceinline__ unsigned xb_xcc_id() { return (unsigned)__builtin_amdgcn_s_getreg((3 << 11) | 20) & 0xFu; }
#define XB_SPIN(cond, bar) do { unsigned _sp = 0; while (cond) { __builtin_amdgcn_s_sleep(1); \
    if ((++_sp & 255u) == 0u) { if (xb_ld(&(bar)[XB_TMO])) break; if (_sp > XB_SPIN_CAP) { atomicAdd(&(bar)[XB_TMO], 1u); break; } } } } while (0)

struct XcdBarrier {
    unsigned* bar; unsigned x;
    volatile LAS unsigned* st;
};

__device__ __forceinline__ XcdBarrier xcd_barrier_post(unsigned* bar, volatile LAS unsigned* st) {
    XcdBarrier b; b.bar = bar; b.x = xb_xcc_id(); b.st = st;
    if (threadIdx.x == 0) (void)xb_add(&bar[XB_XCNT(b.x)], 1u);
    return b;
}
__device__ __forceinline__ void xcd_barrier_complete(unsigned* bar, unsigned x, unsigned& nloc, unsigned& nx) {
    const unsigned G = gridDim.x * gridDim.y * gridDim.z;
    unsigned sum, cnt, mine, sp = 0u;
    for (;;) {
        sum = 0u; cnt = 0u; mine = 0u;
#pragma unroll
        for (unsigned j = 0; j < 16; ++j) { const unsigned c = xb_ld(&bar[XB_XCNT(j)]); sum += c; cnt += (c > 0u) ? 1u : 0u; mine = (j == x) ? c : mine; }
        if (sum == G) break;
        __builtin_amdgcn_s_sleep(1);
        if ((++sp & 255u) == 0u) { if (xb_ld(&bar[XB_TMO])) break; if (sp > XB_SPIN_CAP) { atomicAdd(&bar[XB_TMO], 1u); break; } }
    }
    nloc = mine > 0u ? mine : 1u; nx = cnt > 0u ? cnt : 1u;
}

__device__ __forceinline__ void xcd_barrier(const XcdBarrier& b) {
    asm volatile("s_waitcnt vmcnt(0)" ::: "memory");
    __syncthreads();
    if (threadIdx.x == 0) {
        unsigned* bar = b.bar;
        __builtin_amdgcn_s_waitcnt(0);
        unsigned nloc = b.st[0], nx = b.st[1];
        if (nloc == 0u) { xcd_barrier_complete(bar, b.x, nloc, nx); b.st[0] = nloc; b.st[1] = nx; }
        const unsigned old = xb_add(&bar[XB_XSUB(b.x)], 1u);
        const unsigned gen = old / nloc;
        if (old + 1u == (gen + 1u) * nloc) {
            __builtin_amdgcn_fence(__ATOMIC_RELEASE, "agent");
            asm volatile("s_waitcnt vmcnt(0)" ::: "memory");
            const unsigned og = xb_add(&bar[XB_TOP], 1u);
            const unsigned tg = og / nx;
            if (og + 1u == (tg + 1u) * nx) xb_add(&bar[XB_TOPGEN], 1u);
            else XB_SPIN(xb_ld(&bar[XB_TOPGEN]) == tg, bar);
            __builtin_amdgcn_fence(__ATOMIC_ACQUIRE, "agent");
            xb_add(&bar[XB_XGEN(b.x)], 1u);
            asm volatile("s_waitcnt vmcnt(0)" ::: "memory");
        } else {
            XB_SPIN(xb_ld(&bar[XB_XGEN(b.x)]) == gen, bar);
            __builtin_amdgcn_fence(__ATOMIC_ACQUIRE, "agent");
            asm volatile("s_waitcnt vmcnt(0)" ::: "memory");
        }
    }
    __syncthreads();
}

constexpr int NWAVES = 8, NTHR = NWAVES * 64;
constexpr int RING_BYTES = 132096, LDSCTL_OFF = RING_BYTES, MISC_OFF = LDSCTL_OFF + 320, LDS_BYTES = 147456;
static_assert(hy::L_END <= RING_BYTES && attn_body::ATTN_LDS_BYTES <= RING_BYTES && MISC_OFF + 128 <= LDS_BYTES, "LDS map");
constexpr int CW_BAR = 4096;

__device__ __forceinline__ long opaque_gtid() { int t = threadIdx.x; asm volatile("" : "+v"(t)); return (long)blockIdx.x * 512 + t; }
typedef const __attribute__((address_space(4))) Prm* KPrm;
__device__ __forceinline__ KPrm opaque_kp() { KPrm q = (KPrm)__builtin_amdgcn_kernarg_segment_ptr(); asm volatile("" : "+s"(q)); return q; }
typedef const __attribute__((address_space(4))) unsigned long long* KWords;
__device__ __forceinline__ void load_prm(Prm& p) {
    static_assert(sizeof(Prm) % 8 == 0, "Prm is a pack of pointers");
    KWords src = (KWords)opaque_kp(); unsigned long long* dst = (unsigned long long*)&p;
#pragma unroll
    for (int i = 0; i < (int)(sizeof(Prm) / 8); ++i) dst[i] = src[i];
}
#define LP() Prm p; load_prm(p)
#define GT opaque_gtid()
#define GRID_BAR() xcd_barrier(bar)

template <int L> __device__ __forceinline__ void layer_fwd(LAS unsigned char* lds, const XcdBarrier& bar, const long gsz, const int G) {
    constexpr bool first = L == 0, last = L == NL - 1; constexpr int l = L;
    constexpr int nact = last ? MX : M;
    { LP(); ph_modnorm(p, l, first ? p.x : p.out, first ? p.ctx : p.CX, p.norm_mix + l * D, 0, D, M, false, GT, gsz); }
    GRID_BAR();
    {
        LP(); pg8::Order O; O.init(M / 256, NP / 256, G, (int)blockIdx.x, p.WinT + (size_t)l * NP * D);
        pg8::EpiBf16 E{p.P, NP};
        pg8::gemm_phase<pg8::EpiBf16, true, false>(lds, p.HX, D, O, E);
    }
    GRID_BAR();
    { LP(); ph_prep_hy(p, l, GT, gsz); }
    { LP(); ph_prep_qk(p, l, GT, gsz); }
    GRID_BAR();
    { LP(); hyena_phase(p, l, lds, G); }
    if (!last) { LP(); ph_hyena_naive(p, l, false, true, GT, gsz); }
    { LP(); attn_phase<!last>(p, l, (char*)lds, G); }
    GRID_BAR();
    { LP(); ph_final(p, l, nact, GT, gsz); }
    GRID_BAR();
    {
        LP(); pg8::Order O; O.init(nact / 256, D / 256, G, (int)blockIdx.x, p.WoutT + (size_t)l * D * D);
        pg8::EpiResGate E{first ? p.x : p.out, first ? p.ctx : p.CX, p.out, p.CX, p.MOD + (size_t)l * 9 * 6 * D + 2 * D};
        pg8::gemm_phase<pg8::EpiResGate, true, false>(lds, p.HX, D, O, E);
    }
    GRID_BAR();
    { LP(); ph_modnorm(p, l, p.out, p.CX, p.norm_ffn + l * D, 3 * D, 4 * D, nact, (l & 1) != 0, GT, gsz); }
    GRID_BAR();
    if constexpr ((L & 1) == 0) {
        {   LP(); pg8::Order O; O.init(nact / 256, 2 * DFF / 256, G, (int)blockIdx.x, p.WguT);
            pg8::EpiSwiGLU E{p.HID, DFF};
            pg8::gemm_phase<pg8::EpiSwiGLU, true, false>(lds, p.HX, D, O, E); }
        GRID_BAR();
        {   LP(); pg8::Order O; O.init(nact / 256, D / 256, G, (int)blockIdx.x, p.WdT);
            pg8::EpiResGate E{p.out, p.CX, p.out, p.CX, p.MOD + (size_t)l * 9 * 6 * D + 5 * D};
            pg8::gemm_phase<pg8::EpiResGate, true, false>(lds, p.HID, DFF, O, E); }
        GRID_BAR();
    } else {
        { LP(); ph_moe_count(p, GT, gsz); }
        GRID_BAR();
        { LP(); ph_moe_assign(p, GT, gsz); }
        GRID_BAR();
#pragma unroll
        for (int pass = 0; pass < 2; ++pass) {
            {   LP(); pg8::Order O; int o = 0;
#pragma unroll
                for (int k = 0; k < 8; ++k) { o += (__builtin_amdgcn_readfirstlane(p.ctl[pass * 8 + k]) + 255) / 256; O.pend[k] = o; }
                const int npan = o; O.nM = npan; O.nN = 2 * DFE / 256; O.nwg = O.nM * O.nN; O.G = G; O.c = (int)blockIdx.x; O.Bt = p.WguTe; O.bt_group_stride = (size_t)2 * DFE * D; O.rows = p.LIST + (size_t)pass * MPAD;
                pg8::EpiSwiGLU E{p.HID, DFE};
                pg8::gemm_phase<pg8::EpiSwiGLU, true, true>(lds, p.HX, D, O, E); }
            GRID_BAR();
            {   LP(); pg8::Order O; int o = 0;
#pragma unroll
                for (int k = 0; k < 8; ++k) { o += (__builtin_amdgcn_readfirstlane(p.ctl[pass * 8 + k]) + 255) / 256; O.pend[k] = o; }
                O.nM = o; O.nN = D / 256; O.nwg = O.nM * O.nN; O.G = G; O.c = (int)blockIdx.x; O.Bt = p.WdTe; O.bt_group_stride = (size_t)D * DFE; O.rows = nullptr;
                pg8::EpiMoeDown E{p.LIST + (size_t)pass * MPAD, p.TOPW, pass, p.out, p.MOD + (size_t)l * 9 * 6 * D + 5 * D};
                pg8::gemm_phase<pg8::EpiMoeDown, true, false>(lds, p.HID, DFE, O, E); }
            GRID_BAR();
        }
    }
}

__global__ void __launch_bounds__(NTHR, 2) mega_fwd(Prm p_in) {
    extern __shared__ __attribute__((aligned(16))) unsigned char lds_raw[];
    LAS unsigned char* lds = (LAS unsigned char*)lds_raw;
    volatile LAS unsigned* MISC = (volatile LAS unsigned*)(lds + MISC_OFF);
    const int tid = threadIdx.x;
    for (int u = tid; u < (LDS_BYTES - LDSCTL_OFF) / 4; u += NTHR) ((LAS unsigned*)(lds + LDSCTL_OFF))[u] = 0u;
    __syncthreads();
    XcdBarrier bar = xcd_barrier_post((unsigned*)p_in.ctl + CW_BAR, MISC + 8);
    const int G = gridDim.x;
    const long gsz = (long)G * NTHR;
    { LP(); ph_wconv(p, GT, gsz); }
    { LP(); ph_mod(p, GT, gsz); }
    { LP(); ph_filt1(p, GT, gsz); }
    GRID_BAR();
    { LP(); ph_filt2(p, 0, p.FHA, p.FHB, GT, gsz); }
    GRID_BAR();
    { LP(); ph_filt2(p, 1, p.FHB, p.FHA, GT, gsz); }
    GRID_BAR();
    { LP(); ph_filt3(p, p.FHA, GT, gsz); }
    GRID_BAR();
    layer_fwd<0>(lds, bar, gsz, G);
    layer_fwd<1>(lds, bar, gsz, G);
}

extern "C" void kernel_launch(void* const* d_in, const int* in_sizes, int n_in, void* d_out, int out_size, void* d_ws, size_t ws_size, hipStream_t stream) {
    static int grid = 0;
    if (grid == 0) {
        if (n_in != 34 || out_size != MX * D || ws_size < ws_needed()) { fprintf(stderr, "kernel_launch: unexpected shapes (n_in %d out %d ws %zu need %zu)\n", n_in, out_size, ws_size, ws_needed()); grid = -1; return; }
        int dev = 0, cus = 0, per_cu = 0;
        if (hipGetDevice(&dev) != hipSuccess || hipDeviceGetAttribute(&cus, hipDeviceAttributeMultiprocessorCount, dev) != hipSuccess) { grid = -1; return; }
        if (hipFuncSetAttribute((const void*)mega_fwd, hipFuncAttributeMaxDynamicSharedMemorySize, LDS_BYTES) != hipSuccess) { fprintf(stderr, "kernel_launch: hipFuncSetAttribute failed\n"); grid = -1; return; }
        if (hipOccupancyMaxActiveBlocksPerMultiprocessor(&per_cu, (const void*)mega_fwd, NTHR, LDS_BYTES) != hipSuccess || per_cu < 1) { fprintf(stderr, "kernel_launch: occupancy query reports %d\n", per_cu); }
        (void)hipGetLastError();
        grid = cus;
    }
    if (grid < 0) return;
    (void)in_sizes;
    (void)hipMemsetAsync(d_ws, 0, CTL_BYTES, stream);
    Prm p; __builtin_memset((void*)&p, 0, sizeof(p)); build_prm(p, d_in, d_out, d_ws);
    hipLaunchKernelGGL(mega_fwd, dim3(grid), dim3(NTHR), LDS_BYTES, stream, p);
}
#else
static void forward_emu(void* const* d_in, void* d_out, void* d_ws) {
    memset(d_ws, 0, CTL_BYTES);
    Prm p; memset(&p, 0, sizeof(p)); build_prm(p, d_in, d_out, d_ws);
#define RUN(ph, l, arg) run_phase(p, (ph), (l), (arg), 0, 1)
    RUN(PH_WCONV, 0, 0); RUN(PH_MOD, 0, 0); RUN(PH_F1, 0, 0); RUN(PH_F2A, 0, 0); RUN(PH_F2B, 0, 0); RUN(PH_F3, 0, 0);
    for (int l = 0; l < NL; ++l) {
        const bool last = l == NL - 1;
        RUN(PH_MODNORM1, l, 0); RUN(PH_INPROJ, l, 0); RUN(PH_PREP_HY, l, 0); RUN(PH_PREP_QK, l, 0);
        RUN(PH_HYENA, l, 0); RUN(PH_GA, l, 0); RUN(PH_NA, l, 0); if (!last) RUN(PH_CTXATTN, l, 0);
        RUN(PH_FINAL, l, 0); RUN(PH_OUTPROJ, l, 0); RUN(PH_MODNORM2, l, 0);
        if ((l & 1) == 0) { RUN(PH_FFN_UP, l, 0); RUN(PH_FFN_DOWN, l, 0); }
        else { RUN(PH_MOE_COUNT, l, 0); RUN(PH_MOE_ASSIGN, l, 0); for (int c = 0; c < 2; ++c) { RUN(PH_MOE_UP, l, c); RUN(PH_MOE_DOWN, l, c); } }
    }
}
#endif
```

```cpp
#ifdef CPU_EMU
#include <cmath>
#include <cstdio>
#include <cstdlib>
#include <cstring>
#include <cstdint>
#define __device__
#define __global__
#define __host__
#define __forceinline__ inline
static inline int atomicAdd(int* p, int v) { int o = *p; *p += v; return o; }
#else
#include <hip/hip_runtime.h>
#include <cstdio>
#include <cstdint>
#endif

#ifdef CFG_SMALL
constexpr int D = 512, NB = 2, S = 1024, LC = 64, DFF = 256, DFE = 256;
#else
constexpr int D = 1024, NB = 8, S = 4096, LC = 256, DFF = 2816, DFE = 3584;
#endif
constexpr int NL = 2;
constexpr int DHY = 3 * D / 8, DNA = 3 * D / 8, DGA = D - DHY - DNA, NNA = DNA / 64, NGA = DGA / 64, HD = 64;
constexpr int GW = 64, ROWS = S / GW, KH = 8, KWIN = 16;
constexpr int MX = NB * S, MC = NB * LC, M = MX + MC;
constexpr int NE = 8;
constexpr int NP = 3 * D;
constexpr int PC_HY = 0, PC_NAQ = 3 * DHY, PC_NAK = PC_NAQ + DNA, PC_NAV = PC_NAK + DNA, PC_GAQ = 3 * (DHY + DNA), PC_GAK = PC_GAQ + DGA, PC_GAV = PC_GAK + DGA;
constexpr int MPAD = ((MX + NE * 255 + 255) / 256) * 256;
constexpr float EPS = 1e-6f;
constexpr float LOG2E = 1.4426950408889634f;
constexpr float QSCALE = 0.125f * LOG2E;

typedef unsigned short bf16;
__host__ __device__ __forceinline__ unsigned f2bf_u(float f) { unsigned u; __builtin_memcpy(&u, &f, 4); return (u + 0x7fffu + ((u >> 16) & 1u)) >> 16; }
__host__ __device__ __forceinline__ bf16 f2bf(float f) { return (bf16)f2bf_u(f); }
__host__ __device__ __forceinline__ float bf2f(bf16 h) { unsigned u = ((unsigned)h) << 16; float f; __builtin_memcpy(&f, &u, 4); return f; }
__host__ __device__ __forceinline__ float silu_f(float v) { return v / (1.0f + expf(-v)); }

struct Prm {
    const float *x, *c, *ctx, *c_ctx, *w_mod, *b_mod, *norm_mix, *norm_ffn, *w_in, *hy_conv_w, *hy_conv_b, *hy_w1, *hy_b1, *hy_freq, *hy_w2, *hy_b2, *hy_w3, *hy_skip;
    const float *na_q_norm, *na_k_norm, *na_rpb, *ga_q_norm, *ga_k_norm, *out_norm_hy, *out_norm_na, *out_norm_ga, *w_out;
    const float *ffn_w_gate, *ffn_w_up, *ffn_w_down, *moe_router, *moe_w_gate, *moe_w_up, *moe_w_down;
    float* out;
    int* ctl;
    float* MOD;
    float* ROPE;
    float *FHA, *FHB;
    bf16* FT;
    bf16* FTC;
    bf16 *WinT, *WoutT;
    bf16 *WguT, *WdT;
    bf16 *WguTe, *WdTe;
    float* CX;
    int* TOPI; float* TOPW; int* LIST;
    bf16* HX;
    bf16* P;
    bf16 *VT, *VTC;
    float *YC, *YCC;
    bf16* HID;
};

__device__ __forceinline__ void conv_T(const float* W, int K, int N, bf16* dst, long gtid, long gsz) {
    for (long i = gtid; i < (long)N * K; i += gsz) { const int n = (int)(i / K), k = (int)(i % K); dst[i] = f2bf(W[(size_t)k * N + n]); }
}
__device__ __forceinline__ void conv_gu(const float* Wg, const float* Wu, int K, int F, bf16* dst, long gtid, long gsz) {
    for (long i = gtid; i < (long)2 * F * K; i += gsz) {
        const int n = (int)(i / K), k = (int)(i % K), p = n / 256, j = n % 256;
        const float* src = j < 128 ? Wg : Wu; const int col = 128 * p + (j & 127);
        dst[i] = f2bf(src[(size_t)k * F + col]);
    }
}
__device__ __forceinline__ void ph_wconv(const Prm& p, long gtid, long gsz) {
    for (int l = 0; l < NL; ++l) {
        conv_T(p.w_in + (size_t)l * D * NP, D, NP, p.WinT + (size_t)l * NP * D, gtid, gsz);
        conv_T(p.w_out + (size_t)l * D * D, D, D, p.WoutT + (size_t)l * D * D, gtid, gsz);
    }
    conv_gu(p.ffn_w_gate, p.ffn_w_up, D, DFF, p.WguT, gtid, gsz);
    conv_T(p.ffn_w_down, DFF, D, p.WdT, gtid, gsz);
    for (int e = 0; e < NE; ++e) {
        conv_gu(p.moe_w_gate + (size_t)e * D * DFE, p.moe_w_up + (size_t)e * D * DFE, D, DFE, p.WguTe + (size_t)e * 2 * DFE * D, gtid, gsz);
        conv_T(p.moe_w_down + (size_t)e * DFE * D, DFE, D, p.WdTe + (size_t)e * D * DFE, gtid, gsz);
    }
}
__device__ __forceinline__ void ph_mod(const Prm& p, long gtid, long gsz) {
    for (long i = gtid; i < (long)NL * 9 * 6 * D; i += gsz) {
        const int n = (int)(i % (6 * D)), r = (int)((i / (6 * D)) % 9), l = (int)(i / (6 * D * 9));
        const float* cv = r < 8 ? p.c + (size_t)(r % NB) * D : p.c_ctx;
        const float* w = p.w_mod + (size_t)l * D * 6 * D;
        float acc = p.b_mod[(size_t)l * 6 * D + n];
        for (int k = 0; k < D; ++k) acc += silu_f(cv[k]) * w[(size_t)k * 6 * D + n];
        p.MOD[i] = acc;
    }
}
__device__ __forceinline__ int fset_len(int s) { return s < 2 ? S : LC; }
__device__ __forceinline__ int fset_layer(int s) { return s == 1 ? 1 : 0; }
__device__ __forceinline__ void ph_filt1(const Prm& p, long gtid, long gsz) {
    for (long i = gtid; i < (long)3 * S * 64; i += gsz) {
        const int u = (int)(i % 64), t = (int)((i / 64) % S), s = (int)(i / (64 * S));
        const int Len = fset_len(s), l = fset_layer(s);
        if (t >= Len) continue;
        const float* w1 = p.hy_w1 + (size_t)l * 33 * 64;
        const float tn = (float)t / (float)(Len - 1);
        const float ang = 6.283185307179586f * (float)t / (float)Len;
        float pre = p.hy_b1[l * 64 + u] + tn * w1[u];
        for (int j = 0; j < 16; ++j) {
            const float fr = 1e-4f + (float)j * ((15.0f - 1e-4f) / 15.0f);
            pre += cosf(fr * ang) * w1[(1 + j) * 64 + u] - sinf(fr * ang) * w1[(17 + j) * 64 + u];
        }
        p.FHA[i] = sinf(p.hy_freq[l * 64 + u] * pre);
    }
}
__device__ __forceinline__ void ph_filt2(const Prm& p, int inner, const float* src, float* dst, long gtid, long gsz) {
    for (long i = gtid; i < (long)3 * S * 64; i += gsz) {
        const int u = (int)(i % 64), t = (int)((i / 64) % S), s = (int)(i / (64 * S));
        const int Len = fset_len(s), l = fset_layer(s);
        if (t >= Len) continue;
        const float* w2 = p.hy_w2 + ((size_t)l * 2 + inner) * 64 * 64;
        const float* h = src + (i - u);
        float pre = p.hy_b2[(l * 2 + inner) * 64 + u];
        for (int k = 0; k < 64; ++k) pre += h[k] * w2[k * 64 + u];
        dst[i] = sinf(p.hy_freq[l * 64 + u] * pre);
    }
}
__device__ __forceinline__ void ph_filt3(const Prm& p, const float* src, long gtid, long gsz) {
    for (long i = gtid; i < (long)3 * S * 2 * DHY; i += gsz) {
        const int n = (int)(i % (2 * DHY)), t = (int)((i / (2 * DHY)) % S), s = (int)(i / ((long)2 * DHY * S));
        const int Len = fset_len(s), l = fset_layer(s);
        if (t >= Len) continue;
        const float* w3 = p.hy_w3 + (size_t)l * 64 * 2 * DHY;
        const float* h = src + ((size_t)s * S + t) * 64;
        float acc = 0.f;
        for (int k = 0; k < 64; ++k) acc += h[k] * w3[(size_t)k * 2 * DHY + n];
        const int cch = n % DHY;
        const float d0 = logf(1e-2f) / 1.5f, d1 = logf(1e-2f) / 0.3f;
        const float delta = fabsf(d0 + (float)cch * ((d1 - d0) / (float)(DHY - 1)));
        const float tn = (float)t / (float)(Len - 1);
        const float val = acc * expf(-tn * delta);
        bf16* ft = (s < 2 ? p.FT + (size_t)s * DHY * (2 * S + 8) : p.FTC) + (size_t)cch * (2 * Len + 8);
        if (n < DHY) ft[Len - t] = f2bf(val);
        else if (t > 0) ft[Len + t] = f2bf(val);
        else { ft[0] = 0; for (int k = 0; k < 8; ++k) ft[2 * Len + k] = 0; }
    }
}

__device__ __forceinline__ int row_modrow(int row) { return row < MX ? row / S : 8; }
__device__ __forceinline__ int row_batch(int row) { return row < MX ? row / S : (row - MX) / LC; }

__device__ __forceinline__ void ph_modnorm(const Prm& p, int l, const float* xs, const float* cs, const float* gain, int off_shift, int off_scale, int nrows, bool router, long gtid, long gsz) {
    for (long row = gtid; row < nrows; row += gsz) {
        const float* src = row < MX ? xs + (size_t)row * D : cs + (size_t)(row - MX) * D;
        const float* mod = p.MOD + ((size_t)l * 9 + row_modrow((int)row)) * 6 * D;
        float ss = 0.f;
        for (int k = 0; k < D; ++k) ss += src[k] * src[k];
        const float rstd = 1.0f / sqrtf(ss / (float)D + EPS);
        float lg[NE];
#pragma unroll
        for (int e = 0; e < NE; ++e) lg[e] = 0.f;
        for (int k = 0; k < D; ++k) {
            const float h = src[k] * rstd * gain[k] * (1.0f + mod[off_scale + k]) + mod[off_shift + k];
            p.HX[(size_t)row * D + k] = f2bf(h);
            if (router) {
#pragma unroll
                for (int e = 0; e < NE; ++e) lg[e] += h * p.moe_router[(size_t)k * NE + e]; }
        }
        if (router && row < MX) {
            float b1 = -INFINITY, b2 = -INFINITY; int i1 = 0, i2 = 0;
#pragma unroll
            for (int e = 0; e < NE; ++e) { const float v = lg[e]; if (v > b1) { b2 = b1; i2 = i1; b1 = v; i1 = e; } else if (v > b2) { b2 = v; i2 = e; } }
            const float w1 = 1.0f / (1.0f + expf(b2 - b1));
            p.TOPI[row * 2] = i1; p.TOPI[row * 2 + 1] = i2; p.TOPW[row * 2] = w1; p.TOPW[row * 2 + 1] = 1.0f - w1;
        }
    }
}
struct U4 { unsigned x, y, z, w; };
__device__ __forceinline__ float dot_bf(const bf16* a, const bf16* b, int K) {
    float acc = 0.f;
    for (int k = 0; k < K; k += 8) {
        U4 va, vb; __builtin_memcpy(&va, a + k, 16); __builtin_memcpy(&vb, b + k, 16);
        const unsigned ua[4] = {va.x, va.y, va.z, va.w}, ub[4] = {vb.x, vb.y, vb.z, vb.w};
#pragma unroll
        for (int j = 0; j < 4; ++j) acc += bf2f((bf16)(ua[j] & 0xffffu)) * bf2f((bf16)(ub[j] & 0xffffu)) + bf2f((bf16)(ua[j] >> 16)) * bf2f((bf16)(ub[j] >> 16));
    }
    return acc;
}

__device__ __forceinline__ void ph_inproj(const Prm& p, int l, long gtid, long gsz) {
    const bf16* Bt = p.WinT + (size_t)l * NP * D;
    for (long i = gtid; i < (long)M * NP; i += gsz) { const int m = (int)(i / NP), n = (int)(i % NP); p.P[i] = f2bf(dot_bf(p.HX + (size_t)m * D, Bt + (size_t)n * D, D)); }
}
__device__ __forceinline__ float sconv(const Prm& p, int l, int row, int col) {
    int t, Len; if (row < MX) { t = row % S; Len = S; } else { t = (row - MX) % LC; Len = LC; }
    const float* w = p.hy_conv_w + (size_t)l * 3 * 3 * DHY;
    float y = p.hy_conv_b[(size_t)l * 3 * DHY + col] + w[3 * DHY + col] * bf2f(p.P[(size_t)row * NP + col]);
    if (t > 0) y += w[col] * bf2f(p.P[(size_t)(row - 1) * NP + col]);
    if (t < Len - 1) y += w[2 * 3 * DHY + col] * bf2f(p.P[(size_t)(row + 1) * NP + col]);
    return y;
}
__device__ __forceinline__ void ph_prep_hy(const Prm& p, int l, long gtid, long gsz) {
    for (long i = gtid; i < (long)M * DHY; i += gsz) {
        const int row = (int)(i / DHY), c = (int)(i % DHY);
        const float v = sconv(p, l, row, 2 * DHY + c) * sconv(p, l, row, DHY + c);
        if (row < MX) p.VT[((size_t)c * NB + row / S) * S + row % S] = f2bf(v);
        else { const int rr = row - MX; p.VTC[((size_t)c * NB + rr / LC) * LC + rr % LC] = f2bf(v); }
    }
}
__device__ __forceinline__ void ph_prep_qk(const Prm& p, int l, long gtid, long gsz) {
    constexpr int NS = 2 * NNA + 2 * NGA;
    for (long i = gtid; i < (long)M * NS; i += gsz) {
        const int row = (int)(i / NS), hs = (int)(i % NS);
        int col; const float* g; bool isq, rope;
        if (hs < NNA) { col = PC_NAQ + 64 * hs; g = p.na_q_norm + l * 64; isq = true; rope = false; }
        else if (hs < 2 * NNA) { col = PC_NAK + 64 * (hs - NNA); g = p.na_k_norm + l * 64; isq = false; rope = false; }
        else if (hs < 2 * NNA + NGA) { col = PC_GAQ + 64 * (hs - 2 * NNA); g = p.ga_q_norm + l * 64; isq = true; rope = row < MX; }
        else { col = PC_GAK + 64 * (hs - 2 * NNA - NGA); g = p.ga_k_norm + l * 64; isq = false; rope = row < MX; }
        bf16* v = p.P + (size_t)row * NP + col;
        float ss = 0.f;
        for (int d = 0; d < 64; ++d) { const float a = bf2f(v[d]); ss += a * a; }
        const float rstd = 1.0f / sqrtf(ss / 64.0f + EPS), sc = isq ? QSCALE : 1.0f;
        if (!rope) { for (int d = 0; d < 64; ++d) v[d] = f2bf(bf2f(v[d]) * rstd * g[d] * sc); }
        else {
            const int t = row % S; const float pr = (float)(t / GW), pc = (float)(t % GW);
            for (int hf = 0; hf < 2; ++hf) {
                const float pos = hf == 0 ? pr : pc;
                for (int j = 0; j < 16; ++j) {
                    const float inv = powf(10000.0f, -(float)j / 16.0f), ang = pos * inv, cs = cosf(ang), sn = sinf(ang);
                    const int d1 = 32 * hf + j, d2 = d1 + 16;
                    const float a = bf2f(v[d1]) * rstd * g[d1], b = bf2f(v[d2]) * rstd * g[d2];
                    v[d1] = f2bf((a * cs - b * sn) * sc); v[d2] = f2bf((a * sn + b * cs) * sc);
                }
            }
        }
    }
}
__device__ __forceinline__ void ph_hyena_naive(const Prm& p, int l, bool with_lat, bool with_ctx, long gtid, long gsz) {
    const bf16* FTl = p.FT + (size_t)l * DHY * (2 * S + 8);
    if (with_lat) for (long i = gtid; i < (long)DHY * NB * S; i += gsz) {
        const int t = (int)(i % S), cb = (int)(i / S), c = cb / NB;
        const bf16* ft = FTl + (size_t)c * (2 * S + 8) + S - t; const bf16* v = p.VT + (size_t)cb * S;
        float acc = 0.f;
        for (int s = 0; s < S; ++s) acc += bf2f(ft[s]) * bf2f(v[s]);
        p.YC[i] = acc;
    }
    if (with_ctx) for (long i = gtid; i < (long)DHY * NB * LC; i += gsz) {
        const int t = (int)(i % LC), cb = (int)(i / LC), c = cb / NB;
        const bf16* ft = p.FTC + (size_t)c * (2 * LC + 8) + LC - t; const bf16* v = p.VTC + (size_t)cb * LC;
        float acc = 0.f;
        for (int s = 0; s < LC; ++s) acc += bf2f(ft[s]) * bf2f(v[s]);
        p.YCC[i] = acc;
    }
}
struct OnlineSm { float m, l, o[64]; };
__device__ __forceinline__ void osm_init(OnlineSm& st) { st.m = -INFINITY; st.l = 0.f;
_Pragma("unroll") for (int d = 0; d < 64; ++d) st.o[d] = 0.f; }
__device__ __forceinline__ void osm_step(OnlineSm& st, const float* q, const bf16* k, const bf16* v, float bias) {
    float sc = bias;
_Pragma("unroll") for (int d = 0; d < 64; ++d) sc += q[d] * bf2f(k[d]);
    if (sc > st.m) { const float a = exp2f(st.m - sc); st.l *= a;
_Pragma("unroll") for (int d = 0; d < 64; ++d) st.o[d] *= a;
 st.m = sc; }
    const float pe = exp2f(sc - st.m); st.l += pe;
_Pragma("unroll") for (int d = 0; d < 64; ++d) st.o[d] += pe * bf2f(v[d]);
}
__device__ __forceinline__ void ph_ga_naive(const Prm& p, long gtid, long gsz) {
    for (long i = gtid; i < (long)NB * NGA * S; i += gsz) {
        const int t = (int)(i % S), h = (int)((i / S) % NGA), b = (int)(i / ((long)S * NGA));
        bf16* qp = p.P + ((size_t)b * S + t) * NP + PC_GAQ + 64 * h;
        float q[64];
_Pragma("unroll") for (int d = 0; d < 64; ++d) q[d] = bf2f(qp[d]);
        OnlineSm st; osm_init(st);
        for (int s = 0; s < S; ++s) { const bf16* kr = p.P + ((size_t)b * S + s) * NP; osm_step(st, q, kr + PC_GAK + 64 * h, kr + PC_GAV + 64 * h, 0.f); }
        for (int s = 0; s < LC; ++s) { const bf16* kr = p.P + ((size_t)MX + b * LC + s) * NP; osm_step(st, q, kr + PC_GAK + 64 * h, kr + PC_GAV + 64 * h, 0.f); }
        const float il = 1.0f / st.l;
_Pragma("unroll") for (int d = 0; d < 64; ++d) qp[d] = f2bf(st.o[d] * il);
    }
}
__device__ __forceinline__ void ph_na_naive(const Prm& p, int l, long gtid, long gsz) {
    for (long i = gtid; i < (long)NB * NNA * S; i += gsz) {
        const int t = (int)(i % S), h = (int)((i / S) % NNA), b = (int)(i / ((long)S * NNA));
        const int r = t / GW, qc = t % GW;
        int r0 = r - KH / 2; r0 = r0 < 0 ? 0 : (r0 > ROWS - KH ? ROWS - KH : r0);
        int c0 = qc - KWIN / 2; c0 = c0 < 0 ? 0 : (c0 > GW - KWIN ? GW - KWIN : c0);
        bf16* qp = p.P + ((size_t)b * S + t) * NP + PC_NAQ + 64 * h;
        float q[64];
_Pragma("unroll") for (int d = 0; d < 64; ++d) q[d] = bf2f(qp[d]);
        const float* rpb = p.na_rpb + ((size_t)l * NNA + h) * (2 * KH - 1) * (2 * KWIN - 1);
        OnlineSm st; osm_init(st);
        for (int kr = 0; kr < KH; ++kr) for (int kc = c0; kc < c0 + KWIN; ++kc) {
            const int krow = r0 + kr, dr = krow - r + (KH - 1); int dc = kc - qc; dc = dc < -(KWIN - 1) ? -(KWIN - 1) : (dc > KWIN - 1 ? KWIN - 1 : dc); dc += KWIN - 1;
            const bf16* kp = p.P + ((size_t)b * S + krow * GW + kc) * NP;
            osm_step(st, q, kp + PC_NAK + 64 * h, kp + PC_NAV + 64 * h, rpb[dr * (2 * KWIN - 1) + dc] * LOG2E);
        }
        for (int s = 0; s < LC; ++s) { const bf16* kp = p.P + ((size_t)MX + b * LC + s) * NP; osm_step(st, q, kp + PC_NAK + 64 * h, kp + PC_NAV + 64 * h, 0.f); }
        const float il = 1.0f / st.l;
_Pragma("unroll") for (int d = 0; d < 64; ++d) qp[d] = f2bf(st.o[d] * il);
    }
}
__device__ __forceinline__ void ph_ctxattn_naive(const Prm& p, long gtid, long gsz) {
    for (long i = gtid; i < (long)NB * (NNA + NGA) * LC; i += gsz) {
        const int t = (int)(i % LC), hh = (int)((i / LC) % (NNA + NGA)), b = (int)(i / ((long)LC * (NNA + NGA)));
        const int qo = hh < NNA ? PC_NAQ + 64 * hh : PC_GAQ + 64 * (hh - NNA), ko = hh < NNA ? PC_NAK + 64 * hh : PC_GAK + 64 * (hh - NNA), vo = hh < NNA ? PC_NAV + 64 * hh : PC_GAV + 64 * (hh - NNA);
        bf16* qp = p.P + ((size_t)MX + b * LC + t) * NP + qo;
        float q[64];
_Pragma("unroll") for (int d = 0; d < 64; ++d) q[d] = bf2f(qp[d]);
        OnlineSm st; osm_init(st);
        for (int s = 0; s < LC; ++s) { const bf16* kp = p.P + ((size_t)MX + b * LC + s) * NP; osm_step(st, q, kp + ko, kp + vo, 0.f); }
        const float il = 1.0f / st.l;
_Pragma("unroll") for (int d = 0; d < 64; ++d) qp[d] = f2bf(st.o[d] * il);
    }
}
__device__ __forceinline__ void ph_final(const Prm& p, int l, int nrows, long gtid, long gsz) {
    for (long row = gtid; row < nrows; row += gsz) {
        const int r = (int)row; int b, t; const float* yc;
        if (r < MX) { b = r / S; t = r % S; } else { b = (r - MX) / LC; t = (r - MX) % LC; }
        float ss = 0.f;
        for (int pass = 0; pass < 2; ++pass) {
            const float rstd = pass ? 1.0f / sqrtf(ss / (float)DHY + EPS) : 0.f;
            for (int c = 0; c < DHY; ++c) {
                const float x0 = sconv(p, l, r, c), vp = sconv(p, l, r, 2 * DHY + c) * sconv(p, l, r, DHY + c);
                const float conv = r < MX ? p.YC[((size_t)c * NB + b) * S + t] : p.YCC[((size_t)c * NB + b) * LC + t];
                const float y = (conv + p.hy_skip[l * DHY + c] * vp) * x0;
                if (!pass) ss += y * y; else p.HX[(size_t)r * D + c] = f2bf(y * rstd * p.out_norm_hy[l * DHY + c]);
            }
        }
        { const bf16* o = p.P + (size_t)r * NP + PC_NAQ; float s2 = 0.f; for (int j = 0; j < DNA; ++j) { const float a = bf2f(o[j]); s2 += a * a; }
          const float rstd = 1.0f / sqrtf(s2 / (float)DNA + EPS); for (int j = 0; j < DNA; ++j) p.HX[(size_t)r * D + DHY + j] = f2bf(bf2f(o[j]) * rstd * p.out_norm_na[l * DNA + j]); }
        { const bf16* o = p.P + (size_t)r * NP + PC_GAQ; float s2 = 0.f; for (int j = 0; j < DGA; ++j) { const float a = bf2f(o[j]); s2 += a * a; }
          const float rstd = 1.0f / sqrtf(s2 / (float)DGA + EPS); for (int j = 0; j < DGA; ++j) p.HX[(size_t)r * D + DHY + DNA + j] = f2bf(bf2f(o[j]) * rstd * p.out_norm_ga[l * DGA + j]); }
        (void)yc;
    }
}
__device__ __forceinline__ void ph_outproj(const Prm& p, int l, const float* xs, const float* cs, int nrows, long gtid, long gsz) {
    const bf16* Bt = p.WoutT + (size_t)l * D * D;
    for (long i = gtid; i < (long)nrows * D; i += gsz) {
        const int m = (int)(i / D), n = (int)(i % D);
        const float acc = dot_bf(p.HX + (size_t)m * D, Bt + (size_t)n * D, D);
        const float gate = p.MOD[((size_t)l * 9 + row_modrow(m)) * 6 * D + 2 * D + n];
        if (m < MX) p.out[i] = xs[i] + gate * acc; else p.CX[i - (size_t)MX * D] = cs[i - (size_t)MX * D] + gate * acc;
    }
}
__device__ __forceinline__ void ph_ffn_up(const Prm& p, int nrows, long gtid, long gsz) {
    for (long i = gtid; i < (long)nrows * DFF; i += gsz) {
        const int m = (int)(i / DFF), j = (int)(i % DFF), n = 256 * (j / 128) + (j % 128);
        const float g = dot_bf(p.HX + (size_t)m * D, p.WguT + (size_t)n * D, D), u = dot_bf(p.HX + (size_t)m * D, p.WguT + (size_t)(n + 128) * D, D);
        p.HID[i] = f2bf(silu_f(g) * u);
    }
}
__device__ __forceinline__ void ph_ffn_down(const Prm& p, int l, int nrows, long gtid, long gsz) {
    for (long i = gtid; i < (long)nrows * D; i += gsz) {
        const int m = (int)(i / D), n = (int)(i % D);
        const float acc = dot_bf(p.HID + (size_t)m * DFF, p.WdT + (size_t)n * DFF, DFF);
        const float gate = p.MOD[((size_t)l * 9 + row_modrow(m)) * 6 * D + 5 * D + n];
        if (m < MX) p.out[i] += gate * acc; else p.CX[i - (size_t)MX * D] += gate * acc;
    }
}
__device__ __forceinline__ void ph_moe_count(const Prm& p, long gtid, long gsz) {
    for (long i = gtid; i < (long)2 * MPAD; i += gsz) p.LIST[i] = -1;
    for (long m = gtid; m < MX; m += gsz) { atomicAdd(p.ctl + p.TOPI[m * 2], 1); atomicAdd(p.ctl + 8 + p.TOPI[m * 2 + 1], 1); }
}
__device__ __forceinline__ int moe_off(const Prm& p, int pass, int e) {
    int o = 0;
#pragma unroll
    for (int k = 0; k < NE; ++k) if (k < e) o += (p.ctl[pass * 8 + k] + 255) / 256 * 256;
    return o;
}
__device__ __forceinline__ void ph_moe_assign(const Prm& p, long gtid, long gsz) {
    for (long m = gtid; m < MX; m += gsz) {
        for (int c = 0; c < 2; ++c) { const int e = p.TOPI[m * 2 + c]; const int slot = moe_off(p, c, e) + atomicAdd(p.ctl + 16 + c * 8 + e, 1); p.LIST[(size_t)c * MPAD + slot] = (int)m; }
    }
}
__device__ __forceinline__ int moe_slot_expert(const Prm& p, int pass, int slot) {
    int e = 0, o = 0;
#pragma unroll
    for (int k = 0; k < NE - 1; ++k) { o += (p.ctl[pass * 8 + k] + 255) / 256 * 256; if (slot >= o) e = k + 1; }
    return e;
}
__device__ __forceinline__ void ph_moe_up(const Prm& p, int pass, long gtid, long gsz) {
    const int tot = moe_off(p, pass, NE);
    for (long i = gtid; i < (long)tot * DFE; i += gsz) {
        const int slot = (int)(i / DFE), j = (int)(i % DFE), tok = p.LIST[(size_t)pass * MPAD + slot];
        if (tok < 0) continue;
        const int e = moe_slot_expert(p, pass, slot), n = 256 * (j / 128) + (j % 128);
        const bf16* W = p.WguTe + (size_t)e * 2 * DFE * D;
        const float g = dot_bf(p.HX + (size_t)tok * D, W + (size_t)n * D, D), u = dot_bf(p.HX + (size_t)tok * D, W + (size_t)(n + 128) * D, D);
        p.HID[i] = f2bf(silu_f(g) * u);
    }
}
__device__ __forceinline__ void ph_moe_down(const Prm& p, int l, int pass, long gtid, long gsz) {
    const int tot = moe_off(p, pass, NE);
    for (long i = gtid; i < (long)tot * D; i += gsz) {
        const int slot = (int)(i / D), n = (int)(i % D), tok = p.LIST[(size_t)pass * MPAD + slot];
        if (tok < 0) continue;
        const int e = moe_slot_expert(p, pass, slot);
        const float acc = dot_bf(p.HID + (size_t)slot * DFE, p.WdTe + ((size_t)e * D + n) * DFE, DFE);
        const float gate = p.MOD[((size_t)l * 9 + tok / S) * 6 * D + 5 * D + n];
        p.out[(size_t)tok * D + n] += gate * p.TOPW[tok * 2 + pass] * acc;
    }
}

enum { PH_WCONV, PH_MOD, PH_F1, PH_F2A, PH_F2B, PH_F3, PH_MODNORM1, PH_INPROJ, PH_PREP_HY, PH_PREP_QK, PH_HYENA, PH_GA, PH_NA, PH_CTXATTN, PH_FINAL, PH_OUTPROJ, PH_MODNORM2,
       PH_FFN_UP, PH_FFN_DOWN, PH_MOE_COUNT, PH_MOE_ASSIGN, PH_MOE_UP, PH_MOE_DOWN };
__device__ __forceinline__ void run_phase(const Prm& p, int ph, int l, int arg, long gtid, long gsz) {
    const bool first = l == 0, last = l == NL - 1;
    const float* xs = first ? p.x : p.out; const float* cs = first ? p.ctx : p.CX;
    const int nact = last ? MX : M;
    switch (ph) {
        case PH_WCONV: ph_wconv(p, gtid, gsz); break;
        case PH_MOD: ph_mod(p, gtid, gsz); break;
        case PH_F1: ph_filt1(p, gtid, gsz); break;
        case PH_F2A: ph_filt2(p, 0, p.FHA, p.FHB, gtid, gsz); break;
        case PH_F2B: ph_filt2(p, 1, p.FHB, p.FHA, gtid, gsz); break;
        case PH_F3: ph_filt3(p, p.FHA, gtid, gsz); break;
        case PH_MODNORM1: ph_modnorm(p, l, xs, cs, p.norm_mix + l * D, 0, D, M, false, gtid, gsz); break;
        case PH_INPROJ: ph_inproj(p, l, gtid, gsz); break;
        case PH_PREP_HY: ph_prep_hy(p, l, gtid, gsz); break;
        case PH_PREP_QK: ph_prep_qk(p, l, gtid, gsz); break;
        case PH_HYENA: ph_hyena_naive(p, l, true, !last, gtid, gsz); break;
        case PH_GA: ph_ga_naive(p, gtid, gsz); break;
        case PH_NA: ph_na_naive(p, l, gtid, gsz); break;
        case PH_CTXATTN: ph_ctxattn_naive(p, gtid, gsz); break;
        case PH_FINAL: ph_final(p, l, nact, gtid, gsz); break;
        case PH_OUTPROJ: ph_outproj(p, l, xs, cs, nact, gtid, gsz); break;
        case PH_MODNORM2: ph_modnorm(p, l, p.out, p.CX, p.norm_ffn + l * D, 3 * D, 4 * D, nact, (l & 1) != 0, gtid, gsz); break;
        case PH_FFN_UP: ph_ffn_up(p, nact, gtid, gsz); break;
        case PH_FFN_DOWN: ph_ffn_down(p, l, nact, gtid, gsz); break;
        case PH_MOE_COUNT: ph_moe_count(p, gtid, gsz); break;
        case PH_MOE_ASSIGN: ph_moe_assign(p, gtid, gsz); break;
        case PH_MOE_UP: ph_moe_up(p, arg, gtid, gsz); break;
        case PH_MOE_DOWN: ph_moe_down(p, l, arg, gtid, gsz); break;
    }
}

struct WsMap { size_t off; size_t take(size_t bytes) { const size_t o = off; off = (off + bytes + 255) & ~(size_t)255; return o; } };
constexpr size_t CTL_BYTES = 1u << 20;
static void build_prm(Prm& p, void* const* d_in, void* d_out, void* d_ws) {
    const float** f = (const float**)&p;
    for (int i = 0; i < 34; ++i) f[i] = (const float*)d_in[i];
    p.out = (float*)d_out;
    unsigned char* ws = (unsigned char*)d_ws; WsMap w{0};
    p.ctl = (int*)(ws + w.take(CTL_BYTES));
    p.MOD = (float*)(ws + w.take((size_t)NL * 9 * 6 * D * 4));
    p.ROPE = (float*)(ws + w.take((size_t)64 * 16 * 2 * 4));
    p.FHA = (float*)(ws + w.take((size_t)3 * S * 64 * 4)); p.FHB = (float*)(ws + w.take((size_t)3 * S * 64 * 4));
    p.FT = (bf16*)(ws + w.take((size_t)NL * DHY * (2 * S + 8) * 2)); p.FTC = (bf16*)(ws + w.take((size_t)DHY * (2 * LC + 8) * 2));
    p.WinT = (bf16*)(ws + w.take((size_t)NL * NP * D * 2)); p.WoutT = (bf16*)(ws + w.take((size_t)NL * D * D * 2));
    p.WguT = (bf16*)(ws + w.take((size_t)2 * DFF * D * 2)); p.WdT = (bf16*)(ws + w.take((size_t)D * DFF * 2));
    p.WguTe = (bf16*)(ws + w.take((size_t)NE * 2 * DFE * D * 2)); p.WdTe = (bf16*)(ws + w.take((size_t)NE * D * DFE * 2));
    p.CX = (float*)(ws + w.take((size_t)MC * D * 4));
    p.TOPI = (int*)(ws + w.take((size_t)MX * 2 * 4)); p.TOPW = (float*)(ws + w.take((size_t)MX * 2 * 4)); p.LIST = (int*)(ws + w.take((size_t)2 * MPAD * 4));
    p.HX = (bf16*)(ws + w.take((size_t)M * D * 2));
    const size_t rbase = w.off;
    p.P = (bf16*)(ws + w.take((size_t)M * NP * 2));
    p.VT = (bf16*)(ws + w.take((size_t)DHY * NB * S * 2)); p.VTC = (bf16*)(ws + w.take((size_t)DHY * NB * LC * 2));
    p.YC = (float*)(ws + w.take((size_t)DHY * NB * S * 4)); p.YCC = (float*)(ws + w.take((size_t)DHY * NB * LC * 4));
    p.HID = (bf16*)(ws + rbase);
}
static size_t ws_needed() {
    const size_t hid = (size_t)M * DFF * 2 > (size_t)MPAD * DFE * 2 ? (size_t)M * DFF * 2 : (size_t)MPAD * DFE * 2;
    Prm p; unsigned char* base = (unsigned char*)0x1000; void* din[34] = {}; build_prm(p, din, nullptr, base);
    const size_t endR = (size_t)((unsigned char*)p.YCC - base) + (size_t)DHY * NB * LC * 4, endH = (size_t)((unsigned char*)p.HID - base) + hid;
    return endR > endH ? endR : endH;
}


#ifndef CPU_EMU
#define LAS __attribute__((address_space(3)))
namespace pg8 {
#define PG8_LAS __attribute__((address_space(3)))
typedef unsigned short bf16_t;
typedef short bf16x8 __attribute__((ext_vector_type(8)));
typedef float f32x4 __attribute__((ext_vector_type(4)));
typedef unsigned u32x4 __attribute__((ext_vector_type(4)));
constexpr int BM = 256, BK = 64, HALF = 128, HTB = HALF * BK * 2  , STAGE_BYTES = 8 * HTB, NXCD = 8, WGM = 8;
__host__ __device__ __forceinline__ int lds_byte(int r, int c) { const int st = (r >> 4) * 2 + (c >> 5), rr = r & 15, cc = c & 31, ob = rr * 64 + cc * 2; return st * 1024 + (ob ^ (((ob >> 9) & 1) << 5)); }
__host__ __device__ __forceinline__ void stage_rc(int b, int& R, int& C) { const int st = b / 1024, sb = b % 1024, swz = sb ^ (((sb >> 9) & 1) << 5); R = (st >> 1) * 16 + swz / 64; C = (st & 1) * 32 + (swz % 64) / 2; }
__host__ __device__ __forceinline__ int perm32(int rho) { const int n = rho >> 4, i = rho & 15; return 8 * (i >> 2) + 4 * n + (i & 3); }
struct Unit { int pm, pn; };
struct Order {
    int nM, nN, nwg, G, c;
    const bf16_t* Bt; size_t bt_group_stride; int pend[8];
    const int* rows;
    __device__ void init(int nM_, int nN_, int G_, int c_, const bf16_t* Bt_) { nM = nM_; nN = nN_; nwg = nM * nN; G = G_; c = c_; Bt = Bt_; bt_group_stride = 0; rows = nullptr;
#pragma unroll
        for (int k = 0; k < 8; ++k) pend[k] = 0x7fffffff; }
    __device__ bool next(int i, Unit& u) const {
        const long L = (long)i * G + c; if (L >= nwg) return false;
        int wgid = (int)L; { const int q = nwg / NXCD, r = nwg % NXCD, xcd = wgid % NXCD, off = wgid / NXCD; wgid = (xcd < r ? xcd * (q + 1) : r * (q + 1) + (xcd - r) * q) + off; }
        const int nig = WGM * nN, gid = wgid / nig, fm = gid * WGM, gsz = (nM - fm) < WGM ? (nM - fm) : WGM;
        u.pm = fm + ((wgid % nig) % gsz); u.pn = (wgid % nig) / gsz; return true;
    }
    __device__ __forceinline__ int group(int pm) const { int e = 0;
#pragma unroll
        for (int k = 0; k < 7; ++k) e += (pm >= pend[k]) ? 1 : 0; return e; }
    __device__ __forceinline__ const bf16_t* bt(const Unit& u) const { return Bt + (size_t)group(u.pm) * bt_group_stride; }
    __device__ __forceinline__ int row(const Unit& u, int r) const { const int t = rows[(size_t)u.pm * BM + r]; return t < 0 ? 0 : t; }
};
__device__ __forceinline__ unsigned cvt_pk_bf16(float lo, float hi) { unsigned r; asm volatile("v_cvt_pk_bf16_f32 %0, %1, %2" : "=v"(r) : "v"(lo), "v"(hi)); return r; }

struct EpiBf16 {
    static constexpr bool PERM = true;
    bf16_t* O; int ldc;
    __device__ __forceinline__ void operator()(const f32x4 (&acc)[2][2][4][2], const Unit& u, int wr, int wc, int fr, int fq) const {
        const int row0 = u.pm * BM + wr * 64 + fr, col0 = u.pn * BM + wc * 32 + 8 * fq;
#pragma unroll
        for (int ai = 0; ai < 2; ++ai)
#pragma unroll
            for (int m = 0; m < 4; ++m) { bf16_t* rowp = O + (size_t)(row0 + ai * HALF + m * 16) * ldc + col0;
#pragma unroll
                for (int bj = 0; bj < 2; ++bj) { const f32x4 v0 = acc[ai][bj][m][0], v1 = acc[ai][bj][m][1];
                    u32x4 w; w.x = cvt_pk_bf16(v0[0], v0[1]); w.y = cvt_pk_bf16(v0[2], v0[3]); w.z = cvt_pk_bf16(v1[0], v1[1]); w.w = cvt_pk_bf16(v1[2], v1[3]);
                    *(u32x4*)(rowp + bj * HALF) = w; } }
    }
};
__device__ __forceinline__ float silu_fast(float v) { return v * __builtin_amdgcn_rcpf(1.0f + __builtin_amdgcn_exp2f(-1.4426950408889634f * v)); }
struct EpiSwiGLU {
    static constexpr bool PERM = true;
    bf16_t* H; int ldc;
    __device__ __forceinline__ void operator()(const f32x4 (&acc)[2][2][4][2], const Unit& u, int wr, int wc, int fr, int fq) const {
        const int row0 = u.pm * BM + wr * 64 + fr, col0 = u.pn * HALF + wc * 32 + 8 * fq;
#pragma unroll
        for (int ai = 0; ai < 2; ++ai)
#pragma unroll
            for (int m = 0; m < 4; ++m) { bf16_t* rowp = H + (size_t)(row0 + ai * HALF + m * 16) * ldc + col0;
                const f32x4 g0 = acc[ai][0][m][0], g1 = acc[ai][0][m][1], u0 = acc[ai][1][m][0], u1 = acc[ai][1][m][1];
                u32x4 w; w.x = cvt_pk_bf16(silu_fast(g0[0]) * u0[0], silu_fast(g0[1]) * u0[1]); w.y = cvt_pk_bf16(silu_fast(g0[2]) * u0[2], silu_fast(g0[3]) * u0[3]);
                w.z = cvt_pk_bf16(silu_fast(g1[0]) * u1[0], silu_fast(g1[1]) * u1[1]); w.w = cvt_pk_bf16(silu_fast(g1[2]) * u1[2], silu_fast(g1[3]) * u1[3]);
                *(u32x4*)rowp = w; }
    }
};
struct EpiResGate {
    static constexpr bool PERM = false;
    const float *xs, *cs; float *xd, *cd; const float* gate;
    __device__ __forceinline__ void operator()(const f32x4 (&acc)[2][2][4][2], const Unit& u, int wr, int wc, int fr, int fq) const {
        const bool lat = u.pm < MX / BM; const int prow = (lat ? u.pm : u.pm - MX / BM) * BM + wr * 64 + fr, col0 = u.pn * BM + wc * 32 + 4 * fq;
        const float* s = lat ? xs : cs; float* d = lat ? xd : cd; const float* g = gate + (size_t)(lat ? u.pm / (S / BM) : 8) * 6 * D + col0;
        f32x4 gv[2][2];
#pragma unroll
        for (int bj = 0; bj < 2; ++bj)
#pragma unroll
            for (int n = 0; n < 2; ++n) gv[bj][n] = *(const f32x4*)(g + bj * HALF + n * 16);
#pragma unroll
        for (int ai = 0; ai < 2; ++ai)
#pragma unroll
            for (int m = 0; m < 4; ++m) { const size_t off = (size_t)(prow + ai * HALF + m * 16) * D + col0;
#pragma unroll
                for (int bj = 0; bj < 2; ++bj)
#pragma unroll
                    for (int n = 0; n < 2; ++n) *(f32x4*)(d + off + bj * HALF + n * 16) = *(const f32x4*)(s + off + bj * HALF + n * 16) + gv[bj][n] * acc[ai][bj][m][n]; }
    }
};
struct EpiMoeDown {
    static constexpr bool PERM = false;
    const int* list; const float* topw; int pass; float* x; const float* gate;
    __device__ __forceinline__ void operator()(const f32x4 (&acc)[2][2][4][2], const Unit& u, int wr, int wc, int fr, int fq) const {
        const int slot0 = u.pm * BM + wr * 64 + fr, col0 = u.pn * BM + wc * 32 + 4 * fq;
#pragma unroll
        for (int ai = 0; ai < 2; ++ai)
#pragma unroll
            for (int m = 0; m < 4; ++m) { const int tok = list[slot0 + ai * HALF + m * 16];
                if (tok >= 0) { const float w = topw[tok * 2 + pass]; const float* g = gate + (size_t)(tok / S) * 6 * D + col0; float* xr = x + (size_t)tok * D + col0;
#pragma unroll
                    for (int bj = 0; bj < 2; ++bj)
#pragma unroll
                        for (int n = 0; n < 2; ++n) { const f32x4 gv = *(const f32x4*)(g + bj * HALF + n * 16); f32x4* xp = (f32x4*)(xr + bj * HALF + n * 16); *xp = *xp + gv * w * acc[ai][bj][m][n]; } } }
    }
};

template <class Epi, bool ALIGN_EPI, bool GATHER>
__device__ __forceinline__ void gemm_phase(PG8_LAS unsigned char* lds, const bf16_t* A, int K, const Order& S, const Epi& E) {
    int tid_ = threadIdx.x; asm volatile("" : "+v"(tid_));
    const int tid = tid_, wid = __builtin_amdgcn_readfirstlane(tid >> 6), lane = tid & 63, wr = wid >> 2, wc = wid & 3, fr = lane & 15, fq = lane >> 4;
    const int nt = K / BK;
    unsigned voffB[2]; int RA[2], CA[2];
#pragma unroll
    for (int i = 0; i < 2; ++i) { int R, C; stage_rc(tid * 16 + i * 8192, R, C); const int Rb = Epi::PERM ? ((R & ~31) + perm32(R & 31)) : R; RA[i] = R; CA[i] = C; voffB[i] = (unsigned)(Rb * K + C) * 2u; }
    const size_t kstep = (size_t)(BK * 2);
    const size_t hstep = (size_t)HALF * K * 2;
    const size_t tstep = 2 * hstep;
    const unsigned ldsw = (unsigned)wid * 1024u;
    const int aoff = lds_byte(wr * 64 + fr, fq * 8), boff = lds_byte(wc * 32 + fr, fq * 8);
#define PG8_SA(b, h) (((b) * 2 + (h)) * HTB)
#define PG8_SB(b, h) ((4 + (b) * 2 + (h)) * HTB)
#define PG8_STAGE_B(bufoff, gbase) do { _Pragma("unroll") for (int _i = 0; _i < 2; ++_i) \
        __builtin_amdgcn_global_load_lds((const unsigned*)((const char*)(gbase) + voffB[_i]), (PG8_LAS unsigned*)(lds + (bufoff) + ldsw + _i * 8192), 16, 0, 0); } while (0)
#define PG8_STAGE_A(bufoff, gbase, o0, o1) do { \
        __builtin_amdgcn_global_load_lds((const unsigned*)((const char*)(gbase) + (o0)), (PG8_LAS unsigned*)(lds + (bufoff) + ldsw), 16, 0, 0); \
        __builtin_amdgcn_global_load_lds((const unsigned*)((const char*)(gbase) + (o1)), (PG8_LAS unsigned*)(lds + (bufoff) + ldsw + 8192), 16, 0, 0); } while (0)
#define PG8_LDA(dst, b, h) do { _Pragma("unroll") for (int m = 0; m < 4; ++m) _Pragma("unroll") for (int k = 0; k < 2; ++k) dst[m][k] = *(const PG8_LAS bf16x8*)(lds + PG8_SA(b, h) + aoff + m * 2048 + k * 1024); } while (0)
#define PG8_LDB(dst, b, h) do { _Pragma("unroll") for (int n = 0; n < 2; ++n) _Pragma("unroll") for (int k = 0; k < 2; ++k) dst[n][k] = *(const PG8_LAS bf16x8*)(lds + PG8_SB(b, h) + boff + n * 2048 + k * 1024); } while (0)
#define PG8_MMA(ai, bj, At, Bt) do { __builtin_amdgcn_s_setprio(1); _Pragma("unroll") for (int m = 0; m < 4; ++m) _Pragma("unroll") for (int n = 0; n < 2; ++n) _Pragma("unroll") for (int k = 0; k < 2; ++k) \
        acc[ai][bj][m][n] = __builtin_amdgcn_mfma_f32_16x16x32_bf16(Bt[n][k], At[m][k], acc[ai][bj][m][n], 0, 0, 0); __builtin_amdgcn_s_setprio(0); } while (0)
#define PG8_WAIT_V(n) asm volatile("s_waitcnt vmcnt(" #n ")" ::: "memory")
#define PG8_WAIT_L(n) asm volatile("s_waitcnt lgkmcnt(" #n ")" ::: "memory")
#define PG8_BAR __builtin_amdgcn_s_barrier()
#define PG8_SCHED __builtin_amdgcn_sched_barrier(0)
    Unit cur, nxt, nx2; int ui = 0;
    if (!S.next(0, cur)) return;
    f32x4 acc[2][2][4][2];
#pragma unroll
    for (int a = 0; a < 2; ++a)
#pragma unroll
        for (int b = 0; b < 2; ++b)
#pragma unroll
            for (int m = 0; m < 4; ++m)
#pragma unroll
                for (int n = 0; n < 2; ++n) acc[a][b][m][n] = (f32x4){0.f, 0.f, 0.f, 0.f};
    bf16x8 At[4][2], B0[2][2], B1[2][2];
    unsigned oc00, oc01, oc10, oc11, on00, on01, on10, on11, o200 = 0, o201 = 0, o210 = 0, o211 = 0;
    const char* cA; const char* cB = (const char*)S.bt(cur) + (size_t)cur.pn * tstep;
    bool has_next = S.next(1, nxt), has_nx2 = false;
    if constexpr (GATHER) {
        cA = (const char*)A;
        oc00 = (unsigned)(S.row(cur, RA[0]) * K + CA[0]) * 2u; oc01 = (unsigned)(S.row(cur, RA[1]) * K + CA[1]) * 2u;
        oc10 = (unsigned)(S.row(cur, HALF + RA[0]) * K + CA[0]) * 2u; oc11 = (unsigned)(S.row(cur, HALF + RA[1]) * K + CA[1]) * 2u;
        if (has_next) { on00 = (unsigned)(S.row(nxt, RA[0]) * K + CA[0]) * 2u; on01 = (unsigned)(S.row(nxt, RA[1]) * K + CA[1]) * 2u;
                        on10 = (unsigned)(S.row(nxt, HALF + RA[0]) * K + CA[0]) * 2u; on11 = (unsigned)(S.row(nxt, HALF + RA[1]) * K + CA[1]) * 2u; }
        else { on00 = oc00; on01 = oc01; on10 = oc10; on11 = oc11; }
    } else {
        cA = (const char*)A + (size_t)cur.pm * tstep;
        oc00 = on00 = (unsigned)(RA[0] * K + CA[0]) * 2u; oc01 = on01 = (unsigned)(RA[1] * K + CA[1]) * 2u; oc10 = on10 = oc00 + (unsigned)hstep; oc11 = on11 = oc01 + (unsigned)hstep;
    }
    PG8_STAGE_B(PG8_SB(0, 0), cB); PG8_STAGE_B(PG8_SB(0, 1), cB + hstep); PG8_STAGE_A(PG8_SA(0, 0), cA, oc00, oc01); PG8_STAGE_A(PG8_SA(0, 1), cA, oc10, oc11);
    if (wr == 1) PG8_BAR;
    PG8_WAIT_V(2); PG8_BAR;
    PG8_STAGE_B(PG8_SB(1, 0), cB + kstep); PG8_STAGE_A(PG8_SA(1, 0), cA + kstep, oc00, oc01); PG8_STAGE_B(PG8_SB(1, 1), cB + hstep + kstep);
    PG8_WAIT_V(6); PG8_BAR;
    for (;;) {
        if constexpr (GATHER) {
            has_nx2 = has_next && S.next(ui + 2, nx2);
            if (has_nx2) { o200 = (unsigned)(S.row(nx2, RA[0]) * K + CA[0]) * 2u; o201 = (unsigned)(S.row(nx2, RA[1]) * K + CA[1]) * 2u;
                           o210 = (unsigned)(S.row(nx2, HALF + RA[0]) * K + CA[0]) * 2u; o211 = (unsigned)(S.row(nx2, HALF + RA[1]) * K + CA[1]) * 2u; }
        }
        const char* nA = GATHER ? cA : (has_next ? (const char*)A + (size_t)nxt.pm * tstep : cA);
        const char* nB = has_next ? (const char*)S.bt(nxt) + (size_t)nxt.pn * tstep : cB;
        for (int t = 0; t < nt; t += 2) {
            const bool last = (t == nt - 2);
            const char* a1 = cA + (size_t)(t + 1) * kstep;
            const char* a2 = last ? nA : cA + (size_t)(t + 2) * kstep; const char* b2 = last ? nB : cB + (size_t)(t + 2) * kstep;
            const char* a3 = a2 + kstep; const char* b3 = b2 + kstep;
            unsigned s00 = oc00, s01 = oc01, s10 = oc10, s11 = oc11;
            if constexpr (GATHER) { if (last) { s00 = on00; s01 = on01; s10 = on10; s11 = on11; } }
            PG8_LDB(B0, 0, 0); PG8_LDB(B1, 0, 1); PG8_SCHED; PG8_LDA(At, 0, 0); PG8_STAGE_A(PG8_SA(1, 1), a1, oc10, oc11);
            PG8_WAIT_V(8); PG8_WAIT_L(0); PG8_BAR; PG8_MMA(0, 0, At, B0); PG8_MMA(0, 1, At, B1); PG8_BAR; PG8_SCHED;
            PG8_LDA(At, 0, 1); PG8_STAGE_B(PG8_SB(0, 0), b2); PG8_STAGE_B(PG8_SB(0, 1), b2 + hstep); PG8_STAGE_A(PG8_SA(0, 0), a2, s00, s01);
            PG8_WAIT_V(8); PG8_WAIT_L(0); PG8_BAR; PG8_MMA(1, 0, At, B0); PG8_MMA(1, 1, At, B1); PG8_BAR; PG8_SCHED;
            PG8_LDB(B0, 1, 0); PG8_LDB(B1, 1, 1); PG8_SCHED; PG8_LDA(At, 1, 0); PG8_STAGE_A(PG8_SA(0, 1), a2, s10, s11);
            PG8_WAIT_V(8); PG8_WAIT_L(0); PG8_BAR; PG8_MMA(0, 0, At, B0); PG8_MMA(0, 1, At, B1); PG8_BAR; PG8_SCHED;
            PG8_LDA(At, 1, 1); PG8_STAGE_B(PG8_SB(1, 0), b3); PG8_STAGE_B(PG8_SB(1, 1), b3 + hstep); PG8_STAGE_A(PG8_SA(1, 0), a3, s00, s01);
            PG8_WAIT_V(8); PG8_WAIT_L(0); PG8_BAR; PG8_MMA(1, 0, At, B0); PG8_MMA(1, 1, At, B1); PG8_BAR; PG8_SCHED;
        }
        if constexpr (ALIGN_EPI) { if (wr == 0) PG8_BAR; }
        E(acc, cur, wr, wc, fr, fq);
        if (!has_next) break;
#pragma unroll
        for (int a = 0; a < 2; ++a)
#pragma unroll
            for (int b = 0; b < 2; ++b)
#pragma unroll
                for (int m = 0; m < 4; ++m)
#pragma unroll
                    for (int n = 0; n < 2; ++n) acc[a][b][m][n] = (f32x4){0.f, 0.f, 0.f, 0.f};
        cur = nxt; cA = nA; cB = nB; ++ui;
        if constexpr (GATHER) { oc00 = on00; oc01 = on01; oc10 = on10; oc11 = on11; nxt = nx2; has_next = has_nx2; if (has_nx2) { on00 = o200; on01 = o201; on10 = o210; on11 = o211; } }
        else has_next = S.next(ui + 1, nxt);
        if constexpr (ALIGN_EPI) { if (wr == 1) PG8_BAR; }
    }
    PG8_WAIT_V(0);
    if constexpr (!ALIGN_EPI) { if (wr == 0) PG8_BAR; }
    PG8_BAR;
#undef PG8_SA
#undef PG8_SB
#undef PG8_STAGE_A
#undef PG8_STAGE_B
#undef PG8_LDA
#undef PG8_LDB
#undef PG8_MMA
#undef PG8_WAIT_V
#undef PG8_WAIT_L
#undef PG8_BAR
#undef PG8_SCHED
}
}


#include <hip/hip_bf16.h>
namespace attn_body {
using bf16=__hip_bfloat16;
using bf16x8=__attribute__((ext_vector_type(8)))short;
using s16x4=__attribute__((ext_vector_type(4)))short;
using f32x16=__attribute__((ext_vector_type(16)))float;
using u32x4=__attribute__((ext_vector_type(4)))unsigned;
constexpr int D=64,DM=NP;
constexpr int NW=8,QBLK=32,QB=QBLK*NW,KVBLK=64;
__device__ __forceinline__ int crow(int r,int hi){return (r&3)+8*(r>>2)+4*hi;}
#define SBAR() __builtin_amdgcn_sched_barrier(0)
constexpr int NSLOT=3, SLOTB=8192;
constexpr int LDS_K=0, LDS_V=NSLOT*SLOTB, LDS_WS=2*NSLOT*SLOTB, LDS_OST=LDS_WS+NW*64*4, LDS_TAB=LDS_OST+NW*4096, LDS_BYTES=LDS_TAB+2048;
constexpr float C2=0.125f*1.4426950408889634f;
__device__ __forceinline__ void glds16(const void*gsrc,unsigned lds_dst){unsigned keep;
  asm volatile("s_mov_b32 %0, m0\n\ts_mov_b32 m0, %2\n\ts_nop 0\n\tglobal_load_lds_dwordx4 %1, off\n\ts_mov_b32 m0, %0":"=&s"(keep):"v"(gsrc),"s"(lds_dst):"memory");}
__device__ __forceinline__ float max3f(float a,float b,float c){float r;asm("v_max3_f32 %0, %1, %2, %3":"=v"(r):"v"(a),"v"(b),"v"(c));return r;}
__device__ __forceinline__ float max2f(float a,float b){float r;asm("v_max_f32_e32 %0, %1, %2":"=v"(r):"v"(a),"v"(b));return r;}
__device__ __forceinline__ float fadd_s(float a,float b){float r;asm("v_add_f32_e32 %0, %1, %2":"=v"(r):"v"(a),"v"(b));return r;}
__device__ __forceinline__ float fsub_s(float a,float b){float r;asm("v_sub_f32_e32 %0, %1, %2":"=v"(r):"v"(a),"v"(b));return r;}
typedef float f32x2_t __attribute__((ext_vector_type(2))); typedef __bf16 bf16x2_t __attribute__((ext_vector_type(2)));
__device__ __forceinline__ unsigned cvtpk_s(float lo,float hi){f32x2_t v={lo,hi};bf16x2_t b=__builtin_convertvector(v,bf16x2_t);return __builtin_bit_cast(unsigned,b);}
#define WAIT_BAR(N) asm volatile("s_waitcnt vmcnt(" #N ") lgkmcnt(0)\n\ts_barrier":::"memory")

__device__ __forceinline__ void qkt(f32x16&p0,f32x16&p1,const char*Kslot,const bf16x8*qr,const f32x16&negm,int r32,int hi){
  const char*kb=Kslot+hi*1024+r32*16;
  #pragma unroll
  for(int d0=0;d0<4;++d0){
    const bf16x8 b0=*reinterpret_cast<const bf16x8*>(kb+d0*2048);
    const bf16x8 b1=*reinterpret_cast<const bf16x8*>(kb+d0*2048+512);
    if(d0==0){p0=__builtin_amdgcn_mfma_f32_32x32x16_bf16(b0,qr[0],negm,0,0,0);p1=__builtin_amdgcn_mfma_f32_32x32x16_bf16(b1,qr[0],negm,0,0,0);}
    else{p0=__builtin_amdgcn_mfma_f32_32x32x16_bf16(b0,qr[d0],p0,0,0,0);p1=__builtin_amdgcn_mfma_f32_32x32x16_bf16(b1,qr[d0],p1,0,0,0);}}
}
typedef __attribute__((address_space(3))) const char* lds_cptr;
typedef short v4i16_t __attribute__((ext_vector_type(4)));
__device__ __forceinline__ void kload8(bf16x8*kf,lds_cptr kp){
  kf[0]=*(const __attribute__((address_space(3))) bf16x8*)(kp);      kf[1]=*(const __attribute__((address_space(3))) bf16x8*)(kp+512);
  kf[2]=*(const __attribute__((address_space(3))) bf16x8*)(kp+2048); kf[3]=*(const __attribute__((address_space(3))) bf16x8*)(kp+2560);
  kf[4]=*(const __attribute__((address_space(3))) bf16x8*)(kp+4096); kf[5]=*(const __attribute__((address_space(3))) bf16x8*)(kp+4608);
  kf[6]=*(const __attribute__((address_space(3))) bf16x8*)(kp+6144); kf[7]=*(const __attribute__((address_space(3))) bf16x8*)(kp+6656);
}
__device__ __forceinline__ void kload2(bf16x8*kf,lds_cptr kp,int j){ kf[2*j]=*(const __attribute__((address_space(3))) bf16x8*)(kp+j*2048); kf[2*j+1]=*(const __attribute__((address_space(3))) bf16x8*)(kp+j*2048+512); }
__device__ __forceinline__ s16x4 vtr(lds_cptr p){ return __builtin_bit_cast(s16x4,__builtin_amdgcn_ds_read_tr16_b64_v4i16((__attribute__((address_space(3))) v4i16_t*)p)); }
__device__ __forceinline__ float rowmax(const f32x16&p0,const f32x16&p1){
  float a=max3f(p0[0],p0[1],p1[0]),b=max3f(p0[2],p0[3],p1[1]);a=max3f(a,p1[2],p1[3]);
  #pragma unroll
  for(int r=4;r<16;r+=4){a=max3f(a,p0[r],p0[r+1]);b=max3f(b,p0[r+2],p0[r+3]);a=max3f(a,p1[r],p1[r+1]);b=max3f(b,p1[r+2],p1[r+3]);}
  const float m=max2f(a,b);
  auto rr=__builtin_amdgcn_permlane32_swap(__float_as_uint(m),__float_as_uint(m),false,false);
  return max2f(__uint_as_float(rr[0]),__uint_as_float(rr[1]));
}
__device__ __forceinline__ void pv(f32x16*o,int vb,bf16x8 pa0,bf16x8 pa1,bf16x8 pa2,bf16x8 pa3){
  #pragma unroll
  for(int d0=0;d0<2;++d0){s16x4 lo[4],hi[4];
    #pragma unroll
    for(int ks=0;ks<4;++ks){
      asm volatile("ds_read_b64_tr_b16 %0,%1 offset:%c2":"=&v"(lo[ks]):"v"(vb),"i"(d0*4096+ks*1024):"memory");
      asm volatile("ds_read_b64_tr_b16 %0,%1 offset:%c2":"=&v"(hi[ks]):"v"(vb),"i"(d0*4096+ks*1024+512):"memory");}
    asm volatile("s_waitcnt lgkmcnt(0)":::"memory");SBAR();
    #define PK(k) (bf16x8){lo[k][0],lo[k][1],lo[k][2],lo[k][3],hi[k][0],hi[k][1],hi[k][2],hi[k][3]}
    o[d0]=__builtin_amdgcn_mfma_f32_32x32x16_bf16(pa0,PK(0),o[d0],0,0,0);
    o[d0]=__builtin_amdgcn_mfma_f32_32x32x16_bf16(pa1,PK(1),o[d0],0,0,0);
    o[d0]=__builtin_amdgcn_mfma_f32_32x32x16_bf16(pa2,PK(2),o[d0],0,0,0);
    o[d0]=__builtin_amdgcn_mfma_f32_32x32x16_bf16(pa3,PK(3),o[d0],0,0,0);
    #undef PK
  }
}

#ifndef ATTN_STORE16
#define ATTN_STORE16(p,v) (*(u32x4*)(p)=(v))
#endif
__device__ __forceinline__ void na_mask(f32x16&P0,f32x16&P1,int tl,int klo,int nlat,int wr0,int qgr,int qcol,int cs,int hi,float mhat,const float*tab){
  if(tl<0){
    #pragma unroll
    for(int r=0;r<16;++r){P0[r]-=mhat;P1[r]-=mhat;}
    return; }
  const int krow=klo+tl; const bool rv=(tl<nlat)&&(krow>=wr0)&&(krow<wr0+8);
  if(!rv){
    #pragma unroll
    for(int r=0;r<16;++r){P0[r]=-INFINITY;P1[r]=-INFINITY;}
    return; }
  int hio=hi; asm volatile("":"+v"(hio));
  const float*tb=tab+(krow-qgr+7)*31+15-qcol+4*hio; const int kb=4*hio-cs;
  #pragma unroll
  for(int r=0;r<16;++r){ const int c0=(r&3)+8*(r>>2);
    const bool v0=(unsigned)(c0+kb)<16u, v1=(unsigned)(c0+32+kb)<16u;
    const float b0=tb[c0], b1=tb[c0+32];
    P0[r]=v0?(P0[r]-mhat)+b0:-INFINITY; P1[r]=v1?(P1[r]-mhat)+b1:-INFINITY; }
}
template<int THRL,int MODE> __device__ __forceinline__ void attn_unit(const int b,const int qrow0,const int klo,const int NT,const int nlat,const bf16*Qg,const bf16*__restrict__ Kg,const bf16*__restrict__ Vg,bf16*Og,const float*rpb,char*shm){
  const int tid=threadIdx.x,lane=tid&63,r32=lane&31,hi=lane>>5; const int wid=__builtin_amdgcn_readfirstlane(tid>>6);
  const bf16*Qw=Qg+((long)qrow0+wid*QBLK)*DM;
  #define TROW(t) ((long)(MODE==0 ? ((t)<S/64 ? (long)b*S+64*(t) : (long)MX+(long)b*LC+64*((t)-S/64)) : MODE==1 ? ((t)<LC/64 ? (long)MX+(long)b*LC+64*(t) : (long)b*S+64*(klo+((t)-LC/64<nlat?(t)-LC/64:nlat-1))) : (long)MX+(long)b*LC+64*(t)))
  const unsigned lds0=(unsigned)(uintptr_t)shm;
  float*wsf=(float*)(shm+LDS_WS)+wid*64;
  const bf16*ksrc=Kg+(long)lane*DM+wid*8;
  const bf16*vsrc=Vg+(long)(16*(wid&3)+(lane>>2))*DM+(wid>>2)*32+(lane&3)*8;
  const unsigned kdst=lds0+LDS_K+wid*1024, vdst=lds0+LDS_V+wid*1024;
  #define DMA_K(t,slot) glds16(ksrc+TROW(t)*DM,(unsigned)__builtin_amdgcn_readfirstlane(kdst+(slot)))
  #define DMA_V(t,slot) glds16(vsrc+TROW(t)*DM,(unsigned)__builtin_amdgcn_readfirstlane(vdst+(slot)))
  const int vb0=(int)(lds0+LDS_V)+((lane>>4)&1)*32+(lane&3)*8+(4*hi+((lane&15)>>2))*64;
  const char*Kbase=shm+LDS_K; bf16x8 kf[8];
  const lds_cptr shm3=(lds_cptr)shm; const lds_cptr kp0=shm3+LDS_K+hi*1024+r32*16; const lds_cptr vp0=shm3+LDS_V+((lane>>4)&1)*32+(lane&3)*8+(4*hi+((lane&15)>>2))*64;
  DMA_K(0,0);DMA_V(0,0);DMA_K(1,SLOTB);
  bf16x8 qr[4];
  #pragma unroll
  for(int d0=0;d0<4;++d0)qr[d0]=*reinterpret_cast<const bf16x8*>(&Qw[(long)r32*DM+d0*16+hi*8]);
  float mhat=0.f,l_reg=0.f;f32x16 o[2];o[0]=f32x16{};o[1]=f32x16{};f32x16 negm=f32x16{}; if(MODE!=1){asm volatile("":"+v"(negm));} const f32x16 zero16_=f32x16{};
  #define NEGM_ (MODE==1?zero16_:negm)
  const int qcol=32*(wid&1)+r32, qgr=(qrow0%S)/64+(wid>>1); int cs_=qcol-8; cs_=cs_<0?0:(cs_>48?48:cs_); int wr0_=qgr-4; wr0_=wr0_<0?0:(wr0_>S/64-8?S/64-8:wr0_);
  const float*tab=(const float*)(shm+LDS_TAB);
  if(MODE==1){ for(int i_=tid;i_<15*31;i_+=512)((float*)(shm+LDS_TAB))[i_]=rpb[i_]*1.4426950408889634f; }
  #define CMASK(P0,P1,t) do{ if(MODE==1){ na_mask(P0,P1,(t)-LC/64,klo,nlat,wr0_,qgr,qcol,cs_,hi,mhat,tab); } }while(0)
  bool resc=false;
  #define START(P0,P1) do{ const float rm=rowmax(P0,P1); resc=false; \
    { const float dl=rm; mhat=fadd_s(mhat,dl); \
      _Pragma("unroll") for(int r=0;r<16;++r){P0[r]=fsub_s(P0[r],dl);P1[r]=fsub_s(P1[r],dl);} \
      if(MODE!=1){ _Pragma("unroll") for(int r=0;r<16;++r)negm[r]=-mhat; asm volatile("":"+v"(negm)); } } \
    _Pragma("unroll") for(int r=0;r<16;++r)P0[r]=__builtin_amdgcn_exp2f(P0[r]); }while(0)
  #define RESC() do{ if(resc){ asm volatile("s_waitcnt lgkmcnt(0)":::"memory"); \
      _Pragma("unroll") for(int d_=0;d_<2;++d_) _Pragma("unroll") for(int r=0;r<16;++r)o[d_][r]*=wsf[crow(r,hi)]; } }while(0)
  f32x16 pA0,pA1,pB0,pB1;
  int sl_prev=0,sl_cur=0,sl_next=SLOTB;
  #define ROT() do{sl_prev=sl_cur;sl_cur=sl_next;sl_next=(sl_next==(NSLOT-1)*SLOTB)?0:sl_next+SLOTB;}while(0)
  DMA_K(2,2*SLOTB);
  WAIT_BAR(3);
  qkt(pA0,pA1,Kbase,qr,NEGM_,r32,hi);asm volatile("s_nop 15\n\ts_nop 7":"+v"(pA0),"+v"(pA1));CMASK(pA0,pA1,0);
  START(pA0,pA1);
  _Pragma("unroll") for(int r=0;r<16;++r)pA1[r]=__builtin_amdgcn_exp2f(pA1[r]);
  WAIT_BAR(0);
  DMA_K(3,0);DMA_V(1,SLOTB);
  ROT();
  kload8(kf,kp0+sl_cur);
  WAIT_BAR(2);
  s16x4 vlo[8],vhi[8]; u32x4 pw0,pw1,pw2,pw3;
  #define PKW(P,B) cvtpk_s(P[B],P[B+1])
  #define PAF(k) __builtin_bit_cast(bf16x8,pw##k)
  #define VFR(i) (bf16x8){vlo[i][0],vlo[i][1],vlo[i][2],vlo[i][3],vhi[i][0],vhi[i][1],vhi[i][2],vhi[i][3]}
  #define PIN(x) asm volatile("":"+v"(x))
  #define MX3(a,b,c) __builtin_fmaxf(__builtin_fmaxf((a),(b)),(c))
  #define GAPA(MF,A0,A1,A2,A3,W0,W1,PW) do{ MF; sacc+=A0; sacc+=A1; sacc+=A2; sacc+=A3; PIN(sacc); W0; W1; PIN(PW); SBAR(); }while(0)
  #define EX(v) __builtin_amdgcn_exp2f(v)
  #define GAPB(MF,X,B) do{ MF; X[B]=EX(X[B]); X[B+1]=EX(X[B+1]); X[B+2]=EX(X[B+2]); X[B+3]=EX(X[B+3]); PIN(X); SBAR(); }while(0)
  #define VRD(i) do{ vlo[i]=vtr(vp_+(((i)>>2)*4096+((i)&3)*1024)); vhi[i]=vtr(vp_+(((i)>>2)*4096+((i)&3)*1024+512)); }while(0)
  #define KRD(G,j) do{ if(G){ kload2(kf,kp0+sl_next,j); SBAR(); } }while(0)
  #define STEP(C0,C1,P0,P1,t,GK,GV,GL) do{ SBAR(); \
    const lds_cptr vp_=vp0+sl_prev; \
    VRD(0); SBAR(); float sacc=(P0[0]+P0[1]); \
    GAPA(C0=__builtin_amdgcn_mfma_f32_32x32x16_bf16(kf[0],qr[0],NEGM_,0,0,0), P0[2],P0[3],P0[4],P0[5],     pw0[0]=PKW(P0,0), pw0[1]=PKW(P0,2), pw0); \
    VRD(4); SBAR(); GAPA(C1=__builtin_amdgcn_mfma_f32_32x32x16_bf16(kf[1],qr[0],NEGM_,0,0,0), P0[6],P0[7],P0[8],P0[9],     pw0[2]=PKW(P0,4), pw0[3]=PKW(P0,6), pw0); \
    VRD(1); SBAR(); GAPA(C0=__builtin_amdgcn_mfma_f32_32x32x16_bf16(kf[2],qr[1],C0,0,0,0),   P0[10],P0[11],P0[12],P0[13], pw1[0]=PKW(P0,8), pw1[1]=PKW(P0,10), pw1); \
    VRD(5); SBAR(); GAPA(C1=__builtin_amdgcn_mfma_f32_32x32x16_bf16(kf[3],qr[1],C1,0,0,0),   P0[14],P0[15],P1[0],P1[1],   pw1[2]=PKW(P0,12),pw1[3]=PKW(P0,14), pw1); \
    VRD(2); SBAR(); GAPA(C0=__builtin_amdgcn_mfma_f32_32x32x16_bf16(kf[4],qr[2],C0,0,0,0),   P1[2],P1[3],P1[4],P1[5],     pw2[0]=PKW(P1,0), pw2[1]=PKW(P1,2), pw2); \
    VRD(6); SBAR(); GAPA(C1=__builtin_amdgcn_mfma_f32_32x32x16_bf16(kf[5],qr[2],C1,0,0,0),   P1[6],P1[7],P1[8],P1[9],     pw2[2]=PKW(P1,4), pw2[3]=PKW(P1,6), pw2); \
    VRD(3); SBAR(); GAPA(C0=__builtin_amdgcn_mfma_f32_32x32x16_bf16(kf[6],qr[3],C0,0,0,0),   P1[10],P1[11],P1[12],P1[13], pw3[0]=PKW(P1,8), pw3[1]=PKW(P1,10), pw3); \
    VRD(7); SBAR(); GAPA(C1=__builtin_amdgcn_mfma_f32_32x32x16_bf16(kf[7],qr[3],C1,0,0,0),   P1[14],P1[15],0.f,0.f,       pw3[2]=PKW(P1,12),pw3[3]=PKW(P1,14), pw3); \
    l_reg+=sacc; \
    if(GK){DMA_K((t)+3,sl_cur);} if(GV){DMA_V((t)+1,sl_next);} \
    CMASK(C0,C1,t); \
    { float a=MX3(C0[0],C0[1],C1[0]),b=MX3(C0[2],C0[3],C1[1]); a=MX3(a,C1[2],C1[3]); \
      _Pragma("unroll") for(int r=4;r<16;r+=4){a=MX3(a,C0[r],C0[r+1]);b=MX3(b,C0[r+2],C0[r+3]);a=MX3(a,C1[r],C1[r+1]);b=MX3(b,C1[r+2],C1[r+3]);} \
      float rm=__builtin_fmaxf(a,b); { auto rr=__builtin_amdgcn_permlane32_swap(__float_as_uint(rm),__float_as_uint(rm),false,false); rm=__builtin_fmaxf(__uint_as_float(rr[0]),__uint_as_float(rr[1])); } \
      resc=false; \
      if(__builtin_expect(__any(rm>(float)THRL),0)){ const float dl=__builtin_fmaxf(rm,0.f); mhat+=dl; \
        _Pragma("unroll") for(int r=0;r<16;++r){C0[r]-=dl;C1[r]-=dl;} \
        if(MODE!=1){ _Pragma("unroll") for(int r=0;r<16;++r)negm[r]=-mhat; asm volatile("":"+v"(negm)); } \
        const float f=__builtin_amdgcn_exp2f(-dl); l_reg*=f; if(hi==0)wsf[r32]=f; resc=true; } } \
    SBAR(); \
    GAPB(o[0]=__builtin_amdgcn_mfma_f32_32x32x16_bf16(PAF(0),VFR(0),o[0],0,0,0), C0,0); \
    GAPB(o[1]=__builtin_amdgcn_mfma_f32_32x32x16_bf16(PAF(0),VFR(4),o[1],0,0,0), C0,4); \
    KRD(GL,0); GAPB(o[0]=__builtin_amdgcn_mfma_f32_32x32x16_bf16(PAF(1),VFR(1),o[0],0,0,0), C0,8); \
    KRD(GL,1); GAPB(o[1]=__builtin_amdgcn_mfma_f32_32x32x16_bf16(PAF(1),VFR(5),o[1],0,0,0), C0,12); \
    KRD(GL,2); GAPB(o[0]=__builtin_amdgcn_mfma_f32_32x32x16_bf16(PAF(2),VFR(2),o[0],0,0,0), C1,0); \
    KRD(GL,3); GAPB(o[1]=__builtin_amdgcn_mfma_f32_32x32x16_bf16(PAF(2),VFR(6),o[1],0,0,0), C1,4); \
    GAPB(o[0]=__builtin_amdgcn_mfma_f32_32x32x16_bf16(PAF(3),VFR(3),o[0],0,0,0), C1,8); \
    GAPB(o[1]=__builtin_amdgcn_mfma_f32_32x32x16_bf16(PAF(3),VFR(7),o[1],0,0,0), C1,12); \
    }while(0)
  int t=1;
  #undef CMASK
  #define CMASK(P0,P1,t) do{ if(MODE==1){ na_mask(P0,P1,(t)-LC/64,klo,nlat,wr0_,qgr,qcol,cs_,hi,mhat,tab); } }while(0)
  for(;t+5<NT;t+=2){
    STEP(pB0,pB1,pA0,pA1,t,true,true,true);     WAIT_BAR(2); RESC(); ROT();
    STEP(pA0,pA1,pB0,pB1,t+1,true,true,true);   WAIT_BAR(2); RESC(); ROT();
  }
  #undef CMASK
  #define CMASK(P0,P1,t) do{ if(MODE==1){ na_mask(P0,P1,(t)-LC/64,klo,nlat,wr0_,qgr,qcol,cs_,hi,mhat,tab); } }while(0)
  #define ENDW(tt) do{ if((tt)+3<NT){WAIT_BAR(2);} else if((tt)+2<NT){WAIT_BAR(1);} else {WAIT_BAR(0);} }while(0)
  for(;t+1<NT;t+=2){
    STEP(pB0,pB1,pA0,pA1,t,(t+3<NT),(t+1<NT),(t+1<NT));       ENDW(t);   RESC(); ROT();
    STEP(pA0,pA1,pB0,pB1,t+1,(t+4<NT),(t+2<NT),(t+2<NT));     ENDW(t+1); RESC(); ROT();
  }
  STEP(pB0,pB1,pA0,pA1,NT-1,false,false,false); RESC();
  { float sacc=pB0[0]+pB0[1]; _Pragma("unroll") for(int r=2;r<16;++r)sacc+=pB0[r]; _Pragma("unroll") for(int r=0;r<16;++r)sacc+=pB1[r]; l_reg+=sacc;
    pw0=(u32x4){PKW(pB0,0),PKW(pB0,2),PKW(pB0,4),PKW(pB0,6)};pw1=(u32x4){PKW(pB0,8),PKW(pB0,10),PKW(pB0,12),PKW(pB0,14)};pw2=(u32x4){PKW(pB1,0),PKW(pB1,2),PKW(pB1,4),PKW(pB1,6)};pw3=(u32x4){PKW(pB1,8),PKW(pB1,10),PKW(pB1,12),PKW(pB1,14)};
    SBAR(); pv(o,vb0+sl_cur,PAF(0),PAF(1),PAF(2),PAF(3)); }
  #undef PKW
  #undef PAF
  #undef VFR
  #undef PIN
  #undef MX3
  #undef GAPA
  #undef GAPB
  #undef EX
  #undef VRD
  #undef KRD
  #undef STEP
  #undef ENDW
  {auto rr=__builtin_amdgcn_permlane32_swap(__float_as_uint(l_reg),__float_as_uint(l_reg),false,false);l_reg=__uint_as_float(rr[0])+__uint_as_float(rr[1]);}
  if(hi==0)wsf[32+r32]=l_reg;asm volatile("s_waitcnt lgkmcnt(0)":::"memory");
  float rli[16];
  #pragma unroll
  for(int r=0;r<16;++r)rli[r]=__builtin_amdgcn_rcpf(wsf[32+crow(r,hi)]);
  bf16*Ow=Og+((long)qrow0+wid*QBLK)*DM;
  { bf16*stg=(bf16*)(shm+LDS_OST)+wid*2048;
    #pragma unroll
    for(int r=0;r<16;++r){const int orow=crow(r,hi);
      #pragma unroll
      for(int d0=0;d0<2;++d0)stg[orow*64+d0*32+r32]=__float2bfloat16(o[d0][r]*rli[r]);}
    asm volatile("s_waitcnt lgkmcnt(0)":::"memory");
    #pragma unroll
    for(int i=0;i<4;++i){const int row=i*8+(lane>>3),ch=lane&7; const u32x4 v=*(const u32x4*)(stg+row*64+ch*8); ATTN_STORE16(Ow+(long)row*DM+ch*8,v);} }
  asm volatile("s_waitcnt lgkmcnt(0)\n\ts_barrier":::"memory");
  #undef DMA_K
  #undef NEGM_
  #undef TROW
  #undef DMA_V
  #undef CMASK
  #undef START
  #undef RESC
  #undef ROT
}
constexpr int ATTN_LDS_BYTES=LDS_BYTES;
#undef SBAR
#undef WAIT_BAR
}
template <bool WITH_CTX> __device__ __forceinline__ void attn_phase(const Prm& p, int l, char* shm, int G) {
    using namespace attn_body;
    const int bx = blockIdx.x, vcu = (G % 8 == 0) ? (bx % 8) * (G / 8) + bx / 8 : bx;
    const attn_body::bf16* Pb = (const attn_body::bf16*)p.P;
    constexpr int NQB = S / 256;
    for (int u = vcu * 2; u < NB * NGA * NQB; u += 2 * G) {
#pragma unroll 1
        for (int j = 0; j < 2; ++j) { const int uu = u + j; if (uu >= NB * NGA * NQB) break; const int qb = uu % NQB, h = (uu / NQB) % NGA, b = uu / (NQB * NGA);
            attn_unit<8, 0>(b, b * S + 256 * qb, 0, S / 64 + LC / 64, 0, Pb + PC_GAQ + 64 * h, Pb + PC_GAK + 64 * h, Pb + PC_GAV + 64 * h, (attn_body::bf16*)Pb + PC_GAQ + 64 * h, nullptr, shm); }
    }
    for (int u = vcu * 3; u < NB * NNA * NQB; u += 3 * G) {
#pragma unroll 1
        for (int j = 0; j < 3; ++j) { const int uu = u + j; if (uu >= NB * NNA * NQB) break; const int qb = uu % NQB, h = (uu / NQB) % NNA, b = uu / (NQB * NNA);
            const int r0 = 4 * qb; int klo = r0 - 4; klo = klo < 0 ? 0 : (klo > ROWS - 8 ? ROWS - 8 : klo); int khi = r0 + 3 - 4; khi = (khi < 0 ? 0 : (khi > ROWS - 8 ? ROWS - 8 : khi)) + 7;
            const int nlat = khi - klo + 1, NT = (LC / 64 + nlat + 1) & ~1;
            attn_unit<8, 1>(b, b * S + 256 * qb, klo, NT, nlat, Pb + PC_NAQ + 64 * h, Pb + PC_NAK + 64 * h, Pb + PC_NAV + 64 * h, (attn_body::bf16*)Pb + PC_NAQ + 64 * h, p.na_rpb + ((size_t)l * NNA + h) * 15 * 31, shm); }
    }
    if constexpr (WITH_CTX) {
        static_assert(LC == 256, "context unit = one 256-row query block");
        for (int u = vcu; u < NB * (NNA + NGA); u += G) { const int hh = u % (NNA + NGA), b = u / (NNA + NGA);
            const int qo = hh < NNA ? PC_NAQ + 64 * hh : PC_GAQ + 64 * (hh - NNA), ko = hh < NNA ? PC_NAK + 64 * hh : PC_GAK + 64 * (hh - NNA), vo = hh < NNA ? PC_NAV + 64 * hh : PC_GAV + 64 * (hh - NNA);
            attn_unit<8, 2>(b, MX + b * LC, 0, LC / 64, 0, Pb + qo, Pb + ko, Pb + vo, (attn_body::bf16*)Pb + qo, nullptr, shm); }
    }
}


namespace hy {
typedef short bf16x8 __attribute__((ext_vector_type(8)));
typedef short s16x4 __attribute__((ext_vector_type(4)));
typedef float f32x16 __attribute__((ext_vector_type(16)));
typedef float f32x4 __attribute__((ext_vector_type(4)));
typedef unsigned u32x4 __attribute__((ext_vector_type(4)));
constexpr int NBLK = S / 128, FTP = 2 * S + 8, L_V = 0, L_F = NB * S * 2, FCOPY = 2 * S * 2 + 64, L_END = L_F + 3 * FCOPY + 2 * S * 2;
static_assert(NBLK == 32 && NB == 8, "hyena unit geometry: 32 sequence blocks of 128, 8 batches");
__device__ __forceinline__ void hyena_unit(const bf16* vg, const bf16* fg, float* yg, LAS unsigned char* lds) {
    int tid_ = threadIdx.x; asm volatile("" : "+v"(tid_));
    const int tid = tid_, wid = __builtin_amdgcn_readfirstlane(tid >> 6), lane = tid & 63, n = lane & 31, hi = lane >> 5;
#pragma unroll
    for (int i = 0; i < 8; ++i) { const int q = i * 512 + tid, rowg = q >> 4, ch = q & 15, rowL = (rowg & 31) * 8 + (rowg >> 5);
        const u32x4 v = *(const u32x4*)(vg + (size_t)q * 8); *(LAS u32x4*)(lds + L_V + rowL * 256 + ((ch ^ (rowL & 15)) << 4)) = v; }
#pragma unroll
    for (int i = 0; i < 2; ++i) { const int g = i * 512 + tid; const u32x4 a = *(const u32x4*)(fg + 8 * g), b = *(const u32x4*)(fg + 8 * g + 8);
        const unsigned w[8] = {a.x, a.y, a.z, a.w, b.x, b.y, b.z, b.w};
        u32x4 c1, c3;
#pragma unroll
        for (int k = 0; k < 4; ++k) { c1[k] = __builtin_amdgcn_alignbit(w[k + 1], w[k], 16); c3[k] = __builtin_amdgcn_alignbit(w[k + 2], w[k + 1], 16); }
        *(LAS u32x4*)(lds + L_F + 0 * FCOPY + g * 16) = a; *(LAS u32x4*)(lds + L_F + 1 * FCOPY + g * 16) = c1;
        *(LAS u32x4*)(lds + L_F + 2 * FCOPY + g * 16) = (u32x4){a.y, a.z, a.w, b.x}; *(LAS u32x4*)(lds + L_F + 3 * FCOPY + g * 16) = c3; }
    __syncthreads();
    f32x16 acc[4];
#pragma unroll
    for (int m = 0; m < 4; ++m) acc[m] = f32x16{};
    const int I0 = 4 * wid, I = I0 + (n >> 3), bb = n & 7;
#pragma unroll 1
    for (int cs = 0; cs < NBLK; ++cs) {
        const int rowL = ((I - cs) & 31) * 8 + bb;
        bf16x8 Bf[8];
#pragma unroll
        for (int s = 0; s < 8; ++s) Bf[s] = *(const LAS bf16x8*)(lds + L_V + rowL * 256 + (((2 * s + hi) ^ (rowL & 15)) << 4));
#pragma unroll 1
        for (int pass = 0; pass < 2; ++pass) {
            const bool any = pass == 0 ? (I0 + 3 >= cs) : (I0 < cs);
            if (!any) continue;
            const bool valid = pass == 0 ? (I >= cs) : (I < cs); const int d = pass == 0 ? cs : cs - NBLK;
            const int xb = S - 128 * d - 96 - n + 8 * hi, rho = xb & 3;
            const LAS unsigned char* fa = lds + L_F + rho * FCOPY + 2 * (xb - rho);
            bf16x8 Af[14];
#pragma unroll
            for (int o = 0; o < 14; ++o) { const s16x4 lo = *(const LAS s16x4*)(fa + (13 - o) * 32), hh = *(const LAS s16x4*)(fa + (13 - o) * 32 + 8);
                Af[o] = (bf16x8){lo[0], lo[1], lo[2], lo[3], hh[0], hh[1], hh[2], hh[3]}; }
            bf16x8 Bm[8];
#pragma unroll
            for (int s = 0; s < 8; ++s) Bm[s] = valid ? Bf[s] : (bf16x8){0, 0, 0, 0, 0, 0, 0, 0};
#pragma unroll
            for (int s = 0; s < 8; ++s)
#pragma unroll
                for (int m = 0; m < 4; ++m) acc[m] = __builtin_amdgcn_mfma_f32_32x32x16_bf16(Af[2 * m - s + 7], Bm[s], acc[m], 0, 0, 0);
        }
    }
    __syncthreads();
    LAS unsigned char* st = lds + wid * 16384;
#pragma unroll
    for (int m = 0; m < 4; ++m)
#pragma unroll
        for (int g = 0; g < 4; ++g) { const int q = 8 * m + 2 * g + hi; *(LAS f32x4*)(st + n * 512 + ((q ^ n) << 4)) = (f32x4){acc[m][4 * g], acc[m][4 * g + 1], acc[m][4 * g + 2], acc[m][4 * g + 3]}; }
    asm volatile("s_waitcnt lgkmcnt(0)" ::: "memory");
#pragma unroll
    for (int i = 0; i < 16; ++i) { const int rn = 2 * i + hi, q = n; const f32x4 v = *(const LAS f32x4*)(st + rn * 512 + ((q ^ rn) << 4));
        *(f32x4*)(yg + (size_t)(rn & 7) * S + (I0 + (rn >> 3)) * 128 + 4 * q) = v; }
    __syncthreads();
}
}
__device__ __forceinline__ void hyena_phase(const Prm& p, int l, LAS unsigned char* lds, int G) {
    const int bx = blockIdx.x;
    for (int c = bx; c < DHY; c += G)
        hy::hyena_unit(p.VT + (size_t)c * NB * S, p.FT + ((size_t)l * DHY + c) * hy::FTP, p.YC + (size_t)c * NB * S, lds);
}


namespace thin {
typedef float f32x4 __attribute__((ext_vector_type(4)));
typedef unsigned u32x4 __attribute__((ext_vector_type(4)));
typedef unsigned u32x2 __attribute__((ext_vector_type(2)));
__device__ __forceinline__ float wave_sum(float v) {
#pragma unroll
    for (int o = 1; o < 64; o <<= 1) v += __shfl_xor(v, o);
    return v;
}
__device__ __forceinline__ unsigned pk2(float lo, float hi) { return f2bf_u(lo) | (f2bf_u(hi) << 16); }
__device__ __forceinline__ float lo16(unsigned u) { return __uint_as_float(u << 16); }
__device__ __forceinline__ float hi16(unsigned u) { return __uint_as_float(u & 0xffff0000u); }

__device__ __forceinline__ void transpose_item(const float* W, int K, int N, bf16* WT, int k0, int n0, int drow0, LAS float* scr, int lane) {
#pragma unroll 8
    for (int i = 0; i < 32; ++i) { const int kk = 2 * i + (lane >> 5); scr[kk * 33 + (lane & 31)] = W[(size_t)(k0 + kk) * N + n0 + (lane & 31)]; }
    asm volatile("s_waitcnt lgkmcnt(0)" ::: "memory");
    const int c = lane & 7;
#pragma unroll
    for (int j = 0; j < 4; ++j) { const int n = (lane >> 3) + 8 * j; const LAS float* sp = scr + (8 * c) * 33 + n;
        u32x4 o; o.x = pk2(sp[0 * 33], sp[1 * 33]); o.y = pk2(sp[2 * 33], sp[3 * 33]); o.z = pk2(sp[4 * 33], sp[5 * 33]); o.w = pk2(sp[6 * 33], sp[7 * 33]);
        *(u32x4*)(WT + (size_t)(drow0 + n) * K + k0 + 8 * c) = o; }
    asm volatile("s_waitcnt lgkmcnt(0)" ::: "memory");
}
__device__ __forceinline__ void transpose_matrix(const float* W, int K, int N, bf16* WT, int mode, LAS float* scr, int lane, int gw, int ngw, int& rot) {
    const int nkb = K / 64, nnb = N / 32, items = nkb * nnb;
    for (int it = (gw + ngw - rot % ngw) % ngw; it < items; it += ngw) { const int kb = it / nnb, nb = it % nnb, n0 = 32 * nb;
        const int drow0 = mode == 0 ? n0 : 256 * (n0 / 128) + (n0 % 128) + (mode == 2 ? 128 : 0);
        transpose_item(W, K, N, WT, 64 * kb, n0, drow0, scr, lane); }
    rot += items;
}
__device__ __forceinline__ void wconv_phase(const Prm& p, LAS unsigned char* lds, int G) {
    int tid_ = threadIdx.x; asm volatile("" : "+v"(tid_));
    const int wid = __builtin_amdgcn_readfirstlane(tid_ >> 6), lane = tid_ & 63, gw = blockIdx.x * 8 + wid, ngw = G * 8;
    LAS float* scr = (LAS float*)(lds + wid * 16384);
    int rot = 0;
    for (int l = 0; l < NL; ++l) {
        transpose_matrix(p.w_in + (size_t)l * D * NP, D, NP, p.WinT + (size_t)l * NP * D, 0, scr, lane, gw, ngw, rot);
        transpose_matrix(p.w_out + (size_t)l * D * D, D, D, p.WoutT + (size_t)l * D * D, 0, scr, lane, gw, ngw, rot);
    }
    transpose_matrix(p.ffn_w_gate, D, DFF, p.WguT, 1, scr, lane, gw, ngw, rot);
    transpose_matrix(p.ffn_w_up, D, DFF, p.WguT, 2, scr, lane, gw, ngw, rot);
    transpose_matrix(p.ffn_w_down, DFF, D, p.WdT, 0, scr, lane, gw, ngw, rot);
    for (int e = 0; e < NE; ++e) {
        transpose_matrix(p.moe_w_gate + (size_t)e * D * DFE, D, DFE, p.WguTe + (size_t)e * 2 * DFE * D, 1, scr, lane, gw, ngw, rot);
        transpose_matrix(p.moe_w_up + (size_t)e * D * DFE, D, DFE, p.WguTe + (size_t)e * 2 * DFE * D, 2, scr, lane, gw, ngw, rot);
        transpose_matrix(p.moe_w_down + (size_t)e * DFE * D, DFE, D, p.WdTe + (size_t)e * D * DFE, 0, scr, lane, gw, ngw, rot);
    }
}
__device__ __forceinline__ void rope_table(const Prm& p, long gtid) {
    if (gtid < 64 * 16) { const int i = (int)gtid & 15, pos = (int)gtid >> 4; const float ang = (float)pos * powf(10000.0f, -(float)i / 16.0f); p.ROPE[2 * gtid] = cosf(ang); p.ROPE[2 * gtid + 1] = sinf(ang); }
}

template <bool ROUTER>
__device__ __forceinline__ void modnorm_phase(const Prm& p, int l, const float* xs, const float* cs, const float* gain, int off_shift, int off_scale, int nrows, LAS unsigned char* lds, int G) {
    int tid_ = threadIdx.x; asm volatile("" : "+v"(tid_));
    const int tid = tid_, wid = __builtin_amdgcn_readfirstlane(tid >> 6), lane = tid & 63, gw = blockIdx.x * 8 + wid, ngw = G * 8;
    LAS int* hist = (LAS int*)lds;
    float rw[16][8];
    if constexpr (ROUTER) {
        if (tid < 16) hist[tid] = 0;
        for (long i = (long)blockIdx.x * 512 + tid; i < (long)2 * MPAD; i += (long)G * 512) p.LIST[i] = -1;
#pragma unroll
        for (int j = 0; j < 4; ++j)
#pragma unroll
            for (int i = 0; i < 4; ++i) { const f32x4* wp = (const f32x4*)(p.moe_router + (size_t)(4 * lane + 256 * j + i) * NE); const f32x4 a = wp[0], b = wp[1];
                rw[4 * j + i][0] = a.x; rw[4 * j + i][1] = a.y; rw[4 * j + i][2] = a.z; rw[4 * j + i][3] = a.w; rw[4 * j + i][4] = b.x; rw[4 * j + i][5] = b.y; rw[4 * j + i][6] = b.z; rw[4 * j + i][7] = b.w; }
        __syncthreads();
    }
    for (int row = gw; row < nrows; row += ngw) {
        const float* src = row < MX ? xs + (size_t)row * D : cs + (size_t)(row - MX) * D;
        const float* mod = p.MOD + ((size_t)l * 9 + row_modrow(row)) * 6 * D;
        f32x4 v[4]; float ss = 0.f;
#pragma unroll
        for (int j = 0; j < 4; ++j) { v[j] = ((const f32x4*)src)[lane + 64 * j]; ss += (v[j].x * v[j].x + v[j].y * v[j].y) + (v[j].z * v[j].z + v[j].w * v[j].w); }
        const float rstd = 1.0f / sqrtf(wave_sum(ss) * (1.0f / D) + EPS);
        float lg[NE];
#pragma unroll
        for (int e = 0; e < NE; ++e) lg[e] = 0.f;
#pragma unroll
        for (int j = 0; j < 4; ++j) { const f32x4 g = ((const f32x4*)gain)[lane + 64 * j], sc = ((const f32x4*)(mod + off_scale))[lane + 64 * j], sh = ((const f32x4*)(mod + off_shift))[lane + 64 * j];
            const f32x4 h = v[j] * rstd * g * (sc + 1.0f) + sh;
            *(u32x2*)(p.HX + (size_t)row * D + 4 * lane + 256 * j) = (u32x2){pk2(h.x, h.y), pk2(h.z, h.w)};
            if constexpr (ROUTER) {
#pragma unroll
                for (int e = 0; e < NE; ++e) lg[e] += (h.x * rw[4 * j][e] + h.y * rw[4 * j + 1][e]) + (h.z * rw[4 * j + 2][e] + h.w * rw[4 * j + 3][e]); } }
        if constexpr (ROUTER) {
            if (row < MX) {
                float b1 = -INFINITY, b2 = -INFINITY; int i1 = 0, i2 = 0;
#pragma unroll
                for (int e = 0; e < NE; ++e) { const float x = wave_sum(lg[e]); if (x > b1) { b2 = b1; i2 = i1; b1 = x; i1 = e; } else if (x > b2) { b2 = x; i2 = e; } }
                if (lane == 0) { const float w1 = 1.0f / (1.0f + expf(b2 - b1)); p.TOPI[row * 2] = i1; p.TOPI[row * 2 + 1] = i2; p.TOPW[row * 2] = w1; p.TOPW[row * 2 + 1] = 1.0f - w1;
                    __hip_atomic_fetch_add(hist + i1, 1, __ATOMIC_RELAXED, __HIP_MEMORY_SCOPE_WORKGROUP); __hip_atomic_fetch_add(hist + 8 + i2, 1, __ATOMIC_RELAXED, __HIP_MEMORY_SCOPE_WORKGROUP); }
            }
        }
    }
    if constexpr (ROUTER) { __syncthreads(); if (tid < 16) atomicAdd(p.ctl + tid, hist[tid]); __syncthreads(); }
}

__device__ __forceinline__ void prep_qk_phase(const Prm& p, int l, int G) {
    static_assert(NNA == 6 && NGA == 4 && PC_NAK == PC_NAQ + 384, "pass layout of the q/k preparation");
    int tid_ = threadIdx.x; asm volatile("" : "+v"(tid_));
    const int tid = tid_, wid = __builtin_amdgcn_readfirstlane(tid >> 6), lane = tid & 63, gw = blockIdx.x * 8 + wid, ngw = G * 8;
    const int a = lane & 15, dd = 4 * a;
    const f32x4 gnq = *(const f32x4*)(p.na_q_norm + l * 64 + dd), gnk = *(const f32x4*)(p.na_k_norm + l * 64 + dd), ggq = *(const f32x4*)(p.ga_q_norm + l * 64 + dd), ggk = *(const f32x4*)(p.ga_k_norm + l * 64 + dd);
    const bool x2side = (a >> 2) & 1; const int rhalf = a >> 3, fi = 4 * (a & 3);
    for (int row = gw; row < M; row += ngw) {
        bf16* pr = p.P + (size_t)row * NP;
#pragma unroll
        for (int ps = 0; ps < 5; ++ps) {
            const int col = (ps < 3 ? PC_NAQ + 256 * ps : (ps == 3 ? PC_GAQ : PC_GAK)) + 4 * lane;
            const int hidx = ps * 4 + (lane >> 4);
            const bool isq = ps < 3 ? hidx < NNA : ps == 3;
            const f32x4 g = ps < 3 ? (hidx < NNA ? gnq : gnk) : (ps == 3 ? ggq : ggk);
            const u32x2 raw = *(const u32x2*)(pr + col);
            f32x4 x = (f32x4){lo16(raw.x), hi16(raw.x), lo16(raw.y), hi16(raw.y)};
            float ss = (x.x * x.x + x.y * x.y) + (x.z * x.z + x.w * x.w);
            ss += __shfl_xor(ss, 1); ss += __shfl_xor(ss, 2); ss += __shfl_xor(ss, 4); ss += __shfl_xor(ss, 8);
            const float rstd = 1.0f / sqrtf(ss * (1.0f / 64.0f) + EPS);
            x = x * rstd * g;
            if (ps >= 3 && row < MX) {
                const int t = row % S, pos = rhalf == 0 ? t / GW : t % GW;
                const f32x4 cs0 = *(const f32x4*)(p.ROPE + (size_t)(pos * 16 + fi) * 2), cs1 = *(const f32x4*)(p.ROPE + (size_t)(pos * 16 + fi) * 2 + 4);
                f32x4 o; o.x = __shfl_xor(x.x, 4); o.y = __shfl_xor(x.y, 4); o.z = __shfl_xor(x.z, 4); o.w = __shfl_xor(x.w, 4);
                const f32x4 cs = (f32x4){cs0.x, cs0.z, cs1.x, cs1.z}, sn = (f32x4){cs0.y, cs0.w, cs1.y, cs1.w};
                x = x2side ? (o * sn + x * cs) : (x * cs - o * sn);
            }
            if (isq) x = x * QSCALE;
            *(u32x2*)(pr + col) = (u32x2){pk2(x.x, x.y), pk2(x.z, x.w)};
        }
    }
}

__device__ __forceinline__ void sconv2(const bf16* Prow, const float* w, const float* cb, int col, bool hasp, bool hasn, float& y0, float& y1) {
    const unsigned c = *(const unsigned*)(Prow + col);
    y0 = cb[col] + w[3 * DHY + col] * lo16(c); y1 = cb[col + 1] + w[3 * DHY + col + 1] * hi16(c);
    if (hasp) { const unsigned a = *(const unsigned*)(Prow - NP + col); y0 += w[col] * lo16(a); y1 += w[col + 1] * hi16(a); }
    if (hasn) { const unsigned b = *(const unsigned*)(Prow + NP + col); y0 += w[2 * 3 * DHY + col] * lo16(b); y1 += w[2 * 3 * DHY + col + 1] * hi16(b); }
}
__device__ __forceinline__ void tile_geom(int tile, int& row0, int& b, int& t0, int& Len) {
    row0 = tile * 64; if (row0 < MX) { b = row0 / S; t0 = row0 % S; Len = S; } else { const int rr = row0 - MX; b = rr / LC; t0 = rr % LC; Len = LC; }
}
__device__ __forceinline__ void prep_hy_phase(const Prm& p, int l, LAS unsigned char* lds, int G) {
    int tid_ = threadIdx.x; asm volatile("" : "+v"(tid_));
    const int tid = tid_, wid = __builtin_amdgcn_readfirstlane(tid >> 6), lane = tid & 63;
    constexpr int PITCH = 144;
    const float* w = p.hy_conv_w + (size_t)l * 3 * 3 * DHY; const float* cb = p.hy_conv_b + (size_t)l * 3 * DHY;
    for (int tile = blockIdx.x; tile < M / 64; tile += G) {
        int row0, b, t0, Len; tile_geom(tile, row0, b, t0, Len);
        for (int tt = wid; tt < 64; tt += 8) { const int t = t0 + tt; const bf16* Prow = p.P + (size_t)(row0 + tt) * NP;
#pragma unroll
            for (int j = 0; j < DHY / 128; ++j) { const int c = 2 * lane + 128 * j; float a0, a1, v0, v1;
                sconv2(Prow, w, cb, DHY + c, t > 0, t < Len - 1, a0, a1); sconv2(Prow, w, cb, 2 * DHY + c, t > 0, t < Len - 1, v0, v1);
                *(LAS bf16*)(lds + c * PITCH + 2 * tt) = f2bf(v0 * a0); *(LAS bf16*)(lds + (c + 1) * PITCH + 2 * tt) = f2bf(v1 * a1); } }
        __syncthreads();
        bf16* dst = row0 < MX ? p.VT : p.VTC;
        for (int idx = tid; idx < DHY * 8; idx += 512) { const int c = idx >> 3, part = idx & 7;
            *(u32x4*)(dst + ((size_t)c * NB + b) * Len + t0 + 8 * part) = *(const LAS u32x4*)(lds + c * PITCH + 16 * part); }
        __syncthreads();
    }
}
__device__ __forceinline__ void final_phase(const Prm& p, int l, int nrows, LAS unsigned char* lds, int G) {
    int tid_ = threadIdx.x; asm volatile("" : "+v"(tid_));
    const int tid = tid_, wid = __builtin_amdgcn_readfirstlane(tid >> 6), lane = tid & 63;
    constexpr int PITCH = 65;
    LAS float* T = (LAS float*)lds;
    const float* w = p.hy_conv_w + (size_t)l * 3 * 3 * DHY; const float* cb = p.hy_conv_b + (size_t)l * 3 * DHY;
    for (int tile = blockIdx.x; tile < nrows / 64; tile += G) {
        int row0, b, t0, Len; tile_geom(tile, row0, b, t0, Len);
        const float* ysrc = row0 < MX ? p.YC : p.YCC;
        for (int idx = tid; idx < DHY * 16; idx += 512) { const int c = idx >> 4, part = idx & 15; const f32x4 v = *(const f32x4*)(ysrc + ((size_t)c * NB + b) * Len + t0 + 4 * part);
            LAS float* d = T + c * PITCH + 4 * part; d[0] = v.x; d[1] = v.y; d[2] = v.z; d[3] = v.w; }
        __syncthreads();
        for (int tt = wid; tt < 64; tt += 8) { const int t = t0 + tt, row = row0 + tt; const bf16* Prow = p.P + (size_t)row * NP; bf16* yrow = p.HX + (size_t)row * D;
            float y[2 * (DHY / 128)]; float ss = 0.f;
#pragma unroll
            for (int j = 0; j < DHY / 128; ++j) { const int c = 2 * lane + 128 * j; float x00, x01, a0, a1, v0, v1;
                sconv2(Prow, w, cb, c, t > 0, t < Len - 1, x00, x01); sconv2(Prow, w, cb, DHY + c, t > 0, t < Len - 1, a0, a1); sconv2(Prow, w, cb, 2 * DHY + c, t > 0, t < Len - 1, v0, v1);
                y[2 * j] = (T[c * PITCH + tt] + p.hy_skip[l * DHY + c] * (v0 * a0)) * x00; y[2 * j + 1] = (T[(c + 1) * PITCH + tt] + p.hy_skip[l * DHY + c + 1] * (v1 * a1)) * x01;
                ss += y[2 * j] * y[2 * j] + y[2 * j + 1] * y[2 * j + 1]; }
            { const float rstd = 1.0f / sqrtf(wave_sum(ss) * (1.0f / DHY) + EPS);
#pragma unroll
              for (int j = 0; j < DHY / 128; ++j) { const int c = 2 * lane + 128 * j; *(unsigned*)(yrow + c) = pk2(y[2 * j] * rstd * p.out_norm_hy[l * DHY + c], y[2 * j + 1] * rstd * p.out_norm_hy[l * DHY + c + 1]); } }
            { unsigned o[DNA / 128]; float s2 = 0.f;
#pragma unroll
              for (int j = 0; j < DNA / 128; ++j) { o[j] = *(const unsigned*)(Prow + PC_NAQ + 2 * lane + 128 * j); s2 += lo16(o[j]) * lo16(o[j]) + hi16(o[j]) * hi16(o[j]); }
              const float rstd = 1.0f / sqrtf(wave_sum(s2) * (1.0f / DNA) + EPS);
#pragma unroll
              for (int j = 0; j < DNA / 128; ++j) { const int c = 2 * lane + 128 * j; *(unsigned*)(yrow + DHY + c) = pk2(lo16(o[j]) * rstd * p.out_norm_na[l * DNA + c], hi16(o[j]) * rstd * p.out_norm_na[l * DNA + c + 1]); } }
            { unsigned o[DGA / 128]; float s2 = 0.f;
#pragma unroll
              for (int j = 0; j < DGA / 128; ++j) { o[j] = *(const unsigned*)(Prow + PC_GAQ + 2 * lane + 128 * j); s2 += lo16(o[j]) * lo16(o[j]) + hi16(o[j]) * hi16(o[j]); }
              const float rstd = 1.0f / sqrtf(wave_sum(s2) * (1.0f / DGA) + EPS);
#pragma unroll
              for (int j = 0; j < DGA / 128; ++j) { const int c = 2 * lane + 128 * j; *(unsigned*)(yrow + DHY + DNA + c) = pk2(lo16(o[j]) * rstd * p.out_norm_ga[l * DGA + c], hi16(o[j]) * rstd * p.out_norm_ga[l * DGA + c + 1]); } }
        }
        __syncthreads();
    }
}

__device__ __forceinline__ void mod_phase(const Prm& p, LAS unsigned char* lds, int G) {
    int tid_ = threadIdx.x; asm volatile("" : "+v"(tid_));
    const int tid = tid_, wid = __builtin_amdgcn_readfirstlane(tid >> 6), lane = tid & 63;
    LAS float* sc = (LAS float*)lds;
    LAS float* red = (LAS float*)(lds + 9 * D * 4);
    if ((int)blockIdx.x >= NL * (6 * D / 64)) return;
    for (int i = tid; i < 9 * D; i += 512) { const int r = i / D, k = i % D; sc[i] = silu_f(r < 8 ? p.c[(size_t)(r % NB) * D + k] : p.c_ctx[k]); }
    __syncthreads();
    for (int u = blockIdx.x; u < NL * (6 * D / 64); u += G) { const int l = u / (6 * D / 64), n0 = 64 * (u % (6 * D / 64));
        const float* w = p.w_mod + (size_t)l * D * 6 * D + n0 + lane;
        float acc[9];
#pragma unroll
        for (int r = 0; r < 9; ++r) acc[r] = 0.f;
#pragma unroll 4
        for (int k = wid * (D / 8); k < (wid + 1) * (D / 8); ++k) { const float wv = w[(size_t)k * 6 * D];
#pragma unroll
            for (int r = 0; r < 9; ++r) acc[r] += sc[r * D + k] * wv; }
#pragma unroll
        for (int r = 0; r < 9; ++r) red[(wid * 9 + r) * 64 + lane] = acc[r];
        __syncthreads();
        for (int i = tid; i < 9 * 64; i += 512) { const int r = i >> 6, j = i & 63; float t = p.b_mod[(size_t)l * 6 * D + n0 + j];
#pragma unroll
            for (int ww = 0; ww < 8; ++ww) t += red[(ww * 9 + r) * 64 + j];
            p.MOD[((size_t)l * 9 + r) * 6 * D + n0 + j] = t; }
        __syncthreads();
    }
}
__device__ __forceinline__ float rdl(float v, int i) { return __int_as_float(__builtin_amdgcn_readlane(__float_as_int(v), i)); }
__device__ __forceinline__ void filter_position(const Prm& p, int l, int half, int t, int Len, bf16* ftab, int pitch, LAS const float* W1, LAS const float* W2, LAS const float* W3, int lane_) {
    int lane = lane_; asm volatile("" : "+v"(lane));
    const float tn = (float)t / (float)(Len - 1), ang = 6.283185307179586f * (float)t / (float)Len;
    float z = 0.f;
    if (lane == 0) z = tn; else if (lane < 17) z = cosf((1e-4f + (float)(lane - 1) * ((15.0f - 1e-4f) / 15.0f)) * ang); else if (lane < 33) z = -sinf((1e-4f + (float)(lane - 17) * ((15.0f - 1e-4f) / 15.0f)) * ang);
    const float fq = p.hy_freq[l * 64 + lane];
    float pre = p.hy_b1[l * 64 + lane];
#pragma unroll 11
    for (int j = 0; j < 33; ++j) pre += rdl(z, j) * W1[j * 64 + lane];
    float h = sinf(fq * pre);
#pragma unroll 1
    for (int inner = 0; inner < 2; ++inner) { float q = p.hy_b2[(l * 2 + inner) * 64 + lane];
#pragma unroll 8
        for (int i = 0; i < 64; ++i) q += rdl(h, i) * W2[(inner * 64 + i) * 64 + lane];
        h = sinf(fq * q); }
    float o[DHY / 64];
#pragma unroll
    for (int m = 0; m < DHY / 64; ++m) o[m] = 0.f;
#pragma unroll 4
    for (int i = 0; i < 64; ++i) { const float hi_ = rdl(h, i);
#pragma unroll
        for (int m = 0; m < DHY / 64; ++m) o[m] += hi_ * W3[i * DHY + lane + 64 * m]; }
    const float d0 = logf(1e-2f) / 1.5f, d1 = logf(1e-2f) / 0.3f;
#pragma unroll
    for (int m = 0; m < DHY / 64; ++m) { const int c = lane + 64 * m; const float delta = fabsf(d0 + (float)c * ((d1 - d0) / (float)(DHY - 1)));
        const bf16 v = f2bf(o[m] * expf(-tn * delta)); bf16* ft = ftab + (size_t)c * pitch;
        if (half == 0) ft[Len - t] = v;
        else if (t > 0) ft[Len + t] = v;
        else { ft[0] = 0; for (int k = 0; k < 8; ++k) ft[2 * Len + k] = 0; } }
}
__device__ __forceinline__ void filter_phase(const Prm& p, LAS unsigned char* lds, int G) {
    int tid_ = threadIdx.x; asm volatile("" : "+v"(tid_));
    const int tid = tid_, wid = __builtin_amdgcn_readfirstlane(tid >> 6), lane = tid & 63;
    const int combo = blockIdx.x & 3, l = combo >> 1, half = combo & 1, chunk = blockIdx.x >> 2, nchunk = G >> 2;
    LAS float* W1 = (LAS float*)lds; LAS float* W2 = W1 + 33 * 64; LAS float* W3 = W2 + 2 * 64 * 64;
    for (int i = tid; i < 33 * 64; i += 512) W1[i] = p.hy_w1[(size_t)l * 33 * 64 + i];
    for (int i = tid; i < 2 * 64 * 64; i += 512) W2[i] = p.hy_w2[(size_t)l * 2 * 64 * 64 + i];
    for (int i = tid; i < 64 * DHY; i += 512) { const int k = i / DHY, c = i % DHY; W3[i] = p.hy_w3[((size_t)l * 64 + k) * 2 * DHY + half * DHY + c]; }
    __syncthreads();
    for (int t = chunk * 8 + wid; t < S; t += nchunk * 8) filter_position(p, l, half, t, S, p.FT + (size_t)l * DHY * (2 * S + 8), 2 * S + 8, W1, W2, W3, lane);
    if (l == 0) for (int t = chunk * 8 + wid; t < LC; t += nchunk * 8) filter_position(p, 0, half, t, LC, p.FTC, 2 * LC + 8, W1, W2, W3, lane);
}
__device__ __forceinline__ void moe_assign_phase(const Prm& p, LAS unsigned char* lds, int G) {
    int tid_ = threadIdx.x; asm volatile("" : "+v"(tid_));
    const int tid = tid_;
    LAS int* cnt = (LAS int*)lds; LAS int* base = cnt + 16;
    for (int blk = blockIdx.x; blk < MX / 128; blk += G) {
        if (tid < 16) cnt[tid] = 0;
        __syncthreads();
        const int m = blk * 128 + (tid & 127), c = (tid >> 7) & 1; int g = 0, rank = 0;
        if (tid < 256) { g = c * 8 + p.TOPI[m * 2 + c]; rank = __hip_atomic_fetch_add(cnt + g, 1, __ATOMIC_RELAXED, __HIP_MEMORY_SCOPE_WORKGROUP); }
        __syncthreads();
        if (tid < 16) base[tid] = moe_off(p, tid >> 3, tid & 7) + atomicAdd(p.ctl + 16 + tid, cnt[tid]);
        __syncthreads();
        if (tid < 256) p.LIST[(size_t)c * MPAD + base[g] + rank] = m;
        __syncthreads();
    }
}
__device__ __forceinline__ void hyena_ctx_phase(const Prm& p, LAS unsigned char* lds, int G) {
    int tid_ = threadIdx.x; asm volatile("" : "+v"(tid_));
    const int tid = tid_, wid = __builtin_amdgcn_readfirstlane(tid >> 6), lane = tid & 63;
    static_assert(LC == 256, "context Hyena geometry");
    LAS float* R = (LAS float*)(lds + wid * 4096);
    for (int u = blockIdx.x * 8 + wid; u < DHY * NB; u += G * 8) { const int c = u / NB;
        const bf16* ft = p.FTC + (size_t)c * (2 * LC + 8); const bf16* v = p.VTC + (size_t)u * LC;
#pragma unroll
        for (int i = 0; i < 8; ++i) R[lane + 64 * i] = bf2f(ft[lane + 64 * i]);
        float vv[4];
#pragma unroll
        for (int i = 0; i < 4; ++i) vv[i] = bf2f(v[4 * lane + i]);
        asm volatile("s_waitcnt lgkmcnt(0)" ::: "memory");
        float acc[4] = {0.f, 0.f, 0.f, 0.f};
#pragma unroll 8
        for (int s4 = 0; s4 < 64; ++s4) {
#pragma unroll
            for (int e = 0; e < 4; ++e) { const float vs = __int_as_float(__builtin_amdgcn_readlane(__float_as_int(vv[e]), s4)); const int s = 4 * s4 + e;
#pragma unroll
                for (int k = 0; k < 4; ++k) acc[k] += R[LC - (lane + 64 * k) + s] * vs; } }
#pragma unroll
        for (int k = 0; k < 4; ++k) p.YCC[(size_t)u * LC + lane + 64 * k] = acc[k];
    }
}
}

#define XB_TMO      128
#define XB_XCNT(j)  (256  + 64 * (j))
#define XB_XSUB(j)  (1280 + 64 * (j))
#define XB_XGEN(j)  (2304 + 64 * (j))
#define XB_TOP      3328
#define XB_TOPGEN   3392
#define XCD_BAR_WORDS 3456
#define XB_SPIN_CAP (1u << 23)

__device__ __forceinline__ unsigned xb_ld(unsigned* p)              { return __hip_atomic_load(p, __ATOMIC_RELAXED, __HIP_MEMORY_SCOPE_AGENT); }
__device__ __forceinline__ unsigned xb_add(unsigned* p, unsigned v) { return __hip_atomic_fetch_add(p, v, __ATOMIC_RELAXED, __HIP_MEMORY_SCOPE_AGENT); }
__device__ __forceinline__ unsigned xb_xcc_id() { return (unsigned)__builtin_amdgcn_s_getreg((3 << 11) | 20) & 0xFu; }
#define XB_SPIN(cond, bar) do { unsigned _sp = 0; while (cond) { __builtin_amdgcn_s_sleep(1); \
    if ((++_sp & 255u) == 0u) { if (xb_ld(&(bar)[XB_TMO])) break; if (_sp > XB_SPIN_CAP) { atomicAdd(&(bar)[XB_TMO], 1u); break; } } } } while (0)

struct XcdBarrier {
    unsigned* bar; unsigned x;
    volatile LAS unsigned* st;
};

__device__ __forceinline__ XcdBarrier xcd_barrier_post(unsigned* bar, volatile LAS unsigned* st) {
    XcdBarrier b; b.bar = bar; b.x = xb_xcc_id(); b.st = st;
    if (threadIdx.x == 0) (void)xb_add(&bar[XB_XCNT(b.x)], 1u);
    return b;
}
__device__ __forceinline__ void xcd_barrier_complete(unsigned* bar, unsigned x, unsigned& nloc, unsigned& nx) {
    const unsigned G = gridDim.x * gridDim.y * gridDim.z;
    unsigned sum, cnt, mine, sp = 0u;
    for (;;) {
        sum = 0u; cnt = 0u; mine = 0u;
#pragma unroll
        for (unsigned j = 0; j < 16; ++j) { const unsigned c = xb_ld(&bar[XB_XCNT(j)]); sum += c; cnt += (c > 0u) ? 1u : 0u; mine = (j == x) ? c : mine; }
        if (sum == G) break;
        __builtin_amdgcn_s_sleep(1);
        if ((++sp & 255u) == 0u) { if (xb_ld(&bar[XB_TMO])) break; if (sp > XB_SPIN_CAP) { atomicAdd(&bar[XB_TMO], 1u); break; } }
    }
    nloc = mine > 0u ? mine : 1u; nx = cnt > 0u ? cnt : 1u;
}

__device__ __forceinline__ void xcd_barrier(const XcdBarrier& b) {
    asm volatile("s_waitcnt vmcnt(0)" ::: "memory");
    __syncthreads();
    if (threadIdx.x == 0) {
        unsigned* bar = b.bar;
        __builtin_amdgcn_s_waitcnt(0);
        unsigned nloc = b.st[0], nx = b.st[1];
        if (nloc == 0u) { xcd_barrier_complete(bar, b.x, nloc, nx); b.st[0] = nloc; b.st[1] = nx; }
        const unsigned old = xb_add(&bar[XB_XSUB(b.x)], 1u);
        const unsigned gen = old / nloc;
        if (old + 1u == (gen + 1u) * nloc) {
            __builtin_amdgcn_fence(__ATOMIC_RELEASE, "agent");
            asm volatile("s_waitcnt vmcnt(0)" ::: "memory");
            const unsigned og = xb_add(&bar[XB_TOP], 1u);
            const unsigned tg = og / nx;
            if (og + 1u == (tg + 1u) * nx) xb_add(&bar[XB_TOPGEN], 1u);
            else XB_SPIN(xb_ld(&bar[XB_TOPGEN]) == tg, bar);
            __builtin_amdgcn_fence(__ATOMIC_ACQUIRE, "agent");
            xb_add(&bar[XB_XGEN(b.x)], 1u);
            asm volatile("s_waitcnt vmcnt(0)" ::: "memory");
        } else {
            XB_SPIN(xb_ld(&bar[XB_XGEN(b.x)]) == gen, bar);
            __builtin_amdgcn_fence(__ATOMIC_ACQUIRE, "agent");
            asm volatile("s_waitcnt vmcnt(0)" ::: "memory");
        }
    }
    __syncthreads();
}

constexpr int NWAVES = 8, NTHR = NWAVES * 64;
constexpr int LDS_BYTES = 147456, LDSCTL_OFF = LDS_BYTES - 512, MISC_OFF = LDSCTL_OFF, RING_BYTES = LDSCTL_OFF;
static_assert(hy::L_END <= RING_BYTES && attn_body::ATTN_LDS_BYTES <= RING_BYTES && MISC_OFF + 128 <= LDS_BYTES && (33 * 64 + 2 * 64 * 64 + 64 * DHY) * 4 <= RING_BYTES && DHY * 65 * 4 <= RING_BYTES && pg8::STAGE_BYTES <= RING_BYTES, "LDS map");
constexpr int CW_BAR = 4096;

__device__ __forceinline__ long opaque_gtid() { int t = threadIdx.x; asm volatile("" : "+v"(t)); return (long)blockIdx.x * 512 + t; }
typedef const __attribute__((address_space(4))) Prm* KPrm;
__device__ __forceinline__ KPrm opaque_kp() { KPrm q = (KPrm)__builtin_amdgcn_kernarg_segment_ptr(); asm volatile("" : "+s"(q)); return q; }
typedef const __attribute__((address_space(4))) unsigned long long* KWords;
__device__ __forceinline__ void load_prm(Prm& p) {
    static_assert(sizeof(Prm) % 8 == 0, "Prm is a pack of pointers");
    KWords src = (KWords)opaque_kp(); unsigned long long* dst = (unsigned long long*)&p;
#pragma unroll
    for (int i = 0; i < (int)(sizeof(Prm) / 8); ++i) dst[i] = src[i];
}
#define LP() Prm p; load_prm(p)
#define GT opaque_gtid()
#define GRID_BAR() xcd_barrier(bar)

template <int L> __device__ __forceinline__ void layer_fwd(LAS unsigned char* lds, const XcdBarrier& bar, const long gsz, const int G) {
    constexpr bool first = L == 0, last = L == NL - 1; constexpr int l = L;
    constexpr int nact = last ? MX : M;
    { LP(); thin::modnorm_phase<false>(p, l, first ? p.x : p.out, first ? p.ctx : p.CX, p.norm_mix + l * D, 0, D, M, lds, G); }
    GRID_BAR();
    {
        LP(); pg8::Order O; O.init(M / 256, NP / 256, G, (int)blockIdx.x, p.WinT + (size_t)l * NP * D);
        pg8::EpiBf16 E{p.P, NP};
        pg8::gemm_phase<pg8::EpiBf16, true, false>(lds, p.HX, D, O, E);
    }
    GRID_BAR();
    { LP(); thin::prep_hy_phase(p, l, lds, G); }
    { LP(); thin::prep_qk_phase(p, l, G); }
    GRID_BAR();
    { LP(); hyena_phase(p, l, lds, G); }
    if (!last) { LP(); thin::hyena_ctx_phase(p, lds, G); }
    __syncthreads();
    { LP(); attn_phase<!last>(p, l, (char*)lds, G); }
    GRID_BAR();
    { LP(); thin::final_phase(p, l, nact, lds, G); }
    GRID_BAR();
    {
        LP(); pg8::Order O; O.init(nact / 256, D / 256, G, (int)blockIdx.x, p.WoutT + (size_t)l * D * D);
        pg8::EpiResGate E{first ? p.x : p.out, first ? p.ctx : p.CX, p.out, p.CX, p.MOD + (size_t)l * 9 * 6 * D + 2 * D};
        pg8::gemm_phase<pg8::EpiResGate, true, false>(lds, p.HX, D, O, E);
    }
    GRID_BAR();
    { LP(); thin::modnorm_phase<(L & 1) != 0>(p, l, p.out, p.CX, p.norm_ffn + l * D, 3 * D, 4 * D, nact, lds, G); }
    GRID_BAR();
    if constexpr ((L & 1) == 0) {
        {   LP(); pg8::Order O; O.init(nact / 256, 2 * DFF / 256, G, (int)blockIdx.x, p.WguT);
            pg8::EpiSwiGLU E{p.HID, DFF};
            pg8::gemm_phase<pg8::EpiSwiGLU, true, false>(lds, p.HX, D, O, E); }
        GRID_BAR();
        {   LP(); pg8::Order O; O.init(nact / 256, D / 256, G, (int)blockIdx.x, p.WdT);
            pg8::EpiResGate E{p.out, p.CX, p.out, p.CX, p.MOD + (size_t)l * 9 * 6 * D + 5 * D};
            pg8::gemm_phase<pg8::EpiResGate, true, false>(lds, p.HID, DFF, O, E); }
        GRID_BAR();
    } else {
        { LP(); thin::moe_assign_phase(p, lds, G); }
        GRID_BAR();
#pragma unroll
        for (int pass = 0; pass < 2; ++pass) {
            {   LP(); pg8::Order O; int o = 0;
#pragma unroll
                for (int k = 0; k < 8; ++k) { o += (__builtin_amdgcn_readfirstlane(p.ctl[pass * 8 + k]) + 255) / 256; O.pend[k] = o; }
                const int npan = o; O.nM = npan; O.nN = 2 * DFE / 256; O.nwg = O.nM * O.nN; O.G = G; O.c = (int)blockIdx.x; O.Bt = p.WguTe; O.bt_group_stride = (size_t)2 * DFE * D; O.rows = p.LIST + (size_t)pass * MPAD;
                pg8::EpiSwiGLU E{p.HID, DFE};
                pg8::gemm_phase<pg8::EpiSwiGLU, true, true>(lds, p.HX, D, O, E); }
            GRID_BAR();
            {   LP(); pg8::Order O; int o = 0;
#pragma unroll
                for (int k = 0; k < 8; ++k) { o += (__builtin_amdgcn_readfirstlane(p.ctl[pass * 8 + k]) + 255) / 256; O.pend[k] = o; }
                O.nM = o; O.nN = D / 256; O.nwg = O.nM * O.nN; O.G = G; O.c = (int)blockIdx.x; O.Bt = p.WdTe; O.bt_group_stride = (size_t)D * DFE; O.rows = nullptr;
                pg8::EpiMoeDown E{p.LIST + (size_t)pass * MPAD, p.TOPW, pass, p.out, p.MOD + (size_t)l * 9 * 6 * D + 5 * D};
                pg8::gemm_phase<pg8::EpiMoeDown, true, false>(lds, p.HID, DFE, O, E); }
            GRID_BAR();
        }
    }
}

__global__ void __launch_bounds__(NTHR, 2) mega_fwd(Prm p_in) {
    extern __shared__ __attribute__((aligned(16))) unsigned char lds_raw[];
    LAS unsigned char* lds = (LAS unsigned char*)lds_raw;
    volatile LAS unsigned* MISC = (volatile LAS unsigned*)(lds + MISC_OFF);
    const int tid = threadIdx.x;
    for (int u = tid; u < (LDS_BYTES - LDSCTL_OFF) / 4; u += NTHR) ((LAS unsigned*)(lds + LDSCTL_OFF))[u] = 0u;
    __syncthreads();
    XcdBarrier bar = xcd_barrier_post((unsigned*)p_in.ctl + CW_BAR, MISC + 8);
    const int G = gridDim.x;
    const long gsz = (long)G * NTHR;
    { LP(); thin::wconv_phase(p, lds, G); }
    __syncthreads();
    { LP(); thin::rope_table(p, GT); }
    { LP(); thin::mod_phase(p, lds, G); }
    __syncthreads();
    { LP(); thin::filter_phase(p, lds, G); }
    GRID_BAR();
    layer_fwd<0>(lds, bar, gsz, G);
    layer_fwd<1>(lds, bar, gsz, G);
}

extern "C" void kernel_launch(void* const* d_in, const int* in_sizes, int n_in, void* d_out, int out_size, void* d_ws, size_t ws_size, hipStream_t stream) {
    static int grid = 0;
    if (grid == 0) {
        if (n_in != 34 || out_size != MX * D || ws_size < ws_needed()) { fprintf(stderr, "kernel_launch: unexpected shapes (n_in %d out %d ws %zu need %zu)\n", n_in, out_size, ws_size, ws_needed()); grid = -1; return; }
        int dev = 0, cus = 0, per_cu = 0;
        if (hipGetDevice(&dev) != hipSuccess || hipDeviceGetAttribute(&cus, hipDeviceAttributeMultiprocessorCount, dev) != hipSuccess) { grid = -1; return; }
        if (hipFuncSetAttribute((const void*)mega_fwd, hipFuncAttributeMaxDynamicSharedMemorySize, LDS_BYTES) != hipSuccess) { fprintf(stderr, "kernel_launch: hipFuncSetAttribute failed\n"); grid = -1; return; }
        if (hipOccupancyMaxActiveBlocksPerMultiprocessor(&per_cu, (const void*)mega_fwd, NTHR, LDS_BYTES) != hipSuccess || per_cu < 1) { fprintf(stderr, "kernel_launch: occupancy query reports %d\n", per_cu); }
        (void)hipGetLastError();
        grid = cus;
    }
    if (grid < 0) return;
    (void)in_sizes;
    (void)hipMemsetAsync(d_ws, 0, CTL_BYTES, stream);
    Prm p; __builtin_memset((void*)&p, 0, sizeof(p)); build_prm(p, d_in, d_out, d_ws);
    hipLaunchKernelGGL(mega_fwd, dim3(grid), dim3(NTHR), LDS_BYTES, stream, p);
}
#else
static void forward_emu(void* const* d_in, void* d_out, void* d_ws) {
    memset(d_ws, 0, CTL_BYTES);
    Prm p; memset(&p, 0, sizeof(p)); build_prm(p, d_in, d_out, d_ws);
#define RUN(ph, l, arg) run_phase(p, (ph), (l), (arg), 0, 1)
    RUN(PH_WCONV, 0, 0); RUN(PH_MOD, 0, 0); RUN(PH_F1, 0, 0); RUN(PH_F2A, 0, 0); RUN(PH_F2B, 0, 0); RUN(PH_F3, 0, 0);
    for (int l = 0; l < NL; ++l) {
        const bool last = l == NL - 1;
        RUN(PH_MODNORM1, l, 0); RUN(PH_INPROJ, l, 0); RUN(PH_PREP_HY, l, 0); RUN(PH_PREP_QK, l, 0);
        RUN(PH_HYENA, l, 0); RUN(PH_GA, l, 0); RUN(PH_NA, l, 0); if (!last) RUN(PH_CTXATTN, l, 0);
        RUN(PH_FINAL, l, 0); RUN(PH_OUTPROJ, l, 0); RUN(PH_MODNORM2, l, 0);
        if ((l & 1) == 0) { RUN(PH_FFN_UP, l, 0); RUN(PH_FFN_DOWN, l, 0); }
        else { RUN(PH_MOE_COUNT, l, 0); RUN(PH_MOE_ASSIGN, l, 0); for (int c = 0; c < 2; ++c) { RUN(PH_MOE_UP, l, c); RUN(PH_MOE_DOWN, l, c); } }
    }
}
#endif
```

```cpp
#ifdef CPU_EMU
#include <cmath>
#include <cstdio>
#include <cstdlib>
#include <cstring>
#include <cstdint>
#define __device__
#define __global__
#define __host__
#define __forceinline__ inline
static inline int atomicAdd(int* p, int v) { int o = *p; *p += v; return o; }
#else
#include <hip/hip_runtime.h>
#include <cstdio>
#include <cstdint>
#endif

#ifdef CFG_SMALL
constexpr int D = 512, NB = 2, S = 1024, LC = 64, DFF = 256, DFE = 256;
#else
constexpr int D = 1024, NB = 8, S = 4096, LC = 256, DFF = 2816, DFE = 3584;
#endif
constexpr int NL = 2;
constexpr int DHY = 3 * D / 8, DNA = 3 * D / 8, DGA = D - DHY - DNA, NNA = DNA / 64, NGA = DGA / 64, HD = 64;
constexpr int GW = 64, ROWS = S / GW, KH = 8, KWIN = 16;
constexpr int MX = NB * S, MC = NB * LC, M = MX + MC;
constexpr int NE = 8;
constexpr int NP = 3 * D;
constexpr int PC_HY = 0, PC_NAQ = 3 * DHY, PC_NAK = PC_NAQ + DNA, PC_NAV = PC_NAK + DNA, PC_GAQ = 3 * (DHY + DNA), PC_GAK = PC_GAQ + DGA, PC_GAV = PC_GAK + DGA;
constexpr int MPAD = ((MX + NE * 255 + 255) / 256) * 256;
constexpr float EPS = 1e-6f;
constexpr float LOG2E = 1.4426950408889634f;
constexpr float QSCALE = 0.125f * LOG2E;

typedef unsigned short bf16;
__host__ __device__ __forceinline__ unsigned f2bf_u(float f) { unsigned u; __builtin_memcpy(&u, &f, 4); return (u + 0x7fffu + ((u >> 16) & 1u)) >> 16; }
__host__ __device__ __forceinline__ bf16 f2bf(float f) { return (bf16)f2bf_u(f); }
__host__ __device__ __forceinline__ float bf2f(bf16 h) { unsigned u = ((unsigned)h) << 16; float f; __builtin_memcpy(&f, &u, 4); return f; }
__host__ __device__ __forceinline__ float silu_f(float v) { return v / (1.0f + expf(-v)); }

constexpr float F8_SA = 8.0f, F8_SWU = 128.0f, F8_SH = 4.0f, F8_SWD = 256.0f, F8_MAX = 448.0f;
struct Prm {
    const float *x, *c, *ctx, *c_ctx, *w_mod, *b_mod, *norm_mix, *norm_ffn, *w_in, *hy_conv_w, *hy_conv_b, *hy_w1, *hy_b1, *hy_freq, *hy_w2, *hy_b2, *hy_w3, *hy_skip;
    const float *na_q_norm, *na_k_norm, *na_rpb, *ga_q_norm, *ga_k_norm, *out_norm_hy, *out_norm_na, *out_norm_ga, *w_out;
    const float *ffn_w_gate, *ffn_w_up, *ffn_w_down, *moe_router, *moe_w_gate, *moe_w_up, *moe_w_down;
    float* out;
    int* ctl;
    float* MOD;
    float* ROPE;
    float* QKG;
    float *FHA, *FHB;
    bf16* FT;
    bf16* FTC;
    bf16 *WinT, *WoutT;
    bf16 *WguT, *WdT;
    bf16 *WguTe, *WdTe;
    float* CX;
    int* TOPI; float* TOPW; int* LIST;
    bf16* HX;
    bf16* P;
    bf16 *VT, *VTC;
    float *YC, *YCC;
    bf16* HID;
    bf16* XG;
    bf16* XB;
};

__device__ __forceinline__ void conv_T(const float* W, int K, int N, bf16* dst, long gtid, long gsz) {
    for (long i = gtid; i < (long)N * K; i += gsz) { const int n = (int)(i / K), k = (int)(i % K); dst[i] = f2bf(W[(size_t)k * N + n]); }
}
__device__ __forceinline__ void conv_gu(const float* Wg, const float* Wu, int K, int F, bf16* dst, long gtid, long gsz) {
    for (long i = gtid; i < (long)2 * F * K; i += gsz) {
        const int n = (int)(i / K), k = (int)(i % K), p = n / 256, j = n % 256;
        const float* src = j < 128 ? Wg : Wu; const int col = 128 * p + (j & 127);
        dst[i] = f2bf(src[(size_t)k * F + col]);
    }
}
__device__ __forceinline__ void ph_wconv(const Prm& p, long gtid, long gsz) {
    for (int l = 0; l < NL; ++l) {
        conv_T(p.w_in + (size_t)l * D * NP, D, NP, p.WinT + (size_t)l * NP * D, gtid, gsz);
        conv_T(p.w_out + (size_t)l * D * D, D, D, p.WoutT + (size_t)l * D * D, gtid, gsz);
    }
    conv_gu(p.ffn_w_gate, p.ffn_w_up, D, DFF, p.WguT, gtid, gsz);
    conv_T(p.ffn_w_down, DFF, D, p.WdT, gtid, gsz);
    for (int e = 0; e < NE; ++e) {
        conv_gu(p.moe_w_gate + (size_t)e * D * DFE, p.moe_w_up + (size_t)e * D * DFE, D, DFE, p.WguTe + (size_t)e * 2 * DFE * D, gtid, gsz);
        conv_T(p.moe_w_down + (size_t)e * DFE * D, DFE, D, p.WdTe + (size_t)e * D * DFE, gtid, gsz);
    }
}
__device__ __forceinline__ void ph_mod(const Prm& p, long gtid, long gsz) {
    for (long i = gtid; i < (long)NL * 9 * 6 * D; i += gsz) {
        const int n = (int)(i % (6 * D)), r = (int)((i / (6 * D)) % 9), l = (int)(i / (6 * D * 9));
        const float* cv = r < 8 ? p.c + (size_t)(r % NB) * D : p.c_ctx;
        const float* w = p.w_mod + (size_t)l * D * 6 * D;
        float acc = p.b_mod[(size_t)l * 6 * D + n];
        for (int k = 0; k < D; ++k) acc += silu_f(cv[k]) * w[(size_t)k * 6 * D + n];
        p.MOD[i] = acc;
    }
}
__device__ __forceinline__ int fset_len(int s) { return s < 2 ? S : LC; }
__device__ __forceinline__ int fset_layer(int s) { return s == 1 ? 1 : 0; }
__device__ __forceinline__ void ph_filt1(const Prm& p, long gtid, long gsz) {
    for (long i = gtid; i < (long)3 * S * 64; i += gsz) {
        const int u = (int)(i % 64), t = (int)((i / 64) % S), s = (int)(i / (64 * S));
        const int Len = fset_len(s), l = fset_layer(s);
        if (t >= Len) continue;
        const float* w1 = p.hy_w1 + (size_t)l * 33 * 64;
        const float tn = (float)t / (float)(Len - 1);
        const float ang = 6.283185307179586f * (float)t / (float)Len;
        float pre = p.hy_b1[l * 64 + u] + tn * w1[u];
        for (int j = 0; j < 16; ++j) {
            const float fr = 1e-4f + (float)j * ((15.0f - 1e-4f) / 15.0f);
            pre += cosf(fr * ang) * w1[(1 + j) * 64 + u] - sinf(fr * ang) * w1[(17 + j) * 64 + u];
        }
        p.FHA[i] = sinf(p.hy_freq[l * 64 + u] * pre);
    }
}
__device__ __forceinline__ void ph_filt2(const Prm& p, int inner, const float* src, float* dst, long gtid, long gsz) {
    for (long i = gtid; i < (long)3 * S * 64; i += gsz) {
        const int u = (int)(i % 64), t = (int)((i / 64) % S), s = (int)(i / (64 * S));
        const int Len = fset_len(s), l = fset_layer(s);
        if (t >= Len) continue;
        const float* w2 = p.hy_w2 + ((size_t)l * 2 + inner) * 64 * 64;
        const float* h = src + (i - u);
        float pre = p.hy_b2[(l * 2 + inner) * 64 + u];
        for (int k = 0; k < 64; ++k) pre += h[k] * w2[k * 64 + u];
        dst[i] = sinf(p.hy_freq[l * 64 + u] * pre);
    }
}
__device__ __forceinline__ void ph_filt3(const Prm& p, const float* src, long gtid, long gsz) {
    for (long i = gtid; i < (long)3 * S * 2 * DHY; i += gsz) {
        const int n = (int)(i % (2 * DHY)), t = (int)((i / (2 * DHY)) % S), s = (int)(i / ((long)2 * DHY * S));
        const int Len = fset_len(s), l = fset_layer(s);
        if (t >= Len) continue;
        const float* w3 = p.hy_w3 + (size_t)l * 64 * 2 * DHY;
        const float* h = src + ((size_t)s * S + t) * 64;
        float acc = 0.f;
        for (int k = 0; k < 64; ++k) acc += h[k] * w3[(size_t)k * 2 * DHY + n];
        const int cch = n % DHY;
        const float d0 = logf(1e-2f) / 1.5f, d1 = logf(1e-2f) / 0.3f;
        const float delta = fabsf(d0 + (float)cch * ((d1 - d0) / (float)(DHY - 1)));
        const float tn = (float)t / (float)(Len - 1);
        const float val = acc * expf(-tn * delta);
        bf16* ft = (s < 2 ? p.FT + (size_t)s * DHY * (2 * S + 8) : p.FTC) + (size_t)cch * (2 * Len + 8);
        if (n < DHY) ft[Len - t] = f2bf(val);
        else if (t > 0) ft[Len + t] = f2bf(val);
        else { ft[0] = 0; for (int k = 0; k < 8; ++k) ft[2 * Len + k] = 0; }
    }
}

__device__ __forceinline__ int row_modrow(int row) { return row < MX ? row / S : 8; }
__device__ __forceinline__ int row_batch(int row) { return row < MX ? row / S : (row - MX) / LC; }

__device__ __forceinline__ void ph_modnorm(const Prm& p, int l, const float* xs, const float* cs, const float* gain, int off_shift, int off_scale, int nrows, bool router, long gtid, long gsz) {
    for (long row = gtid; row < nrows; row += gsz) {
        const float* src = row < MX ? xs + (size_t)row * D : cs + (size_t)(row - MX) * D;
        const float* mod = p.MOD + ((size_t)l * 9 + row_modrow((int)row)) * 6 * D;
        float ss = 0.f;
        for (int k = 0; k < D; ++k) ss += src[k] * src[k];
        const float rstd = 1.0f / sqrtf(ss / (float)D + EPS);
        float lg[NE];
#pragma unroll
        for (int e = 0; e < NE; ++e) lg[e] = 0.f;
        for (int k = 0; k < D; ++k) {
            const float h = src[k] * rstd * gain[k] * (1.0f + mod[off_scale + k]) + mod[off_shift + k];
            p.HX[(size_t)row * D + k] = f2bf(h);
            if (router) {
#pragma unroll
                for (int e = 0; e < NE; ++e) lg[e] += h * p.moe_router[(size_t)k * NE + e]; }
        }
        if (router && row < MX) {
            float b1 = -INFINITY, b2 = -INFINITY; int i1 = 0, i2 = 0;
#pragma unroll
            for (int e = 0; e < NE; ++e) { const float v = lg[e]; if (v > b1) { b2 = b1; i2 = i1; b1 = v; i1 = e; } else if (v > b2) { b2 = v; i2 = e; } }
            const float w1 = 1.0f / (1.0f + expf(b2 - b1));
            p.TOPI[row * 2] = i1; p.TOPI[row * 2 + 1] = i2; p.TOPW[row * 2] = w1; p.TOPW[row * 2 + 1] = 1.0f - w1;
        }
    }
}
struct U4 { unsigned x, y, z, w; };
__device__ __forceinline__ float dot_bf(const bf16* a, const bf16* b, int K) {
    float acc = 0.f;
    for (int k = 0; k < K; k += 8) {
        U4 va, vb; __builtin_memcpy(&va, a + k, 16); __builtin_memcpy(&vb, b + k, 16);
        const unsigned ua[4] = {va.x, va.y, va.z, va.w}, ub[4] = {vb.x, vb.y, vb.z, vb.w};
#pragma unroll
        for (int j = 0; j < 4; ++j) acc += bf2f((bf16)(ua[j] & 0xffffu)) * bf2f((bf16)(ub[j] & 0xffffu)) + bf2f((bf16)(ua[j] >> 16)) * bf2f((bf16)(ub[j] >> 16));
    }
    return acc;
}

__device__ __forceinline__ void ph_inproj(const Prm& p, int l, long gtid, long gsz) {
    const bf16* Bt = p.WinT + (size_t)l * NP * D;
    for (long i = gtid; i < (long)M * NP; i += gsz) { const int m = (int)(i / NP), n = (int)(i % NP); p.P[i] = f2bf(dot_bf(p.HX + (size_t)m * D, Bt + (size_t)n * D, D)); }
}
__device__ __forceinline__ float sconv(const Prm& p, int l, int row, int col) {
    int t, Len; if (row < MX) { t = row % S; Len = S; } else { t = (row - MX) % LC; Len = LC; }
    const float* w = p.hy_conv_w + (size_t)l * 3 * 3 * DHY;
    float y = p.hy_conv_b[(size_t)l * 3 * DHY + col] + w[3 * DHY + col] * bf2f(p.P[(size_t)row * NP + col]);
    if (t > 0) y += w[col] * bf2f(p.P[(size_t)(row - 1) * NP + col]);
    if (t < Len - 1) y += w[2 * 3 * DHY + col] * bf2f(p.P[(size_t)(row + 1) * NP + col]);
    return y;
}
__device__ __forceinline__ void ph_prep_hy(const Prm& p, int l, long gtid, long gsz) {
    for (long i = gtid; i < (long)M * DHY; i += gsz) {
        const int row = (int)(i / DHY), c = (int)(i % DHY);
        const float v = sconv(p, l, row, 2 * DHY + c) * sconv(p, l, row, DHY + c);
        if (row < MX) p.VT[((size_t)c * NB + row / S) * S + row % S] = f2bf(v);
        else { const int rr = row - MX; p.VTC[((size_t)c * NB + rr / LC) * LC + rr % LC] = f2bf(v); }
    }
}
__device__ __forceinline__ void ph_prep_qk(const Prm& p, int l, long gtid, long gsz) {
    constexpr int NS = 2 * NNA + 2 * NGA;
    for (long i = gtid; i < (long)M * NS; i += gsz) {
        const int row = (int)(i / NS), hs = (int)(i % NS);
        int col; const float* g; bool isq, rope;
        if (hs < NNA) { col = PC_NAQ + 64 * hs; g = p.na_q_norm + l * 64; isq = true; rope = false; }
        else if (hs < 2 * NNA) { col = PC_NAK + 64 * (hs - NNA); g = p.na_k_norm + l * 64; isq = false; rope = false; }
        else if (hs < 2 * NNA + NGA) { col = PC_GAQ + 64 * (hs - 2 * NNA); g = p.ga_q_norm + l * 64; isq = true; rope = row < MX; }
        else { col = PC_GAK + 64 * (hs - 2 * NNA - NGA); g = p.ga_k_norm + l * 64; isq = false; rope = row < MX; }
        bf16* v = p.P + (size_t)row * NP + col;
        float ss = 0.f;
        for (int d = 0; d < 64; ++d) { const float a = bf2f(v[d]); ss += a * a; }
        const float rstd = 1.0f / sqrtf(ss / 64.0f + EPS), sc = isq ? QSCALE : 1.0f;
        if (!rope) { for (int d = 0; d < 64; ++d) v[d] = f2bf(bf2f(v[d]) * rstd * g[d] * sc); }
        else {
            const int t = row % S; const float pr = (float)(t / GW), pc = (float)(t % GW);
            for (int hf = 0; hf < 2; ++hf) {
                const float pos = hf == 0 ? pr : pc;
                for (int j = 0; j < 16; ++j) {
                    const float inv = powf(10000.0f, -(float)j / 16.0f), ang = pos * inv, cs = cosf(ang), sn = sinf(ang);
                    const int d1 = 32 * hf + j, d2 = d1 + 16;
                    const float a = bf2f(v[d1]) * rstd * g[d1], b = bf2f(v[d2]) * rstd * g[d2];
                    v[d1] = f2bf((a * cs - b * sn) * sc); v[d2] = f2bf((a * sn + b * cs) * sc);
                }
            }
        }
    }
}
__device__ __forceinline__ void ph_hyena_naive(const Prm& p, int l, bool with_lat, bool with_ctx, long gtid, long gsz) {
    const bf16* FTl = p.FT + (size_t)l * DHY * (2 * S + 8);
    if (with_lat) for (long i = gtid; i < (long)DHY * NB * S; i += gsz) {
        const int t = (int)(i % S), cb = (int)(i / S), c = cb / NB;
        const bf16* ft = FTl + (size_t)c * (2 * S + 8) + S - t; const bf16* v = p.VT + (size_t)cb * S;
        float acc = 0.f;
        for (int s = 0; s < S; ++s) acc += bf2f(ft[s]) * bf2f(v[s]);
        p.YC[i] = acc;
    }
    if (with_ctx) for (long i = gtid; i < (long)DHY * NB * LC; i += gsz) {
        const int t = (int)(i % LC), cb = (int)(i / LC), c = cb / NB;
        const bf16* ft = p.FTC + (size_t)c * (2 * LC + 8) + LC - t; const bf16* v = p.VTC + (size_t)cb * LC;
        float acc = 0.f;
        for (int s = 0; s < LC; ++s) acc += bf2f(ft[s]) * bf2f(v[s]);
        p.YCC[i] = acc;
    }
}
struct OnlineSm { float m, l, o[64]; };
__device__ __forceinline__ void osm_init(OnlineSm& st) { st.m = -INFINITY; st.l = 0.f;
_Pragma("unroll") for (int d = 0; d < 64; ++d) st.o[d] = 0.f; }
__device__ __forceinline__ void osm_step(OnlineSm& st, const float* q, const bf16* k, const bf16* v, float bias) {
    float sc = bias;
_Pragma("unroll") for (int d = 0; d < 64; ++d) sc += q[d] * bf2f(k[d]);
    if (sc > st.m) { const float a = exp2f(st.m - sc); st.l *= a;
_Pragma("unroll") for (int d = 0; d < 64; ++d) st.o[d] *= a;
 st.m = sc; }
    const float pe = exp2f(sc - st.m); st.l += pe;
_Pragma("unroll") for (int d = 0; d < 64; ++d) st.o[d] += pe * bf2f(v[d]);
}
__device__ __forceinline__ void ph_ga_naive(const Prm& p, long gtid, long gsz) {
    for (long i = gtid; i < (long)NB * NGA * S; i += gsz) {
        const int t = (int)(i % S), h = (int)((i / S) % NGA), b = (int)(i / ((long)S * NGA));
        bf16* qp = p.P + ((size_t)b * S + t) * NP + PC_GAQ + 64 * h;
        float q[64];
_Pragma("unroll") for (int d = 0; d < 64; ++d) q[d] = bf2f(qp[d]);
        OnlineSm st; osm_init(st);
        for (int s = 0; s < S; ++s) { const bf16* kr = p.P + ((size_t)b * S + s) * NP; osm_step(st, q, kr + PC_GAK + 64 * h, kr + PC_GAV + 64 * h, 0.f); }
        for (int s = 0; s < LC; ++s) { const bf16* kr = p.P + ((size_t)MX + b * LC + s) * NP; osm_step(st, q, kr + PC_GAK + 64 * h, kr + PC_GAV + 64 * h, 0.f); }
        const float il = 1.0f / st.l;
_Pragma("unroll") for (int d = 0; d < 64; ++d) qp[d] = f2bf(st.o[d] * il);
    }
}
__device__ __forceinline__ void ph_na_naive(const Prm& p, int l, long gtid, long gsz) {
    for (long i = gtid; i < (long)NB * NNA * S; i += gsz) {
        const int t = (int)(i % S), h = (int)((i / S) % NNA), b = (int)(i / ((long)S * NNA));
        const int r = t / GW, qc = t % GW;
        int r0 = r - KH / 2; r0 = r0 < 0 ? 0 : (r0 > ROWS - KH ? ROWS - KH : r0);
        int c0 = qc - KWIN / 2; c0 = c0 < 0 ? 0 : (c0 > GW - KWIN ? GW - KWIN : c0);
        bf16* qp = p.P + ((size_t)b * S + t) * NP + PC_NAQ + 64 * h;
        float q[64];
_Pragma("unroll") for (int d = 0; d < 64; ++d) q[d] = bf2f(qp[d]);
        const float* rpb = p.na_rpb + ((size_t)l * NNA + h) * (2 * KH - 1) * (2 * KWIN - 1);
        OnlineSm st; osm_init(st);
        for (int kr = 0; kr < KH; ++kr) for (int kc = c0; kc < c0 + KWIN; ++kc) {
            const int krow = r0 + kr, dr = krow - r + (KH - 1); int dc = kc - qc; dc = dc < -(KWIN - 1) ? -(KWIN - 1) : (dc > KWIN - 1 ? KWIN - 1 : dc); dc += KWIN - 1;
            const bf16* kp = p.P + ((size_t)b * S + krow * GW + kc) * NP;
            osm_step(st, q, kp + PC_NAK + 64 * h, kp + PC_NAV + 64 * h, rpb[dr * (2 * KWIN - 1) + dc] * LOG2E);
        }
        for (int s = 0; s < LC; ++s) { const bf16* kp = p.P + ((size_t)MX + b * LC + s) * NP; osm_step(st, q, kp + PC_NAK + 64 * h, kp + PC_NAV + 64 * h, 0.f); }
        const float il = 1.0f / st.l;
_Pragma("unroll") for (int d = 0; d < 64; ++d) qp[d] = f2bf(st.o[d] * il);
    }
}
__device__ __forceinline__ void ph_ctxattn_naive(const Prm& p, long gtid, long gsz) {
    for (long i = gtid; i < (long)NB * (NNA + NGA) * LC; i += gsz) {
        const int t = (int)(i % LC), hh = (int)((i / LC) % (NNA + NGA)), b = (int)(i / ((long)LC * (NNA + NGA)));
        const int qo = hh < NNA ? PC_NAQ + 64 * hh : PC_GAQ + 64 * (hh - NNA), ko = hh < NNA ? PC_NAK + 64 * hh : PC_GAK + 64 * (hh - NNA), vo = hh < NNA ? PC_NAV + 64 * hh : PC_GAV + 64 * (hh - NNA);
        bf16* qp = p.P + ((size_t)MX + b * LC + t) * NP + qo;
        float q[64];
_Pragma("unroll") for (int d = 0; d < 64; ++d) q[d] = bf2f(qp[d]);
        OnlineSm st; osm_init(st);
        for (int s = 0; s < LC; ++s) { const bf16* kp = p.P + ((size_t)MX + b * LC + s) * NP; osm_step(st, q, kp + ko, kp + vo, 0.f); }
        const float il = 1.0f / st.l;
_Pragma("unroll") for (int d = 0; d < 64; ++d) qp[d] = f2bf(st.o[d] * il);
    }
}
__device__ __forceinline__ void ph_final(const Prm& p, int l, int nrows, long gtid, long gsz) {
    for (long row = gtid; row < nrows; row += gsz) {
        const int r = (int)row; int b, t; const float* yc;
        if (r < MX) { b = r / S; t = r % S; } else { b = (r - MX) / LC; t = (r - MX) % LC; }
        float ss = 0.f;
        for (int pass = 0; pass < 2; ++pass) {
            const float rstd = pass ? 1.0f / sqrtf(ss / (float)DHY + EPS) : 0.f;
            for (int c = 0; c < DHY; ++c) {
                const float x0 = sconv(p, l, r, c), vp = sconv(p, l, r, 2 * DHY + c) * sconv(p, l, r, DHY + c);
                const float conv = r < MX ? p.YC[((size_t)c * NB + b) * S + t] : p.YCC[((size_t)c * NB + b) * LC + t];
                const float y = (conv + p.hy_skip[l * DHY + c] * vp) * x0;
                if (!pass) ss += y * y; else p.HX[(size_t)r * D + c] = f2bf(y * rstd * p.out_norm_hy[l * DHY + c]);
            }
        }
        { const bf16* o = p.P + (size_t)r * NP + PC_NAQ; float s2 = 0.f; for (int j = 0; j < DNA; ++j) { const float a = bf2f(o[j]); s2 += a * a; }
          const float rstd = 1.0f / sqrtf(s2 / (float)DNA + EPS); for (int j = 0; j < DNA; ++j) p.HX[(size_t)r * D + DHY + j] = f2bf(bf2f(o[j]) * rstd * p.out_norm_na[l * DNA + j]); }
        { const bf16* o = p.P + (size_t)r * NP + PC_GAQ; float s2 = 0.f; for (int j = 0; j < DGA; ++j) { const float a = bf2f(o[j]); s2 += a * a; }
          const float rstd = 1.0f / sqrtf(s2 / (float)DGA + EPS); for (int j = 0; j < DGA; ++j) p.HX[(size_t)r * D + DHY + DNA + j] = f2bf(bf2f(o[j]) * rstd * p.out_norm_ga[l * DGA + j]); }
        (void)yc;
    }
}
__device__ __forceinline__ void ph_outproj(const Prm& p, int l, const float* xs, const float* cs, int nrows, long gtid, long gsz) {
    const bf16* Bt = p.WoutT + (size_t)l * D * D;
    for (long i = gtid; i < (long)nrows * D; i += gsz) {
        const int m = (int)(i / D), n = (int)(i % D);
        const float acc = dot_bf(p.HX + (size_t)m * D, Bt + (size_t)n * D, D);
        const float gate = p.MOD[((size_t)l * 9 + row_modrow(m)) * 6 * D + 2 * D + n];
        if (m < MX) p.out[i] = xs[i] + gate * acc; else p.CX[i - (size_t)MX * D] = cs[i - (size_t)MX * D] + gate * acc;
    }
}
__device__ __forceinline__ void ph_ffn_up(const Prm& p, int nrows, long gtid, long gsz) {
    for (long i = gtid; i < (long)nrows * DFF; i += gsz) {
        const int m = (int)(i / DFF), j = (int)(i % DFF), n = 256 * (j / 128) + (j % 128);
        const float g = dot_bf(p.HX + (size_t)m * D, p.WguT + (size_t)n * D, D), u = dot_bf(p.HX + (size_t)m * D, p.WguT + (size_t)(n + 128) * D, D);
        p.HID[i] = f2bf(silu_f(g) * u);
    }
}
__device__ __forceinline__ void ph_ffn_down(const Prm& p, int l, int nrows, long gtid, long gsz) {
    for (long i = gtid; i < (long)nrows * D; i += gsz) {
        const int m = (int)(i / D), n = (int)(i % D);
        const float acc = dot_bf(p.HID + (size_t)m * DFF, p.WdT + (size_t)n * DFF, DFF);
        const float gate = p.MOD[((size_t)l * 9 + row_modrow(m)) * 6 * D + 5 * D + n];
        if (m < MX) p.out[i] += gate * acc; else p.CX[i - (size_t)MX * D] += gate * acc;
    }
}
__device__ __forceinline__ void ph_moe_count(const Prm& p, long gtid, long gsz) {
    for (long i = gtid; i < (long)2 * MPAD; i += gsz) p.LIST[i] = -1;
    for (long m = gtid; m < MX; m += gsz) { atomicAdd(p.ctl + p.TOPI[m * 2], 1); atomicAdd(p.ctl + 8 + p.TOPI[m * 2 + 1], 1); }
}
__device__ __forceinline__ int moe_off(const Prm& p, int pass, int e) {
    int o = 0;
#pragma unroll
    for (int k = 0; k < NE; ++k) if (k < e) o += (p.ctl[pass * 8 + k] + 255) / 256 * 256;
    return o;
}
__device__ __forceinline__ void ph_moe_assign(const Prm& p, long gtid, long gsz) {
    for (long m = gtid; m < MX; m += gsz) {
        for (int c = 0; c < 2; ++c) { const int e = p.TOPI[m * 2 + c]; const int slot = moe_off(p, c, e) + atomicAdd(p.ctl + 16 + c * 8 + e, 1); p.LIST[(size_t)c * MPAD + slot] = (int)m; }
    }
}
__device__ __forceinline__ int moe_slot_expert(const Prm& p, int pass, int slot) {
    int e = 0, o = 0;
#pragma unroll
    for (int k = 0; k < NE - 1; ++k) { o += (p.ctl[pass * 8 + k] + 255) / 256 * 256; if (slot >= o) e = k + 1; }
    return e;
}
__device__ __forceinline__ void ph_moe_up(const Prm& p, int pass, long gtid, long gsz) {
    const int tot = moe_off(p, pass, NE);
    for (long i = gtid; i < (long)tot * DFE; i += gsz) {
        const int slot = (int)(i / DFE), j = (int)(i % DFE), tok = p.LIST[(size_t)pass * MPAD + slot];
        if (tok < 0) continue;
        const int e = moe_slot_expert(p, pass, slot), n = 256 * (j / 128) + (j % 128);
        const bf16* W = p.WguTe + (size_t)e * 2 * DFE * D;
        const float g = dot_bf(p.HX + (size_t)tok * D, W + (size_t)n * D, D), u = dot_bf(p.HX + (size_t)tok * D, W + (size_t)(n + 128) * D, D);
        p.HID[i] = f2bf(silu_f(g) * u);
    }
}
__device__ __forceinline__ void ph_moe_down(const Prm& p, int l, int pass, long gtid, long gsz) {
    const int tot = moe_off(p, pass, NE);
    for (long i = gtid; i < (long)tot * D; i += gsz) {
        const int slot = (int)(i / D), n = (int)(i % D), tok = p.LIST[(size_t)pass * MPAD + slot];
        if (tok < 0) continue;
        const int e = moe_slot_expert(p, pass, slot);
        const float acc = dot_bf(p.HID + (size_t)slot * DFE, p.WdTe + ((size_t)e * D + n) * DFE, DFE);
        const float gate = p.MOD[((size_t)l * 9 + tok / S) * 6 * D + 5 * D + n];
        p.out[(size_t)tok * D + n] += gate * p.TOPW[tok * 2 + pass] * acc;
    }
}

enum { PH_WCONV, PH_MOD, PH_F1, PH_F2A, PH_F2B, PH_F3, PH_MODNORM1, PH_INPROJ, PH_PREP_HY, PH_PREP_QK, PH_HYENA, PH_GA, PH_NA, PH_CTXATTN, PH_FINAL, PH_OUTPROJ, PH_MODNORM2,
       PH_FFN_UP, PH_FFN_DOWN, PH_MOE_COUNT, PH_MOE_ASSIGN, PH_MOE_UP, PH_MOE_DOWN };
__device__ __forceinline__ void run_phase(const Prm& p, int ph, int l, int arg, long gtid, long gsz) {
    const bool first = l == 0, last = l == NL - 1;
    const float* xs = first ? p.x : p.out; const float* cs = first ? p.ctx : p.CX;
    const int nact = last ? MX : M;
    switch (ph) {
        case PH_WCONV: ph_wconv(p, gtid, gsz); break;
        case PH_MOD: ph_mod(p, gtid, gsz); break;
        case PH_F1: ph_filt1(p, gtid, gsz); break;
        case PH_F2A: ph_filt2(p, 0, p.FHA, p.FHB, gtid, gsz); break;
        case PH_F2B: ph_filt2(p, 1, p.FHB, p.FHA, gtid, gsz); break;
        case PH_F3: ph_filt3(p, p.FHA, gtid, gsz); break;
        case PH_MODNORM1: ph_modnorm(p, l, xs, cs, p.norm_mix + l * D, 0, D, M, false, gtid, gsz); break;
        case PH_INPROJ: ph_inproj(p, l, gtid, gsz); break;
        case PH_PREP_HY: ph_prep_hy(p, l, gtid, gsz); break;
        case PH_PREP_QK: ph_prep_qk(p, l, gtid, gsz); break;
        case PH_HYENA: ph_hyena_naive(p, l, true, !last, gtid, gsz); break;
        case PH_GA: ph_ga_naive(p, gtid, gsz); break;
        case PH_NA: ph_na_naive(p, l, gtid, gsz); break;
        case PH_CTXATTN: ph_ctxattn_naive(p, gtid, gsz); break;
        case PH_FINAL: ph_final(p, l, nact, gtid, gsz); break;
        case PH_OUTPROJ: ph_outproj(p, l, xs, cs, nact, gtid, gsz); break;
        case PH_MODNORM2: ph_modnorm(p, l, p.out, p.CX, p.norm_ffn + l * D, 3 * D, 4 * D, nact, (l & 1) != 0, gtid, gsz); break;
        case PH_FFN_UP: ph_ffn_up(p, nact, gtid, gsz); break;
        case PH_FFN_DOWN: ph_ffn_down(p, l, nact, gtid, gsz); break;
        case PH_MOE_COUNT: ph_moe_count(p, gtid, gsz); break;
        case PH_MOE_ASSIGN: ph_moe_assign(p, gtid, gsz); break;
        case PH_MOE_UP: ph_moe_up(p, arg, gtid, gsz); break;
        case PH_MOE_DOWN: ph_moe_down(p, l, arg, gtid, gsz); break;
    }
}

struct WsMap { size_t off; size_t take(size_t bytes) { const size_t o = off; off = (off + bytes + 255) & ~(size_t)255; return o; } };
constexpr size_t CTL_BYTES = 1u << 20;
static void build_prm(Prm& p, void* const* d_in, void* d_out, void* d_ws) {
    const float** f = (const float**)&p;
    for (int i = 0; i < 34; ++i) f[i] = (const float*)d_in[i];
    p.out = (float*)d_out;
    unsigned char* ws = (unsigned char*)d_ws; WsMap w{0};
    p.ctl = (int*)(ws + w.take(CTL_BYTES));
    p.MOD = (float*)(ws + w.take((size_t)NL * 9 * 6 * D * 4));
    p.ROPE = (float*)(ws + w.take((size_t)64 * 16 * 2 * 4));
    p.QKG = (float*)(ws + w.take((size_t)NL * 4 * 64 * 4));
    p.FHA = (float*)(ws + w.take((size_t)3 * S * 64 * 4)); p.FHB = (float*)(ws + w.take((size_t)3 * S * 64 * 4));
    p.FT = (bf16*)(ws + w.take((size_t)NL * DHY * (2 * S + 8) * 2)); p.FTC = (bf16*)(ws + w.take((size_t)DHY * (2 * LC + 8) * 2));
    p.WinT = (bf16*)(ws + w.take((size_t)NL * NP * D * 2)); p.WoutT = (bf16*)(ws + w.take((size_t)NL * D * D * 2));
    p.WguT = (bf16*)(ws + w.take((size_t)2 * DFF * D)); p.WdT = (bf16*)(ws + w.take((size_t)D * DFF));
    p.WguTe = (bf16*)(ws + w.take((size_t)NE * 2 * DFE * D)); p.WdTe = (bf16*)(ws + w.take((size_t)NE * D * DFE));
    p.CX = (float*)(ws + w.take((size_t)MC * D * 4));
    p.XB = (bf16*)(ws + w.take((size_t)MX * D * 2));
    p.TOPI = (int*)(ws + w.take((size_t)MX * 2 * 4)); p.TOPW = (float*)(ws + w.take((size_t)MX * 2 * 4)); p.LIST = (int*)(ws + w.take((size_t)2 * MPAD * 4));
    p.HX = (bf16*)(ws + w.take((size_t)M * D * 2));
    const size_t rbase = w.off;
    p.P = (bf16*)(ws + w.take((size_t)M * NP * 2));
    p.VT = (bf16*)(ws + w.take((size_t)DHY * NB * S * 2)); p.VTC = (bf16*)(ws + w.take((size_t)DHY * NB * LC * 2));
    p.YC = (float*)(ws + w.take((size_t)DHY * NB * S * 4)); p.YCC = (float*)(ws + w.take((size_t)DHY * NB * LC * 4));
    p.HID = (bf16*)(ws + rbase);
    p.XG = (bf16*)(ws + rbase + ((size_t)192 << 20));
    static_assert((size_t)MPAD * DFE + (size_t)(MPAD / 256 - MX / 256) * (D / 256) * 7 * 65536 * 4 <= ((size_t)192 << 20) && ((size_t)192 << 20) + (size_t)2 * MPAD * D <= (size_t)M * NP * 2 + (size_t)DHY * NB * S * 6, "expert buffers inside the dead projection region");
}
static size_t ws_needed() {
    const size_t hid = (size_t)M * DFF * 2 > (size_t)MPAD * DFE * 2 ? (size_t)M * DFF * 2 : (size_t)MPAD * DFE * 2;
    Prm p; unsigned char* base = (unsigned char*)0x1000; void* din[34] = {}; build_prm(p, din, nullptr, base);
    const size_t endR = (size_t)((unsigned char*)p.YCC - base) + (size_t)DHY * NB * LC * 4, endH = (size_t)((unsigned char*)p.HID - base) + hid;
    return endR > endH ? endR : endH;
}


#ifndef CPU_EMU
#define LAS __attribute__((address_space(3)))
extern __shared__ __attribute__((aligned(16))) unsigned char lds_raw[];
constexpr int WIDTAB_OFF = 147456 - 256;
__device__ __forceinline__ int hw_wave_slot() { return (int)(__builtin_amdgcn_s_getreg((5 << 11) | 4) & 63u); }
__device__ __forceinline__ int lane_id() { return (int)__builtin_amdgcn_mbcnt_hi(~0u, __builtin_amdgcn_mbcnt_lo(~0u, 0u)); }
__device__ __forceinline__ int my_tid() { const int w = __builtin_amdgcn_readfirstlane(((volatile LAS int*)((LAS unsigned char*)lds_raw + WIDTAB_OFF))[hw_wave_slot()]); return w * 64 + lane_id(); }
#ifdef PROBE_MASK
#ifndef PROBE_MULT
#define PROBE_MULT 10ull
#endif
#define SEG(id) do { if (blockIdx.x == 0 && my_tid() == 0) { const unsigned long long now_ = __builtin_amdgcn_s_memrealtime(); volatile LAS unsigned long long* T_ = (volatile LAS unsigned long long*)(lds + (147456 - 512) + 64); \
    if (((unsigned long long)(PROBE_MASK) >> (id)) & 1ull) T_[1] += now_ - T_[0]; T_[0] = now_; } } while (0)
#else
#define SEG(id) do { } while (0)
#endif
namespace pg8 {
#define PG8_LAS __attribute__((address_space(3)))
typedef unsigned short bf16_t;
typedef short bf16x8 __attribute__((ext_vector_type(8)));
typedef float f32x4 __attribute__((ext_vector_type(4)));
typedef unsigned u32x4 __attribute__((ext_vector_type(4)));
typedef unsigned u32x2 __attribute__((ext_vector_type(2)));
constexpr int BM = 256, BK = 64, HALF = 128, HTB = HALF * BK * 2  , STAGE_BYTES = 8 * HTB, NXCD = 8, WGM = 8;
__host__ __device__ __forceinline__ int lds_byte(int r, int c) { const int st = (r >> 4) * 2 + (c >> 5), rr = r & 15, cc = c & 31, ob = rr * 64 + cc * 2; return st * 1024 + (ob ^ (((ob >> 9) & 1) << 5)); }
__host__ __device__ __forceinline__ void stage_rc(int b, int& R, int& C) { const int st = b / 1024, sb = b % 1024, swz = sb ^ (((sb >> 9) & 1) << 5); R = (st >> 1) * 16 + swz / 64; C = (st & 1) * 32 + (swz % 64) / 2; }
__host__ __device__ __forceinline__ int perm32(int rho) { const int n = rho >> 4, i = rho & 15; return 8 * (i >> 2) + 4 * n + (i & 3); }
struct Unit { int pm, pn, kp; };
struct Order {
    int nM, nN, nwg, G, c;
    int pm0, ksplit, kplen, nvirt;
    const bf16_t* Bt; size_t bt_group_stride; int pend[8];
    const int* rows;
    __device__ void init(int nM_, int nN_, int G_, int c_, const bf16_t* Bt_) { nM = nM_; nN = nN_; nwg = nM * nN; G = G_; c = c_; Bt = Bt_; bt_group_stride = 0; rows = nullptr; pm0 = 0; ksplit = 1; kplen = 0; nvirt = nwg;
#pragma unroll
        for (int k = 0; k < 8; ++k) pend[k] = 0x7fffffff; }
    __device__ bool next(int i, Unit& u) const {
        const long L = (long)i * G + c; if (L >= nvirt) return false;
        int wgid = (int)L; u.kp = 0; if (ksplit > 1) { wgid = (int)L / ksplit; u.kp = (int)L % ksplit; }
        { const int q = nwg / NXCD, r = nwg % NXCD, xcd = wgid % NXCD, off = wgid / NXCD; wgid = (xcd < r ? xcd * (q + 1) : r * (q + 1) + (xcd - r) * q) + off; }
        const int nig = WGM * nN, gid = wgid / nig, fm = gid * WGM, gsz = (nM - fm) < WGM ? (nM - fm) : WGM;
        u.pm = pm0 + fm + ((wgid % nig) % gsz); u.pn = (wgid % nig) / gsz; return true;
    }
    __device__ __forceinline__ int group(int pm) const { int e = 0;
#pragma unroll
        for (int k = 0; k < 7; ++k) e += (int)((unsigned)(pend[k] - pm - 1) >> 31); return __builtin_amdgcn_readfirstlane(e); }
    __device__ __forceinline__ const bf16_t* bt(const Unit& u) const { return Bt + (size_t)group(u.pm) * bt_group_stride; }
    __device__ __forceinline__ int row(const Unit& u, int r) const { const int t = rows[(size_t)u.pm * BM + r]; return t < 0 ? 0 : t; }
};
__device__ __forceinline__ unsigned cvt_pk_bf16(float lo, float hi) { unsigned r; asm volatile("v_cvt_pk_bf16_f32 %0, %1, %2" : "=v"(r) : "v"(lo), "v"(hi)); return r; }

struct EpiBf16 {
    static constexpr bool PERM = true;
    bf16_t* O; int ldc;
    __device__ __forceinline__ void operator()(const f32x4 (&acc)[2][2][4][2], const Unit& u, int wr, int wc, int fr, int fq) const {
        const int row0 = u.pm * BM + wr * 64 + fr, col0 = u.pn * BM + wc * 32 + 8 * fq;
#pragma unroll
        for (int ai = 0; ai < 2; ++ai)
#pragma unroll
            for (int m = 0; m < 4; ++m) { bf16_t* rowp = O + (size_t)(row0 + ai * HALF + m * 16) * ldc + col0;
#pragma unroll
                for (int bj = 0; bj < 2; ++bj) { const f32x4 v0 = acc[ai][bj][m][0], v1 = acc[ai][bj][m][1];
                    u32x4 w; w.x = cvt_pk_bf16(v0[0], v0[1]); w.y = cvt_pk_bf16(v0[2], v0[3]); w.z = cvt_pk_bf16(v1[0], v1[1]); w.w = cvt_pk_bf16(v1[2], v1[3]);
                    *(u32x4*)(rowp + bj * HALF) = w; } }
    }
};
struct EpiInProj {
    static constexpr bool PERM = true;
    bf16_t* O; const PG8_LAS float* gains; const PG8_LAS float* rope;
    __device__ __forceinline__ void operator()(const f32x4 (&acc)[2][2][4][2], const Unit& u, int wr, int wc, int fr, int fq) const {
        const int c0 = u.pn * BM + 64 * wc;
        const int kind = (c0 >= PC_NAQ && c0 < PC_NAK) ? 1 : (c0 >= PC_NAK && c0 < PC_NAV) ? 2 : (c0 >= PC_GAQ && c0 < PC_GAK) ? 3 : (c0 >= PC_GAK && c0 < PC_GAV) ? 4 : 0;
        const int row0 = u.pm * BM + wr * 64 + fr;
        if (kind == 0) {
#pragma unroll
            for (int ai = 0; ai < 2; ++ai)
#pragma unroll
                for (int m = 0; m < 4; ++m) { bf16_t* rowp = O + (size_t)(row0 + ai * HALF + m * 16) * NP + c0 + 8 * fq;
#pragma unroll
                    for (int bj = 0; bj < 2; ++bj) { const f32x4 v0 = acc[ai][bj][m][0], v1 = acc[ai][bj][m][1];
                        u32x4 w; w.x = cvt_pk_bf16(v0[0], v0[1]); w.y = cvt_pk_bf16(v0[2], v0[3]); w.z = cvt_pk_bf16(v1[0], v1[1]); w.w = cvt_pk_bf16(v1[2], v1[3]);
                        *(u32x4*)(rowp + 32 * bj) = w; } }
            return;
        }
        const PG8_LAS float* gp = gains + (kind - 1) * 64;
        const float qs = (kind == 1 || kind == 3) ? QSCALE : 1.0f;
        const bool dorope = kind >= 3 && u.pm < MX / BM;
#pragma unroll
        for (int ai = 0; ai < 2; ++ai)
#pragma unroll
            for (int m = 0; m < 4; ++m) { const int row = row0 + ai * HALF + m * 16;
                f32x4 v[2][2]; float ss = 0.f;
#pragma unroll
                for (int bj = 0; bj < 2; ++bj)
#pragma unroll
                    for (int n = 0; n < 2; ++n) { v[bj][n] = acc[ai][bj][m][n]; ss += (v[bj][n][0] * v[bj][n][0] + v[bj][n][1] * v[bj][n][1]) + (v[bj][n][2] * v[bj][n][2] + v[bj][n][3] * v[bj][n][3]); }
                ss += __shfl_xor(ss, 16); ss += __shfl_xor(ss, 32);
                const float rstd = 1.0f / sqrtf(ss * (1.0f / 64.0f) + EPS);
#pragma unroll
                for (int bj = 0; bj < 2; ++bj)
#pragma unroll
                    for (int n = 0; n < 2; ++n) v[bj][n] = v[bj][n] * rstd * *(const PG8_LAS f32x4*)(gp + 32 * bj + 8 * fq + 4 * n);
                if (dorope) { const int t = row % S;
#pragma unroll
                    for (int bj = 0; bj < 2; ++bj) { const int pos = bj == 0 ? t / GW : t % GW;
#pragma unroll
                        for (int n = 0; n < 2; ++n) { const PG8_LAS float* rp = rope + (pos * 16 + 8 * (fq & 1) + 4 * n) * 2; const f32x4 a = *(const PG8_LAS f32x4*)rp, b = *(const PG8_LAS f32x4*)(rp + 4);
                            const f32x4 cs = (f32x4){a[0], a[2], b[0], b[2]}, sn = (f32x4){a[1], a[3], b[1], b[3]};
                            f32x4 o; o[0] = __shfl_xor(v[bj][n][0], 32); o[1] = __shfl_xor(v[bj][n][1], 32); o[2] = __shfl_xor(v[bj][n][2], 32); o[3] = __shfl_xor(v[bj][n][3], 32);
                            v[bj][n] = (fq & 2) ? (o * sn + v[bj][n] * cs) : (v[bj][n] * cs - o * sn); } } }
                bf16_t* rowp = O + (size_t)row * NP + c0 + 8 * fq;
#pragma unroll
                for (int bj = 0; bj < 2; ++bj) { const f32x4 v0 = v[bj][0] * qs, v1 = v[bj][1] * qs;
                    u32x4 w; w.x = cvt_pk_bf16(v0[0], v0[1]); w.y = cvt_pk_bf16(v0[2], v0[3]); w.z = cvt_pk_bf16(v1[0], v1[1]); w.w = cvt_pk_bf16(v1[2], v1[3]);
                    *(u32x4*)(rowp + 32 * bj) = w; }
                asm volatile("" ::: "memory"); }
    }
};
__device__ __forceinline__ float silu_fast(float v) { return v * __builtin_amdgcn_rcpf(1.0f + __builtin_amdgcn_exp2f(-1.4426950408889634f * v)); }
struct EpiSwiGLU {
    static constexpr bool PERM = true;
    bf16_t* H; int ldc;
    __device__ __forceinline__ void operator()(const f32x4 (&acc)[2][2][4][2], const Unit& u, int wr, int wc, int fr, int fq) const {
        const int row0 = u.pm * BM + wr * 64 + fr, col0 = u.pn * HALF + wc * 32 + 8 * fq;
#pragma unroll
        for (int ai = 0; ai < 2; ++ai)
#pragma unroll
            for (int m = 0; m < 4; ++m) { bf16_t* rowp = H + (size_t)(row0 + ai * HALF + m * 16) * ldc + col0;
                const f32x4 g0 = acc[ai][0][m][0], g1 = acc[ai][0][m][1], u0 = acc[ai][1][m][0], u1 = acc[ai][1][m][1];
                u32x4 w; w.x = cvt_pk_bf16(silu_fast(g0[0]) * u0[0], silu_fast(g0[1]) * u0[1]); w.y = cvt_pk_bf16(silu_fast(g0[2]) * u0[2], silu_fast(g0[3]) * u0[3]);
                w.z = cvt_pk_bf16(silu_fast(g1[0]) * u1[0], silu_fast(g1[1]) * u1[1]); w.w = cvt_pk_bf16(silu_fast(g1[2]) * u1[2], silu_fast(g1[3]) * u1[3]);
                *(u32x4*)rowp = w; }
    }
};
__device__ __forceinline__ unsigned pk4_fp8(float a, float b, float c, float d) {
    a = __builtin_amdgcn_fmed3f(a, -F8_MAX, F8_MAX); b = __builtin_amdgcn_fmed3f(b, -F8_MAX, F8_MAX); c = __builtin_amdgcn_fmed3f(c, -F8_MAX, F8_MAX); d = __builtin_amdgcn_fmed3f(d, -F8_MAX, F8_MAX);
    int r = __builtin_amdgcn_cvt_pk_fp8_f32(a, b, 0, false); r = __builtin_amdgcn_cvt_pk_fp8_f32(c, d, r, true); return (unsigned)r; }
struct EpiSwiGLU8 {
    static constexpr bool PERM = true;
    unsigned char* H; int ldc;
    __device__ __forceinline__ void operator()(const f32x4 (&acc)[2][2][4][2], const Unit& u, int wr, int wc, int fr, int fq) const {
        const int row0 = u.pm * BM + wr * 64 + fr, col0 = u.pn * HALF + wc * 32 + 8 * fq;
        constexpr float IS = 1.0f / (F8_SA * F8_SWU);
#pragma unroll
        for (int ai = 0; ai < 2; ++ai)
#pragma unroll
            for (int m = 0; m < 4; ++m) { unsigned char* rowp = H + (size_t)(row0 + ai * HALF + m * 16) * ldc + col0;
                const f32x4 g0 = acc[ai][0][m][0] * IS, g1 = acc[ai][0][m][1] * IS, u0 = acc[ai][1][m][0] * (IS * F8_SH), u1 = acc[ai][1][m][1] * (IS * F8_SH);
                u32x2 w; w.x = pk4_fp8(silu_fast(g0[0]) * u0[0], silu_fast(g0[1]) * u0[1], silu_fast(g0[2]) * u0[2], silu_fast(g0[3]) * u0[3]);
                w.y = pk4_fp8(silu_fast(g1[0]) * u1[0], silu_fast(g1[1]) * u1[1], silu_fast(g1[2]) * u1[2], silu_fast(g1[3]) * u1[3]);
                *(u32x2*)rowp = w; }
    }
};
struct EpiResGate {
    static constexpr bool PERM = false;
    const float *xs, *cs; float *xd, *cd; const float* gate; float oscale;
    __device__ __forceinline__ void operator()(const f32x4 (&acc)[2][2][4][2], const Unit& u, int wr, int wc, int fr, int fq) const {
        const bool lat = u.pm < MX / BM; const int prow = (lat ? u.pm : u.pm - MX / BM) * BM + wr * 64 + fr, col0 = u.pn * BM + wc * 32 + 4 * fq;
        const float* s = lat ? xs : cs; float* d = lat ? xd : cd; const float* g = gate + (size_t)(lat ? u.pm / (S / BM) : 8) * 6 * D + col0;
        f32x4 gv[2][2];
#pragma unroll
        for (int bj = 0; bj < 2; ++bj)
#pragma unroll
            for (int n = 0; n < 2; ++n) gv[bj][n] = *(const f32x4*)(g + bj * HALF + n * 16) * oscale;
        constexpr int DEPTH = 3;
        f32x4 xb[DEPTH][2][2];
#define RG_LOAD(b) do { const size_t off_ = (size_t)(prow + ((b) >> 2) * HALF + ((b) & 3) * 16) * D + col0; \
        _Pragma("unroll") for (int bj = 0; bj < 2; ++bj) _Pragma("unroll") for (int n = 0; n < 2; ++n) xb[(b) % DEPTH][bj][n] = *(const f32x4*)(s + off_ + bj * HALF + n * 16); } while (0)
#pragma unroll
        for (int b = 0; b < DEPTH; ++b) RG_LOAD(b);
        __builtin_amdgcn_sched_barrier(0);
#pragma unroll
        for (int b = 0; b < 8; ++b) { const int ai = b >> 2, m = b & 3; const size_t off = (size_t)(prow + ai * HALF + m * 16) * D + col0;
#pragma unroll
            for (int bj = 0; bj < 2; ++bj)
#pragma unroll
                for (int n = 0; n < 2; ++n) *(f32x4*)(d + off + bj * HALF + n * 16) = xb[b % DEPTH][bj][n] + gv[bj][n] * acc[ai][bj][m][n];
            __builtin_amdgcn_sched_barrier(0);
            if (b + DEPTH < 8) { RG_LOAD(b + DEPTH); __builtin_amdgcn_sched_barrier(0); } }
#undef RG_LOAD
    }
};
typedef _Float16 hf2_t __attribute__((ext_vector_type(2))); typedef float f32x2_t __attribute__((ext_vector_type(2)));
__device__ __forceinline__ unsigned pkh(float a, float b) { const f32x2_t v = {a, b}; const hf2_t h = __builtin_convertvector(v, hf2_t); return __builtin_bit_cast(unsigned, h); }
__device__ __forceinline__ f32x4 bflo4(unsigned a, unsigned b) { const hf2_t x = __builtin_bit_cast(hf2_t, a), y = __builtin_bit_cast(hf2_t, b); return (f32x4){(float)x[0], (float)x[1], (float)y[0], (float)y[1]}; }
template <bool SRCF32> struct EpiResB {
    static constexpr bool PERM = true;
    const float* xs; bf16_t* xb; const float* gate; float oscale;
    __device__ __forceinline__ void operator()(const f32x4 (&acc)[2][2][4][2], const Unit& u, int wr, int wc, int fr, int fq) const {
        const int prow = u.pm * BM + wr * 64 + fr, col0 = u.pn * BM + wc * 32 + 8 * fq;
        const float* g = gate + (size_t)(u.pm / (S / BM)) * 6 * D + col0;
        f32x4 gv[2][2];
#pragma unroll
        for (int bj = 0; bj < 2; ++bj)
#pragma unroll
            for (int n = 0; n < 2; ++n) gv[bj][n] = *(const f32x4*)(g + bj * HALF + n * 4) * oscale;
        constexpr int DEPTH = 3;
        f32x4 xf[SRCF32 ? DEPTH : 1][2][2]; u32x4 xh[SRCF32 ? 1 : DEPTH][2];
#define RB_LOAD(b) do { const size_t off_ = (size_t)(prow + ((b) >> 2) * HALF + ((b) & 3) * 16) * D + col0; \
        _Pragma("unroll") for (int bj = 0; bj < 2; ++bj) { if constexpr (SRCF32) { xf[(b) % DEPTH][bj][0] = *(const f32x4*)(xs + off_ + bj * HALF); xf[(b) % DEPTH][bj][1] = *(const f32x4*)(xs + off_ + bj * HALF + 4); } \
            else xh[(b) % DEPTH][bj] = *(const u32x4*)(xb + off_ + bj * HALF); } } while (0)
#pragma unroll
        for (int b = 0; b < DEPTH; ++b) RB_LOAD(b);
        __builtin_amdgcn_sched_barrier(0);
#pragma unroll
        for (int b = 0; b < 8; ++b) { const int ai = b >> 2, m = b & 3; const size_t off = (size_t)(prow + ai * HALF + m * 16) * D + col0;
#pragma unroll
            for (int bj = 0; bj < 2; ++bj) { f32x4 s0, s1;
                if constexpr (SRCF32) { s0 = xf[b % DEPTH][bj][0]; s1 = xf[b % DEPTH][bj][1]; } else { const u32x4 h = xh[b % DEPTH][bj]; s0 = bflo4(h.x, h.y); s1 = bflo4(h.z, h.w); }
                const f32x4 v0 = s0 + gv[bj][0] * acc[ai][bj][m][0], v1 = s1 + gv[bj][1] * acc[ai][bj][m][1];
                u32x4 w; w.x = pkh(v0[0], v0[1]); w.y = pkh(v0[2], v0[3]); w.z = pkh(v1[0], v1[1]); w.w = pkh(v1[2], v1[3]);
                *(u32x4*)(xb + off + bj * HALF) = w; }
            __builtin_amdgcn_sched_barrier(0);
            if (b + DEPTH < 8) { RB_LOAD(b + DEPTH); __builtin_amdgcn_sched_barrier(0); } }
#undef RB_LOAD
    }
};
template <bool LAST> struct EpiMoeDownB {
    static constexpr bool PERM = true;
    const int* list; const float* topw; int pass; bf16_t* xb; float* out; const float* gate; float oscale;
    __device__ __forceinline__ void operator()(const f32x4 (&acc)[2][2][4][2], const Unit& u, int wr, int wc, int fr, int fq) const {
        const int slot0 = u.pm * BM + wr * 64 + fr, col0 = u.pn * BM + wc * 32 + 8 * fq;
        int tok[8]; float w[8];
#pragma unroll
        for (int b = 0; b < 8; ++b) tok[b] = list[slot0 + (b >> 2) * HALF + (b & 3) * 16];
#pragma unroll
        for (int b = 0; b < 8; ++b) { const int t = tok[b] < 0 ? 0 : tok[b]; w[b] = topw[t * 2 + pass] * oscale; }
        constexpr int DEPTH = 2;
        f32x4 gq[DEPTH][2][2]; u32x4 xh[DEPTH][2];
#define MD_LOAD(b) do { const int t_ = tok[b] < 0 ? 0 : tok[b]; const float* g_ = gate + (size_t)(t_ / S) * 6 * D + col0; const bf16_t* x_ = xb + (size_t)t_ * D + col0; \
        _Pragma("unroll") for (int bj = 0; bj < 2; ++bj) { gq[(b) % DEPTH][bj][0] = *(const f32x4*)(g_ + bj * HALF); gq[(b) % DEPTH][bj][1] = *(const f32x4*)(g_ + bj * HALF + 4); xh[(b) % DEPTH][bj] = *(const u32x4*)(x_ + bj * HALF); } } while (0)
#pragma unroll
        for (int b = 0; b < DEPTH; ++b) MD_LOAD(b);
        __builtin_amdgcn_sched_barrier(0);
#pragma unroll
        for (int b = 0; b < 8; ++b) { const int ai = b >> 2, m = b & 3;
            if (tok[b] >= 0) {
#pragma unroll
                for (int bj = 0; bj < 2; ++bj) { const u32x4 h = xh[b % DEPTH][bj];
                    const f32x4 v0 = bflo4(h.x, h.y) + gq[b % DEPTH][bj][0] * w[b] * acc[ai][bj][m][0], v1 = bflo4(h.z, h.w) + gq[b % DEPTH][bj][1] * w[b] * acc[ai][bj][m][1];
                    if constexpr (LAST) { float* o = out + (size_t)tok[b] * D + col0 + bj * HALF; *(f32x4*)o = v0; *(f32x4*)(o + 4) = v1; }
                    else { u32x4 q; q.x = pkh(v0[0], v0[1]); q.y = pkh(v0[2], v0[3]); q.z = pkh(v1[0], v1[1]); q.w = pkh(v1[2], v1[3]); *(u32x4*)(xb + (size_t)tok[b] * D + col0 + bj * HALF) = q; } } }
            __builtin_amdgcn_sched_barrier(0);
            if (b + DEPTH < 8) { MD_LOAD(b + DEPTH); __builtin_amdgcn_sched_barrier(0); } }
#undef MD_LOAD
    }
};
struct EpiPartial {
    static constexpr bool PERM = false;
    float* slab; int nN, pm0, ksplit;
    __device__ __forceinline__ void operator()(const f32x4 (&acc)[2][2][4][2], const Unit& u, int wr, int wc, int fr, int fq) const {
        float* base = slab + ((size_t)((u.pm - pm0) * nN + u.pn) * ksplit + u.kp) * (BM * BM) + (size_t)(wr * 64 + fr) * BM + wc * 32 + 4 * fq;
#pragma unroll
        for (int ai = 0; ai < 2; ++ai)
#pragma unroll
            for (int m = 0; m < 4; ++m)
#pragma unroll
                for (int bj = 0; bj < 2; ++bj)
#pragma unroll
                    for (int n = 0; n < 2; ++n) *(f32x4*)(base + (size_t)(ai * HALF + m * 16) * BM + bj * HALF + n * 16) = acc[ai][bj][m][n];
    }
};
struct EpiMoeDown {
    static constexpr bool PERM = false;
    const int* list; const float* topw; int pass; float* x; const float* gate; float oscale;
    __device__ __forceinline__ void operator()(const f32x4 (&acc)[2][2][4][2], const Unit& u, int wr, int wc, int fr, int fq) const {
        const int slot0 = u.pm * BM + wr * 64 + fr, col0 = u.pn * BM + wc * 32 + 4 * fq;
#pragma unroll
        for (int ai = 0; ai < 2; ++ai)
#pragma unroll
            for (int m = 0; m < 4; ++m) { const int tok = list[slot0 + ai * HALF + m * 16];
                if (tok >= 0) { const float w = topw[tok * 2 + pass] * oscale; const float* g = gate + (size_t)(tok / S) * 6 * D + col0; float* xr = x + (size_t)tok * D + col0;
#pragma unroll
                    for (int bj = 0; bj < 2; ++bj)
#pragma unroll
                        for (int n = 0; n < 2; ++n) { const f32x4 gv = *(const f32x4*)(g + bj * HALF + n * 16); f32x4* xp = (f32x4*)(xr + bj * HALF + n * 16); *xp = *xp + gv * w * acc[ai][bj][m][n]; } } }
    }
};

__device__ __forceinline__ void glds_s(const char* sbase_, unsigned voff, unsigned m0v_) { unsigned keep;
    const unsigned long long b_ = (unsigned long long)(uintptr_t)sbase_;
    const unsigned long long sbase = (unsigned long long)(unsigned)__builtin_amdgcn_readfirstlane((int)(unsigned)b_) | ((unsigned long long)(unsigned)__builtin_amdgcn_readfirstlane((int)(unsigned)(b_ >> 32)) << 32);
    const unsigned m0v = (unsigned)__builtin_amdgcn_readfirstlane((int)m0v_);
    asm volatile("s_mov_b32 %0, m0\n\ts_mov_b32 m0, %3\n\ts_nop 0\n\tglobal_load_lds_dwordx4 %1, %2\n\ts_mov_b32 m0, %0" : "=&s"(keep) : "v"(voff), "s"(sbase), "s"(m0v) : "memory"); }
typedef int i32x4 __attribute__((ext_vector_type(4)));
typedef int i32x8 __attribute__((ext_vector_type(8)));
__device__ __forceinline__ i32x8 cat8(bf16x8 a, bf16x8 b) { const i32x4 x = __builtin_bit_cast(i32x4, a), y = __builtin_bit_cast(i32x4, b); return __builtin_shufflevector(x, y, 0, 1, 2, 3, 4, 5, 6, 7); }
__device__ __forceinline__ bf16x8 lo8(i32x8 v) { return __builtin_bit_cast(bf16x8, (i32x4)__builtin_shufflevector(v, v, 0, 1, 2, 3)); }
__device__ __forceinline__ bf16x8 hi8(i32x8 v) { return __builtin_bit_cast(bf16x8, (i32x4)__builtin_shufflevector(v, v, 4, 5, 6, 7)); }
template <class Epi, bool ALIGN_EPI, bool GATHER, bool F8 = false>
__device__ __forceinline__ void gemm_phase(PG8_LAS unsigned char* lds, const bf16_t* A, int ldk, int K, const Order& S, const Epi& E) {
    int tid_ = my_tid(); asm volatile("" : "+v"(tid_));
    const int tid = tid_, wid = __builtin_amdgcn_readfirstlane(tid >> 6), lane = tid & 63, wr = wid >> 2, wc = wid & 3, fr = lane & 15, fq = lane >> 4;
    const int nt = K / BK;
    unsigned voffB[2]; int RA[2], CA[2];
#pragma unroll
    for (int i = 0; i < 2; ++i) { int R, C; stage_rc(tid * 16 + i * 8192, R, C); const int Rb = Epi::PERM ? ((R & ~31) + perm32(R & 31)) : R; RA[i] = R; CA[i] = C; voffB[i] = (unsigned)(Rb * ldk + C) * 2u; }
    const size_t kstep = (size_t)(BK * 2);
    const size_t hstep = (size_t)HALF * ldk * 2;
    const size_t tstep = 2 * hstep;
    const unsigned ldsw = (unsigned)wid * 1024u;
    const unsigned ldsbase = (unsigned)__builtin_amdgcn_readfirstlane((int)((unsigned)(uintptr_t)lds + ldsw));
    const int aoff = lds_byte(wr * 64 + fr, fq * 8), boff = lds_byte(wc * 32 + fr, fq * 8);
#define PG8_SA(b, h) (((b) * 2 + (h)) * HTB)
#define PG8_SB(b, h) ((4 + (b) * 2 + (h)) * HTB)
#define PG8_STAGE_B(bufoff, gbase) do { _Pragma("unroll") for (int _i = 0; _i < 2; ++_i) glds_s((const char*)(gbase), voffB[_i], ldsbase + (unsigned)((bufoff) + _i * 8192)); } while (0)
#define PG8_STAGE_A(bufoff, gbase, o0, o1) do { glds_s((const char*)(gbase), (o0), ldsbase + (unsigned)(bufoff)); glds_s((const char*)(gbase), (o1), ldsbase + (unsigned)((bufoff) + 8192)); } while (0)
#define PG8_STAGE_AH(bufoff, gbase, oh0, oh1, o0, o1) do { if constexpr (GATHER) PG8_STAGE_A(bufoff, gbase, oh0, oh1); else PG8_STAGE_A(bufoff, (gbase) + hstep, o0, o1); } while (0)
#define PG8_LDA(dst, b, h) do { _Pragma("unroll") for (int m = 0; m < (F8 ? 2 : 4); ++m) _Pragma("unroll") for (int k = 0; k < 2; ++k) dst[m][k] = *(const PG8_LAS bf16x8*)(lds + PG8_SA(b, h) + aoff + m * 2048 + k * 1024); } while (0)
#define PG8_MMA8H(ai, hf) do { __builtin_amdgcn_s_setprio(1); _Pragma("unroll") for (int mm = 0; mm < 2; ++mm) _Pragma("unroll") for (int n = 0; n < 2; ++n) { \
        acc[ai][0][2 * (hf) + mm][n] = __builtin_amdgcn_mfma_scale_f32_16x16x128_f8f6f4(cat8(B0[n][0], B0[n][1]), cat8(At[mm][0], At[mm][1]), acc[ai][0][2 * (hf) + mm][n], 0, 0, 0, 0, 0, 0); \
        acc[ai][1][2 * (hf) + mm][n] = __builtin_amdgcn_mfma_scale_f32_16x16x128_f8f6f4(cat8(B1[n][0], B1[n][1]), cat8(At[mm][0], At[mm][1]), acc[ai][1][2 * (hf) + mm][n], 0, 0, 0, 0, 0, 0); } __builtin_amdgcn_s_setprio(0); } while (0)
#define PG8_CMP(ai, b, h) do { if constexpr (F8) { PG8_MMA8H(ai, 0); PG8_SCHED; \
        _Pragma("unroll") for (int m = 0; m < 2; ++m) _Pragma("unroll") for (int k = 0; k < 2; ++k) At[m][k] = *(const PG8_LAS bf16x8*)(lds + PG8_SA(b, h) + aoff + (2 + m) * 2048 + k * 1024); \
        PG8_WAIT_L(0); PG8_SCHED; PG8_MMA8H(ai, 1); } else { PG8_MMA(ai, 0, At, B0); PG8_MMA(ai, 1, At, B1); } } while (0)
#define PG8_LDB(dst, b, h) do { _Pragma("unroll") for (int n = 0; n < 2; ++n) _Pragma("unroll") for (int k = 0; k < 2; ++k) dst[n][k] = *(const PG8_LAS bf16x8*)(lds + PG8_SB(b, h) + boff + n * 2048 + k * 1024); } while (0)
#define PG8_MMA(ai, bj, At, Bt) do { __builtin_amdgcn_s_setprio(1); _Pragma("unroll") for (int m = 0; m < 4; ++m) _Pragma("unroll") for (int n = 0; n < 2; ++n) _Pragma("unroll") for (int k = 0; k < 2; ++k) \
        acc[ai][bj][m][n] = __builtin_amdgcn_mfma_f32_16x16x32_bf16(Bt[n][k], At[m][k], acc[ai][bj][m][n], 0, 0, 0); __builtin_amdgcn_s_setprio(0); } while (0)
#define PG8_WAIT_V(n) asm volatile("s_waitcnt vmcnt(" #n ")" ::: "memory")
#define PG8_WAIT_L(n) asm volatile("s_waitcnt lgkmcnt(" #n ")" ::: "memory")
#define PG8_BAR __builtin_amdgcn_s_barrier()
#define PG8_SCHED __builtin_amdgcn_sched_barrier(0)
    Unit cur, nxt; int ui = 0;
    if (!S.next(0, cur)) return;
    f32x4 acc[2][2][4][2];
#pragma unroll
    for (int a = 0; a < 2; ++a)
#pragma unroll
        for (int b = 0; b < 2; ++b)
#pragma unroll
            for (int m = 0; m < 4; ++m)
#pragma unroll
                for (int n = 0; n < 2; ++n) { acc[a][b][m][n] = (f32x4){0.f, 0.f, 0.f, 0.f}; if constexpr (F8) asm volatile("" : "+v"(acc[a][b][m][n])); }
    bf16x8 At[F8 ? 2 : 4][2], B0[2][2], B1[2][2];
    unsigned oc00, oc01, oc10, oc11, on00, on01, on10, on11;
    const size_t kpb = (size_t)S.kplen * 2;
    const char* cA; const char* cB = (const char*)S.bt(cur) + (size_t)cur.pn * tstep + cur.kp * kpb;
    bool has_next = S.next(1, nxt);
    if constexpr (GATHER) {
        cA = (const char*)A;
        oc00 = (unsigned)(S.row(cur, RA[0]) * ldk + CA[0]) * 2u; oc01 = (unsigned)(S.row(cur, RA[1]) * ldk + CA[1]) * 2u;
        oc10 = (unsigned)(S.row(cur, HALF + RA[0]) * ldk + CA[0]) * 2u; oc11 = (unsigned)(S.row(cur, HALF + RA[1]) * ldk + CA[1]) * 2u;
        on00 = oc00; on01 = oc01; on10 = oc10; on11 = oc11;
    } else {
        cA = (const char*)A + (size_t)cur.pm * tstep + cur.kp * kpb;
        oc00 = on00 = (unsigned)(RA[0] * ldk + CA[0]) * 2u; oc01 = on01 = (unsigned)(RA[1] * ldk + CA[1]) * 2u; oc10 = on10 = oc00 + (unsigned)hstep; oc11 = on11 = oc01 + (unsigned)hstep;
    }
    PG8_STAGE_B(PG8_SB(0, 0), cB); PG8_STAGE_B(PG8_SB(0, 1), cB + hstep); PG8_STAGE_A(PG8_SA(0, 0), cA, oc00, oc01); PG8_STAGE_AH(PG8_SA(0, 1), cA, oc10, oc11, oc00, oc01);
    if (wr == 1) PG8_BAR;
    PG8_WAIT_V(2); PG8_BAR;
    PG8_STAGE_B(PG8_SB(1, 0), cB + kstep); PG8_STAGE_A(PG8_SA(1, 0), cA + kstep, oc00, oc01); PG8_STAGE_B(PG8_SB(1, 1), cB + hstep + kstep);
    PG8_WAIT_V(6); PG8_BAR;
    for (;;) {
        if constexpr (GATHER) {
            if (has_next) { on00 = (unsigned)(S.row(nxt, RA[0]) * ldk + CA[0]) * 2u; on01 = (unsigned)(S.row(nxt, RA[1]) * ldk + CA[1]) * 2u;
                            on10 = (unsigned)(S.row(nxt, HALF + RA[0]) * ldk + CA[0]) * 2u; on11 = (unsigned)(S.row(nxt, HALF + RA[1]) * ldk + CA[1]) * 2u; }
        }
        const char* nA = GATHER ? cA : (has_next ? (const char*)A + (size_t)nxt.pm * tstep + nxt.kp * kpb : cA);
        const char* nB = has_next ? (const char*)S.bt(nxt) + (size_t)nxt.pn * tstep + nxt.kp * kpb : cB;
#pragma unroll 1
        for (int t = 0; t < nt; t += 2) {
            const bool last = (t == nt - 2);
            const char* a1 = cA + (size_t)(t + 1) * kstep;
            const char* a2 = last ? nA : cA + (size_t)(t + 2) * kstep; const char* b2 = last ? nB : cB + (size_t)(t + 2) * kstep;
            const char* a3 = a2 + kstep; const char* b3 = b2 + kstep;
            unsigned s00 = oc00, s01 = oc01, s10 = oc10, s11 = oc11;
            if constexpr (GATHER) { if (last) { s00 = on00; s01 = on01; s10 = on10; s11 = on11; } }
            PG8_LDB(B0, 0, 0); PG8_LDB(B1, 0, 1); PG8_SCHED; PG8_LDA(At, 0, 0); PG8_STAGE_AH(PG8_SA(1, 1), a1, oc10, oc11, oc00, oc01);
            PG8_WAIT_V(8); PG8_WAIT_L(0); PG8_BAR; PG8_CMP(0, 0, 0); PG8_BAR; PG8_SCHED;
            PG8_LDA(At, 0, 1); PG8_STAGE_B(PG8_SB(0, 0), b2); PG8_STAGE_B(PG8_SB(0, 1), b2 + hstep); PG8_STAGE_A(PG8_SA(0, 0), a2, s00, s01);
            PG8_WAIT_V(8); PG8_WAIT_L(0); PG8_BAR; PG8_CMP(1, 0, 1); PG8_BAR; PG8_SCHED;
            PG8_LDB(B0, 1, 0); PG8_LDB(B1, 1, 1); PG8_SCHED; PG8_LDA(At, 1, 0); PG8_STAGE_AH(PG8_SA(0, 1), a2, s10, s11, s00, s01);
            PG8_WAIT_V(8); PG8_WAIT_L(0); PG8_BAR; PG8_CMP(0, 1, 0); PG8_BAR; PG8_SCHED;
            PG8_LDA(At, 1, 1); PG8_STAGE_B(PG8_SB(1, 0), b3); PG8_STAGE_B(PG8_SB(1, 1), b3 + hstep); PG8_STAGE_A(PG8_SA(1, 0), a3, s00, s01);
            PG8_WAIT_V(8); PG8_WAIT_L(0); PG8_BAR; PG8_CMP(1, 1, 1); PG8_BAR; PG8_SCHED;
        }
        if constexpr (ALIGN_EPI) { if (wr == 0) PG8_BAR; }
        { int l_ = my_tid() & 63; asm volatile("" : "+v"(l_)); E(acc, cur, wr, wc, l_ & 15, l_ >> 4); }
        if (!has_next) break;
#pragma unroll
        for (int a = 0; a < 2; ++a)
#pragma unroll
            for (int b = 0; b < 2; ++b)
#pragma unroll
                for (int m = 0; m < 4; ++m)
#pragma unroll
                    for (int n = 0; n < 2; ++n) { acc[a][b][m][n] = (f32x4){0.f, 0.f, 0.f, 0.f}; if constexpr (F8) asm volatile("" : "+v"(acc[a][b][m][n])); }
        cur = nxt; cA = nA; cB = nB; ++ui;
        if constexpr (GATHER) { oc00 = on00; oc01 = on01; oc10 = on10; oc11 = on11; }
        has_next = S.next(ui + 1, nxt);
        if constexpr (ALIGN_EPI) { if (wr == 1) PG8_BAR; }
    }
    PG8_WAIT_V(0);
    if constexpr (!ALIGN_EPI) { if (wr == 0) PG8_BAR; }
    PG8_BAR;
#undef PG8_SA
#undef PG8_SB
#undef PG8_STAGE_A
#undef PG8_STAGE_B
#undef PG8_LDA
#undef PG8_MMA8H
#undef PG8_CMP
#undef PG8_STAGE_AH
#undef PG8_LDB
#undef PG8_MMA
#undef PG8_WAIT_V
#undef PG8_WAIT_L
#undef PG8_BAR
#undef PG8_SCHED
}
}


#include <hip/hip_bf16.h>
namespace attn_body {
using bf16=__hip_bfloat16;
using bf16x8=__attribute__((ext_vector_type(8)))short;
using s16x4=__attribute__((ext_vector_type(4)))short;
using f32x16=__attribute__((ext_vector_type(16)))float;
using u32x4=__attribute__((ext_vector_type(4)))unsigned;
constexpr int D=64,DM=NP;
constexpr int NW=8,QBLK=32,QB=QBLK*NW,KVBLK=64;
__device__ __forceinline__ int crow(int r,int hi){return (r&3)+8*(r>>2)+4*hi;}
#define SBAR() __builtin_amdgcn_sched_barrier(0)
constexpr int NSLOT=3, SLOTB=8192;
constexpr int LDS_K=0, LDS_V=NSLOT*SLOTB, LDS_WS=2*NSLOT*SLOTB, LDS_OST=LDS_WS+NW*64*4, LDS_TAB=LDS_OST+NW*4096, LDS_BYTES=LDS_TAB+2048;
constexpr float C2=0.125f*1.4426950408889634f;
__device__ __forceinline__ void glds16(const void*gsrc,unsigned lds_dst){unsigned keep;
  asm volatile("s_mov_b32 %0, m0\n\ts_mov_b32 m0, %2\n\ts_nop 0\n\tglobal_load_lds_dwordx4 %1, off\n\ts_mov_b32 m0, %0":"=&s"(keep):"v"(gsrc),"s"(lds_dst):"memory");}
__device__ __forceinline__ float max3f(float a,float b,float c){float r;asm("v_max3_f32 %0, %1, %2, %3":"=v"(r):"v"(a),"v"(b),"v"(c));return r;}
__device__ __forceinline__ float max2f(float a,float b){float r;asm("v_max_f32_e32 %0, %1, %2":"=v"(r):"v"(a),"v"(b));return r;}
__device__ __forceinline__ float fadd_s(float a,float b){float r;asm("v_add_f32_e32 %0, %1, %2":"=v"(r):"v"(a),"v"(b));return r;}
__device__ __forceinline__ float fsub_s(float a,float b){float r;asm("v_sub_f32_e32 %0, %1, %2":"=v"(r):"v"(a),"v"(b));return r;}
typedef float f32x2_t __attribute__((ext_vector_type(2))); typedef __bf16 bf16x2_t __attribute__((ext_vector_type(2)));
__device__ __forceinline__ unsigned cvtpk_s(float lo,float hi){f32x2_t v={lo,hi};bf16x2_t b=__builtin_convertvector(v,bf16x2_t);return __builtin_bit_cast(unsigned,b);}
#define WAIT_BAR(N) asm volatile("s_waitcnt vmcnt(" #N ") lgkmcnt(0)\n\ts_barrier":::"memory")

__device__ __forceinline__ void qkt(f32x16&p0,f32x16&p1,const char*Kslot,const bf16x8*qr,const f32x16&negm,int r32,int hi){
  const char*kb=Kslot+hi*1024+r32*16;
  #pragma unroll
  for(int d0=0;d0<4;++d0){
    const bf16x8 b0=*reinterpret_cast<const bf16x8*>(kb+d0*2048);
    const bf16x8 b1=*reinterpret_cast<const bf16x8*>(kb+d0*2048+512);
    if(d0==0){p0=__builtin_amdgcn_mfma_f32_32x32x16_bf16(b0,qr[0],negm,0,0,0);p1=__builtin_amdgcn_mfma_f32_32x32x16_bf16(b1,qr[0],negm,0,0,0);}
    else{p0=__builtin_amdgcn_mfma_f32_32x32x16_bf16(b0,qr[d0],p0,0,0,0);p1=__builtin_amdgcn_mfma_f32_32x32x16_bf16(b1,qr[d0],p1,0,0,0);}}
}
typedef __attribute__((address_space(3))) const char* lds_cptr;
typedef short v4i16_t __attribute__((ext_vector_type(4)));
__device__ __forceinline__ void kload8(bf16x8*kf,lds_cptr kp){
  kf[0]=*(const __attribute__((address_space(3))) bf16x8*)(kp);      kf[1]=*(const __attribute__((address_space(3))) bf16x8*)(kp+512);
  kf[2]=*(const __attribute__((address_space(3))) bf16x8*)(kp+2048); kf[3]=*(const __attribute__((address_space(3))) bf16x8*)(kp+2560);
  kf[4]=*(const __attribute__((address_space(3))) bf16x8*)(kp+4096); kf[5]=*(const __attribute__((address_space(3))) bf16x8*)(kp+4608);
  kf[6]=*(const __attribute__((address_space(3))) bf16x8*)(kp+6144); kf[7]=*(const __attribute__((address_space(3))) bf16x8*)(kp+6656);
}
__device__ __forceinline__ void kload2(bf16x8*kf,lds_cptr kp,int j){ kf[2*j]=*(const __attribute__((address_space(3))) bf16x8*)(kp+j*2048); kf[2*j+1]=*(const __attribute__((address_space(3))) bf16x8*)(kp+j*2048+512); }
__device__ __forceinline__ s16x4 vtr(lds_cptr p){ return __builtin_bit_cast(s16x4,__builtin_amdgcn_ds_read_tr16_b64_v4i16((__attribute__((address_space(3))) v4i16_t*)p)); }
__device__ __forceinline__ float rowmax(const f32x16&p0,const f32x16&p1){
  float a=max3f(p0[0],p0[1],p1[0]),b=max3f(p0[2],p0[3],p1[1]);a=max3f(a,p1[2],p1[3]);
  #pragma unroll
  for(int r=4;r<16;r+=4){a=max3f(a,p0[r],p0[r+1]);b=max3f(b,p0[r+2],p0[r+3]);a=max3f(a,p1[r],p1[r+1]);b=max3f(b,p1[r+2],p1[r+3]);}
  const float m=max2f(a,b);
  auto rr=__builtin_amdgcn_permlane32_swap(__float_as_uint(m),__float_as_uint(m),false,false);
  return max2f(__uint_as_float(rr[0]),__uint_as_float(rr[1]));
}
__device__ __forceinline__ void pv(f32x16*o,int vb,bf16x8 pa0,bf16x8 pa1,bf16x8 pa2,bf16x8 pa3){
  #pragma unroll
  for(int d0=0;d0<2;++d0){s16x4 lo[4],hi[4];
    #pragma unroll
    for(int ks=0;ks<4;++ks){
      asm volatile("ds_read_b64_tr_b16 %0,%1 offset:%c2":"=&v"(lo[ks]):"v"(vb),"i"(d0*4096+ks*1024):"memory");
      asm volatile("ds_read_b64_tr_b16 %0,%1 offset:%c2":"=&v"(hi[ks]):"v"(vb),"i"(d0*4096+ks*1024+512):"memory");}
    asm volatile("s_waitcnt lgkmcnt(0)":::"memory");SBAR();
    #define PK(k) (bf16x8){lo[k][0],lo[k][1],lo[k][2],lo[k][3],hi[k][0],hi[k][1],hi[k][2],hi[k][3]}
    o[d0]=__builtin_amdgcn_mfma_f32_32x32x16_bf16(pa0,PK(0),o[d0],0,0,0);
    o[d0]=__builtin_amdgcn_mfma_f32_32x32x16_bf16(pa1,PK(1),o[d0],0,0,0);
    o[d0]=__builtin_amdgcn_mfma_f32_32x32x16_bf16(pa2,PK(2),o[d0],0,0,0);
    o[d0]=__builtin_amdgcn_mfma_f32_32x32x16_bf16(pa3,PK(3),o[d0],0,0,0);
    #undef PK
  }
}

#ifndef ATTN_STORE16
#define ATTN_STORE16(p,v) (*(u32x4*)(p)=(v))
#endif
__device__ __forceinline__ void na_mask(f32x16&P0,f32x16&P1,int tl,int klo,int nlat,int wr0,int qgr,int qcol,int cs,int hi,float mhat,const float*tab){
  if(tl<0){
    #pragma unroll
    for(int r=0;r<16;++r){P0[r]-=mhat;P1[r]-=mhat;}
    return; }
  const int krow=klo+tl; const bool rv=(tl<nlat)&&(krow>=wr0)&&(krow<wr0+8);
  if(!rv){
    #pragma unroll
    for(int r=0;r<16;++r){P0[r]=-INFINITY;P1[r]=-INFINITY;}
    return; }
  int hio=hi; asm volatile("":"+v"(hio));
  const float*tb=tab+(krow-qgr+7)*31+15-qcol+4*hio; const int kb=4*hio-cs;
  #pragma unroll
  for(int r=0;r<16;++r){ const int c0=(r&3)+8*(r>>2);
    const bool v0=(unsigned)(c0+kb)<16u, v1=(unsigned)(c0+32+kb)<16u;
    const float b0=tb[c0], b1=tb[c0+32];
    P0[r]=v0?(P0[r]-mhat)+b0:-INFINITY; P1[r]=v1?(P1[r]-mhat)+b1:-INFINITY; }
}
template<int THRL,int MODE> __device__ __forceinline__ void attn_unit(const int b,const int qrow0,const int klo,const int NT,const int nlat,const bf16*Qg,const bf16*__restrict__ Kg,const bf16*__restrict__ Vg,bf16*Og,const float*rpb,char*shm){
  int tid_=my_tid(); asm volatile("":"+v"(tid_));
  const int tid=tid_,lane=tid&63,r32=lane&31,hi=lane>>5; const int wid=__builtin_amdgcn_readfirstlane(tid>>6);
  const bf16*Qw=Qg+((long)qrow0+wid*QBLK)*DM;
  #define TROW(t) ((long)(MODE==0 ? ((t)<S/64 ? (long)b*S+64*(t) : (long)MX+(long)b*LC+64*((t)-S/64)) : MODE==1 ? ((t)<LC/64 ? (long)MX+(long)b*LC+64*(t) : (long)b*S+64*(klo+((t)-LC/64<nlat?(t)-LC/64:nlat-1))) : (long)MX+(long)b*LC+64*(t)))
  const unsigned lds0=(unsigned)(uintptr_t)shm;
  float*wsf=(float*)(shm+LDS_WS)+wid*64;
  const bf16*ksrc=Kg+(long)lane*DM+wid*8;
  const bf16*vsrc=Vg+(long)(16*(wid&3)+(lane>>2))*DM+(wid>>2)*32+(lane&3)*8;
  const unsigned kdst=lds0+LDS_K+wid*1024, vdst=lds0+LDS_V+wid*1024;
  #define DMA_K(t,slot) glds16(ksrc+TROW(t)*DM,(unsigned)__builtin_amdgcn_readfirstlane(kdst+(slot)))
  #define DMA_V(t,slot) glds16(vsrc+TROW(t)*DM,(unsigned)__builtin_amdgcn_readfirstlane(vdst+(slot)))
  const int vb0=(int)(lds0+LDS_V)+((lane>>4)&1)*32+(lane&3)*8+(4*hi+((lane&15)>>2))*64;
  const char*Kbase=shm+LDS_K; bf16x8 kf[8];
  const lds_cptr shm3=(lds_cptr)shm; const lds_cptr kp0=shm3+LDS_K+hi*1024+r32*16; const lds_cptr vp0=shm3+LDS_V+((lane>>4)&1)*32+(lane&3)*8+(4*hi+((lane&15)>>2))*64;
  DMA_K(0,0);DMA_V(0,0);DMA_K(1,SLOTB);
  bf16x8 qr[4];
  #pragma unroll
  for(int d0=0;d0<4;++d0)qr[d0]=*reinterpret_cast<const bf16x8*>(&Qw[(long)r32*DM+d0*16+hi*8]);
  float mhat=0.f,l_reg=0.f;f32x16 o[2];o[0]=f32x16{};o[1]=f32x16{};f32x16 negm=f32x16{}; if(MODE!=1){asm volatile("":"+v"(negm));} const f32x16 zero16_=f32x16{};
  #define NEGM_ (MODE==1?zero16_:negm)
  const int qcol=32*(wid&1)+r32, qgr=(qrow0%S)/64+(wid>>1); int cs_=qcol-8; cs_=cs_<0?0:(cs_>48?48:cs_); int wr0_=qgr-4; wr0_=wr0_<0?0:(wr0_>S/64-8?S/64-8:wr0_);
  const float*tab=(const float*)(shm+LDS_TAB);
  if(MODE==1){ for(int i_=tid;i_<15*31;i_+=512)((float*)(shm+LDS_TAB))[i_]=rpb[i_]*1.4426950408889634f; }
  #define CMASK(P0,P1,t) do{ if(MODE==1){ na_mask(P0,P1,(t)-LC/64,klo,nlat,wr0_,qgr,qcol,cs_,hi,mhat,tab); } }while(0)
  bool resc=false;
  #define START(P0,P1) do{ const float rm=rowmax(P0,P1); resc=false; \
    { const float dl=rm; mhat=fadd_s(mhat,dl); \
      _Pragma("unroll") for(int r=0;r<16;++r){P0[r]=fsub_s(P0[r],dl);P1[r]=fsub_s(P1[r],dl);} \
      if(MODE!=1){ _Pragma("unroll") for(int r=0;r<16;++r)negm[r]=-mhat; asm volatile("":"+v"(negm)); } } \
    _Pragma("unroll") for(int r=0;r<16;++r)P0[r]=__builtin_amdgcn_exp2f(P0[r]); }while(0)
  #define RESC() do{ if(resc){ asm volatile("s_waitcnt lgkmcnt(0)":::"memory"); \
      _Pragma("unroll") for(int d_=0;d_<2;++d_) _Pragma("unroll") for(int r=0;r<16;++r)o[d_][r]*=wsf[crow(r,hi)]; } }while(0)
  f32x16 pA0,pA1,pB0,pB1;
  int sl_prev=0,sl_cur=0,sl_next=SLOTB;
  #define ROT() do{sl_prev=sl_cur;sl_cur=sl_next;sl_next=(sl_next==(NSLOT-1)*SLOTB)?0:sl_next+SLOTB;}while(0)
  DMA_K(2,2*SLOTB);
  WAIT_BAR(3);
  qkt(pA0,pA1,Kbase,qr,NEGM_,r32,hi);asm volatile("s_nop 15\n\ts_nop 7":"+v"(pA0),"+v"(pA1));CMASK(pA0,pA1,0);
  START(pA0,pA1);
  _Pragma("unroll") for(int r=0;r<16;++r)pA1[r]=__builtin_amdgcn_exp2f(pA1[r]);
  WAIT_BAR(0);
  DMA_K(3,0);DMA_V(1,SLOTB);
  ROT();
  kload8(kf,kp0+sl_cur);
  WAIT_BAR(2);
  s16x4 vlo[8],vhi[8]; u32x4 pw0,pw1,pw2,pw3;
  #define PKW(P,B) cvtpk_s(P[B],P[B+1])
  #define PAF(k) __builtin_bit_cast(bf16x8,pw##k)
  #define VFR(i) (bf16x8){vlo[i][0],vlo[i][1],vlo[i][2],vlo[i][3],vhi[i][0],vhi[i][1],vhi[i][2],vhi[i][3]}
  #define PIN(x) asm volatile("":"+v"(x))
  #define MX3(a,b,c) __builtin_fmaxf(__builtin_fmaxf((a),(b)),(c))
  #define GAPA(MF,A0,A1,A2,A3,W0,W1,PW) do{ MF; sacc+=A0; sacc+=A1; sacc+=A2; sacc+=A3; PIN(sacc); W0; W1; PIN(PW); SBAR(); }while(0)
  #define EX(v) __builtin_amdgcn_exp2f(v)
  #define GAPB(MF,X,B) do{ MF; X[B]=EX(X[B]); X[B+1]=EX(X[B+1]); X[B+2]=EX(X[B+2]); X[B+3]=EX(X[B+3]); PIN(X); SBAR(); }while(0)
  #define VRD(i) do{ vlo[i]=vtr(vp_+(((i)>>2)*4096+((i)&3)*1024)); vhi[i]=vtr(vp_+(((i)>>2)*4096+((i)&3)*1024+512)); }while(0)
  #define KRD(G,j) do{ if(G){ kload2(kf,kp0+sl_next,j); SBAR(); } }while(0)
  #define STEP(C0,C1,P0,P1,t,GK,GV,GL) do{ SBAR(); \
    const lds_cptr vp_=vp0+sl_prev; \
    VRD(0); SBAR(); float sacc=(P0[0]+P0[1]); \
    GAPA(C0=__builtin_amdgcn_mfma_f32_32x32x16_bf16(kf[0],qr[0],NEGM_,0,0,0), P0[2],P0[3],P0[4],P0[5],     pw0[0]=PKW(P0,0), pw0[1]=PKW(P0,2), pw0); \
    VRD(4); SBAR(); GAPA(C1=__builtin_amdgcn_mfma_f32_32x32x16_bf16(kf[1],qr[0],NEGM_,0,0,0), P0[6],P0[7],P0[8],P0[9],     pw0[2]=PKW(P0,4), pw0[3]=PKW(P0,6), pw0); \
    VRD(1); SBAR(); GAPA(C0=__builtin_amdgcn_mfma_f32_32x32x16_bf16(kf[2],qr[1],C0,0,0,0),   P0[10],P0[11],P0[12],P0[13], pw1[0]=PKW(P0,8), pw1[1]=PKW(P0,10), pw1); \
    VRD(5); SBAR(); GAPA(C1=__builtin_amdgcn_mfma_f32_32x32x16_bf16(kf[3],qr[1],C1,0,0,0),   P0[14],P0[15],P1[0],P1[1],   pw1[2]=PKW(P0,12),pw1[3]=PKW(P0,14), pw1); \
    VRD(2); SBAR(); GAPA(C0=__builtin_amdgcn_mfma_f32_32x32x16_bf16(kf[4],qr[2],C0,0,0,0),   P1[2],P1[3],P1[4],P1[5],     pw2[0]=PKW(P1,0), pw2[1]=PKW(P1,2), pw2); \
    VRD(6); SBAR(); GAPA(C1=__builtin_amdgcn_mfma_f32_32x32x16_bf16(kf[5],qr[2],C1,0,0,0),   P1[6],P1[7],P1[8],P1[9],     pw2[2]=PKW(P1,4), pw2[3]=PKW(P1,6), pw2); \
    VRD(3); SBAR(); GAPA(C0=__builtin_amdgcn_mfma_f32_32x32x16_bf16(kf[6],qr[3],C0,0,0,0),   P1[10],P1[11],P1[12],P1[13], pw3[0]=PKW(P1,8), pw3[1]=PKW(P1,10), pw3); \
    VRD(7); SBAR(); GAPA(C1=__builtin_amdgcn_mfma_f32_32x32x16_bf16(kf[7],qr[3],C1,0,0,0),   P1[14],P1[15],0.f,0.f,       pw3[2]=PKW(P1,12),pw3[3]=PKW(P1,14), pw3); \
    l_reg+=sacc; \
    if(GK){DMA_K((t)+3,sl_cur);} if(GV){DMA_V((t)+1,sl_next);} \
    CMASK(C0,C1,t); \
    { float a=MX3(C0[0],C0[1],C1[0]),b=MX3(C0[2],C0[3],C1[1]); a=MX3(a,C1[2],C1[3]); \
      _Pragma("unroll") for(int r=4;r<16;r+=4){a=MX3(a,C0[r],C0[r+1]);b=MX3(b,C0[r+2],C0[r+3]);a=MX3(a,C1[r],C1[r+1]);b=MX3(b,C1[r+2],C1[r+3]);} \
      float rm=__builtin_fmaxf(a,b); { auto rr=__builtin_amdgcn_permlane32_swap(__float_as_uint(rm),__float_as_uint(rm),false,false); rm=__builtin_fmaxf(__uint_as_float(rr[0]),__uint_as_float(rr[1])); } \
      resc=false; \
      if(__builtin_expect(__any(rm>(float)THRL),0)){ const float dl=__builtin_fmaxf(rm,0.f); mhat+=dl; \
        _Pragma("unroll") for(int r=0;r<16;++r){C0[r]-=dl;C1[r]-=dl;} \
        if(MODE!=1){ _Pragma("unroll") for(int r=0;r<16;++r)negm[r]=-mhat; asm volatile("":"+v"(negm)); } \
        const float f=__builtin_amdgcn_exp2f(-dl); l_reg*=f; if(hi==0)wsf[r32]=f; resc=true; } } \
    SBAR(); \
    GAPB(o[0]=__builtin_amdgcn_mfma_f32_32x32x16_bf16(PAF(0),VFR(0),o[0],0,0,0), C0,0); \
    GAPB(o[1]=__builtin_amdgcn_mfma_f32_32x32x16_bf16(PAF(0),VFR(4),o[1],0,0,0), C0,4); \
    KRD(GL,0); GAPB(o[0]=__builtin_amdgcn_mfma_f32_32x32x16_bf16(PAF(1),VFR(1),o[0],0,0,0), C0,8); \
    KRD(GL,1); GAPB(o[1]=__builtin_amdgcn_mfma_f32_32x32x16_bf16(PAF(1),VFR(5),o[1],0,0,0), C0,12); \
    KRD(GL,2); GAPB(o[0]=__builtin_amdgcn_mfma_f32_32x32x16_bf16(PAF(2),VFR(2),o[0],0,0,0), C1,0); \
    KRD(GL,3); GAPB(o[1]=__builtin_amdgcn_mfma_f32_32x32x16_bf16(PAF(2),VFR(6),o[1],0,0,0), C1,4); \
    GAPB(o[0]=__builtin_amdgcn_mfma_f32_32x32x16_bf16(PAF(3),VFR(3),o[0],0,0,0), C1,8); \
    GAPB(o[1]=__builtin_amdgcn_mfma_f32_32x32x16_bf16(PAF(3),VFR(7),o[1],0,0,0), C1,12); \
    }while(0)
  int t=1;
  #undef CMASK
  #define CMASK(P0,P1,t) do{ if(MODE==1){ na_mask(P0,P1,(t)-LC/64,klo,nlat,wr0_,qgr,qcol,cs_,hi,mhat,tab); } }while(0)
  for(;t+5<NT;t+=2){
    STEP(pB0,pB1,pA0,pA1,t,true,true,true);     WAIT_BAR(2); RESC(); ROT();
    STEP(pA0,pA1,pB0,pB1,t+1,true,true,true);   WAIT_BAR(2); RESC(); ROT();
  }
  #undef CMASK
  #define CMASK(P0,P1,t) do{ if(MODE==1){ na_mask(P0,P1,(t)-LC/64,klo,nlat,wr0_,qgr,qcol,cs_,hi,mhat,tab); } }while(0)
  #define ENDW(tt) do{ if((tt)+3<NT){WAIT_BAR(2);} else if((tt)+2<NT){WAIT_BAR(1);} else {WAIT_BAR(0);} }while(0)
  for(;t+1<NT;t+=2){
    STEP(pB0,pB1,pA0,pA1,t,(t+3<NT),(t+1<NT),(t+1<NT));       ENDW(t);   RESC(); ROT();
    STEP(pA0,pA1,pB0,pB1,t+1,(t+4<NT),(t+2<NT),(t+2<NT));     ENDW(t+1); RESC(); ROT();
  }
  STEP(pB0,pB1,pA0,pA1,NT-1,false,false,false); RESC();
  { float sacc=pB0[0]+pB0[1]; _Pragma("unroll") for(int r=2;r<16;++r)sacc+=pB0[r]; _Pragma("unroll") for(int r=0;r<16;++r)sacc+=pB1[r]; l_reg+=sacc;
    pw0=(u32x4){PKW(pB0,0),PKW(pB0,2),PKW(pB0,4),PKW(pB0,6)};pw1=(u32x4){PKW(pB0,8),PKW(pB0,10),PKW(pB0,12),PKW(pB0,14)};pw2=(u32x4){PKW(pB1,0),PKW(pB1,2),PKW(pB1,4),PKW(pB1,6)};pw3=(u32x4){PKW(pB1,8),PKW(pB1,10),PKW(pB1,12),PKW(pB1,14)};
    SBAR(); pv(o,vb0+sl_cur,PAF(0),PAF(1),PAF(2),PAF(3)); }
  #undef PKW
  #undef PAF
  #undef VFR
  #undef PIN
  #undef MX3
  #undef GAPA
  #undef GAPB
  #undef EX
  #undef VRD
  #undef KRD
  #undef STEP
  #undef ENDW
  {auto rr=__builtin_amdgcn_permlane32_swap(__float_as_uint(l_reg),__float_as_uint(l_reg),false,false);l_reg=__uint_as_float(rr[0])+__uint_as_float(rr[1]);}
  if(hi==0)wsf[32+r32]=l_reg;asm volatile("s_waitcnt lgkmcnt(0)":::"memory");
  float rli[16];
  #pragma unroll
  for(int r=0;r<16;++r)rli[r]=__builtin_amdgcn_rcpf(wsf[32+crow(r,hi)]);
  bf16*Ow=Og+((long)qrow0+wid*QBLK)*DM;
  { bf16*stg=(bf16*)(shm+LDS_OST)+wid*2048;
    #pragma unroll
    for(int r=0;r<16;++r){const int orow=crow(r,hi);
      #pragma unroll
      for(int d0=0;d0<2;++d0)stg[orow*64+d0*32+r32]=__float2bfloat16(o[d0][r]*rli[r]);}
    asm volatile("s_waitcnt lgkmcnt(0)":::"memory");
    #pragma unroll
    for(int i=0;i<4;++i){const int row=i*8+(lane>>3),ch=lane&7; const u32x4 v=*(const u32x4*)(stg+row*64+ch*8); ATTN_STORE16(Ow+(long)row*DM+ch*8,v);} }
  asm volatile("s_waitcnt lgkmcnt(0)\n\ts_barrier":::"memory");
  #undef DMA_K
  #undef NEGM_
  #undef TROW
  #undef DMA_V
  #undef CMASK
  #undef START
  #undef RESC
  #undef ROT
}
constexpr int ATTN_LDS_BYTES=LDS_BYTES;
#undef SBAR
#undef WAIT_BAR
}
__device__ __forceinline__ int pull_unit(int* ctr, LAS unsigned char* lds) {
    volatile LAS int* slot = (volatile LAS int*)(lds + (147456 - 512) + 16);
    __syncthreads();
    if (my_tid() == 0) *slot = __hip_atomic_fetch_add(ctr, 1, __ATOMIC_RELAXED, __HIP_MEMORY_SCOPE_AGENT);
    __syncthreads();
    return __builtin_amdgcn_readfirstlane(*slot);
}
template <int PART> __device__ __forceinline__ void attn_phase(const Prm& p, int l, char* shm, int G) {
    using namespace attn_body;
    const int bx = blockIdx.x, vcu = (G % 8 == 0) ? (bx % 8) * (G / 8) + bx / 8 : bx;
    const attn_body::bf16* Pb = (const attn_body::bf16*)p.P;
    constexpr int NQB = S / 256;
    if constexpr (PART == 0) for (int u = vcu * 2; u < NB * NGA * NQB; u += 2 * G) {
#pragma unroll 1
        for (int j = 0; j < 2; ++j) { const int uu = u + j; if (uu >= NB * NGA * NQB) break; const int qb = uu % NQB, h = (uu / NQB) % NGA, b = uu / (NQB * NGA);
            attn_unit<8, 0>(b, b * S + 256 * qb, 0, S / 64 + LC / 64, 0, Pb + PC_GAQ + 64 * h, Pb + PC_GAK + 64 * h, Pb + PC_GAV + 64 * h, (attn_body::bf16*)Pb + PC_GAQ + 64 * h, nullptr, shm); }
    }
    if constexpr (PART == 1) {
        for (;;) { const int uu = pull_unit(p.ctl + 32 + 2 * l + 1, (LAS unsigned char*)shm); if (uu >= NB * NNA * NQB) break; const int qb = uu % NQB, h = (uu / NQB) % NNA, b = uu / (NQB * NNA);
            const int r0 = 4 * qb; int klo = r0 - 4; klo = klo < 0 ? 0 : (klo > ROWS - 8 ? ROWS - 8 : klo); int khi = r0 + 3 - 4; khi = (khi < 0 ? 0 : (khi > ROWS - 8 ? ROWS - 8 : khi)) + 7;
            const int nlat = khi - klo + 1, NT = (LC / 64 + nlat + 1) & ~1;
            attn_unit<8, 1>(b, b * S + 256 * qb, klo, NT, nlat, Pb + PC_NAQ + 64 * h, Pb + PC_NAK + 64 * h, Pb + PC_NAV + 64 * h, (attn_body::bf16*)Pb + PC_NAQ + 64 * h, p.na_rpb + ((size_t)l * NNA + h) * 15 * 31, shm); }
    }
    if constexpr (PART == 2) {
        static_assert(LC == 256, "context unit = one 256-row query block");
        for (int u = vcu; u < NB * (NNA + NGA); u += G) { const int hh = u % (NNA + NGA), b = u / (NNA + NGA);
            const int qo = hh < NNA ? PC_NAQ + 64 * hh : PC_GAQ + 64 * (hh - NNA), ko = hh < NNA ? PC_NAK + 64 * hh : PC_GAK + 64 * (hh - NNA), vo = hh < NNA ? PC_NAV + 64 * hh : PC_GAV + 64 * (hh - NNA);
            attn_unit<8, 2>(b, MX + b * LC, 0, LC / 64, 0, Pb + qo, Pb + ko, Pb + vo, (attn_body::bf16*)Pb + qo, nullptr, shm); }
    }
}


namespace hy {
typedef short bf16x8 __attribute__((ext_vector_type(8)));
typedef short s16x4 __attribute__((ext_vector_type(4)));
typedef float f32x16 __attribute__((ext_vector_type(16)));
typedef float f32x4 __attribute__((ext_vector_type(4)));
typedef unsigned u32x4 __attribute__((ext_vector_type(4)));
constexpr int NBLK = S / 128, FTP = 2 * S + 8, L_V = 0, L_F = NB * S * 2, FCOPY = 2 * S * 2 + 64, L_END = L_F + 3 * FCOPY + 2 * S * 2;
static_assert(NBLK == 32 && NB == 8, "hyena unit geometry: 32 sequence blocks of 128, 8 batches");
__device__ __forceinline__ void hyena_unit(const bf16* vg, const bf16* fg, float* yg, LAS unsigned char* lds) {
    int tid_ = my_tid(); asm volatile("" : "+v"(tid_));
    const int tid = tid_, wid = __builtin_amdgcn_readfirstlane(tid >> 6), lane = tid & 63, n = lane & 31, hi = lane >> 5;
#pragma unroll
    for (int i = 0; i < 8; ++i) { const int q = i * 512 + tid, rowg = q >> 4, ch = q & 15, rowL = (rowg & 31) * 8 + (rowg >> 5);
        const u32x4 v = *(const u32x4*)(vg + (size_t)q * 8); *(LAS u32x4*)(lds + L_V + rowL * 256 + ((ch ^ (rowL & 15)) << 4)) = v; }
#pragma unroll
    for (int i = 0; i < 2; ++i) { const int g = i * 512 + tid; const u32x4 a = *(const u32x4*)(fg + 8 * g), b = *(const u32x4*)(fg + 8 * g + 8);
        const unsigned w[8] = {a.x, a.y, a.z, a.w, b.x, b.y, b.z, b.w};
        u32x4 c1, c3;
#pragma unroll
        for (int k = 0; k < 4; ++k) { c1[k] = __builtin_amdgcn_alignbit(w[k + 1], w[k], 16); c3[k] = __builtin_amdgcn_alignbit(w[k + 2], w[k + 1], 16); }
        *(LAS u32x4*)(lds + L_F + 0 * FCOPY + g * 16) = a; *(LAS u32x4*)(lds + L_F + 1 * FCOPY + g * 16) = c1;
        *(LAS u32x4*)(lds + L_F + 2 * FCOPY + g * 16) = (u32x4){a.y, a.z, a.w, b.x}; *(LAS u32x4*)(lds + L_F + 3 * FCOPY + g * 16) = c3; }
    __syncthreads();
    SEG(50);
    f32x16 acc[4];
#pragma unroll
    for (int m = 0; m < 4; ++m) acc[m] = f32x16{};
    const int I0 = 4 * wid, I = I0 + (n >> 3), bb = n & 7;
    if (wid >= 4) __builtin_amdgcn_s_setprio(2);
#pragma unroll 1
    for (int cs = 0; cs < NBLK; ++cs) {
        const int rowL = ((I - cs) & 31) * 8 + bb;
        bf16x8 Bf[8];
#pragma unroll
        for (int s = 0; s < 8; ++s) Bf[s] = *(const LAS bf16x8*)(lds + L_V + rowL * 256 + (((2 * s + hi) ^ (rowL & 15)) << 4));
#pragma unroll 1
        for (int pass = 0; pass < 2; ++pass) {
            const bool any = pass == 0 ? (I0 + 3 >= cs) : (I0 < cs);
            if (!any) continue;
            const bool valid = pass == 0 ? (I >= cs) : (I < cs); const int d = pass == 0 ? cs : cs - NBLK;
            const int xb = S - 128 * d - 96 - n + 8 * hi, rho = xb & 3;
            const LAS unsigned char* fa = lds + L_F + rho * FCOPY + 2 * (xb - rho);
            bf16x8 Af[14];
#pragma unroll
            for (int o = 0; o < 14; ++o) { const s16x4 lo = *(const LAS s16x4*)(fa + (13 - o) * 32), hh = *(const LAS s16x4*)(fa + (13 - o) * 32 + 8);
                Af[o] = (bf16x8){lo[0], lo[1], lo[2], lo[3], hh[0], hh[1], hh[2], hh[3]}; }
            const bool straddle = (I0 < cs) && (I0 + 3 >= cs);
            if (!straddle) {
#pragma unroll
                for (int s = 0; s < 8; ++s)
#pragma unroll
                    for (int m = 0; m < 4; ++m) acc[m] = __builtin_amdgcn_mfma_f32_32x32x16_bf16(Af[2 * m - s + 7], Bf[s], acc[m], 0, 0, 0);
            } else {
                bf16x8 Bm[8];
#pragma unroll
                for (int s = 0; s < 8; ++s) Bm[s] = valid ? Bf[s] : (bf16x8){0, 0, 0, 0, 0, 0, 0, 0};
#pragma unroll
                for (int s = 0; s < 8; ++s)
#pragma unroll
                    for (int m = 0; m < 4; ++m) acc[m] = __builtin_amdgcn_mfma_f32_32x32x16_bf16(Af[2 * m - s + 7], Bm[s], acc[m], 0, 0, 0);
            }
        }
    }
    __builtin_amdgcn_s_setprio(0);
    __syncthreads();
    SEG(51);
    LAS unsigned char* st = lds + wid * 16384;
#pragma unroll
    for (int m = 0; m < 4; ++m)
#pragma unroll
        for (int g = 0; g < 4; ++g) { const int q = 8 * m + 2 * g + hi; *(LAS f32x4*)(st + n * 512 + ((q ^ n) << 4)) = (f32x4){acc[m][4 * g], acc[m][4 * g + 1], acc[m][4 * g + 2], acc[m][4 * g + 3]}; }
    asm volatile("s_waitcnt lgkmcnt(0)" ::: "memory");
#pragma unroll
    for (int i = 0; i < 16; ++i) { const int rn = 2 * i + hi, q = n; const f32x4 v = *(const LAS f32x4*)(st + rn * 512 + ((q ^ rn) << 4));
        *(f32x4*)(yg + (size_t)(rn & 7) * S + (I0 + (rn >> 3)) * 128 + 4 * q) = v; }
    __syncthreads();
    SEG(52);
}
}
__device__ __forceinline__ void hyena_phase(const Prm& p, int l, LAS unsigned char* lds, int G) {
    (void)G;
    for (;;) { const int c = pull_unit(p.ctl + 32 + 2 * l, lds); if (c >= DHY) break;
        hy::hyena_unit(p.VT + (size_t)c * NB * S, p.FT + ((size_t)l * DHY + c) * hy::FTP, p.YC + (size_t)c * NB * S, lds); }
}


namespace thin {
typedef float f32x4 __attribute__((ext_vector_type(4)));
typedef unsigned u32x4 __attribute__((ext_vector_type(4)));
typedef unsigned u32x2 __attribute__((ext_vector_type(2)));
typedef unsigned u32x3a __attribute__((ext_vector_type(3), aligned(4)));
__device__ __forceinline__ float wave_sum(float v) {
#pragma unroll
    for (int o = 1; o < 64; o <<= 1) v += __shfl_xor(v, o);
    return v;
}
__device__ __forceinline__ unsigned pk2(float lo, float hi) { return f2bf_u(lo) | (f2bf_u(hi) << 16); }
__device__ __forceinline__ float lo16(unsigned u) { return __uint_as_float(u << 16); }
__device__ __forceinline__ float hi16(unsigned u) { return __uint_as_float(u & 0xffff0000u); }

__device__ __forceinline__ void transpose_item(const float* W, int K, int N, bf16* WT, int k0, int n0, int drow0, int drow1, LAS float* scr, int lane) {
    const int lr = lane >> 4, lc = 4 * (lane & 15);
    f32x4 v[16];
#pragma unroll
    for (int i = 0; i < 16; ++i) v[i] = __builtin_nontemporal_load((const f32x4*)(W + (size_t)(k0 + 4 * i + lr) * N + n0 + lc));
#pragma unroll
    for (int i = 0; i < 16; ++i) { LAS float* d = scr + (4 * i + lr) * 65 + lc; d[0] = v[i].x; d[1] = v[i].y; d[2] = v[i].z; d[3] = v[i].w; }
    asm volatile("s_waitcnt lgkmcnt(0)" ::: "memory");
    const int c = lane & 7;
#pragma unroll
    for (int j = 0; j < 8; ++j) { const int n = (lane >> 3) + 8 * j; const LAS float* sp = scr + (8 * c) * 65 + n;
        u32x4 o; o.x = pk2(sp[0 * 65], sp[1 * 65]); o.y = pk2(sp[2 * 65], sp[3 * 65]); o.z = pk2(sp[4 * 65], sp[5 * 65]); o.w = pk2(sp[6 * 65], sp[7 * 65]);
        *(u32x4*)(WT + (size_t)(n < 32 ? drow0 + n : drow1 + n - 32) * K + k0 + 8 * c) = o; }
    asm volatile("s_waitcnt lgkmcnt(0)" ::: "memory");
}
__device__ __forceinline__ void transpose_item8(const float* W, int K, int N, unsigned char* WT, int k0, int n0, int drow0, int drow1, float scale, LAS float* scr, int lane) {
    const int lr = lane >> 4, lc = 4 * (lane & 15);
    f32x4 v[16];
#pragma unroll
    for (int i = 0; i < 16; ++i) v[i] = __builtin_nontemporal_load((const f32x4*)(W + (size_t)(k0 + 4 * i + lr) * N + n0 + lc));
#pragma unroll
    for (int i = 0; i < 16; ++i) { LAS float* d = scr + (4 * i + lr) * 65 + lc; d[0] = v[i].x; d[1] = v[i].y; d[2] = v[i].z; d[3] = v[i].w; }
    asm volatile("s_waitcnt lgkmcnt(0)" ::: "memory");
    const int c = lane & 3;
#pragma unroll
    for (int j = 0; j < 4; ++j) { const int n = (lane >> 2) + 16 * j; const LAS float* sp = scr + (16 * c) * 65 + n;
        u32x4 o;
        o.x = pg8::pk4_fp8(sp[0 * 65] * scale, sp[1 * 65] * scale, sp[2 * 65] * scale, sp[3 * 65] * scale); o.y = pg8::pk4_fp8(sp[4 * 65] * scale, sp[5 * 65] * scale, sp[6 * 65] * scale, sp[7 * 65] * scale);
        o.z = pg8::pk4_fp8(sp[8 * 65] * scale, sp[9 * 65] * scale, sp[10 * 65] * scale, sp[11 * 65] * scale); o.w = pg8::pk4_fp8(sp[12 * 65] * scale, sp[13 * 65] * scale, sp[14 * 65] * scale, sp[15 * 65] * scale);
        *(u32x4*)(WT + (size_t)(n < 32 ? drow0 + n : drow1 + n - 32) * K + k0 + 16 * c) = o; }
    asm volatile("s_waitcnt lgkmcnt(0)" ::: "memory");
}
__device__ __forceinline__ void transpose_matrix(const float* W, int K, int N, bf16* WT, int mode, LAS float* scr, int lane, int gw, int ngw, int& rot) {
    const int nkb = K / 64, nnb = N / 64, items = nkb * nnb;
    for (int it = (gw + ngw - rot % ngw) % ngw; it < items; it += ngw) { const int kb = it / nnb, nb = it % nnb, n0 = 64 * nb;
        const int drow0 = mode == 3 ? (n0 & ~255) + 32 * ((n0 & 255) >> 6) : (mode == 0 ? n0 : 256 * (n0 / 128) + (n0 % 128) + (mode == 2 ? 128 : 0));
        transpose_item(W, K, N, WT, 64 * kb, n0, drow0, mode == 3 ? drow0 + 128 : drow0 + 32, scr, lane); }
    rot += items;
}
__device__ __forceinline__ void transpose_matrix8(const float* W, int K, int N, unsigned char* WT, int mode, float scale, LAS float* scr, int lane, int gw, int ngw, int& rot) {
    const int nkb = K / 64, nnb = N / 64, items = nkb * nnb;
    for (int it = (gw + ngw - rot % ngw) % ngw; it < items; it += ngw) { const int kb = it / nnb, nb = it % nnb, n0 = 64 * nb;
        const int drow0 = mode == 0 ? n0 : 256 * (n0 / 128) + (n0 % 128) + (mode == 2 ? 128 : 0);
        transpose_item8(W, K, N, WT, 64 * kb, n0, drow0, drow0 + 32, scale, scr, lane); }
    rot += items;
}
__device__ __forceinline__ void wconv_phase(const Prm& p, LAS unsigned char* lds, int G) {
    int tid_ = my_tid(); asm volatile("" : "+v"(tid_));
    const int wid = __builtin_amdgcn_readfirstlane(tid_ >> 6), lane = tid_ & 63, gw = blockIdx.x * 8 + wid, ngw = G * 8;
    LAS float* scr = (LAS float*)(lds + wid * (64 * 65 * 4));
    int rot = 0;
    for (int l = 0; l < NL; ++l) {
        transpose_matrix(p.w_in + (size_t)l * D * NP, D, NP, p.WinT + (size_t)l * NP * D, 3, scr, lane, gw, ngw, rot);
        transpose_matrix(p.w_out + (size_t)l * D * D, D, D, p.WoutT + (size_t)l * D * D, 0, scr, lane, gw, ngw, rot);
    }
    transpose_matrix8(p.ffn_w_gate, D, DFF, (unsigned char*)p.WguT, 1, F8_SWU, scr, lane, gw, ngw, rot);
    transpose_matrix8(p.ffn_w_up, D, DFF, (unsigned char*)p.WguT, 2, F8_SWU, scr, lane, gw, ngw, rot);
    transpose_matrix8(p.ffn_w_down, DFF, D, (unsigned char*)p.WdT, 0, F8_SWD, scr, lane, gw, ngw, rot);
    for (int e = 0; e < NE; ++e) {
        transpose_matrix8(p.moe_w_gate + (size_t)e * D * DFE, D, DFE, (unsigned char*)p.WguTe + (size_t)e * 2 * DFE * D, 1, F8_SWU, scr, lane, gw, ngw, rot);
        transpose_matrix8(p.moe_w_up + (size_t)e * D * DFE, D, DFE, (unsigned char*)p.WguTe + (size_t)e * 2 * DFE * D, 2, F8_SWU, scr, lane, gw, ngw, rot);
        transpose_matrix8(p.moe_w_down + (size_t)e * DFE * D, DFE, D, (unsigned char*)p.WdTe + (size_t)e * D * DFE, 0, F8_SWD, scr, lane, gw, ngw, rot);
    }
}
__device__ __forceinline__ void rope_table(const Prm& p, long gtid) {
    if (gtid < NL * 4 * 64) { const int d = (int)gtid & 63, k = ((int)gtid >> 6) & 3, l = (int)gtid >> 8; const float* src = k == 0 ? p.na_q_norm : k == 1 ? p.na_k_norm : k == 2 ? p.ga_q_norm : p.ga_k_norm; p.QKG[gtid] = src[l * 64 + d]; }
    if (gtid < 64 * 16) { const int i = (int)gtid & 15, pos = (int)gtid >> 4; const float ang = (float)pos * powf(10000.0f, -(float)i / 16.0f); p.ROPE[2 * gtid] = cosf(ang); p.ROPE[2 * gtid + 1] = sinf(ang); }
}

template <bool ROUTER, bool F8OUT = ROUTER, bool XBF16 = false>
__device__ __forceinline__ void modnorm_phase(const Prm& p, int l, const float* xs, const float* cs, const float* gain, int off_shift, int off_scale, int nrows, LAS unsigned char* lds, int G) {
    int tid_ = my_tid(); asm volatile("" : "+v"(tid_));
    const int tid = tid_, wid = __builtin_amdgcn_readfirstlane(tid >> 6), lane = tid & 63, gw = blockIdx.x * 8 + wid, ngw = G * 8;
    LAS int* hist = (LAS int*)lds;
    LAS f32x4* RW = (LAS f32x4*)(lds + 1024);
    if constexpr (ROUTER) {
        if (tid < 16) hist[tid] = 0;
        for (long i = (long)blockIdx.x * 512 + tid; i < (long)2 * MPAD; i += (long)G * 512) p.LIST[i] = -1;
        for (int q = tid; q < D * 2; q += 512) { const int k = q >> 1, h = q & 1, j = k >> 8, ln = (k & 255) >> 2, i = k & 3;
            RW[((4 * j + i) * 2 + h) * 64 + ln] = *(const f32x4*)(p.moe_router + (size_t)k * NE + 4 * h); }
        __syncthreads();
    }
    constexpr int RB = 4;
    const int nbat = (nrows + RB - 1) / RB, qb = nbat / ngw, rb_ = nbat % ngw, wv = gw;
    const int bbeg = wv * qb + (wv < rb_ ? wv : rb_), bcnt = qb + (wv < rb_ ? 1 : 0);
    const int rbeg = bbeg * RB, rend = (bbeg + bcnt) * RB < nrows ? (bbeg + bcnt) * RB : nrows;
    f32x4 gs[4], shv[4]; int curmod = -1;
    for (int row0 = rbeg; row0 < rend; row0 += RB) {
        f32x4 v[RB][4]; float ss[RB];
#pragma unroll
        for (int r = 0; r < RB; ++r) { const int row = row0 + r < rend ? row0 + r : rend - 1;
            if (XBF16 && row < MX) { const bf16* sb = p.XB + (size_t)row * D;
#pragma unroll
                for (int j = 0; j < 4; ++j) { const u32x2 h = __builtin_nontemporal_load((const u32x2*)sb + lane + 64 * j); v[r][j] = pg8::bflo4(h.x, h.y); } }
            else { const float* src = row < MX ? xs + (size_t)row * D : cs + (size_t)(row - MX) * D;
#pragma unroll
                for (int j = 0; j < 4; ++j) v[r][j] = __builtin_nontemporal_load((const f32x4*)src + lane + 64 * j); } }
#pragma unroll
        for (int r = 0; r < RB; ++r) { float a = 0.f;
#pragma unroll
            for (int j = 0; j < 4; ++j) a += (v[r][j].x * v[r][j].x + v[r][j].y * v[r][j].y) + (v[r][j].z * v[r][j].z + v[r][j].w * v[r][j].w);
            ss[r] = a; }
#pragma unroll
        for (int r = 0; r < RB; ++r) { const int row = row0 + r; if (row >= rend) break;
            const int mr = row_modrow(row);
            if (mr != curmod) { curmod = mr; const float* mod = p.MOD + ((size_t)l * 9 + mr) * 6 * D;
#pragma unroll
                for (int j = 0; j < 4; ++j) { gs[j] = ((const f32x4*)gain)[lane + 64 * j] * (((const f32x4*)(mod + off_scale))[lane + 64 * j] + 1.0f); shv[j] = ((const f32x4*)(mod + off_shift))[lane + 64 * j]; } }
            const float rstd = 1.0f / sqrtf(wave_sum(ss[r]) * (1.0f / D) + EPS);
            float lg[NE];
#pragma unroll
            for (int e = 0; e < NE; ++e) lg[e] = 0.f;
#pragma unroll
            for (int j = 0; j < 4; ++j) { const f32x4 h = v[r][j] * rstd * gs[j] + shv[j];
                if constexpr (F8OUT) *(unsigned*)((unsigned char*)p.HX + (size_t)row * D + 4 * lane + 256 * j) = pg8::pk4_fp8(h.x * F8_SA, h.y * F8_SA, h.z * F8_SA, h.w * F8_SA);
                else *(u32x2*)(p.HX + (size_t)row * D + 4 * lane + 256 * j) = (u32x2){pk2(h.x, h.y), pk2(h.z, h.w)};
                if constexpr (ROUTER) {
#pragma unroll
                    for (int i = 0; i < 4; ++i) { const f32x4 w0 = RW[((4 * j + i) * 2 + 0) * 64 + lane], w1 = RW[((4 * j + i) * 2 + 1) * 64 + lane]; const float hv = h[i];
                        lg[0] += hv * w0.x; lg[1] += hv * w0.y; lg[2] += hv * w0.z; lg[3] += hv * w0.w; lg[4] += hv * w1.x; lg[5] += hv * w1.y; lg[6] += hv * w1.z; lg[7] += hv * w1.w; } } }
            if constexpr (ROUTER) {
                if (row < MX) {
                    float b1 = -INFINITY, b2 = -INFINITY; int i1 = 0, i2 = 0;
                    float a4[4], b2_[2], c1;
#pragma unroll
                    for (int e = 0; e < 4; ++e) { const float mine = (lane & 1) ? lg[2 * e + 1] : lg[2 * e], oth = (lane & 1) ? lg[2 * e] : lg[2 * e + 1]; a4[e] = mine + __shfl_xor(oth, 1); }
#pragma unroll
                    for (int e = 0; e < 2; ++e) { const float mine = (lane & 2) ? a4[2 * e + 1] : a4[2 * e], oth = (lane & 2) ? a4[2 * e] : a4[2 * e + 1]; b2_[e] = mine + __shfl_xor(oth, 2); }
                    { const float mine = (lane & 4) ? b2_[1] : b2_[0], oth = (lane & 4) ? b2_[0] : b2_[1]; c1 = mine + __shfl_xor(oth, 4); }
                    c1 += __shfl_xor(c1, 8); c1 += __shfl_xor(c1, 16); c1 += __shfl_xor(c1, 32);
#pragma unroll
                    for (int e = 0; e < NE; ++e) { const float x = __int_as_float(__builtin_amdgcn_readlane(__float_as_int(c1), e)); if (x > b1) { b2 = b1; i2 = i1; b1 = x; i1 = e; } else if (x > b2) { b2 = x; i2 = e; } }
                    if (lane == 0) { const float w1 = 1.0f / (1.0f + expf(b2 - b1)); p.TOPI[row * 2] = i1; p.TOPI[row * 2 + 1] = i2; p.TOPW[row * 2] = w1; p.TOPW[row * 2 + 1] = 1.0f - w1;
                        __hip_atomic_fetch_add(hist + i1, 1, __ATOMIC_RELAXED, __HIP_MEMORY_SCOPE_WORKGROUP); __hip_atomic_fetch_add(hist + 8 + i2, 1, __ATOMIC_RELAXED, __HIP_MEMORY_SCOPE_WORKGROUP); }
                }
            }
        }
    }
    if constexpr (ROUTER) { __syncthreads(); if (tid < 16) atomicAdd(p.ctl + tid, hist[tid]); __syncthreads(); }
}

__device__ __forceinline__ void prep_qk_phase(const Prm& p, int l, int G) {
    static_assert(NNA == 6 && NGA == 4 && PC_NAK == PC_NAQ + 384, "pass layout of the q/k preparation");
    int tid_ = my_tid(); asm volatile("" : "+v"(tid_));
    const int tid = tid_, wid = __builtin_amdgcn_readfirstlane(tid >> 6), lane = tid & 63, gw = blockIdx.x * 8 + wid, ngw = G * 8;
    const int a = lane & 15, dd = 4 * a;
    const f32x4 gnq = *(const f32x4*)(p.na_q_norm + l * 64 + dd), gnk = *(const f32x4*)(p.na_k_norm + l * 64 + dd), ggq = *(const f32x4*)(p.ga_q_norm + l * 64 + dd), ggk = *(const f32x4*)(p.ga_k_norm + l * 64 + dd);
    const bool x2side = (a >> 2) & 1; const int rhalf = a >> 3, fi = 4 * (a & 3);
    for (int row0 = 2 * gw; row0 < M; row0 += 2 * ngw) {
        u32x2 raw[2][5];
#pragma unroll
        for (int rr = 0; rr < 2; ++rr)
#pragma unroll
            for (int ps = 0; ps < 5; ++ps) raw[rr][ps] = *(const u32x2*)(p.P + (size_t)(row0 + rr) * NP + (ps < 3 ? PC_NAQ + 256 * ps : (ps == 3 ? PC_GAQ : PC_GAK)) + 4 * lane);
#pragma unroll
        for (int rr = 0; rr < 2; ++rr) { const int row = row0 + rr; bf16* pr = p.P + (size_t)row * NP;
#pragma unroll
        for (int ps = 0; ps < 5; ++ps) {
            const int col = (ps < 3 ? PC_NAQ + 256 * ps : (ps == 3 ? PC_GAQ : PC_GAK)) + 4 * lane;
            const int hidx = ps * 4 + (lane >> 4);
            const bool isq = ps < 3 ? hidx < NNA : ps == 3;
            const f32x4 g = ps < 3 ? (hidx < NNA ? gnq : gnk) : (ps == 3 ? ggq : ggk);
            f32x4 x = (f32x4){lo16(raw[rr][ps].x), hi16(raw[rr][ps].x), lo16(raw[rr][ps].y), hi16(raw[rr][ps].y)};
            float ss = (x.x * x.x + x.y * x.y) + (x.z * x.z + x.w * x.w);
            ss += __shfl_xor(ss, 1); ss += __shfl_xor(ss, 2); ss += __shfl_xor(ss, 4); ss += __shfl_xor(ss, 8);
            const float rstd = 1.0f / sqrtf(ss * (1.0f / 64.0f) + EPS);
            x = x * rstd * g;
            if (ps >= 3 && row < MX) {
                const int t = row % S, pos = rhalf == 0 ? t / GW : t % GW;
                const f32x4 cs0 = *(const f32x4*)(p.ROPE + (size_t)(pos * 16 + fi) * 2), cs1 = *(const f32x4*)(p.ROPE + (size_t)(pos * 16 + fi) * 2 + 4);
                f32x4 o; o.x = __shfl_xor(x.x, 4); o.y = __shfl_xor(x.y, 4); o.z = __shfl_xor(x.z, 4); o.w = __shfl_xor(x.w, 4);
                const f32x4 cs = (f32x4){cs0.x, cs0.z, cs1.x, cs1.z}, sn = (f32x4){cs0.y, cs0.w, cs1.y, cs1.w};
                x = x2side ? (o * sn + x * cs) : (x * cs - o * sn);
            }
            if (isq) x = x * QSCALE;
            *(u32x2*)(pr + col) = (u32x2){pk2(x.x, x.y), pk2(x.z, x.w)};
        } }
    }
}

__device__ __forceinline__ void sconv2(const bf16* Prow, const float* w, const float* cb, int col, bool hasp, bool hasn, float& y0, float& y1) {
    const unsigned c = *(const unsigned*)(Prow + col);
    y0 = cb[col] + w[3 * DHY + col] * lo16(c); y1 = cb[col + 1] + w[3 * DHY + col + 1] * hi16(c);
    if (hasp) { const unsigned a = *(const unsigned*)(Prow - NP + col); y0 += w[col] * lo16(a); y1 += w[col + 1] * hi16(a); }
    if (hasn) { const unsigned b = *(const unsigned*)(Prow + NP + col); y0 += w[2 * 3 * DHY + col] * lo16(b); y1 += w[2 * 3 * DHY + col + 1] * hi16(b); }
}
__device__ __forceinline__ void tile_geom(int tile, int& row0, int& b, int& t0, int& Len) {
    row0 = tile * 64; if (row0 < MX) { b = row0 / S; t0 = row0 % S; Len = S; } else { const int rr = row0 - MX; b = rr / LC; t0 = rr % LC; Len = LC; }
}
template <int S0, int NS> __device__ __forceinline__ void ld_row(const bf16* Pl, bool ok, unsigned (&raw)[NS][DHY / 128]) {
    static_assert(DHY / 128 == 3, "a lane owns 6 consecutive channels = one 12-byte load per set");
#pragma unroll
    for (int s_ = 0; s_ < NS; ++s_) { u32x3a t = (u32x3a){0u, 0u, 0u}; if (ok) t = __builtin_nontemporal_load((const u32x3a*)(Pl + (S0 + s_) * DHY)); raw[s_][0] = t.x; raw[s_][1] = t.y; raw[s_][2] = t.z; }
}
template <int S0, int NS> struct ConvK {
    float wp[NS][DHY / 128][2], wc[NS][DHY / 128][2], wn[NS][DHY / 128][2], cb[NS][DHY / 128][2];
    __device__ __forceinline__ void load(const float* w, const float* b, int lane) {
#pragma unroll
        for (int s_ = 0; s_ < NS; ++s_)
#pragma unroll
            for (int j = 0; j < DHY / 128; ++j)
#pragma unroll
                for (int e = 0; e < 2; ++e) { const int col = (S0 + s_) * DHY + 6 * lane + 2 * j + e; wp[s_][j][e] = w[col]; wc[s_][j][e] = w[3 * DHY + col]; wn[s_][j][e] = w[2 * 3 * DHY + col]; cb[s_][j][e] = b[col]; }
    }
    __device__ __forceinline__ float ev(int s_, int j, int e, unsigned a, unsigned c, unsigned n) const {
        return e == 0 ? cb[s_][j][0] + wp[s_][j][0] * lo16(a) + wc[s_][j][0] * lo16(c) + wn[s_][j][0] * lo16(n) : cb[s_][j][1] + wp[s_][j][1] * hi16(a) + wc[s_][j][1] * hi16(c) + wn[s_][j][1] * hi16(n);
    }
};
__device__ __forceinline__ void prep_hy_phase(const Prm& p, int l, LAS unsigned char* lds, int G) {
    int tid_ = my_tid(); asm volatile("" : "+v"(tid_));
    const int tid = tid_, wid = __builtin_amdgcn_readfirstlane(tid >> 6), lane = tid & 63;
    constexpr int PITCH = 144, NJ = DHY / 128;
    ConvK<1, 2> K; K.load(p.hy_conv_w + (size_t)l * 3 * 3 * DHY, p.hy_conv_b + (size_t)l * 3 * DHY, lane);
    for (int tile = blockIdx.x; tile < M / 64; tile += G) {
        int row0, b, t0, Len; tile_geom(tile, row0, b, t0, Len);
        const int tt0 = 8 * wid; const bf16* Pl = p.P + (size_t)(row0 + tt0) * NP + 6 * lane;
        unsigned ra[2][NJ], rb[2][NJ], rc[2][NJ];
        ld_row<1, 2>(Pl - NP, t0 + tt0 - 1 >= 0, ra); ld_row<1, 2>(Pl, true, rb);
#pragma unroll
        for (int i = 0; i < 8; ++i) {
            ld_row<1, 2>(Pl + (size_t)(i + 1) * NP, t0 + tt0 + i + 1 < Len, rc);
#pragma unroll
            for (int j = 0; j < NJ; ++j) { const int c = 6 * lane + 2 * j;
                const float v0 = K.ev(1, j, 0, ra[1][j], rb[1][j], rc[1][j]) * K.ev(0, j, 0, ra[0][j], rb[0][j], rc[0][j]), v1 = K.ev(1, j, 1, ra[1][j], rb[1][j], rc[1][j]) * K.ev(0, j, 1, ra[0][j], rb[0][j], rc[0][j]);
                *(LAS bf16*)(lds + c * PITCH + 2 * (tt0 + i)) = f2bf(v0); *(LAS bf16*)(lds + (c + 1) * PITCH + 2 * (tt0 + i)) = f2bf(v1); }
#pragma unroll
            for (int s_ = 0; s_ < 2; ++s_)
#pragma unroll
                for (int j = 0; j < NJ; ++j) { ra[s_][j] = rb[s_][j]; rb[s_][j] = rc[s_][j]; }
        }
        __syncthreads();
        bf16* dst = row0 < MX ? p.VT : p.VTC;
        for (int idx = tid; idx < DHY * 8; idx += 512) { const int c = idx >> 3, part = idx & 7;
            *(u32x4*)(dst + ((size_t)c * NB + b) * Len + t0 + 8 * part) = *(const LAS u32x4*)(lds + c * PITCH + 16 * part); }
        __syncthreads();
    }
}
__device__ __forceinline__ void final_phase(const Prm& p, int l, int nrows, LAS unsigned char* lds, int G) {
    int tid_ = my_tid(); asm volatile("" : "+v"(tid_));
    const int tid = tid_, wid = __builtin_amdgcn_readfirstlane(tid >> 6), lane = tid & 63;
    constexpr int PITCH = 65, NJ = DHY / 128;
    LAS float* T = (LAS float*)lds;
    ConvK<0, 3> K; K.load(p.hy_conv_w + (size_t)l * 3 * 3 * DHY, p.hy_conv_b + (size_t)l * 3 * DHY, lane);
    float sk[NJ][2], gh[NJ][2], gn[DNA / 128][2], gg[DGA / 128][2];
#pragma unroll
    for (int j = 0; j < NJ; ++j)
#pragma unroll
        for (int e = 0; e < 2; ++e) { sk[j][e] = p.hy_skip[l * DHY + 6 * lane + 2 * j + e]; gh[j][e] = p.out_norm_hy[l * DHY + 6 * lane + 2 * j + e]; }
#pragma unroll
    for (int j = 0; j < DNA / 128; ++j) { gn[j][0] = p.out_norm_na[l * DNA + 6 * lane + 2 * j]; gn[j][1] = p.out_norm_na[l * DNA + 6 * lane + 2 * j + 1]; }
#pragma unroll
    for (int j = 0; j < DGA / 128; ++j) { gg[j][0] = p.out_norm_ga[l * DGA + 4 * lane + 2 * j]; gg[j][1] = p.out_norm_ga[l * DGA + 4 * lane + 2 * j + 1]; }
    for (int tile = blockIdx.x; tile < nrows / 64; tile += G) {
        int row0, b, t0, Len; tile_geom(tile, row0, b, t0, Len);
        const float* ysrc = row0 < MX ? p.YC : p.YCC;
        for (int idx = tid; idx < DHY * 16; idx += 512) { const int c = idx >> 4, part = idx & 15; const f32x4 v = __builtin_nontemporal_load((const f32x4*)(ysrc + ((size_t)c * NB + b) * Len + t0 + 4 * part));
            LAS float* d = T + c * PITCH + 4 * part; d[0] = v.x; d[1] = v.y; d[2] = v.z; d[3] = v.w; }
        __syncthreads();
        const int tt0 = 8 * wid; const bf16* Pl = p.P + (size_t)(row0 + tt0) * NP + 6 * lane;
        unsigned ra[3][NJ], rb[3][NJ], rc[3][NJ];
        ld_row<0, 3>(Pl - NP, t0 + tt0 - 1 >= 0, ra); ld_row<0, 3>(Pl, true, rb);
#pragma unroll 2
        for (int i = 0; i < 8; ++i) { const int tt = tt0 + i, row = row0 + tt; const bf16* Prow = p.P + (size_t)row * NP; bf16* yrow = p.HX + (size_t)row * D;
            ld_row<0, 3>(Pl + (size_t)(i + 1) * NP, t0 + tt + 1 < Len, rc);
            unsigned on[DNA / 128], og[DGA / 128];
            static_assert(DNA / 128 == 3 && DGA / 128 == 2, "12- and 8-byte pieces per lane");
            { const u32x3a t = __builtin_nontemporal_load((const u32x3a*)(Prow + PC_NAQ + 6 * lane)); on[0] = t.x; on[1] = t.y; on[2] = t.z; }
            { const u32x2 t = __builtin_nontemporal_load((const u32x2*)(Prow + PC_GAQ + 4 * lane)); og[0] = t.x; og[1] = t.y; }
            float y[NJ][2]; float ss = 0.f, s2 = 0.f, s3 = 0.f;
#pragma unroll
            for (int j = 0; j < NJ; ++j)
#pragma unroll
                for (int e = 0; e < 2; ++e) { const int c = 6 * lane + 2 * j + e;
                    const float x0 = K.ev(0, j, e, ra[0][j], rb[0][j], rc[0][j]), vp = K.ev(2, j, e, ra[2][j], rb[2][j], rc[2][j]) * K.ev(1, j, e, ra[1][j], rb[1][j], rc[1][j]);
                    y[j][e] = (T[c * PITCH + tt] + sk[j][e] * vp) * x0; ss += y[j][e] * y[j][e]; }
#pragma unroll
            for (int j = 0; j < DNA / 128; ++j) s2 += lo16(on[j]) * lo16(on[j]) + hi16(on[j]) * hi16(on[j]);
#pragma unroll
            for (int j = 0; j < DGA / 128; ++j) s3 += lo16(og[j]) * lo16(og[j]) + hi16(og[j]) * hi16(og[j]);
            const float r1 = 1.0f / sqrtf(wave_sum(ss) * (1.0f / DHY) + EPS), r2 = 1.0f / sqrtf(wave_sum(s2) * (1.0f / DNA) + EPS), r3 = 1.0f / sqrtf(wave_sum(s3) * (1.0f / DGA) + EPS);
            *(u32x3a*)(yrow + 6 * lane) = (u32x3a){pk2(y[0][0] * r1 * gh[0][0], y[0][1] * r1 * gh[0][1]), pk2(y[1][0] * r1 * gh[1][0], y[1][1] * r1 * gh[1][1]), pk2(y[2][0] * r1 * gh[2][0], y[2][1] * r1 * gh[2][1])};
            *(u32x3a*)(yrow + DHY + 6 * lane) = (u32x3a){pk2(lo16(on[0]) * r2 * gn[0][0], hi16(on[0]) * r2 * gn[0][1]), pk2(lo16(on[1]) * r2 * gn[1][0], hi16(on[1]) * r2 * gn[1][1]), pk2(lo16(on[2]) * r2 * gn[2][0], hi16(on[2]) * r2 * gn[2][1])};
            *(u32x2*)(yrow + DHY + DNA + 4 * lane) = (u32x2){pk2(lo16(og[0]) * r3 * gg[0][0], hi16(og[0]) * r3 * gg[0][1]), pk2(lo16(og[1]) * r3 * gg[1][0], hi16(og[1]) * r3 * gg[1][1])};
#pragma unroll
            for (int s_ = 0; s_ < 3; ++s_)
#pragma unroll
                for (int j = 0; j < NJ; ++j) { ra[s_][j] = rb[s_][j]; rb[s_][j] = rc[s_][j]; }
        }
        __syncthreads();
    }
}
}
namespace thin {

__device__ __forceinline__ void mod_phase(const Prm& p, LAS unsigned char* lds, int G) {
    int tid_ = my_tid(); asm volatile("" : "+v"(tid_));
    const int tid = tid_, wid = __builtin_amdgcn_readfirstlane(tid >> 6), lane = tid & 63;
    LAS float* sc = (LAS float*)lds;
    LAS float* red = (LAS float*)(lds + 9 * D * 4);
    if ((int)blockIdx.x >= NL * (6 * D / 64)) return;
    for (int i = tid; i < 9 * D; i += 512) { const int r = i / D, k = i % D; sc[i] = silu_f(r < 8 ? p.c[(size_t)(r % NB) * D + k] : p.c_ctx[k]); }
    __syncthreads();
    for (int u = blockIdx.x; u < NL * (6 * D / 64); u += G) { const int l = u / (6 * D / 64), n0 = 64 * (u % (6 * D / 64));
        const float* w = p.w_mod + (size_t)l * D * 6 * D + n0 + lane;
        float acc[9];
#pragma unroll
        for (int r = 0; r < 9; ++r) acc[r] = 0.f;
#pragma unroll 4
        for (int k = wid * (D / 8); k < (wid + 1) * (D / 8); ++k) { const float wv = __builtin_nontemporal_load(w + (size_t)k * 6 * D);
#pragma unroll
            for (int r = 0; r < 9; ++r) acc[r] += sc[r * D + k] * wv; }
#pragma unroll
        for (int r = 0; r < 9; ++r) red[(wid * 9 + r) * 64 + lane] = acc[r];
        __syncthreads();
        for (int i = tid; i < 9 * 64; i += 512) { const int r = i >> 6, j = i & 63; float t = p.b_mod[(size_t)l * 6 * D + n0 + j];
#pragma unroll
            for (int ww = 0; ww < 8; ++ww) t += red[(ww * 9 + r) * 64 + j];
            p.MOD[((size_t)l * 9 + r) * 6 * D + n0 + j] = t; }
        __syncthreads();
    }
}
__device__ __forceinline__ float rdl(float v, int i) { return __int_as_float(__builtin_amdgcn_readlane(__float_as_int(v), i)); }
__device__ __forceinline__ void filter_position(const Prm& p, int l, int half, int t, int Len, bf16* ftab, int pitch, LAS const float* W1, LAS const float* W2, LAS const float* W3, int lane_) {
    int lane = lane_; asm volatile("" : "+v"(lane));
    const float tn = (float)t / (float)(Len - 1), ang = 6.283185307179586f * (float)t / (float)Len;
    float z = 0.f;
    if (lane == 0) z = tn; else if (lane < 17) z = cosf((1e-4f + (float)(lane - 1) * ((15.0f - 1e-4f) / 15.0f)) * ang); else if (lane < 33) z = -sinf((1e-4f + (float)(lane - 17) * ((15.0f - 1e-4f) / 15.0f)) * ang);
    const float fq = p.hy_freq[l * 64 + lane];
    float pre = p.hy_b1[l * 64 + lane];
#pragma unroll 11
    for (int j = 0; j < 33; ++j) pre += rdl(z, j) * W1[j * 64 + lane];
    float h = sinf(fq * pre);
#pragma unroll 1
    for (int inner = 0; inner < 2; ++inner) { float q = p.hy_b2[(l * 2 + inner) * 64 + lane];
#pragma unroll 4
        for (int i4 = 0; i4 < 16; ++i4) { const f32x4 w = *(const LAS f32x4*)(W2 + ((inner * 16 + i4) * 64 + lane) * 4);
            q += rdl(h, 4 * i4) * w.x; q += rdl(h, 4 * i4 + 1) * w.y; q += rdl(h, 4 * i4 + 2) * w.z; q += rdl(h, 4 * i4 + 3) * w.w; }
        h = sinf(fq * q); }
    float o[DHY / 64];
#pragma unroll
    for (int m = 0; m < DHY / 64; ++m) o[m] = 0.f;
#pragma unroll 4
    for (int i = 0; i < 64; ++i) { const float hi_ = rdl(h, i); typedef float f32x2_ __attribute__((ext_vector_type(2)));
        const LAS f32x2_* w3p = (const LAS f32x2_*)(W3 + (i * 64 + lane) * (DHY / 64));
#pragma unroll
        for (int m2 = 0; m2 < DHY / 128; ++m2) { const f32x2_ w = w3p[m2]; o[2 * m2] += hi_ * w.x; o[2 * m2 + 1] += hi_ * w.y; } }
    const float d0 = logf(1e-2f) / 1.5f, d1 = logf(1e-2f) / 0.3f;
#pragma unroll
    for (int m = 0; m < DHY / 64; ++m) { const int c = lane + 64 * m; const float delta = fabsf(d0 + (float)c * ((d1 - d0) / (float)(DHY - 1)));
        const bf16 v = f2bf(o[m] * expf(-tn * delta)); bf16* ft = ftab + (size_t)c * pitch;
        if (half == 0) ft[Len - t] = v;
        else if (t > 0) ft[Len + t] = v;
        else { ft[0] = 0; for (int k = 0; k < 8; ++k) ft[2 * Len + k] = 0; } }
}
__device__ __forceinline__ void filter_phase(const Prm& p, LAS unsigned char* lds, int G) {
    int tid_ = my_tid(); asm volatile("" : "+v"(tid_));
    const int tid = tid_, wid = __builtin_amdgcn_readfirstlane(tid >> 6), lane = tid & 63;
    const int combo = blockIdx.x & 3, l = combo >> 1, half = combo & 1, chunk = blockIdx.x >> 2, nchunk = G >> 2;
    LAS float* W1 = (LAS float*)lds; LAS float* W2 = W1 + 33 * 64; LAS float* W3 = W2 + 2 * 64 * 64;
    for (int i = tid; i < 33 * 64; i += 512) W1[i] = p.hy_w1[(size_t)l * 33 * 64 + i];
    for (int i = tid; i < 2 * 64 * 64; i += 512) { const int ln = i & 63, k = (i >> 6) & 63, inner = i >> 12; W2[((inner * 16 + (k >> 2)) * 64 + ln) * 4 + (k & 3)] = p.hy_w2[(size_t)l * 2 * 64 * 64 + i]; }
    for (int i = tid; i < 64 * DHY; i += 512) { const int k = i / DHY, c = i % DHY; W3[(k * 64 + (c & 63)) * (DHY / 64) + (c >> 6)] = p.hy_w3[((size_t)l * 64 + k) * 2 * DHY + half * DHY + c]; }
    __syncthreads();
    for (int t = chunk * 8 + wid; t < S; t += nchunk * 8) filter_position(p, l, half, t, S, p.FT + (size_t)l * DHY * (2 * S + 8), 2 * S + 8, W1, W2, W3, lane);
    if (l == 0) for (int t = chunk * 8 + wid; t < LC; t += nchunk * 8) filter_position(p, 0, half, t, LC, p.FTC, 2 * LC + 8, W1, W2, W3, lane);
}
__device__ __forceinline__ void moe_assign_phase(const Prm& p, LAS unsigned char* lds, int G) {
    int tid_ = my_tid(); asm volatile("" : "+v"(tid_));
    const int tid = tid_;
    LAS int* cnt = (LAS int*)lds; LAS int* base = cnt + 16;
    for (int blk = blockIdx.x; blk < MX / 128; blk += G) {
        if (tid < 16) cnt[tid] = 0;
        __syncthreads();
        const int m = blk * 128 + (tid & 127), c = (tid >> 7) & 1; int g = 0, rank = 0;
        if (tid < 256) { g = c * 8 + p.TOPI[m * 2 + c]; rank = __hip_atomic_fetch_add(cnt + g, 1, __ATOMIC_RELAXED, __HIP_MEMORY_SCOPE_WORKGROUP); }
        __syncthreads();
        if (tid < 16) base[tid] = moe_off(p, tid >> 3, tid & 7) + atomicAdd(p.ctl + 16 + tid, cnt[tid]);
        __syncthreads();
        LAS int* slots = base + 16;
        if (tid < 256) { const int sl = base[g] + rank; p.LIST[(size_t)c * MPAD + sl] = m; slots[tid] = c * MPAD + sl; }
        __syncthreads();
        {
            const int w = tid >> 6, lane = tid & 63; const unsigned char* src = (const unsigned char*)p.HX; unsigned char* dst = (unsigned char*)p.XG;
#pragma unroll
            for (int q = 0; q < 4; ++q) { pg8::u32x4 v[8];
#pragma unroll
                for (int i = 0; i < 8; ++i) { const int r = 32 * w + 8 * q + i; v[i] = __builtin_nontemporal_load((const pg8::u32x4*)(src + (size_t)(blk * 128 + (r & 127)) * D + 16 * lane)); }
#pragma unroll
                for (int i = 0; i < 8; ++i) { const int r = 32 * w + 8 * q + i; *(pg8::u32x4*)(dst + (size_t)slots[r] * D + 16 * lane) = v[i]; } } }
        __syncthreads();
    }
}
__device__ __forceinline__ void hyena_ctx_phase(const Prm& p, LAS unsigned char* lds, int G) {
    int tid_ = my_tid(); asm volatile("" : "+v"(tid_));
    const int tid = tid_, wid = __builtin_amdgcn_readfirstlane(tid >> 6), lane = tid & 63;
    static_assert(LC == 256, "context Hyena geometry");
    LAS float* R = (LAS float*)(lds + wid * 4096);
    for (int u = blockIdx.x * 8 + wid; u < DHY * NB; u += G * 8) { const int c = u / NB;
        const bf16* ft = p.FTC + (size_t)c * (2 * LC + 8); const bf16* v = p.VTC + (size_t)u * LC;
#pragma unroll
        for (int i = 0; i < 8; ++i) R[lane + 64 * i] = bf2f(ft[lane + 64 * i]);
        float vv[4];
#pragma unroll
        for (int i = 0; i < 4; ++i) vv[i] = bf2f(v[4 * lane + i]);
        asm volatile("s_waitcnt lgkmcnt(0)" ::: "memory");
        float acc[4] = {0.f, 0.f, 0.f, 0.f};
#pragma unroll 8
        for (int s4 = 0; s4 < 64; ++s4) {
#pragma unroll
            for (int e = 0; e < 4; ++e) { const float vs = __int_as_float(__builtin_amdgcn_readlane(__float_as_int(vv[e]), s4)); const int s = 4 * s4 + e;
#pragma unroll
                for (int k = 0; k < 4; ++k) acc[k] += R[LC - (lane + 64 * k) + s] * vs; } }
#pragma unroll
        for (int k = 0; k < 4; ++k) p.YCC[(size_t)u * LC + lane + 64 * k] = acc[k];
    }
}
}

#define XB_TMO      128
#define XB_XCNT(j)  (256  + 64 * (j))
#define XB_XSUB(j)  (1280 + 64 * (j))
#define XB_XGEN(j)  (2304 + 64 * (j))
#define XB_TOP      3328
#define XB_TOPGEN   3392
#define XCD_BAR_WORDS 3456
#define XB_SPIN_CAP (1u << 23)

__device__ __forceinline__ unsigned xb_ld(unsigned* p)              { return __hip_atomic_load(p, __ATOMIC_RELAXED, __HIP_MEMORY_SCOPE_AGENT); }
__device__ __forceinline__ unsigned xb_add(unsigned* p, unsigned v) { return __hip_atomic_fetch_add(p, v, __ATOMIC_RELAXED, __HIP_MEMORY_SCOPE_AGENT); }
__device__ __forceinline__ unsigned xb_xcc_id() { return (unsigned)__builtin_amdgcn_s_getreg((3 << 11) | 20) & 0xFu; }
#define XB_SPIN(cond, bar) do { unsigned _sp = 0; while (cond) { __builtin_amdgcn_s_sleep(1); \
    if ((++_sp & 255u) == 0u) { if (xb_ld(&(bar)[XB_TMO])) break; if (_sp > XB_SPIN_CAP) { atomicAdd(&(bar)[XB_TMO], 1u); break; } } } } while (0)

struct XcdBarrier {
    unsigned* bar; unsigned x;
    volatile LAS unsigned* st;
};

__device__ __forceinline__ XcdBarrier xcd_barrier_post(unsigned* bar, volatile LAS unsigned* st) {
    XcdBarrier b; b.bar = bar; b.x = xb_xcc_id(); b.st = st;
    if (my_tid() == 0) (void)xb_add(&bar[XB_XCNT(b.x)], 1u);
    return b;
}
__device__ __forceinline__ void xcd_barrier_complete(unsigned* bar, unsigned x, unsigned& nloc, unsigned& nx) {
    const unsigned G = gridDim.x * gridDim.y * gridDim.z;
    unsigned sum, cnt, mine, sp = 0u;
    for (;;) {
        sum = 0u; cnt = 0u; mine = 0u;
#pragma unroll
        for (unsigned j = 0; j < 16; ++j) { const unsigned c = xb_ld(&bar[XB_XCNT(j)]); sum += c; cnt += (c > 0u) ? 1u : 0u; mine = (j == x) ? c : mine; }
        if (sum == G) break;
        __builtin_amdgcn_s_sleep(1);
        if ((++sp & 255u) == 0u) { if (xb_ld(&bar[XB_TMO])) break; if (sp > XB_SPIN_CAP) { atomicAdd(&bar[XB_TMO], 1u); break; } }
    }
    nloc = mine > 0u ? mine : 1u; nx = cnt > 0u ? cnt : 1u;
}

__device__ __forceinline__ void xcd_barrier(const XcdBarrier& b) {
    asm volatile("s_waitcnt vmcnt(0)" ::: "memory");
    __syncthreads();
    if (my_tid() == 0) {
        unsigned* bar = b.bar;
        __builtin_amdgcn_s_waitcnt(0);
        unsigned nloc = b.st[0], nx = b.st[1];
        if (nloc == 0u) { xcd_barrier_complete(bar, b.x, nloc, nx); b.st[0] = nloc; b.st[1] = nx; }
        const unsigned old = xb_add(&bar[XB_XSUB(b.x)], 1u);
        const unsigned gen = old / nloc;
        if (old + 1u == (gen + 1u) * nloc) {
            __builtin_amdgcn_fence(__ATOMIC_RELEASE, "agent");
            asm volatile("s_waitcnt vmcnt(0)" ::: "memory");
            const unsigned og = xb_add(&bar[XB_TOP], 1u);
            const unsigned tg = og / nx;
            if (og + 1u == (tg + 1u) * nx) xb_add(&bar[XB_TOPGEN], 1u);
            else XB_SPIN(xb_ld(&bar[XB_TOPGEN]) == tg, bar);
            __builtin_amdgcn_fence(__ATOMIC_ACQUIRE, "agent");
            xb_add(&bar[XB_XGEN(b.x)], 1u);
            asm volatile("s_waitcnt vmcnt(0)" ::: "memory");
        } else {
            XB_SPIN(xb_ld(&bar[XB_XGEN(b.x)]) == gen, bar);
            __builtin_amdgcn_fence(__ATOMIC_ACQUIRE, "agent");
            asm volatile("s_waitcnt vmcnt(0)" ::: "memory");
        }
    }
    __syncthreads();
}

constexpr int NWAVES = 8, NTHR = NWAVES * 64;
constexpr int LDS_BYTES = 147456, LDSCTL_OFF = LDS_BYTES - 512, MISC_OFF = LDSCTL_OFF, RING_BYTES = LDSCTL_OFF;
static_assert(hy::L_END <= RING_BYTES && attn_body::ATTN_LDS_BYTES <= RING_BYTES && MISC_OFF + 128 <= LDS_BYTES && (33 * 64 + 2 * 64 * 64 + 64 * DHY) * 4 <= RING_BYTES && 8 * 64 * 65 * 4 <= RING_BYTES && DHY * 65 * 4 <= RING_BYTES && pg8::STAGE_BYTES <= RING_BYTES, "LDS map");
constexpr int EPI_TAB_OFF = pg8::STAGE_BYTES;
static_assert(EPI_TAB_OFF + (256 + 2048) * 4 <= LDSCTL_OFF, "epilogue tables");
constexpr int CW_BAR = 4096;

__device__ __forceinline__ long opaque_gtid() { int t = my_tid(); asm volatile("" : "+v"(t)); return (long)blockIdx.x * 512 + t; }
typedef const __attribute__((address_space(4))) Prm* KPrm;
__device__ __forceinline__ KPrm opaque_kp() { KPrm q = (KPrm)__builtin_amdgcn_kernarg_segment_ptr(); asm volatile("" : "+s"(q)); return q; }
typedef __attribute__((address_space(1))) void* GPtr;
typedef const __attribute__((address_space(4))) GPtr* KWords;
__device__ __forceinline__ void load_prm(Prm& p) {
    static_assert(sizeof(Prm) % 8 == 0, "Prm is a pack of pointers");
    KWords src = (KWords)opaque_kp(); void** dst = (void**)&p;
#pragma unroll
    for (int i = 0; i < (int)(sizeof(Prm) / 8); ++i) dst[i] = (void*)src[i];
}
#define LP() Prm p; load_prm(p)
#define GT opaque_gtid()
#define GRID_BAR() do { XcdBarrier b_; b_.bar = (unsigned*)opaque_kp()->ctl + CW_BAR; b_.x = xb_xcc_id(); b_.st = (volatile LAS unsigned*)(lds + MISC_OFF) + 8; xcd_barrier(b_); } while (0)

__device__ __forceinline__ void reduce_resgate(const Prm& p, const float* slab, int npanels, int ks, const float* src, float* dst, const float* gate, long gtid, long gsz) {
    typedef float f32x4 __attribute__((ext_vector_type(4)));
    for (long it = gtid; it < (long)npanels * (D / 256) * 16384; it += gsz) { const int tile = (int)(it >> 14), e = (int)(it & 16383), r = e >> 6, c4 = (e & 63) * 4, pm = tile / (D / 256), pn = tile % (D / 256);
        f32x4 a = (f32x4){0.f, 0.f, 0.f, 0.f};
        for (int k = 0; k < ks; ++k) a += *(const f32x4*)(slab + ((size_t)tile * ks + k) * 65536 + r * 256 + c4);
        const size_t off = (size_t)(pm * 256 + r) * D + pn * 256 + c4; const f32x4 g = *(const f32x4*)(gate + pn * 256 + c4);
        *(f32x4*)(dst + off) = *(const f32x4*)(src + off) + g * a; }
}
__device__ __forceinline__ void reduce_moedown(const Prm& p, const float* slab, int pm0, int npanels, int ks, int l, int pass, long gtid, long gsz) {
    typedef float f32x4 __attribute__((ext_vector_type(4)));
    for (long it = gtid; it < (long)npanels * (D / 256) * 16384; it += gsz) { const int tile = (int)(it >> 14), e = (int)(it & 16383), r = e >> 6, c4 = (e & 63) * 4, pm = pm0 + tile / (D / 256), pn = tile % (D / 256);
        const int tok = p.LIST[(size_t)pass * MPAD + pm * 256 + r]; if (tok < 0) continue;
        f32x4 a = (f32x4){0.f, 0.f, 0.f, 0.f};
        for (int k = 0; k < ks; ++k) a += *(const f32x4*)(slab + ((size_t)tile * ks + k) * 65536 + r * 256 + c4);
        const int col = pn * 256 + c4; const f32x4 g = *(const f32x4*)(p.MOD + ((size_t)l * 9 + tok / S) * 6 * D + 5 * D + col); const float w = p.TOPW[tok * 2 + pass] * (1.0f / (F8_SH * F8_SWD));
        typedef unsigned u32x2_ __attribute__((ext_vector_type(2)));
        u32x2_* xp = (u32x2_*)(p.XB + (size_t)tok * D + col); const u32x2_ h = *xp;
        const f32x4 v = pg8::bflo4(h.x, h.y) + g * w * a;
        if (pass == 0) *xp = (u32x2_){pg8::pkh(v.x, v.y), pg8::pkh(v.z, v.w)}; else *(f32x4*)(p.out + (size_t)tok * D + col) = v; }
}
#ifndef SPLIT_OUTPROJ
#define SPLIT_OUTPROJ 1
#endif
#ifndef SPLIT_FFN
#define SPLIT_FFN 1
#endif
#ifndef SPLIT_MOE
#define SPLIT_MOE 1
#endif
template <int L> __device__ __forceinline__ void layer_fwd(LAS unsigned char* lds, const long gsz, const int G) {
    constexpr bool first = L == 0, last = L == NL - 1; constexpr int l = L;
    constexpr int nact = last ? MX : M;
    { LP(); thin::modnorm_phase<false, false, !first>(p, l, p.x, first ? p.ctx : p.CX, p.norm_mix + l * D, 0, D, M, lds, G); }
    GRID_BAR(); SEG(1 + 12 * L + 0);
    {
        LP(); pg8::Order O; O.init(M / 256, NP / 256, G, (int)blockIdx.x, p.WinT + (size_t)l * NP * D);
        {   LAS float* T = (LAS float*)(lds + EPI_TAB_OFF);
            for (int i = my_tid(); i < 4 * 64; i += NTHR) T[i] = p.QKG[l * 4 * 64 + i];
            for (int i = my_tid(); i < 64 * 16 * 2; i += NTHR) T[256 + i] = p.ROPE[i];
            __syncthreads(); }
        pg8::EpiInProj E{p.P, (const LAS float*)(lds + EPI_TAB_OFF), (const LAS float*)(lds + EPI_TAB_OFF) + 256};
        pg8::gemm_phase<pg8::EpiInProj, true, false>(lds, p.HX, D, D, O, E);
    }
    GRID_BAR(); SEG(1 + 12 * L + 1);
    { LP(); thin::prep_hy_phase(p, l, lds, G); }
    GRID_BAR(); SEG(1 + 12 * L + 2);
    { LP(); attn_phase<0>(p, l, (char*)lds, G); }
    SEG(53);
    { LP(); hyena_phase(p, l, lds, G); }
    SEG(62);
    { LP(); attn_phase<1>(p, l, (char*)lds, G); }
    SEG(54);
    if (!last) { { LP(); attn_phase<2>(p, l, (char*)lds, G); }
        __syncthreads();
        { LP(); thin::hyena_ctx_phase(p, lds, G); } }
    SEG(63);
    GRID_BAR(); SEG(1 + 12 * L + 3);
    { LP(); thin::final_phase(p, l, nact, lds, G); }
    GRID_BAR(); SEG(1 + 12 * L + 4);
    {
        LP(); pg8::Order O; O.init((SPLIT_OUTPROJ ? MX : nact) / 256, D / 256, G, (int)blockIdx.x, p.WoutT + (size_t)l * D * D);
        pg8::EpiResB<first> E{p.x, p.XB, p.MOD + (size_t)l * 9 * 6 * D + 2 * D, 1.0f};
        pg8::gemm_phase<pg8::EpiResB<first>, true, false>(lds, p.HX, D, D, O, E);
    }
    if constexpr (!last && SPLIT_OUTPROJ) {
        constexpr int KS = 4;
        {   LP(); pg8::Order O; O.init(MC / 256, D / 256, G, (int)blockIdx.x, p.WoutT + (size_t)l * D * D); O.pm0 = MX / 256; O.ksplit = KS; O.kplen = D / KS; O.nvirt = O.nwg * KS;
            pg8::EpiPartial E{p.YC, D / 256, MX / 256, KS};
            pg8::gemm_phase<pg8::EpiPartial, true, false>(lds, p.HX, D, D / KS, O, E); }
        GRID_BAR();
        { LP(); reduce_resgate(p, p.YC, MC / 256, KS, first ? p.ctx : p.CX, p.CX, p.MOD + ((size_t)l * 9 + 8) * 6 * D + 2 * D, GT, gsz); }
    }
    GRID_BAR(); SEG(1 + 12 * L + 5);
    { LP(); thin::modnorm_phase<(L & 1) != 0, true, true>(p, l, nullptr, p.CX, p.norm_ffn + l * D, 3 * D, 4 * D, nact, lds, G); }
    GRID_BAR(); SEG(1 + 12 * L + 6);
    if constexpr ((L & 1) == 0) {
        {   LP(); pg8::Order O; O.init(nact / 256, 2 * DFF / 256, G, (int)blockIdx.x, p.WguT);
            pg8::EpiSwiGLU8 E{(unsigned char*)p.HID, DFF};
            pg8::gemm_phase<pg8::EpiSwiGLU8, true, false, true>(lds, p.HX, D / 2, D / 2, O, E); }
        GRID_BAR(); SEG(1 + 12 * L + 7);
        {   LP(); pg8::Order O; O.init(MX / 256, D / 256, G, (int)blockIdx.x, p.WdT);
            pg8::EpiResB<false> E{nullptr, p.XB, p.MOD + (size_t)l * 9 * 6 * D + 5 * D, 1.0f / (F8_SH * F8_SWD)};
            pg8::gemm_phase<pg8::EpiResB<false>, true, false, true>(lds, p.HID, DFF / 2, DFF / 2, O, E); }
        if constexpr (!last) {   LP(); pg8::Order O; O.init(MC / 256, D / 256, G, (int)blockIdx.x, p.WdT); O.pm0 = MX / 256;
            pg8::EpiResGate E{nullptr, p.CX, nullptr, p.CX, p.MOD + (size_t)l * 9 * 6 * D + 5 * D, 1.0f / (F8_SH * F8_SWD)};
            pg8::gemm_phase<pg8::EpiResGate, true, false, true>(lds, p.HID, DFF / 2, DFF / 2, O, E); }
        if constexpr (false) {
            constexpr int KS = 11; static_assert(DFF % (KS * 128) == 0 && (size_t)M * DFF * 2 + (size_t)(MC / 256) * (D / 256) * KS * 65536 * 4 <= (size_t)M * NP * 2 + (size_t)DHY * NB * S * 6, "slab space behind the dense hidden buffer");
            {   LP(); pg8::Order O; O.init(MC / 256, D / 256, G, (int)blockIdx.x, p.WdT); O.pm0 = MX / 256; O.ksplit = KS; O.kplen = DFF / KS; O.nvirt = O.nwg * KS;
                pg8::EpiPartial E{(float*)(p.HID + (size_t)M * DFF), D / 256, MX / 256, KS};
                pg8::gemm_phase<pg8::EpiPartial, true, false>(lds, p.HID, DFF, DFF / KS, O, E); }
            GRID_BAR();
            { LP(); reduce_resgate(p, (float*)(p.HID + (size_t)M * DFF), MC / 256, KS, p.CX, p.CX, p.MOD + ((size_t)l * 9 + 8) * 6 * D + 5 * D, GT, gsz); }
        }
        GRID_BAR(); SEG(1 + 12 * L + 8);
    } else {
        { LP(); thin::moe_assign_phase(p, lds, G); }
        GRID_BAR(); SEG(1 + 12 * L + 7);
#pragma unroll
        for (int pass = 0; pass < 2; ++pass) {
            {   LP(); pg8::Order O; int o = 0;
#pragma unroll
                for (int k = 0; k < 8; ++k) { o += (__builtin_amdgcn_readfirstlane(p.ctl[pass * 8 + k]) + 255) / 256; O.pend[k] = o; }
                const int npan = o; O.nM = npan; O.nN = 2 * DFE / 256; O.nwg = O.nM * O.nN; O.G = G; O.c = (int)blockIdx.x; O.Bt = p.WguTe; O.bt_group_stride = (size_t)2 * DFE * D / 2; O.rows = nullptr; O.pm0 = 0; O.ksplit = 1; O.kplen = 0; O.nvirt = O.nwg;
                pg8::EpiSwiGLU8 E{(unsigned char*)p.HID, DFE};
                pg8::gemm_phase<pg8::EpiSwiGLU8, true, false, true>(lds, p.XG + (size_t)pass * MPAD * D / 2, D / 2, D / 2, O, E); }
            GRID_BAR(); SEG(1 + 12 * L + 8 + 2 * pass);
            {   LP(); pg8::Order O; int o = 0;
#pragma unroll
                for (int k = 0; k < 8; ++k) { o += (__builtin_amdgcn_readfirstlane(p.ctl[pass * 8 + k]) + 255) / 256; O.pend[k] = o; }
                const int npan = o, nmain = (SPLIT_MOE && npan > MX / 256) ? MX / 256 : npan;
                O.nM = nmain; O.nN = D / 256; O.nwg = O.nM * O.nN; O.G = G; O.c = (int)blockIdx.x; O.Bt = p.WdTe; O.bt_group_stride = (size_t)D * DFE / 2; O.rows = nullptr; O.pm0 = 0; O.ksplit = 1; O.kplen = 0; O.nvirt = O.nwg;
                if (pass == 0) { pg8::EpiMoeDownB<false> E{p.LIST + (size_t)pass * MPAD, p.TOPW, pass, p.XB, p.out, p.MOD + (size_t)l * 9 * 6 * D + 5 * D, 1.0f / (F8_SH * F8_SWD)};
                    pg8::gemm_phase<pg8::EpiMoeDownB<false>, true, false, true>(lds, p.HID, DFE / 2, DFE / 2, O, E); }
                else { pg8::EpiMoeDownB<true> E{p.LIST + (size_t)pass * MPAD, p.TOPW, pass, p.XB, p.out, p.MOD + (size_t)l * 9 * 6 * D + 5 * D, 1.0f / (F8_SH * F8_SWD)};
                    pg8::gemm_phase<pg8::EpiMoeDownB<true>, true, false, true>(lds, p.HID, DFE / 2, DFE / 2, O, E); }
                constexpr int KS = 7; static_assert(DFE % (KS * 256) == 0 && (size_t)MPAD * DFE + (size_t)(MPAD / 256 - MX / 256) * (D / 256) * KS * 65536 * 4 <= (size_t)M * NP * 2 + (size_t)DHY * NB * S * 6, "slab space behind the (fp8) expert hidden buffer");
                if (npan > nmain) {
                    int ks = KS; asm volatile("" : "+s"(ks));
                    O.nM = npan - nmain; O.nwg = O.nM * O.nN; O.pm0 = nmain; O.ksplit = ks; O.kplen = DFE / 2 / ks; O.nvirt = O.nwg * ks;
                    pg8::EpiPartial E2{(float*)(p.HID + (size_t)MPAD * DFE / 2), D / 256, nmain, ks};
                    pg8::gemm_phase<pg8::EpiPartial, true, false, true>(lds, p.HID, DFE / 2, DFE / 2 / ks, O, E2); } }
            GRID_BAR();
            {   LP(); int o = 0;
#pragma unroll
                for (int k = 0; k < 8; ++k) o += (__builtin_amdgcn_readfirstlane(p.ctl[pass * 8 + k]) + 255) / 256;
                if (o > MX / 256) reduce_moedown(p, (float*)(p.HID + (size_t)MPAD * DFE / 2), MX / 256, o - MX / 256, 7, l, pass, GT, gsz); }
            GRID_BAR(); SEG(1 + 12 * L + 9 + 2 * pass);
        }
    }
}

__global__ void __launch_bounds__(NTHR, 2) mega_fwd(Prm p_in) {
    LAS unsigned char* lds = (LAS unsigned char*)lds_raw;
    volatile LAS unsigned* MISC = (volatile LAS unsigned*)(lds + MISC_OFF);
    const int tid = threadIdx.x;
    for (int u = tid; u < (LDS_BYTES - LDSCTL_OFF) / 4; u += NTHR) ((LAS unsigned*)(lds + LDSCTL_OFF))[u] = 0u;
    __syncthreads();
    if ((tid & 63) == 0) ((volatile LAS int*)(lds + WIDTAB_OFF))[hw_wave_slot()] = tid >> 6;
    (void)xcd_barrier_post((unsigned*)p_in.ctl + CW_BAR, MISC + 8);
#ifdef PROBE_MASK
    if (blockIdx.x == 0 && tid == 0) { volatile LAS unsigned long long* T_ = (volatile LAS unsigned long long*)(lds + MISC_OFF + 64); T_[0] = __builtin_amdgcn_s_memrealtime(); T_[1] = 0ull; }
#endif
    const int G = gridDim.x;
    const long gsz = (long)G * NTHR;
    { LP(); thin::wconv_phase(p, lds, G); }
    __syncthreads();
    SEG(60);
    { LP(); thin::rope_table(p, GT); }
    { LP(); thin::mod_phase(p, lds, G); }
    __syncthreads();
    SEG(61);
    { LP(); thin::filter_phase(p, lds, G); }
    GRID_BAR(); SEG(0);
    layer_fwd<0>(lds, gsz, G);
    layer_fwd<1>(lds, gsz, G);
#ifdef PROBE_MASK
    if (blockIdx.x == 0 && tid == 0) { volatile LAS unsigned long long* T_ = (volatile LAS unsigned long long*)(lds + MISC_OFF + 64); const unsigned long long t0_ = __builtin_amdgcn_s_memrealtime(), w_ = PROBE_MULT * T_[1];
        while (__builtin_amdgcn_s_memrealtime() - t0_ < w_) __builtin_amdgcn_s_sleep(8); }
#endif
}

extern "C" void kernel_launch(void* const* d_in, const int* in_sizes, int n_in, void* d_out, int out_size, void* d_ws, size_t ws_size, hipStream_t stream) {
    static int grid = 0;
    if (grid == 0) {
        if (n_in != 34 || out_size != MX * D || ws_size < ws_needed()) { fprintf(stderr, "kernel_launch: unexpected shapes (n_in %d out %d ws %zu need %zu)\n", n_in, out_size, ws_size, ws_needed()); grid = -1; return; }
        int dev = 0, cus = 0, per_cu = 0;
        if (hipGetDevice(&dev) != hipSuccess || hipDeviceGetAttribute(&cus, hipDeviceAttributeMultiprocessorCount, dev) != hipSuccess) { grid = -1; return; }
        if (hipFuncSetAttribute((const void*)mega_fwd, hipFuncAttributeMaxDynamicSharedMemorySize, LDS_BYTES) != hipSuccess) { fprintf(stderr, "kernel_launch: hipFuncSetAttribute failed\n"); grid = -1; return; }
        if (hipOccupancyMaxActiveBlocksPerMultiprocessor(&per_cu, (const void*)mega_fwd, NTHR, LDS_BYTES) != hipSuccess || per_cu < 1) { fprintf(stderr, "kernel_launch: occupancy query reports %d\n", per_cu); }
        (void)hipGetLastError();
        grid = cus;
    }
    if (grid < 0) return;
    (void)in_sizes;
    (void)hipMemsetAsync(d_ws, 0, CTL_BYTES, stream);
    Prm p; __builtin_memset((void*)&p, 0, sizeof(p)); build_prm(p, d_in, d_out, d_ws);
    hipLaunchKernelGGL(mega_fwd, dim3(grid), dim3(NTHR), LDS_BYTES, stream, p);
}
#else
static void forward_emu(void* const* d_in, void* d_out, void* d_ws) {
    memset(d_ws, 0, CTL_BYTES);
    Prm p; memset(&p, 0, sizeof(p)); build_prm(p, d_in, d_out, d_ws);
#define RUN(ph, l, arg) run_phase(p, (ph), (l), (arg), 0, 1)
    RUN(PH_WCONV, 0, 0); RUN(PH_MOD, 0, 0); RUN(PH_F1, 0, 0); RUN(PH_F2A, 0, 0); RUN(PH_F2B, 0, 0); RUN(PH_F3, 0, 0);
    for (int l = 0; l < NL; ++l) {
        const bool last = l == NL - 1;
        RUN(PH_MODNORM1, l, 0); RUN(PH_INPROJ, l, 0); RUN(PH_PREP_HY, l, 0); RUN(PH_PREP_QK, l, 0);
        RUN(PH_HYENA, l, 0); RUN(PH_GA, l, 0); RUN(PH_NA, l, 0); if (!last) RUN(PH_CTXATTN, l, 0);
        RUN(PH_FINAL, l, 0); RUN(PH_OUTPROJ, l, 0); RUN(PH_MODNORM2, l, 0);
        if ((l & 1) == 0) { RUN(PH_FFN_UP, l, 0); RUN(PH_FFN_DOWN, l, 0); }
        else { RUN(PH_MOE_COUNT, l, 0); RUN(PH_MOE_ASSIGN, l, 0); for (int c = 0; c < 2; ++c) { RUN(PH_MOE_UP, l, c); RUN(PH_MOE_DOWN, l, c); } }
    }
}
#endif
```

```cpp
#ifdef CPU_EMU
#include <cmath>
#include <cstdio>
#include <cstdlib>
#include <cstring>
#include <cstdint>
#define __device__
#define __global__
#define __host__
#define __forceinline__ inline
static inline int atomicAdd(int* p, int v) { int o = *p; *p += v; return o; }
#else
#include <hip/hip_runtime.h>
#include <cstdio>
#include <cstdint>
#endif

#ifdef CFG_SMALL
constexpr int D = 512, NB = 2, S = 1024, LC = 64, DFF = 256, DFE = 256;
#else
constexpr int D = 1024, NB = 8, S = 4096, LC = 256, DFF = 2816, DFE = 3584;
#endif
constexpr int NL = 2;
constexpr int DHY = 3 * D / 8, DNA = 3 * D / 8, DGA = D - DHY - DNA, NNA = DNA / 64, NGA = DGA / 64, HD = 64;
constexpr int GW = 64, ROWS = S / GW, KH = 8, KWIN = 16;
constexpr int MX = NB * S, MC = NB * LC, M = MX + MC;
constexpr int NE = 8;
constexpr int NP = 3 * D;
constexpr int PC_HY = 0, PC_NAQ = 3 * DHY, PC_NAK = PC_NAQ + DNA, PC_NAV = PC_NAK + DNA, PC_GAQ = 3 * (DHY + DNA), PC_GAK = PC_GAQ + DGA, PC_GAV = PC_GAK + DGA;
constexpr int MPAD = ((MX + NE * 255 + 255) / 256) * 256;
constexpr float EPS = 1e-6f;
constexpr float LOG2E = 1.4426950408889634f;
constexpr float QSCALE = 0.125f * LOG2E;

typedef unsigned short bf16;
__host__ __device__ __forceinline__ unsigned f2bf_u(float f) { unsigned u; __builtin_memcpy(&u, &f, 4); return (u + 0x7fffu + ((u >> 16) & 1u)) >> 16; }
__host__ __device__ __forceinline__ bf16 f2bf(float f) { return (bf16)f2bf_u(f); }
__host__ __device__ __forceinline__ float bf2f(bf16 h) { unsigned u = ((unsigned)h) << 16; float f; __builtin_memcpy(&f, &u, 4); return f; }
__host__ __device__ __forceinline__ float silu_f(float v) { return v / (1.0f + expf(-v)); }

constexpr float F8_SA = 8.0f, F8_SWU = 128.0f, F8_SH = 4.0f, F8_SWD = 256.0f, F8_MAX = 448.0f;
struct Prm {
    const float *x, *c, *ctx, *c_ctx, *w_mod, *b_mod, *norm_mix, *norm_ffn, *w_in, *hy_conv_w, *hy_conv_b, *hy_w1, *hy_b1, *hy_freq, *hy_w2, *hy_b2, *hy_w3, *hy_skip;
    const float *na_q_norm, *na_k_norm, *na_rpb, *ga_q_norm, *ga_k_norm, *out_norm_hy, *out_norm_na, *out_norm_ga, *w_out;
    const float *ffn_w_gate, *ffn_w_up, *ffn_w_down, *moe_router, *moe_w_gate, *moe_w_up, *moe_w_down;
    float* out;
    int* ctl;
    float* MOD;
    float* ROPE;
    float* QKG;
    float *FHA, *FHB;
    bf16* FT;
    bf16* FTC;
    bf16 *WinT, *WoutT;
    bf16 *WguT, *WdT;
    bf16 *WguTe, *WdTe;
    float* CX;
    int* TOPI; float* TOPW; int* LIST;
    bf16* HX;
    bf16* P;
    bf16 *VT, *VTC;
    float *YC, *YCC;
    bf16* HID;
    bf16* XG;
    bf16* XB;
};

__device__ __forceinline__ void conv_T(const float* W, int K, int N, bf16* dst, long gtid, long gsz) {
    for (long i = gtid; i < (long)N * K; i += gsz) { const int n = (int)(i / K), k = (int)(i % K); dst[i] = f2bf(W[(size_t)k * N + n]); }
}
__device__ __forceinline__ void conv_gu(const float* Wg, const float* Wu, int K, int F, bf16* dst, long gtid, long gsz) {
    for (long i = gtid; i < (long)2 * F * K; i += gsz) {
        const int n = (int)(i / K), k = (int)(i % K), p = n / 256, j = n % 256;
        const float* src = j < 128 ? Wg : Wu; const int col = 128 * p + (j & 127);
        dst[i] = f2bf(src[(size_t)k * F + col]);
    }
}
__device__ __forceinline__ void ph_wconv(const Prm& p, long gtid, long gsz) {
    for (int l = 0; l < NL; ++l) {
        conv_T(p.w_in + (size_t)l * D * NP, D, NP, p.WinT + (size_t)l * NP * D, gtid, gsz);
        conv_T(p.w_out + (size_t)l * D * D, D, D, p.WoutT + (size_t)l * D * D, gtid, gsz);
    }
    conv_gu(p.ffn_w_gate, p.ffn_w_up, D, DFF, p.WguT, gtid, gsz);
    conv_T(p.ffn_w_down, DFF, D, p.WdT, gtid, gsz);
    for (int e = 0; e < NE; ++e) {
        conv_gu(p.moe_w_gate + (size_t)e * D * DFE, p.moe_w_up + (size_t)e * D * DFE, D, DFE, p.WguTe + (size_t)e * 2 * DFE * D, gtid, gsz);
        conv_T(p.moe_w_down + (size_t)e * DFE * D, DFE, D, p.WdTe + (size_t)e * D * DFE, gtid, gsz);
    }
}
__device__ __forceinline__ void ph_mod(const Prm& p, long gtid, long gsz) {
    for (long i = gtid; i < (long)NL * 9 * 6 * D; i += gsz) {
        const int n = (int)(i % (6 * D)), r = (int)((i / (6 * D)) % 9), l = (int)(i / (6 * D * 9));
        const float* cv = r < 8 ? p.c + (size_t)(r % NB) * D : p.c_ctx;
        const float* w = p.w_mod + (size_t)l * D * 6 * D;
        float acc = p.b_mod[(size_t)l * 6 * D + n];
        for (int k = 0; k < D; ++k) acc += silu_f(cv[k]) * w[(size_t)k * 6 * D + n];
        p.MOD[i] = acc;
    }
}
__device__ __forceinline__ int fset_len(int s) { return s < 2 ? S : LC; }
__device__ __forceinline__ int fset_layer(int s) { return s == 1 ? 1 : 0; }
__device__ __forceinline__ void ph_filt1(const Prm& p, long gtid, long gsz) {
    for (long i = gtid; i < (long)3 * S * 64; i += gsz) {
        const int u = (int)(i % 64), t = (int)((i / 64) % S), s = (int)(i / (64 * S));
        const int Len = fset_len(s), l = fset_layer(s);
        if (t >= Len) continue;
        const float* w1 = p.hy_w1 + (size_t)l * 33 * 64;
        const float tn = (float)t / (float)(Len - 1);
        const float ang = 6.283185307179586f * (float)t / (float)Len;
        float pre = p.hy_b1[l * 64 + u] + tn * w1[u];
        for (int j = 0; j < 16; ++j) {
            const float fr = 1e-4f + (float)j * ((15.0f - 1e-4f) / 15.0f);
            pre += cosf(fr * ang) * w1[(1 + j) * 64 + u] - sinf(fr * ang) * w1[(17 + j) * 64 + u];
        }
        p.FHA[i] = sinf(p.hy_freq[l * 64 + u] * pre);
    }
}
__device__ __forceinline__ void ph_filt2(const Prm& p, int inner, const float* src, float* dst, long gtid, long gsz) {
    for (long i = gtid; i < (long)3 * S * 64; i += gsz) {
        const int u = (int)(i % 64), t = (int)((i / 64) % S), s = (int)(i / (64 * S));
        const int Len = fset_len(s), l = fset_layer(s);
        if (t >= Len) continue;
        const float* w2 = p.hy_w2 + ((size_t)l * 2 + inner) * 64 * 64;
        const float* h = src + (i - u);
        float pre = p.hy_b2[(l * 2 + inner) * 64 + u];
        for (int k = 0; k < 64; ++k) pre += h[k] * w2[k * 64 + u];
        dst[i] = sinf(p.hy_freq[l * 64 + u] * pre);
    }
}
__device__ __forceinline__ void ph_filt3(const Prm& p, const float* src, long gtid, long gsz) {
    for (long i = gtid; i < (long)3 * S * 2 * DHY; i += gsz) {
        const int n = (int)(i % (2 * DHY)), t = (int)((i / (2 * DHY)) % S), s = (int)(i / ((long)2 * DHY * S));
        const int Len = fset_len(s), l = fset_layer(s);
        if (t >= Len) continue;
        const float* w3 = p.hy_w3 + (size_t)l * 64 * 2 * DHY;
        const float* h = src + ((size_t)s * S + t) * 64;
        float acc = 0.f;
        for (int k = 0; k < 64; ++k) acc += h[k] * w3[(size_t)k * 2 * DHY + n];
        const int cch = n % DHY;
        const float d0 = logf(1e-2f) / 1.5f, d1 = logf(1e-2f) / 0.3f;
        const float delta = fabsf(d0 + (float)cch * ((d1 - d0) / (float)(DHY - 1)));
        const float tn = (float)t / (float)(Len - 1);
        const float val = acc * expf(-tn * delta);
        bf16* ft = (s < 2 ? p.FT + (size_t)s * DHY * (2 * S + 8) : p.FTC) + (size_t)cch * (2 * Len + 8);
        if (n < DHY) ft[Len - t] = f2bf(val);
        else if (t > 0) ft[Len + t] = f2bf(val);
        else { ft[0] = 0; for (int k = 0; k < 8; ++k) ft[2 * Len + k] = 0; }
    }
}

__device__ __forceinline__ int row_modrow(int row) { return row < MX ? row / S : 8; }
__device__ __forceinline__ int row_batch(int row) { return row < MX ? row / S : (row - MX) / LC; }

__device__ __forceinline__ void ph_modnorm(const Prm& p, int l, const float* xs, const float* cs, const float* gain, int off_shift, int off_scale, int nrows, bool router, long gtid, long gsz) {
    for (long row = gtid; row < nrows; row += gsz) {
        const float* src = row < MX ? xs + (size_t)row * D : cs + (size_t)(row - MX) * D;
        const float* mod = p.MOD + ((size_t)l * 9 + row_modrow((int)row)) * 6 * D;
        float ss = 0.f;
        for (int k = 0; k < D; ++k) ss += src[k] * src[k];
        const float rstd = 1.0f / sqrtf(ss / (float)D + EPS);
        float lg[NE];
#pragma unroll
        for (int e = 0; e < NE; ++e) lg[e] = 0.f;
        for (int k = 0; k < D; ++k) {
            const float h = src[k] * rstd * gain[k] * (1.0f + mod[off_scale + k]) + mod[off_shift + k];
            p.HX[(size_t)row * D + k] = f2bf(h);
            if (router) {
#pragma unroll
                for (int e = 0; e < NE; ++e) lg[e] += h * p.moe_router[(size_t)k * NE + e]; }
        }
        if (router && row < MX) {
            float b1 = -INFINITY, b2 = -INFINITY; int i1 = 0, i2 = 0;
#pragma unroll
            for (int e = 0; e < NE; ++e) { const float v = lg[e]; if (v > b1) { b2 = b1; i2 = i1; b1 = v; i1 = e; } else if (v > b2) { b2 = v; i2 = e; } }
            const float w1 = 1.0f / (1.0f + expf(b2 - b1));
            p.TOPI[row * 2] = i1; p.TOPI[row * 2 + 1] = i2; p.TOPW[row * 2] = w1; p.TOPW[row * 2 + 1] = 1.0f - w1;
        }
    }
}
struct U4 { unsigned x, y, z, w; };
__device__ __forceinline__ float dot_bf(const bf16* a, const bf16* b, int K) {
    float acc = 0.f;
    for (int k = 0; k < K; k += 8) {
        U4 va, vb; __builtin_memcpy(&va, a + k, 16); __builtin_memcpy(&vb, b + k, 16);
        const unsigned ua[4] = {va.x, va.y, va.z, va.w}, ub[4] = {vb.x, vb.y, vb.z, vb.w};
#pragma unroll
        for (int j = 0; j < 4; ++j) acc += bf2f((bf16)(ua[j] & 0xffffu)) * bf2f((bf16)(ub[j] & 0xffffu)) + bf2f((bf16)(ua[j] >> 16)) * bf2f((bf16)(ub[j] >> 16));
    }
    return acc;
}

__device__ __forceinline__ void ph_inproj(const Prm& p, int l, long gtid, long gsz) {
    const bf16* Bt = p.WinT + (size_t)l * NP * D;
    for (long i = gtid; i < (long)M * NP; i += gsz) { const int m = (int)(i / NP), n = (int)(i % NP); p.P[i] = f2bf(dot_bf(p.HX + (size_t)m * D, Bt + (size_t)n * D, D)); }
}
__device__ __forceinline__ float sconv(const Prm& p, int l, int row, int col) {
    int t, Len; if (row < MX) { t = row % S; Len = S; } else { t = (row - MX) % LC; Len = LC; }
    const float* w = p.hy_conv_w + (size_t)l * 3 * 3 * DHY;
    float y = p.hy_conv_b[(size_t)l * 3 * DHY + col] + w[3 * DHY + col] * bf2f(p.P[(size_t)row * NP + col]);
    if (t > 0) y += w[col] * bf2f(p.P[(size_t)(row - 1) * NP + col]);
    if (t < Len - 1) y += w[2 * 3 * DHY + col] * bf2f(p.P[(size_t)(row + 1) * NP + col]);
    return y;
}
__device__ __forceinline__ void ph_prep_hy(const Prm& p, int l, long gtid, long gsz) {
    for (long i = gtid; i < (long)M * DHY; i += gsz) {
        const int row = (int)(i / DHY), c = (int)(i % DHY);
        const float v = sconv(p, l, row, 2 * DHY + c) * sconv(p, l, row, DHY + c);
        if (row < MX) p.VT[((size_t)c * NB + row / S) * S + row % S] = f2bf(v);
        else { const int rr = row - MX; p.VTC[((size_t)c * NB + rr / LC) * LC + rr % LC] = f2bf(v); }
    }
}
__device__ __forceinline__ void ph_prep_qk(const Prm& p, int l, long gtid, long gsz) {
    constexpr int NS = 2 * NNA + 2 * NGA;
    for (long i = gtid; i < (long)M * NS; i += gsz) {
        const int row = (int)(i / NS), hs = (int)(i % NS);
        int col; const float* g; bool isq, rope;
        if (hs < NNA) { col = PC_NAQ + 64 * hs; g = p.na_q_norm + l * 64; isq = true; rope = false; }
        else if (hs < 2 * NNA) { col = PC_NAK + 64 * (hs - NNA); g = p.na_k_norm + l * 64; isq = false; rope = false; }
        else if (hs < 2 * NNA + NGA) { col = PC_GAQ + 64 * (hs - 2 * NNA); g = p.ga_q_norm + l * 64; isq = true; rope = row < MX; }
        else { col = PC_GAK + 64 * (hs - 2 * NNA - NGA); g = p.ga_k_norm + l * 64; isq = false; rope = row < MX; }
        bf16* v = p.P + (size_t)row * NP + col;
        float ss = 0.f;
        for (int d = 0; d < 64; ++d) { const float a = bf2f(v[d]); ss += a * a; }
        const float rstd = 1.0f / sqrtf(ss / 64.0f + EPS), sc = isq ? QSCALE : 1.0f;
        if (!rope) { for (int d = 0; d < 64; ++d) v[d] = f2bf(bf2f(v[d]) * rstd * g[d] * sc); }
        else {
            const int t = row % S; const float pr = (float)(t / GW), pc = (float)(t % GW);
            for (int hf = 0; hf < 2; ++hf) {
                const float pos = hf == 0 ? pr : pc;
                for (int j = 0; j < 16; ++j) {
                    const float inv = powf(10000.0f, -(float)j / 16.0f), ang = pos * inv, cs = cosf(ang), sn = sinf(ang);
                    const int d1 = 32 * hf + j, d2 = d1 + 16;
                    const float a = bf2f(v[d1]) * rstd * g[d1], b = bf2f(v[d2]) * rstd * g[d2];
                    v[d1] = f2bf((a * cs - b * sn) * sc); v[d2] = f2bf((a * sn + b * cs) * sc);
                }
            }
        }
    }
}
__device__ __forceinline__ void ph_hyena_naive(const Prm& p, int l, bool with_lat, bool with_ctx, long gtid, long gsz) {
    const bf16* FTl = p.FT + (size_t)l * DHY * (2 * S + 8);
    if (with_lat) for (long i = gtid; i < (long)DHY * NB * S; i += gsz) {
        const int t = (int)(i % S), cb = (int)(i / S), c = cb / NB;
        const bf16* ft = FTl + (size_t)c * (2 * S + 8) + S - t; const bf16* v = p.VT + (size_t)cb * S;
        float acc = 0.f;
        for (int s = 0; s < S; ++s) acc += bf2f(ft[s]) * bf2f(v[s]);
        p.YC[i] = acc;
    }
    if (with_ctx) for (long i = gtid; i < (long)DHY * NB * LC; i += gsz) {
        const int t = (int)(i % LC), cb = (int)(i / LC), c = cb / NB;
        const bf16* ft = p.FTC + (size_t)c * (2 * LC + 8) + LC - t; const bf16* v = p.VTC + (size_t)cb * LC;
        float acc = 0.f;
        for (int s = 0; s < LC; ++s) acc += bf2f(ft[s]) * bf2f(v[s]);
        p.YCC[i] = acc;
    }
}
struct OnlineSm { float m, l, o[64]; };
__device__ __forceinline__ void osm_init(OnlineSm& st) { st.m = -INFINITY; st.l = 0.f;
_Pragma("unroll") for (int d = 0; d < 64; ++d) st.o[d] = 0.f; }
__device__ __forceinline__ void osm_step(OnlineSm& st, const float* q, const bf16* k, const bf16* v, float bias) {
    float sc = bias;
_Pragma("unroll") for (int d = 0; d < 64; ++d) sc += q[d] * bf2f(k[d]);
    if (sc > st.m) { const float a = exp2f(st.m - sc); st.l *= a;
_Pragma("unroll") for (int d = 0; d < 64; ++d) st.o[d] *= a;
 st.m = sc; }
    const float pe = exp2f(sc - st.m); st.l += pe;
_Pragma("unroll") for (int d = 0; d < 64; ++d) st.o[d] += pe * bf2f(v[d]);
}
__device__ __forceinline__ void ph_ga_naive(const Prm& p, long gtid, long gsz) {
    for (long i = gtid; i < (long)NB * NGA * S; i += gsz) {
        const int t = (int)(i % S), h = (int)((i / S) % NGA), b = (int)(i / ((long)S * NGA));
        bf16* qp = p.P + ((size_t)b * S + t) * NP + PC_GAQ + 64 * h;
        float q[64];
_Pragma("unroll") for (int d = 0; d < 64; ++d) q[d] = bf2f(qp[d]);
        OnlineSm st; osm_init(st);
        for (int s = 0; s < S; ++s) { const bf16* kr = p.P + ((size_t)b * S + s) * NP; osm_step(st, q, kr + PC_GAK + 64 * h, kr + PC_GAV + 64 * h, 0.f); }
        for (int s = 0; s < LC; ++s) { const bf16* kr = p.P + ((size_t)MX + b * LC + s) * NP; osm_step(st, q, kr + PC_GAK + 64 * h, kr + PC_GAV + 64 * h, 0.f); }
        const float il = 1.0f / st.l;
_Pragma("unroll") for (int d = 0; d < 64; ++d) qp[d] = f2bf(st.o[d] * il);
    }
}
__device__ __forceinline__ void ph_na_naive(const Prm& p, int l, long gtid, long gsz) {
    for (long i = gtid; i < (long)NB * NNA * S; i += gsz) {
        const int t = (int)(i % S), h = (int)((i / S) % NNA), b = (int)(i / ((long)S * NNA));
        const int r = t / GW, qc = t % GW;
        int r0 = r - KH / 2; r0 = r0 < 0 ? 0 : (r0 > ROWS - KH ? ROWS - KH : r0);
        int c0 = qc - KWIN / 2; c0 = c0 < 0 ? 0 : (c0 > GW - KWIN ? GW - KWIN : c0);
        bf16* qp = p.P + ((size_t)b * S + t) * NP + PC_NAQ + 64 * h;
        float q[64];
_Pragma("unroll") for (int d = 0; d < 64; ++d) q[d] = bf2f(qp[d]);
        const float* rpb = p.na_rpb + ((size_t)l * NNA + h) * (2 * KH - 1) * (2 * KWIN - 1);
        OnlineSm st; osm_init(st);
        for (int kr = 0; kr < KH; ++kr) for (int kc = c0; kc < c0 + KWIN; ++kc) {
            const int krow = r0 + kr, dr = krow - r + (KH - 1); int dc = kc - qc; dc = dc < -(KWIN - 1) ? -(KWIN - 1) : (dc > KWIN - 1 ? KWIN - 1 : dc); dc += KWIN - 1;
            const bf16* kp = p.P + ((size_t)b * S + krow * GW + kc) * NP;
            osm_step(st, q, kp + PC_NAK + 64 * h, kp + PC_NAV + 64 * h, rpb[dr * (2 * KWIN - 1) + dc] * LOG2E);
        }
        for (int s = 0; s < LC; ++s) { const bf16* kp = p.P + ((size_t)MX + b * LC + s) * NP; osm_step(st, q, kp + PC_NAK + 64 * h, kp + PC_NAV + 64 * h, 0.f); }
        const float il = 1.0f / st.l;
_Pragma("unroll") for (int d = 0; d < 64; ++d) qp[d] = f2bf(st.o[d] * il);
    }
}
__device__ __forceinline__ void ph_ctxattn_naive(const Prm& p, long gtid, long gsz) {
    for (long i = gtid; i < (long)NB * (NNA + NGA) * LC; i += gsz) {
        const int t = (int)(i % LC), hh = (int)((i / LC) % (NNA + NGA)), b = (int)(i / ((long)LC * (NNA + NGA)));
        const int qo = hh < NNA ? PC_NAQ + 64 * hh : PC_GAQ + 64 * (hh - NNA), ko = hh < NNA ? PC_NAK + 64 * hh : PC_GAK + 64 * (hh - NNA), vo = hh < NNA ? PC_NAV + 64 * hh : PC_GAV + 64 * (hh - NNA);
        bf16* qp = p.P + ((size_t)MX + b * LC + t) * NP + qo;
        float q[64];
_Pragma("unroll") for (int d = 0; d < 64; ++d) q[d] = bf2f(qp[d]);
        OnlineSm st; osm_init(st);
        for (int s = 0; s < LC; ++s) { const bf16* kp = p.P + ((size_t)MX + b * LC + s) * NP; osm_step(st, q, kp + ko, kp + vo, 0.f); }
        const float il = 1.0f / st.l;
_Pragma("unroll") for (int d = 0; d < 64; ++d) qp[d] = f2bf(st.o[d] * il);
    }
}
__device__ __forceinline__ void ph_final(const Prm& p, int l, int nrows, long gtid, long gsz) {
    for (long row = gtid; row < nrows; row += gsz) {
        const int r = (int)row; int b, t; const float* yc;
        if (r < MX) { b = r / S; t = r % S; } else { b = (r - MX) / LC; t = (r - MX) % LC; }
        float ss = 0.f;
        for (int pass = 0; pass < 2; ++pass) {
            const float rstd = pass ? 1.0f / sqrtf(ss / (float)DHY + EPS) : 0.f;
            for (int c = 0; c < DHY; ++c) {
                const float x0 = sconv(p, l, r, c), vp = sconv(p, l, r, 2 * DHY + c) * sconv(p, l, r, DHY + c);
                const float conv = r < MX ? p.YC[((size_t)c * NB + b) * S + t] : p.YCC[((size_t)c * NB + b) * LC + t];
                const float y = (conv + p.hy_skip[l * DHY + c] * vp) * x0;
                if (!pass) ss += y * y; else p.HX[(size_t)r * D + c] = f2bf(y * rstd * p.out_norm_hy[l * DHY + c]);
            }
        }
        { const bf16* o = p.P + (size_t)r * NP + PC_NAQ; float s2 = 0.f; for (int j = 0; j < DNA; ++j) { const float a = bf2f(o[j]); s2 += a * a; }
          const float rstd = 1.0f / sqrtf(s2 / (float)DNA + EPS); for (int j = 0; j < DNA; ++j) p.HX[(size_t)r * D + DHY + j] = f2bf(bf2f(o[j]) * rstd * p.out_norm_na[l * DNA + j]); }
        { const bf16* o = p.P + (size_t)r * NP + PC_GAQ; float s2 = 0.f; for (int j = 0; j < DGA; ++j) { const float a = bf2f(o[j]); s2 += a * a; }
          const float rstd = 1.0f / sqrtf(s2 / (float)DGA + EPS); for (int j = 0; j < DGA; ++j) p.HX[(size_t)r * D + DHY + DNA + j] = f2bf(bf2f(o[j]) * rstd * p.out_norm_ga[l * DGA + j]); }
        (void)yc;
    }
}
__device__ __forceinline__ void ph_outproj(const Prm& p, int l, const float* xs, const float* cs, int nrows, long gtid, long gsz) {
    const bf16* Bt = p.WoutT + (size_t)l * D * D;
    for (long i = gtid; i < (long)nrows * D; i += gsz) {
        const int m = (int)(i / D), n = (int)(i % D);
        const float acc = dot_bf(p.HX + (size_t)m * D, Bt + (size_t)n * D, D);
        const float gate = p.MOD[((size_t)l * 9 + row_modrow(m)) * 6 * D + 2 * D + n];
        if (m < MX) p.out[i] = xs[i] + gate * acc; else p.CX[i - (size_t)MX * D] = cs[i - (size_t)MX * D] + gate * acc;
    }
}
__device__ __forceinline__ void ph_ffn_up(const Prm& p, int nrows, long gtid, long gsz) {
    for (long i = gtid; i < (long)nrows * DFF; i += gsz) {
        const int m = (int)(i / DFF), j = (int)(i % DFF), n = 256 * (j / 128) + (j % 128);
        const float g = dot_bf(p.HX + (size_t)m * D, p.WguT + (size_t)n * D, D), u = dot_bf(p.HX + (size_t)m * D, p.WguT + (size_t)(n + 128) * D, D);
        p.HID[i] = f2bf(silu_f(g) * u);
    }
}
__device__ __forceinline__ void ph_ffn_down(const Prm& p, int l, int nrows, long gtid, long gsz) {
    for (long i = gtid; i < (long)nrows * D; i += gsz) {
        const int m = (int)(i / D), n = (int)(i % D);
        const float acc = dot_bf(p.HID + (size_t)m * DFF, p.WdT + (size_t)n * DFF, DFF);
        const float gate = p.MOD[((size_t)l * 9 + row_modrow(m)) * 6 * D + 5 * D + n];
        if (m < MX) p.out[i] += gate * acc; else p.CX[i - (size_t)MX * D] += gate * acc;
    }
}
__device__ __forceinline__ void ph_moe_count(const Prm& p, long gtid, long gsz) {
    for (long i = gtid; i < (long)2 * MPAD; i += gsz) p.LIST[i] = -1;
    for (long m = gtid; m < MX; m += gsz) { atomicAdd(p.ctl + p.TOPI[m * 2], 1); atomicAdd(p.ctl + 8 + p.TOPI[m * 2 + 1], 1); }
}
__device__ __forceinline__ int moe_off(const Prm& p, int pass, int e) {
    int o = 0;
#pragma unroll
    for (int k = 0; k < NE; ++k) if (k < e) o += (p.ctl[pass * 8 + k] + 255) / 256 * 256;
    return o;
}
__device__ __forceinline__ void ph_moe_assign(const Prm& p, long gtid, long gsz) {
    for (long m = gtid; m < MX; m += gsz) {
        for (int c = 0; c < 2; ++c) { const int e = p.TOPI[m * 2 + c]; const int slot = moe_off(p, c, e) + atomicAdd(p.ctl + 16 + c * 8 + e, 1); p.LIST[(size_t)c * MPAD + slot] = (int)m; }
    }
}
__device__ __forceinline__ int moe_slot_expert(const Prm& p, int pass, int slot) {
    int e = 0, o = 0;
#pragma unroll
    for (int k = 0; k < NE - 1; ++k) { o += (p.ctl[pass * 8 + k] + 255) / 256 * 256; if (slot >= o) e = k + 1; }
    return e;
}
__device__ __forceinline__ void ph_moe_up(const Prm& p, int pass, long gtid, long gsz) {
    const int tot = moe_off(p, pass, NE);
    for (long i = gtid; i < (long)tot * DFE; i += gsz) {
        const int slot = (int)(i / DFE), j = (int)(i % DFE), tok = p.LIST[(size_t)pass * MPAD + slot];
        if (tok < 0) continue;
        const int e = moe_slot_expert(p, pass, slot), n = 256 * (j / 128) + (j % 128);
        const bf16* W = p.WguTe + (size_t)e * 2 * DFE * D;
        const float g = dot_bf(p.HX + (size_t)tok * D, W + (size_t)n * D, D), u = dot_bf(p.HX + (size_t)tok * D, W + (size_t)(n + 128) * D, D);
        p.HID[i] = f2bf(silu_f(g) * u);
    }
}
__device__ __forceinline__ void ph_moe_down(const Prm& p, int l, int pass, long gtid, long gsz) {
    const int tot = moe_off(p, pass, NE);
    for (long i = gtid; i < (long)tot * D; i += gsz) {
        const int slot = (int)(i / D), n = (int)(i % D), tok = p.LIST[(size_t)pass * MPAD + slot];
        if (tok < 0) continue;
        const int e = moe_slot_expert(p, pass, slot);
        const float acc = dot_bf(p.HID + (size_t)slot * DFE, p.WdTe + ((size_t)e * D + n) * DFE, DFE);
        const float gate = p.MOD[((size_t)l * 9 + tok / S) * 6 * D + 5 * D + n];
        p.out[(size_t)tok * D + n] += gate * p.TOPW[tok * 2 + pass] * acc;
    }
}

enum { PH_WCONV, PH_MOD, PH_F1, PH_F2A, PH_F2B, PH_F3, PH_MODNORM1, PH_INPROJ, PH_PREP_HY, PH_PREP_QK, PH_HYENA, PH_GA, PH_NA, PH_CTXATTN, PH_FINAL, PH_OUTPROJ, PH_MODNORM2,
       PH_FFN_UP, PH_FFN_DOWN, PH_MOE_COUNT, PH_MOE_ASSIGN, PH_MOE_UP, PH_MOE_DOWN };
__device__ __forceinline__ void run_phase(const Prm& p, int ph, int l, int arg, long gtid, long gsz) {
    const bool first = l == 0, last = l == NL - 1;
    const float* xs = first ? p.x : p.out; const float* cs = first ? p.ctx : p.CX;
    const int nact = last ? MX : M;
    switch (ph) {
        case PH_WCONV: ph_wconv(p, gtid, gsz); break;
        case PH_MOD: ph_mod(p, gtid, gsz); break;
        case PH_F1: ph_filt1(p, gtid, gsz); break;
        case PH_F2A: ph_filt2(p, 0, p.FHA, p.FHB, gtid, gsz); break;
        case PH_F2B: ph_filt2(p, 1, p.FHB, p.FHA, gtid, gsz); break;
        case PH_F3: ph_filt3(p, p.FHA, gtid, gsz); break;
        case PH_MODNORM1: ph_modnorm(p, l, xs, cs, p.norm_mix + l * D, 0, D, M, false, gtid, gsz); break;
        case PH_INPROJ: ph_inproj(p, l, gtid, gsz); break;
        case PH_PREP_HY: ph_prep_hy(p, l, gtid, gsz); break;
        case PH_PREP_QK: ph_prep_qk(p, l, gtid, gsz); break;
        case PH_HYENA: ph_hyena_naive(p, l, true, !last, gtid, gsz); break;
        case PH_GA: ph_ga_naive(p, gtid, gsz); break;
        case PH_NA: ph_na_naive(p, l, gtid, gsz); break;
        case PH_CTXATTN: ph_ctxattn_naive(p, gtid, gsz); break;
        case PH_FINAL: ph_final(p, l, nact, gtid, gsz); break;
        case PH_OUTPROJ: ph_outproj(p, l, xs, cs, nact, gtid, gsz); break;
        case PH_MODNORM2: ph_modnorm(p, l, p.out, p.CX, p.norm_ffn + l * D, 3 * D, 4 * D, nact, (l & 1) != 0, gtid, gsz); break;
        case PH_FFN_UP: ph_ffn_up(p, nact, gtid, gsz); break;
        case PH_FFN_DOWN: ph_ffn_down(p, l, nact, gtid, gsz); break;
        case PH_MOE_COUNT: ph_moe_count(p, gtid, gsz); break;
        case PH_MOE_ASSIGN: ph_moe_assign(p, gtid, gsz); break;
        case PH_MOE_UP: ph_moe_up(p, arg, gtid, gsz); break;
        case PH_MOE_DOWN: ph_moe_down(p, l, arg, gtid, gsz); break;
    }
}

struct WsMap { size_t off; size_t take(size_t bytes) { const size_t o = off; off = (off + bytes + 255) & ~(size_t)255; return o; } };
constexpr size_t CTL_BYTES = 1u << 20;
static void build_prm(Prm& p, void* const* d_in, void* d_out, void* d_ws) {
    const float** f = (const float**)&p;
    for (int i = 0; i < 34; ++i) f[i] = (const float*)d_in[i];
    p.out = (float*)d_out;
    unsigned char* ws = (unsigned char*)d_ws; WsMap w{0};
    p.ctl = (int*)(ws + w.take(CTL_BYTES));
    p.MOD = (float*)(ws + w.take((size_t)NL * 9 * 6 * D * 4));
    p.ROPE = (float*)(ws + w.take((size_t)64 * 16 * 2 * 4));
    p.QKG = (float*)(ws + w.take((size_t)NL * 4 * 64 * 4));
    p.FHA = (float*)(ws + w.take((size_t)3 * S * 64 * 4)); p.FHB = (float*)(ws + w.take((size_t)3 * S * 64 * 4));
    p.FT = (bf16*)(ws + w.take((size_t)NL * DHY * (2 * S + 8) * 2)); p.FTC = (bf16*)(ws + w.take((size_t)DHY * (2 * LC + 8) * 2));
    p.WinT = (bf16*)(ws + w.take((size_t)NL * NP * D * 2)); p.WoutT = (bf16*)(ws + w.take((size_t)NL * D * D * 2));
    p.WguT = (bf16*)(ws + w.take((size_t)2 * DFF * D)); p.WdT = (bf16*)(ws + w.take((size_t)D * DFF));
    p.WguTe = (bf16*)(ws + w.take((size_t)NE * 2 * DFE * D)); p.WdTe = (bf16*)(ws + w.take((size_t)NE * D * DFE));
    p.CX = (float*)(ws + w.take((size_t)MC * D * 4));
    p.XB = (bf16*)(ws + w.take((size_t)MX * D * 2));
    p.TOPI = (int*)(ws + w.take((size_t)MX * 2 * 4)); p.TOPW = (float*)(ws + w.take((size_t)MX * 2 * 4)); p.LIST = (int*)(ws + w.take((size_t)2 * MPAD * 4));
    p.HX = (bf16*)(ws + w.take((size_t)M * D * 2));
    const size_t rbase = w.off;
    p.P = (bf16*)(ws + w.take((size_t)M * NP * 2));
    p.VT = (bf16*)(ws + w.take((size_t)DHY * NB * S * 2)); p.VTC = (bf16*)(ws + w.take((size_t)DHY * NB * LC * 2));
    p.YC = (float*)(ws + w.take((size_t)DHY * NB * S * 4)); p.YCC = (float*)(ws + w.take((size_t)DHY * NB * LC * 4));
    p.HID = (bf16*)(ws + rbase);
    p.XG = (bf16*)(ws + rbase + ((size_t)192 << 20));
    static_assert((size_t)MPAD * DFE + (size_t)(MPAD / 256 - MX / 256) * (D / 256) * 7 * 65536 * 4 <= ((size_t)192 << 20) && ((size_t)192 << 20) + (size_t)2 * MPAD * D <= (size_t)M * NP * 2 + (size_t)DHY * NB * S * 6, "expert buffers inside the dead projection region");
}
static size_t ws_needed() {
    const size_t hid = (size_t)M * DFF * 2 > (size_t)MPAD * DFE * 2 ? (size_t)M * DFF * 2 : (size_t)MPAD * DFE * 2;
    Prm p; unsigned char* base = (unsigned char*)0x1000; void* din[34] = {}; build_prm(p, din, nullptr, base);
    const size_t endR = (size_t)((unsigned char*)p.YCC - base) + (size_t)DHY * NB * LC * 4, endH = (size_t)((unsigned char*)p.HID - base) + hid;
    return endR > endH ? endR : endH;
}


#ifndef CPU_EMU
#define LAS __attribute__((address_space(3)))
extern __shared__ __attribute__((aligned(16))) unsigned char lds_raw[];
constexpr int WIDTAB_OFF = 147456 - 256;
__device__ __forceinline__ int hw_wave_slot() { return (int)(__builtin_amdgcn_s_getreg((5 << 11) | 4) & 63u); }
__device__ __forceinline__ int lane_id() { return (int)__builtin_amdgcn_mbcnt_hi(~0u, __builtin_amdgcn_mbcnt_lo(~0u, 0u)); }
__device__ __forceinline__ int my_tid() { const int w = __builtin_amdgcn_readfirstlane(((volatile LAS int*)((LAS unsigned char*)lds_raw + WIDTAB_OFF))[hw_wave_slot()]); return w * 64 + lane_id(); }
#ifdef PROBE_MASK
#ifndef PROBE_MULT
#define PROBE_MULT 10ull
#endif
#define SEG(id) do { if (blockIdx.x == 0 && my_tid() == 0) { const unsigned long long now_ = __builtin_amdgcn_s_memrealtime(); volatile LAS unsigned long long* T_ = (volatile LAS unsigned long long*)(lds + (147456 - 512) + 64); \
    if (((unsigned long long)(PROBE_MASK) >> (id)) & 1ull) T_[1] += now_ - T_[0]; T_[0] = now_; } } while (0)
#else
#define SEG(id) do { } while (0)
#endif
namespace pg8 {
#define PG8_LAS __attribute__((address_space(3)))
typedef unsigned short bf16_t;
typedef short bf16x8 __attribute__((ext_vector_type(8)));
typedef float f32x4 __attribute__((ext_vector_type(4)));
typedef unsigned u32x4 __attribute__((ext_vector_type(4)));
typedef unsigned u32x2 __attribute__((ext_vector_type(2)));
constexpr int BM = 256, BK = 64, HALF = 128, HTB = HALF * BK * 2  , STAGE_BYTES = 8 * HTB, NXCD = 8, WGM = 8;
__host__ __device__ __forceinline__ int lds_byte(int r, int c) { const int st = (r >> 4) * 2 + (c >> 5), rr = r & 15, cc = c & 31, ob = rr * 64 + cc * 2; return st * 1024 + (ob ^ (((ob >> 9) & 1) << 5)); }
__host__ __device__ __forceinline__ void stage_rc(int b, int& R, int& C) { const int st = b / 1024, sb = b % 1024, swz = sb ^ (((sb >> 9) & 1) << 5); R = (st >> 1) * 16 + swz / 64; C = (st & 1) * 32 + (swz % 64) / 2; }
__host__ __device__ __forceinline__ int perm32(int rho) { const int n = rho >> 4, i = rho & 15; return 8 * (i >> 2) + 4 * n + (i & 3); }
struct Unit { int pm, pn, kp; };
struct Order {
    int nM, nN, nwg, G, c;
    int pm0, ksplit, kplen, nvirt;
    const bf16_t* Bt; size_t bt_group_stride; int pend[8];
    const int* rows;
    __device__ void init(int nM_, int nN_, int G_, int c_, const bf16_t* Bt_) { nM = nM_; nN = nN_; nwg = nM * nN; G = G_; c = c_; Bt = Bt_; bt_group_stride = 0; rows = nullptr; pm0 = 0; ksplit = 1; kplen = 0; nvirt = nwg;
#pragma unroll
        for (int k = 0; k < 8; ++k) pend[k] = 0x7fffffff; }
    __device__ bool next(int i, Unit& u) const {
        const long L = (long)i * G + c; if (L >= nvirt) return false;
        int wgid = (int)L; u.kp = 0; if (ksplit > 1) { wgid = (int)L / ksplit; u.kp = (int)L % ksplit; }
        { const int q = nwg / NXCD, r = nwg % NXCD, xcd = wgid % NXCD, off = wgid / NXCD; wgid = (xcd < r ? xcd * (q + 1) : r * (q + 1) + (xcd - r) * q) + off; }
        const int nig = WGM * nN, gid = wgid / nig, fm = gid * WGM, gsz = (nM - fm) < WGM ? (nM - fm) : WGM;
        u.pm = pm0 + fm + ((wgid % nig) % gsz); u.pn = (wgid % nig) / gsz; return true;
    }
    __device__ __forceinline__ int group(int pm) const { int e = 0;
#pragma unroll
        for (int k = 0; k < 7; ++k) e += (int)((unsigned)(pend[k] - pm - 1) >> 31); return __builtin_amdgcn_readfirstlane(e); }
    __device__ __forceinline__ const bf16_t* bt(const Unit& u) const { return Bt + (size_t)group(u.pm) * bt_group_stride; }
    __device__ __forceinline__ int row(const Unit& u, int r) const { const int t = rows[(size_t)u.pm * BM + r]; return t < 0 ? 0 : t; }
};
__device__ __forceinline__ unsigned cvt_pk_bf16(float lo, float hi) { unsigned r; asm volatile("v_cvt_pk_bf16_f32 %0, %1, %2" : "=v"(r) : "v"(lo), "v"(hi)); return r; }

struct EpiBf16 {
    static constexpr bool PERM = true;
    bf16_t* O; int ldc;
    __device__ __forceinline__ void operator()(const f32x4 (&acc)[2][2][4][2], const Unit& u, int wr, int wc, int fr, int fq) const {
        const int row0 = u.pm * BM + wr * 64 + fr, col0 = u.pn * BM + wc * 32 + 8 * fq;
#pragma unroll
        for (int ai = 0; ai < 2; ++ai)
#pragma unroll
            for (int m = 0; m < 4; ++m) { bf16_t* rowp = O + (size_t)(row0 + ai * HALF + m * 16) * ldc + col0;
#pragma unroll
                for (int bj = 0; bj < 2; ++bj) { const f32x4 v0 = acc[ai][bj][m][0], v1 = acc[ai][bj][m][1];
                    u32x4 w; w.x = cvt_pk_bf16(v0[0], v0[1]); w.y = cvt_pk_bf16(v0[2], v0[3]); w.z = cvt_pk_bf16(v1[0], v1[1]); w.w = cvt_pk_bf16(v1[2], v1[3]);
                    *(u32x4*)(rowp + bj * HALF) = w; } }
    }
};
struct EpiInProj {
    static constexpr bool PERM = true;
    bf16_t* O; const PG8_LAS float* gains; const PG8_LAS float* rope;
    __device__ __forceinline__ void operator()(const f32x4 (&acc)[2][2][4][2], const Unit& u, int wr, int wc, int fr, int fq) const {
        const int c0 = u.pn * BM + 64 * wc;
        const int kind = (c0 >= PC_NAQ && c0 < PC_NAK) ? 1 : (c0 >= PC_NAK && c0 < PC_NAV) ? 2 : (c0 >= PC_GAQ && c0 < PC_GAK) ? 3 : (c0 >= PC_GAK && c0 < PC_GAV) ? 4 : 0;
        const int row0 = u.pm * BM + wr * 64 + fr;
        if (kind == 0) {
#pragma unroll
            for (int ai = 0; ai < 2; ++ai)
#pragma unroll
                for (int m = 0; m < 4; ++m) { bf16_t* rowp = O + (size_t)(row0 + ai * HALF + m * 16) * NP + c0 + 8 * fq;
#pragma unroll
                    for (int bj = 0; bj < 2; ++bj) { const f32x4 v0 = acc[ai][bj][m][0], v1 = acc[ai][bj][m][1];
                        u32x4 w; w.x = cvt_pk_bf16(v0[0], v0[1]); w.y = cvt_pk_bf16(v0[2], v0[3]); w.z = cvt_pk_bf16(v1[0], v1[1]); w.w = cvt_pk_bf16(v1[2], v1[3]);
                        *(u32x4*)(rowp + 32 * bj) = w; } }
            return;
        }
        const PG8_LAS float* gp = gains + (kind - 1) * 64;
        const float qs = (kind == 1 || kind == 3) ? QSCALE : 1.0f;
        const bool dorope = kind >= 3 && u.pm < MX / BM;
#pragma unroll
        for (int ai = 0; ai < 2; ++ai)
#pragma unroll
            for (int m = 0; m < 4; ++m) { const int row = row0 + ai * HALF + m * 16;
                f32x4 v[2][2]; float ss = 0.f;
#pragma unroll
                for (int bj = 0; bj < 2; ++bj)
#pragma unroll
                    for (int n = 0; n < 2; ++n) { v[bj][n] = acc[ai][bj][m][n]; ss += (v[bj][n][0] * v[bj][n][0] + v[bj][n][1] * v[bj][n][1]) + (v[bj][n][2] * v[bj][n][2] + v[bj][n][3] * v[bj][n][3]); }
                ss += __shfl_xor(ss, 16); ss += __shfl_xor(ss, 32);
                const float rstd = 1.0f / sqrtf(ss * (1.0f / 64.0f) + EPS);
#pragma unroll
                for (int bj = 0; bj < 2; ++bj)
#pragma unroll
                    for (int n = 0; n < 2; ++n) v[bj][n] = v[bj][n] * rstd * *(const PG8_LAS f32x4*)(gp + 32 * bj + 8 * fq + 4 * n);
                if (dorope) { const int t = row % S;
#pragma unroll
                    for (int bj = 0; bj < 2; ++bj) { const int pos = bj == 0 ? t / GW : t % GW;
#pragma unroll
                        for (int n = 0; n < 2; ++n) { const PG8_LAS float* rp = rope + (pos * 16 + 8 * (fq & 1) + 4 * n) * 2; const f32x4 a = *(const PG8_LAS f32x4*)rp, b = *(const PG8_LAS f32x4*)(rp + 4);
                            const f32x4 cs = (f32x4){a[0], a[2], b[0], b[2]}, sn = (f32x4){a[1], a[3], b[1], b[3]};
                            f32x4 o; o[0] = __shfl_xor(v[bj][n][0], 32); o[1] = __shfl_xor(v[bj][n][1], 32); o[2] = __shfl_xor(v[bj][n][2], 32); o[3] = __shfl_xor(v[bj][n][3], 32);
                            v[bj][n] = (fq & 2) ? (o * sn + v[bj][n] * cs) : (v[bj][n] * cs - o * sn); } } }
                bf16_t* rowp = O + (size_t)row * NP + c0 + 8 * fq;
#pragma unroll
                for (int bj = 0; bj < 2; ++bj) { const f32x4 v0 = v[bj][0] * qs, v1 = v[bj][1] * qs;
                    u32x4 w; w.x = cvt_pk_bf16(v0[0], v0[1]); w.y = cvt_pk_bf16(v0[2], v0[3]); w.z = cvt_pk_bf16(v1[0], v1[1]); w.w = cvt_pk_bf16(v1[2], v1[3]);
                    *(u32x4*)(rowp + 32 * bj) = w; }
                asm volatile("" ::: "memory"); }
    }
};
__device__ __forceinline__ float silu_fast(float v) { return v * __builtin_amdgcn_rcpf(1.0f + __builtin_amdgcn_exp2f(-1.4426950408889634f * v)); }
struct EpiSwiGLU {
    static constexpr bool PERM = true;
    bf16_t* H; int ldc;
    __device__ __forceinline__ void operator()(const f32x4 (&acc)[2][2][4][2], const Unit& u, int wr, int wc, int fr, int fq) const {
        const int row0 = u.pm * BM + wr * 64 + fr, col0 = u.pn * HALF + wc * 32 + 8 * fq;
#pragma unroll
        for (int ai = 0; ai < 2; ++ai)
#pragma unroll
            for (int m = 0; m < 4; ++m) { bf16_t* rowp = H + (size_t)(row0 + ai * HALF + m * 16) * ldc + col0;
                const f32x4 g0 = acc[ai][0][m][0], g1 = acc[ai][0][m][1], u0 = acc[ai][1][m][0], u1 = acc[ai][1][m][1];
                u32x4 w; w.x = cvt_pk_bf16(silu_fast(g0[0]) * u0[0], silu_fast(g0[1]) * u0[1]); w.y = cvt_pk_bf16(silu_fast(g0[2]) * u0[2], silu_fast(g0[3]) * u0[3]);
                w.z = cvt_pk_bf16(silu_fast(g1[0]) * u1[0], silu_fast(g1[1]) * u1[1]); w.w = cvt_pk_bf16(silu_fast(g1[2]) * u1[2], silu_fast(g1[3]) * u1[3]);
                *(u32x4*)rowp = w; }
    }
};
__device__ __forceinline__ unsigned pk4_fp8(float a, float b, float c, float d) {
    a = __builtin_amdgcn_fmed3f(a, -F8_MAX, F8_MAX); b = __builtin_amdgcn_fmed3f(b, -F8_MAX, F8_MAX); c = __builtin_amdgcn_fmed3f(c, -F8_MAX, F8_MAX); d = __builtin_amdgcn_fmed3f(d, -F8_MAX, F8_MAX);
    int r = __builtin_amdgcn_cvt_pk_fp8_f32(a, b, 0, false); r = __builtin_amdgcn_cvt_pk_fp8_f32(c, d, r, true); return (unsigned)r; }
struct EpiSwiGLU8 {
    static constexpr bool PERM = true;
    unsigned char* H; int ldc;
    __device__ __forceinline__ void operator()(const f32x4 (&acc)[2][2][4][2], const Unit& u, int wr, int wc, int fr, int fq) const {
        typedef float f32x2 __attribute__((ext_vector_type(2)));
        static_assert(F8_SA * F8_SWU == 1024.0f && F8_SH == 4.0f, "the folded constants below");
        const int row0 = u.pm * BM + wr * 64 + fr, col0 = u.pn * HALF + wc * 32 + 8 * fq;
        constexpr float K1 = -1.4426950408889634f / 1024.0f, C0 = 18.0f, D0 = 262144.0f;
#pragma unroll
        for (int ai = 0; ai < 2; ++ai)
#pragma unroll
            for (int m = 0; m < 4; ++m) { unsigned char* rowp = H + (size_t)(row0 + ai * HALF + m * 16) * ldc + col0;
                f32x2 o[4];
#pragma unroll
                for (int q = 0; q < 4; ++q) { const f32x4 ga = acc[ai][0][m][q >> 1], ua = acc[ai][1][m][q >> 1];
                    const f32x2 g = (q & 1) ? (f32x2){ga[2], ga[3]} : (f32x2){ga[0], ga[1]}, uu = (q & 1) ? (f32x2){ua[2], ua[3]} : (f32x2){ua[0], ua[1]};
                    const f32x2 a = g * K1 + C0; f32x2 t; t.x = __builtin_amdgcn_exp2f(a.x); t.y = __builtin_amdgcn_exp2f(a.y);
                    const f32x2 d = t + D0; f32x2 r; r.x = __builtin_amdgcn_rcpf(d.x); r.y = __builtin_amdgcn_rcpf(d.y);
                    o[q] = (g * uu) * r; }
                u32x2 w; w.x = pk4_fp8(o[0].x, o[0].y, o[1].x, o[1].y); w.y = pk4_fp8(o[2].x, o[2].y, o[3].x, o[3].y);
                *(u32x2*)rowp = w; }
    }
};
struct EpiResGate {
    static constexpr bool PERM = false;
    const float *xs, *cs; float *xd, *cd; const float* gate; float oscale;
    __device__ __forceinline__ void operator()(const f32x4 (&acc)[2][2][4][2], const Unit& u, int wr, int wc, int fr, int fq) const {
        const bool lat = u.pm < MX / BM; const int prow = (lat ? u.pm : u.pm - MX / BM) * BM + wr * 64 + fr, col0 = u.pn * BM + wc * 32 + 4 * fq;
        const float* s = lat ? xs : cs; float* d = lat ? xd : cd; const float* g = gate + (size_t)(lat ? u.pm / (S / BM) : 8) * 6 * D + col0;
        f32x4 gv[2][2];
#pragma unroll
        for (int bj = 0; bj < 2; ++bj)
#pragma unroll
            for (int n = 0; n < 2; ++n) gv[bj][n] = *(const f32x4*)(g + bj * HALF + n * 16) * oscale;
        constexpr int DEPTH = 3;
        f32x4 xb[DEPTH][2][2];
#define RG_LOAD(b) do { const size_t off_ = (size_t)(prow + ((b) >> 2) * HALF + ((b) & 3) * 16) * D + col0; \
        _Pragma("unroll") for (int bj = 0; bj < 2; ++bj) _Pragma("unroll") for (int n = 0; n < 2; ++n) xb[(b) % DEPTH][bj][n] = *(const f32x4*)(s + off_ + bj * HALF + n * 16); } while (0)
#pragma unroll
        for (int b = 0; b < DEPTH; ++b) RG_LOAD(b);
        __builtin_amdgcn_sched_barrier(0);
#pragma unroll
        for (int b = 0; b < 8; ++b) { const int ai = b >> 2, m = b & 3; const size_t off = (size_t)(prow + ai * HALF + m * 16) * D + col0;
#pragma unroll
            for (int bj = 0; bj < 2; ++bj)
#pragma unroll
                for (int n = 0; n < 2; ++n) *(f32x4*)(d + off + bj * HALF + n * 16) = xb[b % DEPTH][bj][n] + gv[bj][n] * acc[ai][bj][m][n];
            __builtin_amdgcn_sched_barrier(0);
            if (b + DEPTH < 8) { RG_LOAD(b + DEPTH); __builtin_amdgcn_sched_barrier(0); } }
#undef RG_LOAD
    }
};
typedef _Float16 hf2_t __attribute__((ext_vector_type(2))); typedef float f32x2_t __attribute__((ext_vector_type(2)));
__device__ __forceinline__ unsigned pkh(float a, float b) { const f32x2_t v = {a, b}; const hf2_t h = __builtin_convertvector(v, hf2_t); return __builtin_bit_cast(unsigned, h); }
__device__ __forceinline__ f32x4 bflo4(unsigned a, unsigned b) { const hf2_t x = __builtin_bit_cast(hf2_t, a), y = __builtin_bit_cast(hf2_t, b); return (f32x4){(float)x[0], (float)x[1], (float)y[0], (float)y[1]}; }
template <bool SRCF32> struct EpiResB {
    static constexpr bool PERM = true;
    const float* xs; bf16_t* xb; const float* gate; float oscale;
    __device__ __forceinline__ void operator()(const f32x4 (&acc)[2][2][4][2], const Unit& u, int wr, int wc, int fr, int fq) const {
        const int prow = u.pm * BM + wr * 64 + fr, col0 = u.pn * BM + wc * 32 + 8 * fq;
        const float* g = gate + (size_t)(u.pm / (S / BM)) * 6 * D + col0;
        f32x4 gv[2][2];
#pragma unroll
        for (int bj = 0; bj < 2; ++bj)
#pragma unroll
            for (int n = 0; n < 2; ++n) gv[bj][n] = *(const f32x4*)(g + bj * HALF + n * 4) * oscale;
        constexpr int DEPTH = 3;
        f32x4 xf[SRCF32 ? DEPTH : 1][2][2]; u32x4 xh[SRCF32 ? 1 : DEPTH][2];
#define RB_LOAD(b) do { const size_t off_ = (size_t)(prow + ((b) >> 2) * HALF + ((b) & 3) * 16) * D + col0; \
        _Pragma("unroll") for (int bj = 0; bj < 2; ++bj) { if constexpr (SRCF32) { xf[(b) % DEPTH][bj][0] = *(const f32x4*)(xs + off_ + bj * HALF); xf[(b) % DEPTH][bj][1] = *(const f32x4*)(xs + off_ + bj * HALF + 4); } \
            else xh[(b) % DEPTH][bj] = *(const u32x4*)(xb + off_ + bj * HALF); } } while (0)
#pragma unroll
        for (int b = 0; b < DEPTH; ++b) RB_LOAD(b);
        __builtin_amdgcn_sched_barrier(0);
#pragma unroll
        for (int b = 0; b < 8; ++b) { const int ai = b >> 2, m = b & 3; const size_t off = (size_t)(prow + ai * HALF + m * 16) * D + col0;
#pragma unroll
            for (int bj = 0; bj < 2; ++bj) { f32x4 s0, s1;
                if constexpr (SRCF32) { s0 = xf[b % DEPTH][bj][0]; s1 = xf[b % DEPTH][bj][1]; } else { const u32x4 h = xh[b % DEPTH][bj]; s0 = bflo4(h.x, h.y); s1 = bflo4(h.z, h.w); }
                const f32x4 v0 = s0 + gv[bj][0] * acc[ai][bj][m][0], v1 = s1 + gv[bj][1] * acc[ai][bj][m][1];
                u32x4 w; w.x = pkh(v0[0], v0[1]); w.y = pkh(v0[2], v0[3]); w.z = pkh(v1[0], v1[1]); w.w = pkh(v1[2], v1[3]);
                *(u32x4*)(xb + off + bj * HALF) = w; }
            __builtin_amdgcn_sched_barrier(0);
            if (b + DEPTH < 8) { RB_LOAD(b + DEPTH); __builtin_amdgcn_sched_barrier(0); } }
#undef RB_LOAD
    }
};
template <bool LAST> struct EpiMoeDownB {
    static constexpr bool PERM = true;
    const int* list; const float* topw; int pass; bf16_t* xb; float* out; const float* gate; float oscale;
    __device__ __forceinline__ void operator()(const f32x4 (&acc)[2][2][4][2], const Unit& u, int wr, int wc, int fr, int fq) const {
        const int slot0 = u.pm * BM + wr * 64 + fr, col0 = u.pn * BM + wc * 32 + 8 * fq;
        int tok[8]; float w[8];
#pragma unroll
        for (int b = 0; b < 8; ++b) tok[b] = list[slot0 + (b >> 2) * HALF + (b & 3) * 16];
#pragma unroll
        for (int b = 0; b < 8; ++b) { const int t = tok[b] < 0 ? 0 : tok[b]; w[b] = topw[t * 2 + pass] * oscale; }
        constexpr int DEPTH = 2;
        f32x4 gq[DEPTH][2][2]; u32x4 xh[DEPTH][2];
#define MD_LOAD(b) do { const int t_ = tok[b] < 0 ? 0 : tok[b]; const float* g_ = gate + (size_t)(t_ / S) * 6 * D + col0; const bf16_t* x_ = xb + (size_t)t_ * D + col0; \
        _Pragma("unroll") for (int bj = 0; bj < 2; ++bj) { gq[(b) % DEPTH][bj][0] = *(const f32x4*)(g_ + bj * HALF); gq[(b) % DEPTH][bj][1] = *(const f32x4*)(g_ + bj * HALF + 4); xh[(b) % DEPTH][bj] = *(const u32x4*)(x_ + bj * HALF); } } while (0)
#pragma unroll
        for (int b = 0; b < DEPTH; ++b) MD_LOAD(b);
        __builtin_amdgcn_sched_barrier(0);
#pragma unroll
        for (int b = 0; b < 8; ++b) { const int ai = b >> 2, m = b & 3;
            if (tok[b] >= 0) {
#pragma unroll
                for (int bj = 0; bj < 2; ++bj) { const u32x4 h = xh[b % DEPTH][bj];
                    const f32x4 v0 = bflo4(h.x, h.y) + gq[b % DEPTH][bj][0] * w[b] * acc[ai][bj][m][0], v1 = bflo4(h.z, h.w) + gq[b % DEPTH][bj][1] * w[b] * acc[ai][bj][m][1];
                    if constexpr (LAST) { float* o = out + (size_t)tok[b] * D + col0 + bj * HALF; *(f32x4*)o = v0; *(f32x4*)(o + 4) = v1; }
                    else { u32x4 q; q.x = pkh(v0[0], v0[1]); q.y = pkh(v0[2], v0[3]); q.z = pkh(v1[0], v1[1]); q.w = pkh(v1[2], v1[3]); *(u32x4*)(xb + (size_t)tok[b] * D + col0 + bj * HALF) = q; } } }
            __builtin_amdgcn_sched_barrier(0);
            if (b + DEPTH < 8) { MD_LOAD(b + DEPTH); __builtin_amdgcn_sched_barrier(0); } }
#undef MD_LOAD
    }
};
struct EpiPartial {
    static constexpr bool PERM = false;
    float* slab; int nN, pm0, ksplit;
    __device__ __forceinline__ void operator()(const f32x4 (&acc)[2][2][4][2], const Unit& u, int wr, int wc, int fr, int fq) const {
        float* base = slab + ((size_t)((u.pm - pm0) * nN + u.pn) * ksplit + u.kp) * (BM * BM) + (size_t)(wr * 64 + fr) * BM + wc * 32 + 4 * fq;
#pragma unroll
        for (int ai = 0; ai < 2; ++ai)
#pragma unroll
            for (int m = 0; m < 4; ++m)
#pragma unroll
                for (int bj = 0; bj < 2; ++bj)
#pragma unroll
                    for (int n = 0; n < 2; ++n) *(f32x4*)(base + (size_t)(ai * HALF + m * 16) * BM + bj * HALF + n * 16) = acc[ai][bj][m][n];
    }
};
struct EpiMoeDown {
    static constexpr bool PERM = false;
    const int* list; const float* topw; int pass; float* x; const float* gate; float oscale;
    __device__ __forceinline__ void operator()(const f32x4 (&acc)[2][2][4][2], const Unit& u, int wr, int wc, int fr, int fq) const {
        const int slot0 = u.pm * BM + wr * 64 + fr, col0 = u.pn * BM + wc * 32 + 4 * fq;
#pragma unroll
        for (int ai = 0; ai < 2; ++ai)
#pragma unroll
            for (int m = 0; m < 4; ++m) { const int tok = list[slot0 + ai * HALF + m * 16];
                if (tok >= 0) { const float w = topw[tok * 2 + pass] * oscale; const float* g = gate + (size_t)(tok / S) * 6 * D + col0; float* xr = x + (size_t)tok * D + col0;
#pragma unroll
                    for (int bj = 0; bj < 2; ++bj)
#pragma unroll
                        for (int n = 0; n < 2; ++n) { const f32x4 gv = *(const f32x4*)(g + bj * HALF + n * 16); f32x4* xp = (f32x4*)(xr + bj * HALF + n * 16); *xp = *xp + gv * w * acc[ai][bj][m][n]; } } }
    }
};

__device__ __forceinline__ void glds_s(const char* sbase_, unsigned voff, unsigned m0v_) { unsigned keep;
    const unsigned long long b_ = (unsigned long long)(uintptr_t)sbase_;
    const unsigned long long sbase = (unsigned long long)(unsigned)__builtin_amdgcn_readfirstlane((int)(unsigned)b_) | ((unsigned long long)(unsigned)__builtin_amdgcn_readfirstlane((int)(unsigned)(b_ >> 32)) << 32);
    const unsigned m0v = (unsigned)__builtin_amdgcn_readfirstlane((int)m0v_);
    asm volatile("s_mov_b32 %0, m0\n\ts_mov_b32 m0, %3\n\ts_nop 0\n\tglobal_load_lds_dwordx4 %1, %2\n\ts_mov_b32 m0, %0" : "=&s"(keep) : "v"(voff), "s"(sbase), "s"(m0v) : "memory"); }
typedef int i32x4 __attribute__((ext_vector_type(4)));
typedef int i32x8 __attribute__((ext_vector_type(8)));
__device__ __forceinline__ i32x8 cat8(bf16x8 a, bf16x8 b) { const i32x4 x = __builtin_bit_cast(i32x4, a), y = __builtin_bit_cast(i32x4, b); return __builtin_shufflevector(x, y, 0, 1, 2, 3, 4, 5, 6, 7); }
__device__ __forceinline__ bf16x8 lo8(i32x8 v) { return __builtin_bit_cast(bf16x8, (i32x4)__builtin_shufflevector(v, v, 0, 1, 2, 3)); }
__device__ __forceinline__ bf16x8 hi8(i32x8 v) { return __builtin_bit_cast(bf16x8, (i32x4)__builtin_shufflevector(v, v, 4, 5, 6, 7)); }
template <class Epi, bool ALIGN_EPI, bool GATHER, bool F8 = false>
__device__ __forceinline__ void gemm_phase(PG8_LAS unsigned char* lds, const bf16_t* A, int ldk, int K, const Order& S, const Epi& E) {
    int tid_ = my_tid(); asm volatile("" : "+v"(tid_));
    const int tid = tid_, wid = __builtin_amdgcn_readfirstlane(tid >> 6), lane = tid & 63, wr = wid >> 2, wc = wid & 3, fr = lane & 15, fq = lane >> 4;
    const int nt = K / BK;
    unsigned voffB[2]; int RA[2], CA[2];
#pragma unroll
    for (int i = 0; i < 2; ++i) { int R, C; stage_rc(tid * 16 + i * 8192, R, C); const int Rb = Epi::PERM ? ((R & ~31) + perm32(R & 31)) : R; RA[i] = R; CA[i] = C; voffB[i] = (unsigned)(Rb * ldk + C) * 2u; }
    const size_t kstep = (size_t)(BK * 2);
    const size_t hstep = (size_t)HALF * ldk * 2;
    const size_t tstep = 2 * hstep;
    const unsigned ldsw = (unsigned)wid * 1024u;
    const unsigned ldsbase = (unsigned)__builtin_amdgcn_readfirstlane((int)((unsigned)(uintptr_t)lds + ldsw));
    const int aoff = lds_byte(wr * 64 + fr, fq * 8), boff = lds_byte(wc * 32 + fr, fq * 8);
#define PG8_SA(b, h) (((b) * 2 + (h)) * HTB)
#define PG8_SB(b, h) ((4 + (b) * 2 + (h)) * HTB)
#define PG8_STAGE_B(bufoff, gbase) do { _Pragma("unroll") for (int _i = 0; _i < 2; ++_i) glds_s((const char*)(gbase), voffB[_i], ldsbase + (unsigned)((bufoff) + _i * 8192)); } while (0)
#define PG8_STAGE_A(bufoff, gbase, o0, o1) do { glds_s((const char*)(gbase), (o0), ldsbase + (unsigned)(bufoff)); glds_s((const char*)(gbase), (o1), ldsbase + (unsigned)((bufoff) + 8192)); } while (0)
#define PG8_STAGE_AH(bufoff, gbase, oh0, oh1, o0, o1) do { if constexpr (GATHER) PG8_STAGE_A(bufoff, gbase, oh0, oh1); else PG8_STAGE_A(bufoff, (gbase) + hstep, o0, o1); } while (0)
#define PG8_LDA(dst, b, h) do { _Pragma("unroll") for (int m = 0; m < (F8 ? 2 : 4); ++m) _Pragma("unroll") for (int k = 0; k < 2; ++k) dst[m][k] = *(const PG8_LAS bf16x8*)(lds + PG8_SA(b, h) + aoff + m * 2048 + k * 1024); } while (0)
#define PG8_MMA8H(ai, hf) do { __builtin_amdgcn_s_setprio(1); _Pragma("unroll") for (int mm = 0; mm < 2; ++mm) _Pragma("unroll") for (int n = 0; n < 2; ++n) { \
        acc[ai][0][2 * (hf) + mm][n] = __builtin_amdgcn_mfma_scale_f32_16x16x128_f8f6f4(cat8(B0[n][0], B0[n][1]), cat8(At[mm][0], At[mm][1]), acc[ai][0][2 * (hf) + mm][n], 0, 0, 0, 0, 0, 0); \
        acc[ai][1][2 * (hf) + mm][n] = __builtin_amdgcn_mfma_scale_f32_16x16x128_f8f6f4(cat8(B1[n][0], B1[n][1]), cat8(At[mm][0], At[mm][1]), acc[ai][1][2 * (hf) + mm][n], 0, 0, 0, 0, 0, 0); } __builtin_amdgcn_s_setprio(0); } while (0)
#define PG8_CMP(ai, b, h) do { if constexpr (F8) { PG8_MMA8H(ai, 0); PG8_SCHED; \
        _Pragma("unroll") for (int m = 0; m < 2; ++m) _Pragma("unroll") for (int k = 0; k < 2; ++k) At[m][k] = *(const PG8_LAS bf16x8*)(lds + PG8_SA(b, h) + aoff + (2 + m) * 2048 + k * 1024); \
        PG8_WAIT_L(0); PG8_SCHED; PG8_MMA8H(ai, 1); } else { PG8_MMA(ai, 0, At, B0); PG8_MMA(ai, 1, At, B1); } } while (0)
#define PG8_LDB(dst, b, h) do { _Pragma("unroll") for (int n = 0; n < 2; ++n) _Pragma("unroll") for (int k = 0; k < 2; ++k) dst[n][k] = *(const PG8_LAS bf16x8*)(lds + PG8_SB(b, h) + boff + n * 2048 + k * 1024); } while (0)
#define PG8_MMA(ai, bj, At, Bt) do { __builtin_amdgcn_s_setprio(1); _Pragma("unroll") for (int m = 0; m < 4; ++m) _Pragma("unroll") for (int n = 0; n < 2; ++n) _Pragma("unroll") for (int k = 0; k < 2; ++k) \
        acc[ai][bj][m][n] = __builtin_amdgcn_mfma_f32_16x16x32_bf16(Bt[n][k], At[m][k], acc[ai][bj][m][n], 0, 0, 0); __builtin_amdgcn_s_setprio(0); } while (0)
#define PG8_WAIT_V(n) asm volatile("s_waitcnt vmcnt(" #n ")" ::: "memory")
#define PG8_WAIT_L(n) asm volatile("s_waitcnt lgkmcnt(" #n ")" ::: "memory")
#define PG8_BAR __builtin_amdgcn_s_barrier()
#define PG8_SCHED __builtin_amdgcn_sched_barrier(0)
    Unit cur, nxt; int ui = 0;
    if (!S.next(0, cur)) return;
    f32x4 acc[2][2][4][2];
#pragma unroll
    for (int a = 0; a < 2; ++a)
#pragma unroll
        for (int b = 0; b < 2; ++b)
#pragma unroll
            for (int m = 0; m < 4; ++m)
#pragma unroll
                for (int n = 0; n < 2; ++n) { acc[a][b][m][n] = (f32x4){0.f, 0.f, 0.f, 0.f}; if constexpr (F8) asm volatile("" : "+v"(acc[a][b][m][n])); }
    bf16x8 At[F8 ? 2 : 4][2], B0[2][2], B1[2][2];
    unsigned oc00, oc01, oc10, oc11, on00, on01, on10, on11;
    const size_t kpb = (size_t)S.kplen * 2;
    const char* cA; const char* cB = (const char*)S.bt(cur) + (size_t)cur.pn * tstep + cur.kp * kpb;
    bool has_next = S.next(1, nxt);
    if constexpr (GATHER) {
        cA = (const char*)A;
        oc00 = (unsigned)(S.row(cur, RA[0]) * ldk + CA[0]) * 2u; oc01 = (unsigned)(S.row(cur, RA[1]) * ldk + CA[1]) * 2u;
        oc10 = (unsigned)(S.row(cur, HALF + RA[0]) * ldk + CA[0]) * 2u; oc11 = (unsigned)(S.row(cur, HALF + RA[1]) * ldk + CA[1]) * 2u;
        on00 = oc00; on01 = oc01; on10 = oc10; on11 = oc11;
    } else {
        cA = (const char*)A + (size_t)cur.pm * tstep + cur.kp * kpb;
        oc00 = on00 = (unsigned)(RA[0] * ldk + CA[0]) * 2u; oc01 = on01 = (unsigned)(RA[1] * ldk + CA[1]) * 2u; oc10 = on10 = oc00 + (unsigned)hstep; oc11 = on11 = oc01 + (unsigned)hstep;
    }
    PG8_STAGE_B(PG8_SB(0, 0), cB); PG8_STAGE_B(PG8_SB(0, 1), cB + hstep); PG8_STAGE_A(PG8_SA(0, 0), cA, oc00, oc01); PG8_STAGE_AH(PG8_SA(0, 1), cA, oc10, oc11, oc00, oc01);
    if (wr == 1) PG8_BAR;
    PG8_WAIT_V(2); PG8_BAR;
    PG8_STAGE_B(PG8_SB(1, 0), cB + kstep); PG8_STAGE_A(PG8_SA(1, 0), cA + kstep, oc00, oc01); PG8_STAGE_B(PG8_SB(1, 1), cB + hstep + kstep);
    PG8_WAIT_V(6); PG8_BAR;
    for (;;) {
        if constexpr (GATHER) {
            if (has_next) { on00 = (unsigned)(S.row(nxt, RA[0]) * ldk + CA[0]) * 2u; on01 = (unsigned)(S.row(nxt, RA[1]) * ldk + CA[1]) * 2u;
                            on10 = (unsigned)(S.row(nxt, HALF + RA[0]) * ldk + CA[0]) * 2u; on11 = (unsigned)(S.row(nxt, HALF + RA[1]) * ldk + CA[1]) * 2u; }
        }
        const char* nA = GATHER ? cA : (has_next ? (const char*)A + (size_t)nxt.pm * tstep + nxt.kp * kpb : cA);
        const char* nB = has_next ? (const char*)S.bt(nxt) + (size_t)nxt.pn * tstep + nxt.kp * kpb : cB;
#pragma unroll 1
        for (int t = 0; t < nt; t += 2) {
            const bool last = (t == nt - 2);
            const char* a1 = cA + (size_t)(t + 1) * kstep;
            const char* a2 = last ? nA : cA + (size_t)(t + 2) * kstep; const char* b2 = last ? nB : cB + (size_t)(t + 2) * kstep;
            const char* a3 = a2 + kstep; const char* b3 = b2 + kstep;
            unsigned s00 = oc00, s01 = oc01, s10 = oc10, s11 = oc11;
            if constexpr (GATHER) { if (last) { s00 = on00; s01 = on01; s10 = on10; s11 = on11; } }
            PG8_LDB(B0, 0, 0); PG8_LDB(B1, 0, 1); PG8_SCHED; PG8_LDA(At, 0, 0); PG8_STAGE_AH(PG8_SA(1, 1), a1, oc10, oc11, oc00, oc01);
            PG8_WAIT_V(8); PG8_WAIT_L(0); PG8_BAR; PG8_CMP(0, 0, 0); PG8_BAR; PG8_SCHED;
            PG8_LDA(At, 0, 1); PG8_STAGE_B(PG8_SB(0, 0), b2); PG8_STAGE_B(PG8_SB(0, 1), b2 + hstep); PG8_STAGE_A(PG8_SA(0, 0), a2, s00, s01);
            PG8_WAIT_V(8); PG8_WAIT_L(0); PG8_BAR; PG8_CMP(1, 0, 1); PG8_BAR; PG8_SCHED;
            PG8_LDB(B0, 1, 0); PG8_LDB(B1, 1, 1); PG8_SCHED; PG8_LDA(At, 1, 0); PG8_STAGE_AH(PG8_SA(0, 1), a2, s10, s11, s00, s01);
            PG8_WAIT_V(8); PG8_WAIT_L(0); PG8_BAR; PG8_CMP(0, 1, 0); PG8_BAR; PG8_SCHED;
            PG8_LDA(At, 1, 1); PG8_STAGE_B(PG8_SB(1, 0), b3); PG8_STAGE_B(PG8_SB(1, 1), b3 + hstep); PG8_STAGE_A(PG8_SA(1, 0), a3, s00, s01);
            PG8_WAIT_V(8); PG8_WAIT_L(0); PG8_BAR; PG8_CMP(1, 1, 1); PG8_BAR; PG8_SCHED;
        }
        if constexpr (ALIGN_EPI) { if (wr == 0) PG8_BAR; }
        { int l_ = my_tid() & 63; asm volatile("" : "+v"(l_)); E(acc, cur, wr, wc, l_ & 15, l_ >> 4); }
        if (!has_next) break;
#pragma unroll
        for (int a = 0; a < 2; ++a)
#pragma unroll
            for (int b = 0; b < 2; ++b)
#pragma unroll
                for (int m = 0; m < 4; ++m)
#pragma unroll
                    for (int n = 0; n < 2; ++n) { acc[a][b][m][n] = (f32x4){0.f, 0.f, 0.f, 0.f}; if constexpr (F8) asm volatile("" : "+v"(acc[a][b][m][n])); }
        cur = nxt; cA = nA; cB = nB; ++ui;
        if constexpr (GATHER) { oc00 = on00; oc01 = on01; oc10 = on10; oc11 = on11; }
        has_next = S.next(ui + 1, nxt);
        if constexpr (ALIGN_EPI) { if (wr == 1) PG8_BAR; }
    }
    PG8_WAIT_V(0);
    if constexpr (!ALIGN_EPI) { if (wr == 0) PG8_BAR; }
    PG8_BAR;
#undef PG8_SA
#undef PG8_SB
#undef PG8_STAGE_A
#undef PG8_STAGE_B
#undef PG8_LDA
#undef PG8_MMA8H
#undef PG8_CMP
#undef PG8_STAGE_AH
#undef PG8_LDB
#undef PG8_MMA
#undef PG8_WAIT_V
#undef PG8_WAIT_L
#undef PG8_BAR
#undef PG8_SCHED
}
}


#include <hip/hip_bf16.h>
namespace attn_body {
using bf16=__hip_bfloat16;
using bf16x8=__attribute__((ext_vector_type(8)))short;
using s16x4=__attribute__((ext_vector_type(4)))short;
using f32x16=__attribute__((ext_vector_type(16)))float;
using u32x4=__attribute__((ext_vector_type(4)))unsigned;
constexpr int D=64,DM=NP;
constexpr int NW=8,QBLK=32,QB=QBLK*NW,KVBLK=64;
__device__ __forceinline__ int crow(int r,int hi){return (r&3)+8*(r>>2)+4*hi;}
#define SBAR() __builtin_amdgcn_sched_barrier(0)
constexpr int NSLOT=3, SLOTB=8192;
constexpr int LDS_K=0, LDS_V=NSLOT*SLOTB, LDS_WS=2*NSLOT*SLOTB, LDS_OST=LDS_WS+NW*64*4, LDS_TAB=LDS_OST+NW*4096, LDS_BYTES=LDS_TAB+2048;
constexpr float C2=0.125f*1.4426950408889634f;
__device__ __forceinline__ void glds16(const void*gsrc,unsigned lds_dst){unsigned keep;
  asm volatile("s_mov_b32 %0, m0\n\ts_mov_b32 m0, %2\n\ts_nop 0\n\tglobal_load_lds_dwordx4 %1, off\n\ts_mov_b32 m0, %0":"=&s"(keep):"v"(gsrc),"s"(lds_dst):"memory");}
__device__ __forceinline__ float max3f(float a,float b,float c){float r;asm("v_max3_f32 %0, %1, %2, %3":"=v"(r):"v"(a),"v"(b),"v"(c));return r;}
__device__ __forceinline__ float max2f(float a,float b){float r;asm("v_max_f32_e32 %0, %1, %2":"=v"(r):"v"(a),"v"(b));return r;}
__device__ __forceinline__ float fadd_s(float a,float b){float r;asm("v_add_f32_e32 %0, %1, %2":"=v"(r):"v"(a),"v"(b));return r;}
__device__ __forceinline__ float fsub_s(float a,float b){float r;asm("v_sub_f32_e32 %0, %1, %2":"=v"(r):"v"(a),"v"(b));return r;}
typedef float f32x2_t __attribute__((ext_vector_type(2))); typedef __bf16 bf16x2_t __attribute__((ext_vector_type(2)));
__device__ __forceinline__ unsigned cvtpk_s(float lo,float hi){f32x2_t v={lo,hi};bf16x2_t b=__builtin_convertvector(v,bf16x2_t);return __builtin_bit_cast(unsigned,b);}
#define WAIT_BAR(N) asm volatile("s_waitcnt vmcnt(" #N ") lgkmcnt(0)\n\ts_barrier":::"memory")

__device__ __forceinline__ void qkt(f32x16&p0,f32x16&p1,const char*Kslot,const bf16x8*qr,const f32x16&negm,int r32,int hi){
  const char*kb=Kslot+hi*1024+r32*16;
  #pragma unroll
  for(int d0=0;d0<4;++d0){
    const bf16x8 b0=*reinterpret_cast<const bf16x8*>(kb+d0*2048);
    const bf16x8 b1=*reinterpret_cast<const bf16x8*>(kb+d0*2048+512);
    if(d0==0){p0=__builtin_amdgcn_mfma_f32_32x32x16_bf16(b0,qr[0],negm,0,0,0);p1=__builtin_amdgcn_mfma_f32_32x32x16_bf16(b1,qr[0],negm,0,0,0);}
    else{p0=__builtin_amdgcn_mfma_f32_32x32x16_bf16(b0,qr[d0],p0,0,0,0);p1=__builtin_amdgcn_mfma_f32_32x32x16_bf16(b1,qr[d0],p1,0,0,0);}}
}
typedef __attribute__((address_space(3))) const char* lds_cptr;
typedef short v4i16_t __attribute__((ext_vector_type(4)));
__device__ __forceinline__ void kload8(bf16x8*kf,lds_cptr kp){
  kf[0]=*(const __attribute__((address_space(3))) bf16x8*)(kp);      kf[1]=*(const __attribute__((address_space(3))) bf16x8*)(kp+512);
  kf[2]=*(const __attribute__((address_space(3))) bf16x8*)(kp+2048); kf[3]=*(const __attribute__((address_space(3))) bf16x8*)(kp+2560);
  kf[4]=*(const __attribute__((address_space(3))) bf16x8*)(kp+4096); kf[5]=*(const __attribute__((address_space(3))) bf16x8*)(kp+4608);
  kf[6]=*(const __attribute__((address_space(3))) bf16x8*)(kp+6144); kf[7]=*(const __attribute__((address_space(3))) bf16x8*)(kp+6656);
}
__device__ __forceinline__ void kload2(bf16x8*kf,lds_cptr kp,int j){ kf[2*j]=*(const __attribute__((address_space(3))) bf16x8*)(kp+j*2048); kf[2*j+1]=*(const __attribute__((address_space(3))) bf16x8*)(kp+j*2048+512); }
__device__ __forceinline__ s16x4 vtr(lds_cptr p){ return __builtin_bit_cast(s16x4,__builtin_amdgcn_ds_read_tr16_b64_v4i16((__attribute__((address_space(3))) v4i16_t*)p)); }
__device__ __forceinline__ float rowmax(const f32x16&p0,const f32x16&p1){
  float a=max3f(p0[0],p0[1],p1[0]),b=max3f(p0[2],p0[3],p1[1]);a=max3f(a,p1[2],p1[3]);
  #pragma unroll
  for(int r=4;r<16;r+=4){a=max3f(a,p0[r],p0[r+1]);b=max3f(b,p0[r+2],p0[r+3]);a=max3f(a,p1[r],p1[r+1]);b=max3f(b,p1[r+2],p1[r+3]);}
  const float m=max2f(a,b);
  auto rr=__builtin_amdgcn_permlane32_swap(__float_as_uint(m),__float_as_uint(m),false,false);
  return max2f(__uint_as_float(rr[0]),__uint_as_float(rr[1]));
}
__device__ __forceinline__ void pv(f32x16*o,int vb,bf16x8 pa0,bf16x8 pa1,bf16x8 pa2,bf16x8 pa3){
  #pragma unroll
  for(int d0=0;d0<2;++d0){s16x4 lo[4],hi[4];
    #pragma unroll
    for(int ks=0;ks<4;++ks){
      asm volatile("ds_read_b64_tr_b16 %0,%1 offset:%c2":"=&v"(lo[ks]):"v"(vb),"i"(d0*4096+ks*1024):"memory");
      asm volatile("ds_read_b64_tr_b16 %0,%1 offset:%c2":"=&v"(hi[ks]):"v"(vb),"i"(d0*4096+ks*1024+512):"memory");}
    asm volatile("s_waitcnt lgkmcnt(0)":::"memory");SBAR();
    #define PK(k) (bf16x8){lo[k][0],lo[k][1],lo[k][2],lo[k][3],hi[k][0],hi[k][1],hi[k][2],hi[k][3]}
    o[d0]=__builtin_amdgcn_mfma_f32_32x32x16_bf16(pa0,PK(0),o[d0],0,0,0);
    o[d0]=__builtin_amdgcn_mfma_f32_32x32x16_bf16(pa1,PK(1),o[d0],0,0,0);
    o[d0]=__builtin_amdgcn_mfma_f32_32x32x16_bf16(pa2,PK(2),o[d0],0,0,0);
    o[d0]=__builtin_amdgcn_mfma_f32_32x32x16_bf16(pa3,PK(3),o[d0],0,0,0);
    #undef PK
  }
}

#ifndef ATTN_STORE16
#define ATTN_STORE16(p,v) (*(u32x4*)(p)=(v))
#endif
__device__ __forceinline__ void na_mask(f32x16&P0,f32x16&P1,int tl,int klo,int nlat,int wr0,int qgr,int qcol,int cs,int hi,float mhat,const float*tab){
  if(tl<0){
    #pragma unroll
    for(int r=0;r<16;++r){P0[r]-=mhat;P1[r]-=mhat;}
    return; }
  const int krow=klo+tl; const bool rv=(tl<nlat)&&(krow>=wr0)&&(krow<wr0+8);
  if(!rv){
    #pragma unroll
    for(int r=0;r<16;++r){P0[r]=-INFINITY;P1[r]=-INFINITY;}
    return; }
  int hio=hi; asm volatile("":"+v"(hio));
  const float*tb=tab+(krow-qgr+7)*31+15-qcol+4*hio; const int kb=4*hio-cs;
  #pragma unroll
  for(int r=0;r<16;++r){ const int c0=(r&3)+8*(r>>2);
    const bool v0=(unsigned)(c0+kb)<16u, v1=(unsigned)(c0+32+kb)<16u;
    const float b0=tb[c0], b1=tb[c0+32];
    P0[r]=v0?(P0[r]-mhat)+b0:-INFINITY; P1[r]=v1?(P1[r]-mhat)+b1:-INFINITY; }
}
template<int THRL,int MODE> __device__ __forceinline__ void attn_unit(const int b,const int qrow0,const int klo,const int NT,const int nlat,const bf16*Qg,const bf16*__restrict__ Kg,const bf16*__restrict__ Vg,bf16*Og,const float*rpb,char*shm){
  int tid_=my_tid(); asm volatile("":"+v"(tid_));
  const int tid=tid_,lane=tid&63,r32=lane&31,hi=lane>>5; const int wid=__builtin_amdgcn_readfirstlane(tid>>6);
  const bf16*Qw=Qg+((long)qrow0+wid*QBLK)*DM;
  #define TROW(t) ((long)(MODE==0 ? ((t)<S/64 ? (long)b*S+64*(t) : (long)MX+(long)b*LC+64*((t)-S/64)) : MODE==1 ? ((t)<LC/64 ? (long)MX+(long)b*LC+64*(t) : (long)b*S+64*(klo+((t)-LC/64<nlat?(t)-LC/64:nlat-1))) : (long)MX+(long)b*LC+64*(t)))
  const unsigned lds0=(unsigned)(uintptr_t)shm;
  float*wsf=(float*)(shm+LDS_WS)+wid*64;
  const bf16*ksrc=Kg+(long)lane*DM+wid*8;
  const bf16*vsrc=Vg+(long)(16*(wid&3)+(lane>>2))*DM+(wid>>2)*32+(lane&3)*8;
  const unsigned kdst=lds0+LDS_K+wid*1024, vdst=lds0+LDS_V+wid*1024;
  #define DMA_K(t,slot) glds16(ksrc+TROW(t)*DM,(unsigned)__builtin_amdgcn_readfirstlane(kdst+(slot)))
  #define DMA_V(t,slot) glds16(vsrc+TROW(t)*DM,(unsigned)__builtin_amdgcn_readfirstlane(vdst+(slot)))
  const int vb0=(int)(lds0+LDS_V)+((lane>>4)&1)*32+(lane&3)*8+(4*hi+((lane&15)>>2))*64;
  const char*Kbase=shm+LDS_K; bf16x8 kf[8];
  const lds_cptr shm3=(lds_cptr)shm; const lds_cptr kp0=shm3+LDS_K+hi*1024+r32*16; const lds_cptr vp0=shm3+LDS_V+((lane>>4)&1)*32+(lane&3)*8+(4*hi+((lane&15)>>2))*64;
  DMA_K(0,0);DMA_V(0,0);DMA_K(1,SLOTB);
  bf16x8 qr[4];
  #pragma unroll
  for(int d0=0;d0<4;++d0)qr[d0]=*reinterpret_cast<const bf16x8*>(&Qw[(long)r32*DM+d0*16+hi*8]);
  float mhat=0.f,l_reg=0.f;f32x16 o[2];o[0]=f32x16{};o[1]=f32x16{};f32x16 negm=f32x16{}; if(MODE!=1){asm volatile("":"+v"(negm));} const f32x16 zero16_=f32x16{};
  #define NEGM_ (MODE==1?zero16_:negm)
  const int qcol=32*(wid&1)+r32, qgr=(qrow0%S)/64+(wid>>1); int cs_=qcol-8; cs_=cs_<0?0:(cs_>48?48:cs_); int wr0_=qgr-4; wr0_=wr0_<0?0:(wr0_>S/64-8?S/64-8:wr0_);
  const float*tab=(const float*)(shm+LDS_TAB);
  if(MODE==1){ for(int i_=tid;i_<15*31;i_+=512)((float*)(shm+LDS_TAB))[i_]=rpb[i_]*1.4426950408889634f; }
  #define CMASK(P0,P1,t) do{ if(MODE==1){ na_mask(P0,P1,(t)-LC/64,klo,nlat,wr0_,qgr,qcol,cs_,hi,mhat,tab); } }while(0)
  bool resc=false;
  #define START(P0,P1) do{ const float rm=rowmax(P0,P1); resc=false; \
    { const float dl=rm; mhat=fadd_s(mhat,dl); \
      _Pragma("unroll") for(int r=0;r<16;++r){P0[r]=fsub_s(P0[r],dl);P1[r]=fsub_s(P1[r],dl);} \
      if(MODE!=1){ _Pragma("unroll") for(int r=0;r<16;++r)negm[r]=-mhat; asm volatile("":"+v"(negm)); } } \
    _Pragma("unroll") for(int r=0;r<16;++r)P0[r]=__builtin_amdgcn_exp2f(P0[r]); }while(0)
  #define RESC() do{ if(resc){ asm volatile("s_waitcnt lgkmcnt(0)":::"memory"); \
      _Pragma("unroll") for(int d_=0;d_<2;++d_) _Pragma("unroll") for(int r=0;r<16;++r)o[d_][r]*=wsf[crow(r,hi)]; } }while(0)
  f32x16 pA0,pA1,pB0,pB1;
  int sl_prev=0,sl_cur=0,sl_next=SLOTB;
  #define ROT() do{sl_prev=sl_cur;sl_cur=sl_next;sl_next=(sl_next==(NSLOT-1)*SLOTB)?0:sl_next+SLOTB;}while(0)
  DMA_K(2,2*SLOTB);
  WAIT_BAR(3);
  qkt(pA0,pA1,Kbase,qr,NEGM_,r32,hi);asm volatile("s_nop 15\n\ts_nop 7":"+v"(pA0),"+v"(pA1));CMASK(pA0,pA1,0);
  START(pA0,pA1);
  _Pragma("unroll") for(int r=0;r<16;++r)pA1[r]=__builtin_amdgcn_exp2f(pA1[r]);
  WAIT_BAR(0);
  DMA_K(3,0);DMA_V(1,SLOTB);
  ROT();
  kload8(kf,kp0+sl_cur);
  WAIT_BAR(2);
  s16x4 vlo[8],vhi[8]; u32x4 pw0,pw1,pw2,pw3;
  #define PKW(P,B) cvtpk_s(P[B],P[B+1])
  #define PAF(k) __builtin_bit_cast(bf16x8,pw##k)
  #define VFR(i) (bf16x8){vlo[i][0],vlo[i][1],vlo[i][2],vlo[i][3],vhi[i][0],vhi[i][1],vhi[i][2],vhi[i][3]}
  #define PIN(x) asm volatile("":"+v"(x))
  #define MX3(a,b,c) __builtin_fmaxf(__builtin_fmaxf((a),(b)),(c))
  #define GAPA(MF,A0,A1,A2,A3,W0,W1,PW) do{ MF; sacc+=A0; sacc+=A1; sacc+=A2; sacc+=A3; PIN(sacc); W0; W1; PIN(PW); SBAR(); }while(0)
  #define EX(v) __builtin_amdgcn_exp2f(v)
  #define GAPB(MF,X,B) do{ MF; X[B]=EX(X[B]); X[B+1]=EX(X[B+1]); X[B+2]=EX(X[B+2]); X[B+3]=EX(X[B+3]); PIN(X); SBAR(); }while(0)
  #define VRD(i) do{ vlo[i]=vtr(vp_+(((i)>>2)*4096+((i)&3)*1024)); vhi[i]=vtr(vp_+(((i)>>2)*4096+((i)&3)*1024+512)); }while(0)
  #define KRD(G,j) do{ if(G){ kload2(kf,kp0+sl_next,j); SBAR(); } }while(0)
  #define STEP(C0,C1,P0,P1,t,GK,GV,GL) do{ SBAR(); \
    const lds_cptr vp_=vp0+sl_prev; \
    VRD(0); SBAR(); float sacc=(P0[0]+P0[1]); \
    GAPA(C0=__builtin_amdgcn_mfma_f32_32x32x16_bf16(kf[0],qr[0],NEGM_,0,0,0), P0[2],P0[3],P0[4],P0[5],     pw0[0]=PKW(P0,0), pw0[1]=PKW(P0,2), pw0); \
    VRD(4); SBAR(); GAPA(C1=__builtin_amdgcn_mfma_f32_32x32x16_bf16(kf[1],qr[0],NEGM_,0,0,0), P0[6],P0[7],P0[8],P0[9],     pw0[2]=PKW(P0,4), pw0[3]=PKW(P0,6), pw0); \
    VRD(1); SBAR(); GAPA(C0=__builtin_amdgcn_mfma_f32_32x32x16_bf16(kf[2],qr[1],C0,0,0,0),   P0[10],P0[11],P0[12],P0[13], pw1[0]=PKW(P0,8), pw1[1]=PKW(P0,10), pw1); \
    VRD(5); SBAR(); GAPA(C1=__builtin_amdgcn_mfma_f32_32x32x16_bf16(kf[3],qr[1],C1,0,0,0),   P0[14],P0[15],P1[0],P1[1],   pw1[2]=PKW(P0,12),pw1[3]=PKW(P0,14), pw1); \
    VRD(2); SBAR(); GAPA(C0=__builtin_amdgcn_mfma_f32_32x32x16_bf16(kf[4],qr[2],C0,0,0,0),   P1[2],P1[3],P1[4],P1[5],     pw2[0]=PKW(P1,0), pw2[1]=PKW(P1,2), pw2); \
    VRD(6); SBAR(); GAPA(C1=__builtin_amdgcn_mfma_f32_32x32x16_bf16(kf[5],qr[2],C1,0,0,0),   P1[6],P1[7],P1[8],P1[9],     pw2[2]=PKW(P1,4), pw2[3]=PKW(P1,6), pw2); \
    VRD(3); SBAR(); GAPA(C0=__builtin_amdgcn_mfma_f32_32x32x16_bf16(kf[6],qr[3],C0,0,0,0),   P1[10],P1[11],P1[12],P1[13], pw3[0]=PKW(P1,8), pw3[1]=PKW(P1,10), pw3); \
    VRD(7); SBAR(); GAPA(C1=__builtin_amdgcn_mfma_f32_32x32x16_bf16(kf[7],qr[3],C1,0,0,0),   P1[14],P1[15],0.f,0.f,       pw3[2]=PKW(P1,12),pw3[3]=PKW(P1,14), pw3); \
    l_reg+=sacc; \
    if(GK){DMA_K((t)+3,sl_cur);} if(GV){DMA_V((t)+1,sl_next);} \
    CMASK(C0,C1,t); \
    { float a=MX3(C0[0],C0[1],C1[0]),b=MX3(C0[2],C0[3],C1[1]); a=MX3(a,C1[2],C1[3]); \
      _Pragma("unroll") for(int r=4;r<16;r+=4){a=MX3(a,C0[r],C0[r+1]);b=MX3(b,C0[r+2],C0[r+3]);a=MX3(a,C1[r],C1[r+1]);b=MX3(b,C1[r+2],C1[r+3]);} \
      float rm=__builtin_fmaxf(a,b); { auto rr=__builtin_amdgcn_permlane32_swap(__float_as_uint(rm),__float_as_uint(rm),false,false); rm=__builtin_fmaxf(__uint_as_float(rr[0]),__uint_as_float(rr[1])); } \
      resc=false; \
      if(__builtin_expect(__any(rm>(float)THRL),0)){ const float dl=__builtin_fmaxf(rm,0.f); mhat+=dl; \
        _Pragma("unroll") for(int r=0;r<16;++r){C0[r]-=dl;C1[r]-=dl;} \
        if(MODE!=1){ _Pragma("unroll") for(int r=0;r<16;++r)negm[r]=-mhat; asm volatile("":"+v"(negm)); } \
        const float f=__builtin_amdgcn_exp2f(-dl); l_reg*=f; if(hi==0)wsf[r32]=f; resc=true; } } \
    SBAR(); \
    GAPB(o[0]=__builtin_amdgcn_mfma_f32_32x32x16_bf16(PAF(0),VFR(0),o[0],0,0,0), C0,0); \
    GAPB(o[1]=__builtin_amdgcn_mfma_f32_32x32x16_bf16(PAF(0),VFR(4),o[1],0,0,0), C0,4); \
    KRD(GL,0); GAPB(o[0]=__builtin_amdgcn_mfma_f32_32x32x16_bf16(PAF(1),VFR(1),o[0],0,0,0), C0,8); \
    KRD(GL,1); GAPB(o[1]=__builtin_amdgcn_mfma_f32_32x32x16_bf16(PAF(1),VFR(5),o[1],0,0,0), C0,12); \
    KRD(GL,2); GAPB(o[0]=__builtin_amdgcn_mfma_f32_32x32x16_bf16(PAF(2),VFR(2),o[0],0,0,0), C1,0); \
    KRD(GL,3); GAPB(o[1]=__builtin_amdgcn_mfma_f32_32x32x16_bf16(PAF(2),VFR(6),o[1],0,0,0), C1,4); \
    GAPB(o[0]=__builtin_amdgcn_mfma_f32_32x32x16_bf16(PAF(3),VFR(3),o[0],0,0,0), C1,8); \
    GAPB(o[1]=__builtin_amdgcn_mfma_f32_32x32x16_bf16(PAF(3),VFR(7),o[1],0,0,0), C1,12); \
    }while(0)
  int t=1;
  #undef CMASK
  #define CMASK(P0,P1,t) do{ if(MODE==1){ na_mask(P0,P1,(t)-LC/64,klo,nlat,wr0_,qgr,qcol,cs_,hi,mhat,tab); } }while(0)
  for(;t+5<NT;t+=2){
    STEP(pB0,pB1,pA0,pA1,t,true,true,true);     WAIT_BAR(2); RESC(); ROT();
    STEP(pA0,pA1,pB0,pB1,t+1,true,true,true);   WAIT_BAR(2); RESC(); ROT();
  }
  #undef CMASK
  #define CMASK(P0,P1,t) do{ if(MODE==1){ na_mask(P0,P1,(t)-LC/64,klo,nlat,wr0_,qgr,qcol,cs_,hi,mhat,tab); } }while(0)
  #define ENDW(tt) do{ if((tt)+3<NT){WAIT_BAR(2);} else if((tt)+2<NT){WAIT_BAR(1);} else {WAIT_BAR(0);} }while(0)
  for(;t+1<NT;t+=2){
    STEP(pB0,pB1,pA0,pA1,t,(t+3<NT),(t+1<NT),(t+1<NT));       ENDW(t);   RESC(); ROT();
    STEP(pA0,pA1,pB0,pB1,t+1,(t+4<NT),(t+2<NT),(t+2<NT));     ENDW(t+1); RESC(); ROT();
  }
  STEP(pB0,pB1,pA0,pA1,NT-1,false,false,false); RESC();
  { float sacc=pB0[0]+pB0[1]; _Pragma("unroll") for(int r=2;r<16;++r)sacc+=pB0[r]; _Pragma("unroll") for(int r=0;r<16;++r)sacc+=pB1[r]; l_reg+=sacc;
    pw0=(u32x4){PKW(pB0,0),PKW(pB0,2),PKW(pB0,4),PKW(pB0,6)};pw1=(u32x4){PKW(pB0,8),PKW(pB0,10),PKW(pB0,12),PKW(pB0,14)};pw2=(u32x4){PKW(pB1,0),PKW(pB1,2),PKW(pB1,4),PKW(pB1,6)};pw3=(u32x4){PKW(pB1,8),PKW(pB1,10),PKW(pB1,12),PKW(pB1,14)};
    SBAR(); pv(o,vb0+sl_cur,PAF(0),PAF(1),PAF(2),PAF(3)); }
  #undef PKW
  #undef PAF
  #undef VFR
  #undef PIN
  #undef MX3
  #undef GAPA
  #undef GAPB
  #undef EX
  #undef VRD
  #undef KRD
  #undef STEP
  #undef ENDW
  {auto rr=__builtin_amdgcn_permlane32_swap(__float_as_uint(l_reg),__float_as_uint(l_reg),false,false);l_reg=__uint_as_float(rr[0])+__uint_as_float(rr[1]);}
  if(hi==0)wsf[32+r32]=l_reg;asm volatile("s_waitcnt lgkmcnt(0)":::"memory");
  float rli[16];
  #pragma unroll
  for(int r=0;r<16;++r)rli[r]=__builtin_amdgcn_rcpf(wsf[32+crow(r,hi)]);
  bf16*Ow=Og+((long)qrow0+wid*QBLK)*DM;
  { bf16*stg=(bf16*)(shm+LDS_OST)+wid*2048;
    #pragma unroll
    for(int r=0;r<16;++r){const int orow=crow(r,hi);
      #pragma unroll
      for(int d0=0;d0<2;++d0)stg[orow*64+d0*32+r32]=__float2bfloat16(o[d0][r]*rli[r]);}
    asm volatile("s_waitcnt lgkmcnt(0)":::"memory");
    #pragma unroll
    for(int i=0;i<4;++i){const int row=i*8+(lane>>3),ch=lane&7; const u32x4 v=*(const u32x4*)(stg+row*64+ch*8); ATTN_STORE16(Ow+(long)row*DM+ch*8,v);} }
  asm volatile("s_waitcnt lgkmcnt(0)\n\ts_barrier":::"memory");
  #undef DMA_K
  #undef NEGM_
  #undef TROW
  #undef DMA_V
  #undef CMASK
  #undef START
  #undef RESC
  #undef ROT
}
constexpr int ATTN_LDS_BYTES=LDS_BYTES;
#undef SBAR
#undef WAIT_BAR
}
__device__ __forceinline__ int pull_unit(int* ctr, LAS unsigned char* lds) {
    volatile LAS int* slot = (volatile LAS int*)(lds + (147456 - 512) + 16);
    __syncthreads();
    if (my_tid() == 0) *slot = __hip_atomic_fetch_add(ctr, 1, __ATOMIC_RELAXED, __HIP_MEMORY_SCOPE_AGENT);
    __syncthreads();
    return __builtin_amdgcn_readfirstlane(*slot);
}
template <int PART> __device__ __forceinline__ void attn_phase(const Prm& p, int l, char* shm, int G) {
    using namespace attn_body;
    const int bx = blockIdx.x, vcu = (G % 8 == 0) ? (bx % 8) * (G / 8) + bx / 8 : bx;
    const attn_body::bf16* Pb = (const attn_body::bf16*)p.P;
    constexpr int NQB = S / 256;
    if constexpr (PART == 0) for (int u = vcu * 2; u < NB * NGA * NQB; u += 2 * G) {
#pragma unroll 1
        for (int j = 0; j < 2; ++j) { const int uu = u + j; if (uu >= NB * NGA * NQB) break; const int qb = uu % NQB, h = (uu / NQB) % NGA, b = uu / (NQB * NGA);
            attn_unit<8, 0>(b, b * S + 256 * qb, 0, S / 64 + LC / 64, 0, Pb + PC_GAQ + 64 * h, Pb + PC_GAK + 64 * h, Pb + PC_GAV + 64 * h, (attn_body::bf16*)Pb + PC_GAQ + 64 * h, nullptr, shm); }
    }
    if constexpr (PART == 1) {
        for (;;) { const int uu = pull_unit(p.ctl + 32 + 2 * l + 1, (LAS unsigned char*)shm); if (uu >= NB * NNA * NQB) break; const int qb = uu % NQB, h = (uu / NQB) % NNA, b = uu / (NQB * NNA);
            const int r0 = 4 * qb; int klo = r0 - 4; klo = klo < 0 ? 0 : (klo > ROWS - 8 ? ROWS - 8 : klo); int khi = r0 + 3 - 4; khi = (khi < 0 ? 0 : (khi > ROWS - 8 ? ROWS - 8 : khi)) + 7;
            const int nlat = khi - klo + 1, NT = (LC / 64 + nlat + 1) & ~1;
            attn_unit<8, 1>(b, b * S + 256 * qb, klo, NT, nlat, Pb + PC_NAQ + 64 * h, Pb + PC_NAK + 64 * h, Pb + PC_NAV + 64 * h, (attn_body::bf16*)Pb + PC_NAQ + 64 * h, p.na_rpb + ((size_t)l * NNA + h) * 15 * 31, shm); }
    }
    if constexpr (PART == 2) {
        static_assert(LC == 256, "context unit = one 256-row query block");
        for (int u = vcu; u < NB * (NNA + NGA); u += G) { const int hh = u % (NNA + NGA), b = u / (NNA + NGA);
            const int qo = hh < NNA ? PC_NAQ + 64 * hh : PC_GAQ + 64 * (hh - NNA), ko = hh < NNA ? PC_NAK + 64 * hh : PC_GAK + 64 * (hh - NNA), vo = hh < NNA ? PC_NAV + 64 * hh : PC_GAV + 64 * (hh - NNA);
            attn_unit<8, 2>(b, MX + b * LC, 0, LC / 64, 0, Pb + qo, Pb + ko, Pb + vo, (attn_body::bf16*)Pb + qo, nullptr, shm); }
    }
}


namespace hy {
typedef short bf16x8 __attribute__((ext_vector_type(8)));
typedef short s16x4 __attribute__((ext_vector_type(4)));
typedef float f32x16 __attribute__((ext_vector_type(16)));
typedef float f32x4 __attribute__((ext_vector_type(4)));
typedef unsigned u32x4 __attribute__((ext_vector_type(4)));
constexpr int NBLK = S / 128, FTP = 2 * S + 8, L_V = 0, L_F = NB * S * 2, FCOPY = 2 * S * 2 + 64, L_END = L_F + 3 * FCOPY + 2 * S * 2;
static_assert(NBLK == 32 && NB == 8, "hyena unit geometry: 32 sequence blocks of 128, 8 batches");
__device__ __forceinline__ void hyena_unit(const bf16* vg, const bf16* fg, float* yg, LAS unsigned char* lds) {
    int tid_ = my_tid(); asm volatile("" : "+v"(tid_));
    const int tid = tid_, wid = __builtin_amdgcn_readfirstlane(tid >> 6), lane = tid & 63, n = lane & 31, hi = lane >> 5;
#pragma unroll
    for (int i = 0; i < 8; ++i) { const int q = i * 512 + tid, rowg = q >> 4, ch = q & 15, rowL = (rowg & 31) * 8 + (rowg >> 5);
        const u32x4 v = *(const u32x4*)(vg + (size_t)q * 8); *(LAS u32x4*)(lds + L_V + rowL * 256 + ((ch ^ (rowL & 15)) << 4)) = v; }
#pragma unroll
    for (int i = 0; i < 2; ++i) { const int g = i * 512 + tid; const u32x4 a = *(const u32x4*)(fg + 8 * g), b = *(const u32x4*)(fg + 8 * g + 8);
        const unsigned w[8] = {a.x, a.y, a.z, a.w, b.x, b.y, b.z, b.w};
        u32x4 c1, c3;
#pragma unroll
        for (int k = 0; k < 4; ++k) { c1[k] = __builtin_amdgcn_alignbit(w[k + 1], w[k], 16); c3[k] = __builtin_amdgcn_alignbit(w[k + 2], w[k + 1], 16); }
        *(LAS u32x4*)(lds + L_F + 0 * FCOPY + g * 16) = a; *(LAS u32x4*)(lds + L_F + 1 * FCOPY + g * 16) = c1;
        *(LAS u32x4*)(lds + L_F + 2 * FCOPY + g * 16) = (u32x4){a.y, a.z, a.w, b.x}; *(LAS u32x4*)(lds + L_F + 3 * FCOPY + g * 16) = c3; }
    __syncthreads();
    SEG(50);
    f32x16 acc[4];
#pragma unroll
    for (int m = 0; m < 4; ++m) acc[m] = f32x16{};
    const int I0 = 4 * wid, I = I0 + (n >> 3), bb = n & 7;
    if (wid >= 4) __builtin_amdgcn_s_setprio(2);
#pragma unroll 1
    for (int cs = 0; cs < NBLK; ++cs) {
        const int rowL = ((I - cs) & 31) * 8 + bb;
        bf16x8 Bf[8];
#pragma unroll
        for (int s = 0; s < 8; ++s) Bf[s] = *(const LAS bf16x8*)(lds + L_V + rowL * 256 + (((2 * s + hi) ^ (rowL & 15)) << 4));
#pragma unroll 1
        for (int pass = 0; pass < 2; ++pass) {
            const bool any = pass == 0 ? (I0 + 3 >= cs) : (I0 < cs);
            if (!any) continue;
            const bool valid = pass == 0 ? (I >= cs) : (I < cs); const int d = pass == 0 ? cs : cs - NBLK;
            const int xb = S - 128 * d - 96 - n + 8 * hi, rho = xb & 3;
            const LAS unsigned char* fa = lds + L_F + rho * FCOPY + 2 * (xb - rho);
            bf16x8 Af[14];
#pragma unroll
            for (int o = 0; o < 14; ++o) { const s16x4 lo = *(const LAS s16x4*)(fa + (13 - o) * 32), hh = *(const LAS s16x4*)(fa + (13 - o) * 32 + 8);
                Af[o] = (bf16x8){lo[0], lo[1], lo[2], lo[3], hh[0], hh[1], hh[2], hh[3]}; }
            const bool straddle = (I0 < cs) && (I0 + 3 >= cs);
            if (!straddle) {
#pragma unroll
                for (int s = 0; s < 8; ++s)
#pragma unroll
                    for (int m = 0; m < 4; ++m) acc[m] = __builtin_amdgcn_mfma_f32_32x32x16_bf16(Af[2 * m - s + 7], Bf[s], acc[m], 0, 0, 0);
            } else {
                bf16x8 Bm[8];
#pragma unroll
                for (int s = 0; s < 8; ++s) Bm[s] = valid ? Bf[s] : (bf16x8){0, 0, 0, 0, 0, 0, 0, 0};
#pragma unroll
                for (int s = 0; s < 8; ++s)
#pragma unroll
                    for (int m = 0; m < 4; ++m) acc[m] = __builtin_amdgcn_mfma_f32_32x32x16_bf16(Af[2 * m - s + 7], Bm[s], acc[m], 0, 0, 0);
            }
        }
    }
    __builtin_amdgcn_s_setprio(0);
    __syncthreads();
    SEG(51);
    LAS unsigned char* st = lds + wid * 16384;
#pragma unroll
    for (int m = 0; m < 4; ++m)
#pragma unroll
        for (int g = 0; g < 4; ++g) { const int q = 8 * m + 2 * g + hi; *(LAS f32x4*)(st + n * 512 + ((q ^ n) << 4)) = (f32x4){acc[m][4 * g], acc[m][4 * g + 1], acc[m][4 * g + 2], acc[m][4 * g + 3]}; }
    asm volatile("s_waitcnt lgkmcnt(0)" ::: "memory");
#pragma unroll
    for (int i = 0; i < 16; ++i) { const int rn = 2 * i + hi, q = n; const f32x4 v = *(const LAS f32x4*)(st + rn * 512 + ((q ^ rn) << 4));
        *(f32x4*)(yg + (size_t)(rn & 7) * S + (I0 + (rn >> 3)) * 128 + 4 * q) = v; }
    __syncthreads();
    SEG(52);
}
}
__device__ __forceinline__ void hyena_phase(const Prm& p, int l, LAS unsigned char* lds, int G) {
    (void)G;
    for (;;) { const int c = pull_unit(p.ctl + 32 + 2 * l, lds); if (c >= DHY) break;
        hy::hyena_unit(p.VT + (size_t)c * NB * S, p.FT + ((size_t)l * DHY + c) * hy::FTP, p.YC + (size_t)c * NB * S, lds); }
}


namespace thin {
typedef float f32x4 __attribute__((ext_vector_type(4)));
typedef unsigned u32x4 __attribute__((ext_vector_type(4)));
typedef unsigned u32x2 __attribute__((ext_vector_type(2)));
typedef unsigned u32x3a __attribute__((ext_vector_type(3), aligned(4)));
__device__ __forceinline__ float wave_sum(float v) {
#pragma unroll
    for (int o = 1; o < 64; o <<= 1) v += __shfl_xor(v, o);
    return v;
}
__device__ __forceinline__ unsigned pk2(float lo, float hi) { return f2bf_u(lo) | (f2bf_u(hi) << 16); }
__device__ __forceinline__ float lo16(unsigned u) { return __uint_as_float(u << 16); }
__device__ __forceinline__ float hi16(unsigned u) { return __uint_as_float(u & 0xffff0000u); }

__device__ __forceinline__ void transpose_item(const float* W, int K, int N, bf16* WT, int k0, int n0, int drow0, int drow1, LAS float* scr, int lane) {
    const int lr = lane >> 4, lc = 4 * (lane & 15);
    f32x4 v[16];
#pragma unroll
    for (int i = 0; i < 16; ++i) v[i] = __builtin_nontemporal_load((const f32x4*)(W + (size_t)(k0 + 4 * i + lr) * N + n0 + lc));
#pragma unroll
    for (int i = 0; i < 16; ++i) { LAS float* d = scr + (4 * i + lr) * 65 + lc; d[0] = v[i].x; d[1] = v[i].y; d[2] = v[i].z; d[3] = v[i].w; }
    asm volatile("s_waitcnt lgkmcnt(0)" ::: "memory");
    const int c = lane & 7;
#pragma unroll
    for (int j = 0; j < 8; ++j) { const int n = (lane >> 3) + 8 * j; const LAS float* sp = scr + (8 * c) * 65 + n;
        u32x4 o; o.x = pk2(sp[0 * 65], sp[1 * 65]); o.y = pk2(sp[2 * 65], sp[3 * 65]); o.z = pk2(sp[4 * 65], sp[5 * 65]); o.w = pk2(sp[6 * 65], sp[7 * 65]);
        *(u32x4*)(WT + (size_t)(n < 32 ? drow0 + n : drow1 + n - 32) * K + k0 + 8 * c) = o; }
    asm volatile("s_waitcnt lgkmcnt(0)" ::: "memory");
}
__device__ __forceinline__ void transpose_item8(const float* W, int K, int N, unsigned char* WT, int k0, int n0, int drow0, int drow1, float scale, LAS float* scr, int lane) {
    const int lr = lane >> 4, lc = 4 * (lane & 15);
    f32x4 v[16];
#pragma unroll
    for (int i = 0; i < 16; ++i) v[i] = __builtin_nontemporal_load((const f32x4*)(W + (size_t)(k0 + 4 * i + lr) * N + n0 + lc));
#pragma unroll
    for (int i = 0; i < 16; ++i) { LAS float* d = scr + (4 * i + lr) * 65 + lc; d[0] = v[i].x; d[1] = v[i].y; d[2] = v[i].z; d[3] = v[i].w; }
    asm volatile("s_waitcnt lgkmcnt(0)" ::: "memory");
    const int c = lane & 3;
#pragma unroll
    for (int j = 0; j < 4; ++j) { const int n = (lane >> 2) + 16 * j; const LAS float* sp = scr + (16 * c) * 65 + n;
        u32x4 o;
        o.x = pg8::pk4_fp8(sp[0 * 65] * scale, sp[1 * 65] * scale, sp[2 * 65] * scale, sp[3 * 65] * scale); o.y = pg8::pk4_fp8(sp[4 * 65] * scale, sp[5 * 65] * scale, sp[6 * 65] * scale, sp[7 * 65] * scale);
        o.z = pg8::pk4_fp8(sp[8 * 65] * scale, sp[9 * 65] * scale, sp[10 * 65] * scale, sp[11 * 65] * scale); o.w = pg8::pk4_fp8(sp[12 * 65] * scale, sp[13 * 65] * scale, sp[14 * 65] * scale, sp[15 * 65] * scale);
        *(u32x4*)(WT + (size_t)(n < 32 ? drow0 + n : drow1 + n - 32) * K + k0 + 16 * c) = o; }
    asm volatile("s_waitcnt lgkmcnt(0)" ::: "memory");
}
__device__ __forceinline__ void transpose_matrix(const float* W, int K, int N, bf16* WT, int mode, LAS float* scr, int lane, int gw, int ngw, int& rot) {
    const int nkb = K / 64, nnb = N / 64, items = nkb * nnb;
    for (int it = (gw + ngw - rot % ngw) % ngw; it < items; it += ngw) { const int kb = it / nnb, nb = it % nnb, n0 = 64 * nb;
        const int drow0 = mode == 3 ? (n0 & ~255) + 32 * ((n0 & 255) >> 6) : (mode == 0 ? n0 : 256 * (n0 / 128) + (n0 % 128) + (mode == 2 ? 128 : 0));
        transpose_item(W, K, N, WT, 64 * kb, n0, drow0, mode == 3 ? drow0 + 128 : drow0 + 32, scr, lane); }
    rot += items;
}
__device__ __forceinline__ void transpose_matrix8(const float* W, int K, int N, unsigned char* WT, int mode, float scale, LAS float* scr, int lane, int gw, int ngw, int& rot) {
    const int nkb = K / 64, nnb = N / 64, items = nkb * nnb;
    for (int it = (gw + ngw - rot % ngw) % ngw; it < items; it += ngw) { const int kb = it / nnb, nb = it % nnb, n0 = 64 * nb;
        const int drow0 = mode == 0 ? n0 : 256 * (n0 / 128) + (n0 % 128) + (mode == 2 ? 128 : 0);
        transpose_item8(W, K, N, WT, 64 * kb, n0, drow0, drow0 + 32, scale, scr, lane); }
    rot += items;
}
__device__ __forceinline__ void wconv_phase(const Prm& p, LAS unsigned char* lds, int G) {
    int tid_ = my_tid(); asm volatile("" : "+v"(tid_));
    const int wid = __builtin_amdgcn_readfirstlane(tid_ >> 6), lane = tid_ & 63, gw = blockIdx.x * 8 + wid, ngw = G * 8;
    LAS float* scr = (LAS float*)(lds + wid * (64 * 65 * 4));
    int rot = 0;
    for (int l = 0; l < NL; ++l) {
        transpose_matrix(p.w_in + (size_t)l * D * NP, D, NP, p.WinT + (size_t)l * NP * D, 3, scr, lane, gw, ngw, rot);
        transpose_matrix(p.w_out + (size_t)l * D * D, D, D, p.WoutT + (size_t)l * D * D, 0, scr, lane, gw, ngw, rot);
    }
    transpose_matrix8(p.ffn_w_gate, D, DFF, (unsigned char*)p.WguT, 1, F8_SWU, scr, lane, gw, ngw, rot);
    transpose_matrix8(p.ffn_w_up, D, DFF, (unsigned char*)p.WguT, 2, F8_SWU, scr, lane, gw, ngw, rot);
    transpose_matrix8(p.ffn_w_down, DFF, D, (unsigned char*)p.WdT, 0, F8_SWD, scr, lane, gw, ngw, rot);
    for (int e = 0; e < NE; ++e) {
        transpose_matrix8(p.moe_w_gate + (size_t)e * D * DFE, D, DFE, (unsigned char*)p.WguTe + (size_t)e * 2 * DFE * D, 1, F8_SWU, scr, lane, gw, ngw, rot);
        transpose_matrix8(p.moe_w_up + (size_t)e * D * DFE, D, DFE, (unsigned char*)p.WguTe + (size_t)e * 2 * DFE * D, 2, F8_SWU, scr, lane, gw, ngw, rot);
        transpose_matrix8(p.moe_w_down + (size_t)e * DFE * D, DFE, D, (unsigned char*)p.WdTe + (size_t)e * D * DFE, 0, F8_SWD, scr, lane, gw, ngw, rot);
    }
}
__device__ __forceinline__ void rope_table(const Prm& p, long gtid) {
    if (gtid < NL * 4 * 64) { const int d = (int)gtid & 63, k = ((int)gtid >> 6) & 3, l = (int)gtid >> 8; const float* src = k == 0 ? p.na_q_norm : k == 1 ? p.na_k_norm : k == 2 ? p.ga_q_norm : p.ga_k_norm; p.QKG[gtid] = src[l * 64 + d]; }
    if (gtid < 64 * 16) { const int i = (int)gtid & 15, pos = (int)gtid >> 4; const float ang = (float)pos * powf(10000.0f, -(float)i / 16.0f); p.ROPE[2 * gtid] = cosf(ang); p.ROPE[2 * gtid + 1] = sinf(ang); }
}

template <bool ROUTER, bool F8OUT = ROUTER, bool XBF16 = false>
__device__ __forceinline__ void modnorm_phase(const Prm& p, int l, const float* xs, const float* cs, const float* gain, int off_shift, int off_scale, int nrows, LAS unsigned char* lds, int G) {
    int tid_ = my_tid(); asm volatile("" : "+v"(tid_));
    const int tid = tid_, wid = __builtin_amdgcn_readfirstlane(tid >> 6), lane = tid & 63, gw = blockIdx.x * 8 + wid, ngw = G * 8;
    LAS int* hist = (LAS int*)lds;
    LAS f32x4* RW = (LAS f32x4*)(lds + 1024);
    if constexpr (ROUTER) {
        if (tid < 16) hist[tid] = 0;
        for (long i = (long)blockIdx.x * 512 + tid; i < (long)2 * MPAD; i += (long)G * 512) p.LIST[i] = -1;
        for (int q = tid; q < D * 2; q += 512) { const int k = q >> 1, h = q & 1, j = k >> 8, ln = (k & 255) >> 2, i = k & 3;
            RW[((4 * j + i) * 2 + h) * 64 + ln] = *(const f32x4*)(p.moe_router + (size_t)k * NE + 4 * h); }
        __syncthreads();
    }
    constexpr int RB = 4;
    const int nbat = (nrows + RB - 1) / RB, qb = nbat / ngw, rb_ = nbat % ngw, wv = gw;
    const int bbeg = wv * qb + (wv < rb_ ? wv : rb_), bcnt = qb + (wv < rb_ ? 1 : 0);
    const int rbeg = bbeg * RB, rend = (bbeg + bcnt) * RB < nrows ? (bbeg + bcnt) * RB : nrows;
    f32x4 gs[4], shv[4]; int curmod = -1;
    for (int row0 = rbeg; row0 < rend; row0 += RB) {
        f32x4 v[RB][4]; float ss[RB];
#pragma unroll
        for (int r = 0; r < RB; ++r) { const int row = row0 + r < rend ? row0 + r : rend - 1;
            if (XBF16 && row < MX) { const bf16* sb = p.XB + (size_t)row * D;
#pragma unroll
                for (int j = 0; j < 4; ++j) { const u32x2 h = __builtin_nontemporal_load((const u32x2*)sb + lane + 64 * j); v[r][j] = pg8::bflo4(h.x, h.y); } }
            else { const float* src = row < MX ? xs + (size_t)row * D : cs + (size_t)(row - MX) * D;
#pragma unroll
                for (int j = 0; j < 4; ++j) v[r][j] = __builtin_nontemporal_load((const f32x4*)src + lane + 64 * j); } }
#pragma unroll
        for (int r = 0; r < RB; ++r) { float a = 0.f;
#pragma unroll
            for (int j = 0; j < 4; ++j) a += (v[r][j].x * v[r][j].x + v[r][j].y * v[r][j].y) + (v[r][j].z * v[r][j].z + v[r][j].w * v[r][j].w);
            ss[r] = a; }
#pragma unroll
        for (int r = 0; r < RB; ++r) { const int row = row0 + r; if (row >= rend) break;
            const int mr = row_modrow(row);
            if (mr != curmod) { curmod = mr; const float* mod = p.MOD + ((size_t)l * 9 + mr) * 6 * D;
#pragma unroll
                for (int j = 0; j < 4; ++j) { gs[j] = ((const f32x4*)gain)[lane + 64 * j] * (((const f32x4*)(mod + off_scale))[lane + 64 * j] + 1.0f); shv[j] = ((const f32x4*)(mod + off_shift))[lane + 64 * j]; } }
            const float rstd = 1.0f / sqrtf(wave_sum(ss[r]) * (1.0f / D) + EPS);
            float lg[NE];
#pragma unroll
            for (int e = 0; e < NE; ++e) lg[e] = 0.f;
#pragma unroll
            for (int j = 0; j < 4; ++j) { const f32x4 h = v[r][j] * rstd * gs[j] + shv[j];
                if constexpr (F8OUT) *(unsigned*)((unsigned char*)p.HX + (size_t)row * D + 4 * lane + 256 * j) = pg8::pk4_fp8(h.x * F8_SA, h.y * F8_SA, h.z * F8_SA, h.w * F8_SA);
                else *(u32x2*)(p.HX + (size_t)row * D + 4 * lane + 256 * j) = (u32x2){pk2(h.x, h.y), pk2(h.z, h.w)};
                if constexpr (ROUTER) {
#pragma unroll
                    for (int i = 0; i < 4; ++i) { const f32x4 w0 = RW[((4 * j + i) * 2 + 0) * 64 + lane], w1 = RW[((4 * j + i) * 2 + 1) * 64 + lane]; const float hv = h[i];
                        lg[0] += hv * w0.x; lg[1] += hv * w0.y; lg[2] += hv * w0.z; lg[3] += hv * w0.w; lg[4] += hv * w1.x; lg[5] += hv * w1.y; lg[6] += hv * w1.z; lg[7] += hv * w1.w; } } }
            if constexpr (ROUTER) {
                if (row < MX) {
                    float b1 = -INFINITY, b2 = -INFINITY; int i1 = 0, i2 = 0;
                    float a4[4], b2_[2], c1;
#pragma unroll
                    for (int e = 0; e < 4; ++e) { const float mine = (lane & 1) ? lg[2 * e + 1] : lg[2 * e], oth = (lane & 1) ? lg[2 * e] : lg[2 * e + 1]; a4[e] = mine + __shfl_xor(oth, 1); }
#pragma unroll
                    for (int e = 0; e < 2; ++e) { const float mine = (lane & 2) ? a4[2 * e + 1] : a4[2 * e], oth = (lane & 2) ? a4[2 * e] : a4[2 * e + 1]; b2_[e] = mine + __shfl_xor(oth, 2); }
                    { const float mine = (lane & 4) ? b2_[1] : b2_[0], oth = (lane & 4) ? b2_[0] : b2_[1]; c1 = mine + __shfl_xor(oth, 4); }
                    c1 += __shfl_xor(c1, 8); c1 += __shfl_xor(c1, 16); c1 += __shfl_xor(c1, 32);
#pragma unroll
                    for (int e = 0; e < NE; ++e) { const float x = __int_as_float(__builtin_amdgcn_readlane(__float_as_int(c1), e)); if (x > b1) { b2 = b1; i2 = i1; b1 = x; i1 = e; } else if (x > b2) { b2 = x; i2 = e; } }
                    if (lane == 0) { const float w1 = 1.0f / (1.0f + expf(b2 - b1)); p.TOPI[row * 2] = i1; p.TOPI[row * 2 + 1] = i2; p.TOPW[row * 2] = w1; p.TOPW[row * 2 + 1] = 1.0f - w1;
                        __hip_atomic_fetch_add(hist + i1, 1, __ATOMIC_RELAXED, __HIP_MEMORY_SCOPE_WORKGROUP); __hip_atomic_fetch_add(hist + 8 + i2, 1, __ATOMIC_RELAXED, __HIP_MEMORY_SCOPE_WORKGROUP); }
                }
            }
        }
    }
    if constexpr (ROUTER) { __syncthreads(); if (tid < 16) atomicAdd(p.ctl + tid, hist[tid]); __syncthreads(); }
}

__device__ __forceinline__ void prep_qk_phase(const Prm& p, int l, int G) {
    static_assert(NNA == 6 && NGA == 4 && PC_NAK == PC_NAQ + 384, "pass layout of the q/k preparation");
    int tid_ = my_tid(); asm volatile("" : "+v"(tid_));
    const int tid = tid_, wid = __builtin_amdgcn_readfirstlane(tid >> 6), lane = tid & 63, gw = blockIdx.x * 8 + wid, ngw = G * 8;
    const int a = lane & 15, dd = 4 * a;
    const f32x4 gnq = *(const f32x4*)(p.na_q_norm + l * 64 + dd), gnk = *(const f32x4*)(p.na_k_norm + l * 64 + dd), ggq = *(const f32x4*)(p.ga_q_norm + l * 64 + dd), ggk = *(const f32x4*)(p.ga_k_norm + l * 64 + dd);
    const bool x2side = (a >> 2) & 1; const int rhalf = a >> 3, fi = 4 * (a & 3);
    for (int row0 = 2 * gw; row0 < M; row0 += 2 * ngw) {
        u32x2 raw[2][5];
#pragma unroll
        for (int rr = 0; rr < 2; ++rr)
#pragma unroll
            for (int ps = 0; ps < 5; ++ps) raw[rr][ps] = *(const u32x2*)(p.P + (size_t)(row0 + rr) * NP + (ps < 3 ? PC_NAQ + 256 * ps : (ps == 3 ? PC_GAQ : PC_GAK)) + 4 * lane);
#pragma unroll
        for (int rr = 0; rr < 2; ++rr) { const int row = row0 + rr; bf16* pr = p.P + (size_t)row * NP;
#pragma unroll
        for (int ps = 0; ps < 5; ++ps) {
            const int col = (ps < 3 ? PC_NAQ + 256 * ps : (ps == 3 ? PC_GAQ : PC_GAK)) + 4 * lane;
            const int hidx = ps * 4 + (lane >> 4);
            const bool isq = ps < 3 ? hidx < NNA : ps == 3;
            const f32x4 g = ps < 3 ? (hidx < NNA ? gnq : gnk) : (ps == 3 ? ggq : ggk);
            f32x4 x = (f32x4){lo16(raw[rr][ps].x), hi16(raw[rr][ps].x), lo16(raw[rr][ps].y), hi16(raw[rr][ps].y)};
            float ss = (x.x * x.x + x.y * x.y) + (x.z * x.z + x.w * x.w);
            ss += __shfl_xor(ss, 1); ss += __shfl_xor(ss, 2); ss += __shfl_xor(ss, 4); ss += __shfl_xor(ss, 8);
            const float rstd = 1.0f / sqrtf(ss * (1.0f / 64.0f) + EPS);
            x = x * rstd * g;
            if (ps >= 3 && row < MX) {
                const int t = row % S, pos = rhalf == 0 ? t / GW : t % GW;
                const f32x4 cs0 = *(const f32x4*)(p.ROPE + (size_t)(pos * 16 + fi) * 2), cs1 = *(const f32x4*)(p.ROPE + (size_t)(pos * 16 + fi) * 2 + 4);
                f32x4 o; o.x = __shfl_xor(x.x, 4); o.y = __shfl_xor(x.y, 4); o.z = __shfl_xor(x.z, 4); o.w = __shfl_xor(x.w, 4);
                const f32x4 cs = (f32x4){cs0.x, cs0.z, cs1.x, cs1.z}, sn = (f32x4){cs0.y, cs0.w, cs1.y, cs1.w};
                x = x2side ? (o * sn + x * cs) : (x * cs - o * sn);
            }
            if (isq) x = x * QSCALE;
            *(u32x2*)(pr + col) = (u32x2){pk2(x.x, x.y), pk2(x.z, x.w)};
        } }
    }
}

__device__ __forceinline__ void sconv2(const bf16* Prow, const float* w, const float* cb, int col, bool hasp, bool hasn, float& y0, float& y1) {
    const unsigned c = *(const unsigned*)(Prow + col);
    y0 = cb[col] + w[3 * DHY + col] * lo16(c); y1 = cb[col + 1] + w[3 * DHY + col + 1] * hi16(c);
    if (hasp) { const unsigned a = *(const unsigned*)(Prow - NP + col); y0 += w[col] * lo16(a); y1 += w[col + 1] * hi16(a); }
    if (hasn) { const unsigned b = *(const unsigned*)(Prow + NP + col); y0 += w[2 * 3 * DHY + col] * lo16(b); y1 += w[2 * 3 * DHY + col + 1] * hi16(b); }
}
__device__ __forceinline__ void tile_geom(int tile, int& row0, int& b, int& t0, int& Len) {
    row0 = tile * 64; if (row0 < MX) { b = row0 / S; t0 = row0 % S; Len = S; } else { const int rr = row0 - MX; b = rr / LC; t0 = rr % LC; Len = LC; }
}
template <int S0, int NS> __device__ __forceinline__ void ld_row(const bf16* Pl, bool ok, unsigned (&raw)[NS][DHY / 128]) {
    static_assert(DHY / 128 == 3, "a lane owns 6 consecutive channels = one 12-byte load per set");
#pragma unroll
    for (int s_ = 0; s_ < NS; ++s_) { u32x3a t = (u32x3a){0u, 0u, 0u}; if (ok) t = __builtin_nontemporal_load((const u32x3a*)(Pl + (S0 + s_) * DHY)); raw[s_][0] = t.x; raw[s_][1] = t.y; raw[s_][2] = t.z; }
}
template <int S0, int NS> struct ConvK {
    float wp[NS][DHY / 128][2], wc[NS][DHY / 128][2], wn[NS][DHY / 128][2], cb[NS][DHY / 128][2];
    __device__ __forceinline__ void load(const float* w, const float* b, int lane) {
#pragma unroll
        for (int s_ = 0; s_ < NS; ++s_)
#pragma unroll
            for (int j = 0; j < DHY / 128; ++j)
#pragma unroll
                for (int e = 0; e < 2; ++e) { const int col = (S0 + s_) * DHY + 6 * lane + 2 * j + e; wp[s_][j][e] = w[col]; wc[s_][j][e] = w[3 * DHY + col]; wn[s_][j][e] = w[2 * 3 * DHY + col]; cb[s_][j][e] = b[col]; }
    }
    __device__ __forceinline__ float ev(int s_, int j, int e, unsigned a, unsigned c, unsigned n) const {
        return e == 0 ? cb[s_][j][0] + wp[s_][j][0] * lo16(a) + wc[s_][j][0] * lo16(c) + wn[s_][j][0] * lo16(n) : cb[s_][j][1] + wp[s_][j][1] * hi16(a) + wc[s_][j][1] * hi16(c) + wn[s_][j][1] * hi16(n);
    }
};
__device__ __forceinline__ void prep_hy_phase(const Prm& p, int l, LAS unsigned char* lds, int G) {
    int tid_ = my_tid(); asm volatile("" : "+v"(tid_));
    const int tid = tid_, wid = __builtin_amdgcn_readfirstlane(tid >> 6), lane = tid & 63;
    constexpr int PITCH = 144, NJ = DHY / 128;
    ConvK<1, 2> K; K.load(p.hy_conv_w + (size_t)l * 3 * 3 * DHY, p.hy_conv_b + (size_t)l * 3 * DHY, lane);
    for (int tile = blockIdx.x; tile < M / 64; tile += G) {
        int row0, b, t0, Len; tile_geom(tile, row0, b, t0, Len);
        const int tt0 = 8 * wid; const bf16* Pl = p.P + (size_t)(row0 + tt0) * NP + 6 * lane;
        unsigned ra[2][NJ], rb[2][NJ], rc[2][NJ];
        ld_row<1, 2>(Pl - NP, t0 + tt0 - 1 >= 0, ra); ld_row<1, 2>(Pl, true, rb);
#pragma unroll
        for (int i = 0; i < 8; ++i) {
            ld_row<1, 2>(Pl + (size_t)(i + 1) * NP, t0 + tt0 + i + 1 < Len, rc);
#pragma unroll
            for (int j = 0; j < NJ; ++j) { const int c = 6 * lane + 2 * j;
                const float v0 = K.ev(1, j, 0, ra[1][j], rb[1][j], rc[1][j]) * K.ev(0, j, 0, ra[0][j], rb[0][j], rc[0][j]), v1 = K.ev(1, j, 1, ra[1][j], rb[1][j], rc[1][j]) * K.ev(0, j, 1, ra[0][j], rb[0][j], rc[0][j]);
                *(LAS bf16*)(lds + c * PITCH + 2 * (tt0 + i)) = f2bf(v0); *(LAS bf16*)(lds + (c + 1) * PITCH + 2 * (tt0 + i)) = f2bf(v1); }
#pragma unroll
            for (int s_ = 0; s_ < 2; ++s_)
#pragma unroll
                for (int j = 0; j < NJ; ++j) { ra[s_][j] = rb[s_][j]; rb[s_][j] = rc[s_][j]; }
        }
        __syncthreads();
        bf16* dst = row0 < MX ? p.VT : p.VTC;
        for (int idx = tid; idx < DHY * 8; idx += 512) { const int c = idx >> 3, part = idx & 7;
            *(u32x4*)(dst + ((size_t)c * NB + b) * Len + t0 + 8 * part) = *(const LAS u32x4*)(lds + c * PITCH + 16 * part); }
        __syncthreads();
    }
}
__device__ __forceinline__ void final_phase(const Prm& p, int l, int nrows, LAS unsigned char* lds, int G) {
    int tid_ = my_tid(); asm volatile("" : "+v"(tid_));
    const int tid = tid_, wid = __builtin_amdgcn_readfirstlane(tid >> 6), lane = tid & 63;
    constexpr int PITCH = 65, NJ = DHY / 128;
    LAS float* T = (LAS float*)lds;
    ConvK<0, 3> K; K.load(p.hy_conv_w + (size_t)l * 3 * 3 * DHY, p.hy_conv_b + (size_t)l * 3 * DHY, lane);
    float sk[NJ][2], gh[NJ][2], gn[DNA / 128][2], gg[DGA / 128][2];
#pragma unroll
    for (int j = 0; j < NJ; ++j)
#pragma unroll
        for (int e = 0; e < 2; ++e) { sk[j][e] = p.hy_skip[l * DHY + 6 * lane + 2 * j + e]; gh[j][e] = p.out_norm_hy[l * DHY + 6 * lane + 2 * j + e]; }
#pragma unroll
    for (int j = 0; j < DNA / 128; ++j) { gn[j][0] = p.out_norm_na[l * DNA + 6 * lane + 2 * j]; gn[j][1] = p.out_norm_na[l * DNA + 6 * lane + 2 * j + 1]; }
#pragma unroll
    for (int j = 0; j < DGA / 128; ++j) { gg[j][0] = p.out_norm_ga[l * DGA + 4 * lane + 2 * j]; gg[j][1] = p.out_norm_ga[l * DGA + 4 * lane + 2 * j + 1]; }
    for (int tile = blockIdx.x; tile < nrows / 64; tile += G) {
        int row0, b, t0, Len; tile_geom(tile, row0, b, t0, Len);
        const float* ysrc = row0 < MX ? p.YC : p.YCC;
        for (int idx = tid; idx < DHY * 16; idx += 512) { const int c = idx >> 4, part = idx & 15; const f32x4 v = __builtin_nontemporal_load((const f32x4*)(ysrc + ((size_t)c * NB + b) * Len + t0 + 4 * part));
            LAS float* d = T + c * PITCH + 4 * part; d[0] = v.x; d[1] = v.y; d[2] = v.z; d[3] = v.w; }
        __syncthreads();
        const int tt0 = 8 * wid; const bf16* Pl = p.P + (size_t)(row0 + tt0) * NP + 6 * lane;
        unsigned ra[3][NJ], rb[3][NJ], rc[3][NJ];
        ld_row<0, 3>(Pl - NP, t0 + tt0 - 1 >= 0, ra); ld_row<0, 3>(Pl, true, rb);
#pragma unroll 2
        for (int i = 0; i < 8; ++i) { const int tt = tt0 + i, row = row0 + tt; const bf16* Prow = p.P + (size_t)row * NP; bf16* yrow = p.HX + (size_t)row * D;
            ld_row<0, 3>(Pl + (size_t)(i + 1) * NP, t0 + tt + 1 < Len, rc);
            unsigned on[DNA / 128], og[DGA / 128];
            static_assert(DNA / 128 == 3 && DGA / 128 == 2, "12- and 8-byte pieces per lane");
            { const u32x3a t = __builtin_nontemporal_load((const u32x3a*)(Prow + PC_NAQ + 6 * lane)); on[0] = t.x; on[1] = t.y; on[2] = t.z; }
            { const u32x2 t = __builtin_nontemporal_load((const u32x2*)(Prow + PC_GAQ + 4 * lane)); og[0] = t.x; og[1] = t.y; }
            float y[NJ][2]; float ss = 0.f, s2 = 0.f, s3 = 0.f;
#pragma unroll
            for (int j = 0; j < NJ; ++j)
#pragma unroll
                for (int e = 0; e < 2; ++e) { const int c = 6 * lane + 2 * j + e;
                    const float x0 = K.ev(0, j, e, ra[0][j], rb[0][j], rc[0][j]), vp = K.ev(2, j, e, ra[2][j], rb[2][j], rc[2][j]) * K.ev(1, j, e, ra[1][j], rb[1][j], rc[1][j]);
                    y[j][e] = (T[c * PITCH + tt] + sk[j][e] * vp) * x0; ss += y[j][e] * y[j][e]; }
#pragma unroll
            for (int j = 0; j < DNA / 128; ++j) s2 += lo16(on[j]) * lo16(on[j]) + hi16(on[j]) * hi16(on[j]);
#pragma unroll
            for (int j = 0; j < DGA / 128; ++j) s3 += lo16(og[j]) * lo16(og[j]) + hi16(og[j]) * hi16(og[j]);
            const float r1 = 1.0f / sqrtf(wave_sum(ss) * (1.0f / DHY) + EPS), r2 = 1.0f / sqrtf(wave_sum(s2) * (1.0f / DNA) + EPS), r3 = 1.0f / sqrtf(wave_sum(s3) * (1.0f / DGA) + EPS);
            *(u32x3a*)(yrow + 6 * lane) = (u32x3a){pk2(y[0][0] * r1 * gh[0][0], y[0][1] * r1 * gh[0][1]), pk2(y[1][0] * r1 * gh[1][0], y[1][1] * r1 * gh[1][1]), pk2(y[2][0] * r1 * gh[2][0], y[2][1] * r1 * gh[2][1])};
            *(u32x3a*)(yrow + DHY + 6 * lane) = (u32x3a){pk2(lo16(on[0]) * r2 * gn[0][0], hi16(on[0]) * r2 * gn[0][1]), pk2(lo16(on[1]) * r2 * gn[1][0], hi16(on[1]) * r2 * gn[1][1]), pk2(lo16(on[2]) * r2 * gn[2][0], hi16(on[2]) * r2 * gn[2][1])};
            *(u32x2*)(yrow + DHY + DNA + 4 * lane) = (u32x2){pk2(lo16(og[0]) * r3 * gg[0][0], hi16(og[0]) * r3 * gg[0][1]), pk2(lo16(og[1]) * r3 * gg[1][0], hi16(og[1]) * r3 * gg[1][1])};
#pragma unroll
            for (int s_ = 0; s_ < 3; ++s_)
#pragma unroll
                for (int j = 0; j < NJ; ++j) { ra[s_][j] = rb[s_][j]; rb[s_][j] = rc[s_][j]; }
        }
        __syncthreads();
    }
}
}
namespace thin {

__device__ __forceinline__ void mod_phase(const Prm& p, LAS unsigned char* lds, int G) {
    int tid_ = my_tid(); asm volatile("" : "+v"(tid_));
    const int tid = tid_, wid = __builtin_amdgcn_readfirstlane(tid >> 6), lane = tid & 63;
    LAS float* sc = (LAS float*)lds;
    LAS float* red = (LAS float*)(lds + 9 * D * 4);
    if ((int)blockIdx.x >= NL * (6 * D / 64)) return;
    for (int i = tid; i < 9 * D; i += 512) { const int r = i / D, k = i % D; sc[i] = silu_f(r < 8 ? p.c[(size_t)(r % NB) * D + k] : p.c_ctx[k]); }
    __syncthreads();
    for (int u = blockIdx.x; u < NL * (6 * D / 64); u += G) { const int l = u / (6 * D / 64), n0 = 64 * (u % (6 * D / 64));
        const float* w = p.w_mod + (size_t)l * D * 6 * D + n0 + lane;
        float acc[9];
#pragma unroll
        for (int r = 0; r < 9; ++r) acc[r] = 0.f;
#pragma unroll 4
        for (int k = wid * (D / 8); k < (wid + 1) * (D / 8); ++k) { const float wv = __builtin_nontemporal_load(w + (size_t)k * 6 * D);
#pragma unroll
            for (int r = 0; r < 9; ++r) acc[r] += sc[r * D + k] * wv; }
#pragma unroll
        for (int r = 0; r < 9; ++r) red[(wid * 9 + r) * 64 + lane] = acc[r];
        __syncthreads();
        for (int i = tid; i < 9 * 64; i += 512) { const int r = i >> 6, j = i & 63; float t = p.b_mod[(size_t)l * 6 * D + n0 + j];
#pragma unroll
            for (int ww = 0; ww < 8; ++ww) t += red[(ww * 9 + r) * 64 + j];
            p.MOD[((size_t)l * 9 + r) * 6 * D + n0 + j] = t; }
        __syncthreads();
    }
}
__device__ __forceinline__ float rdl(float v, int i) { return __int_as_float(__builtin_amdgcn_readlane(__float_as_int(v), i)); }
__device__ __forceinline__ void filter_position(const Prm& p, int l, int half, int t, int Len, bf16* ftab, int pitch, LAS const float* W1, LAS const float* W2, LAS const float* W3, int lane_) {
    int lane = lane_; asm volatile("" : "+v"(lane));
    const float tn = (float)t / (float)(Len - 1), ang = 6.283185307179586f * (float)t / (float)Len;
    float z = 0.f;
    if (lane == 0) z = tn; else if (lane < 17) z = cosf((1e-4f + (float)(lane - 1) * ((15.0f - 1e-4f) / 15.0f)) * ang); else if (lane < 33) z = -sinf((1e-4f + (float)(lane - 17) * ((15.0f - 1e-4f) / 15.0f)) * ang);
    const float fq = p.hy_freq[l * 64 + lane];
    float pre = p.hy_b1[l * 64 + lane];
#pragma unroll 11
    for (int j = 0; j < 33; ++j) pre += rdl(z, j) * W1[j * 64 + lane];
    float h = sinf(fq * pre);
#pragma unroll 1
    for (int inner = 0; inner < 2; ++inner) { float q = p.hy_b2[(l * 2 + inner) * 64 + lane];
#pragma unroll 8
        for (int i = 0; i < 64; ++i) q += rdl(h, i) * W2[(inner * 64 + i) * 64 + lane];
        h = sinf(fq * q); }
    float o[DHY / 64];
#pragma unroll
    for (int m = 0; m < DHY / 64; ++m) o[m] = 0.f;
#pragma unroll 4
    for (int i = 0; i < 64; ++i) { const float hi_ = rdl(h, i);
#pragma unroll
        for (int m = 0; m < DHY / 64; ++m) o[m] += hi_ * W3[i * DHY + lane + 64 * m]; }
    const float d0 = logf(1e-2f) / 1.5f, d1 = logf(1e-2f) / 0.3f;
#pragma unroll
    for (int m = 0; m < DHY / 64; ++m) { const int c = lane + 64 * m; const float delta = fabsf(d0 + (float)c * ((d1 - d0) / (float)(DHY - 1)));
        const bf16 v = f2bf(o[m] * expf(-tn * delta)); bf16* ft = ftab + (size_t)c * pitch;
        if (half == 0) ft[Len - t] = v;
        else if (t > 0) ft[Len + t] = v;
        else { ft[0] = 0; for (int k = 0; k < 8; ++k) ft[2 * Len + k] = 0; } }
}
__device__ __forceinline__ void filter_phase(const Prm& p, LAS unsigned char* lds, int G) {
    int tid_ = my_tid(); asm volatile("" : "+v"(tid_));
    const int tid = tid_, wid = __builtin_amdgcn_readfirstlane(tid >> 6), lane = tid & 63;
    const int combo = blockIdx.x & 3, l = combo >> 1, half = combo & 1, chunk = blockIdx.x >> 2, nchunk = G >> 2;
    LAS float* W1 = (LAS float*)lds; LAS float* W2 = W1 + 33 * 64; LAS float* W3 = W2 + 2 * 64 * 64;
    for (int i = tid; i < 33 * 64; i += 512) W1[i] = p.hy_w1[(size_t)l * 33 * 64 + i];
    for (int i = tid; i < 2 * 64 * 64; i += 512) W2[i] = p.hy_w2[(size_t)l * 2 * 64 * 64 + i];
    for (int i = tid; i < 64 * DHY; i += 512) { const int k = i / DHY, c = i % DHY; W3[i] = p.hy_w3[((size_t)l * 64 + k) * 2 * DHY + half * DHY + c]; }
    __syncthreads();
    for (int t = chunk * 8 + wid; t < S; t += nchunk * 8) filter_position(p, l, half, t, S, p.FT + (size_t)l * DHY * (2 * S + 8), 2 * S + 8, W1, W2, W3, lane);
    if (l == 0) for (int t = chunk * 8 + wid; t < LC; t += nchunk * 8) filter_position(p, 0, half, t, LC, p.FTC, 2 * LC + 8, W1, W2, W3, lane);
}
__device__ __forceinline__ void moe_assign_phase(const Prm& p, LAS unsigned char* lds, int G) {
    int tid_ = my_tid(); asm volatile("" : "+v"(tid_));
    const int tid = tid_;
    LAS int* cnt = (LAS int*)lds; LAS int* base = cnt + 16;
    for (int blk = blockIdx.x; blk < MX / 128; blk += G) {
        if (tid < 16) cnt[tid] = 0;
        __syncthreads();
        const int m = blk * 128 + (tid & 127), c = (tid >> 7) & 1; int g = 0, rank = 0;
        if (tid < 256) { g = c * 8 + p.TOPI[m * 2 + c]; rank = __hip_atomic_fetch_add(cnt + g, 1, __ATOMIC_RELAXED, __HIP_MEMORY_SCOPE_WORKGROUP); }
        __syncthreads();
        if (tid < 16) base[tid] = moe_off(p, tid >> 3, tid & 7) + atomicAdd(p.ctl + 16 + tid, cnt[tid]);
        __syncthreads();
        LAS int* slots = base + 16;
        if (tid < 256) { const int sl = base[g] + rank; p.LIST[(size_t)c * MPAD + sl] = m; slots[tid] = c * MPAD + sl; }
        __syncthreads();
        {
            const int w = tid >> 6, lane = tid & 63; const unsigned char* src = (const unsigned char*)p.HX; unsigned char* dst = (unsigned char*)p.XG;
#pragma unroll
            for (int q = 0; q < 4; ++q) { pg8::u32x4 v[8];
#pragma unroll
                for (int i = 0; i < 8; ++i) { const int r = 32 * w + 8 * q + i; v[i] = __builtin_nontemporal_load((const pg8::u32x4*)(src + (size_t)(blk * 128 + (r & 127)) * D + 16 * lane)); }
#pragma unroll
                for (int i = 0; i < 8; ++i) { const int r = 32 * w + 8 * q + i; *(pg8::u32x4*)(dst + (size_t)slots[r] * D + 16 * lane) = v[i]; } } }
        __syncthreads();
    }
}
__device__ __forceinline__ void hyena_ctx_phase(const Prm& p, LAS unsigned char* lds, int G) {
    int tid_ = my_tid(); asm volatile("" : "+v"(tid_));
    const int tid = tid_, wid = __builtin_amdgcn_readfirstlane(tid >> 6), lane = tid & 63;
    static_assert(LC == 256, "context Hyena geometry");
    LAS float* R = (LAS float*)(lds + wid * 4096);
    for (int u = blockIdx.x * 8 + wid; u < DHY * NB; u += G * 8) { const int c = u / NB;
        const bf16* ft = p.FTC + (size_t)c * (2 * LC + 8); const bf16* v = p.VTC + (size_t)u * LC;
#pragma unroll
        for (int i = 0; i < 8; ++i) R[lane + 64 * i] = bf2f(ft[lane + 64 * i]);
        float vv[4];
#pragma unroll
        for (int i = 0; i < 4; ++i) vv[i] = bf2f(v[4 * lane + i]);
        asm volatile("s_waitcnt lgkmcnt(0)" ::: "memory");
        float acc[4] = {0.f, 0.f, 0.f, 0.f};
#pragma unroll 8
        for (int s4 = 0; s4 < 64; ++s4) {
#pragma unroll
            for (int e = 0; e < 4; ++e) { const float vs = __int_as_float(__builtin_amdgcn_readlane(__float_as_int(vv[e]), s4)); const int s = 4 * s4 + e;
#pragma unroll
                for (int k = 0; k < 4; ++k) acc[k] += R[LC - (lane + 64 * k) + s] * vs; } }
#pragma unroll
        for (int k = 0; k < 4; ++k) p.YCC[(size_t)u * LC + lane + 64 * k] = acc[k];
    }
}
}

#define XB_TMO      128
#define XB_XCNT(j)  (256  + 64 * (j))
#define XB_XSUB(j)  (1280 + 64 * (j))
#define XB_XGEN(j)  (2304 + 64 * (j))
#define XB_TOP      3328
#define XB_TOPGEN   3392
#define XCD_BAR_WORDS 3456
#define XB_SPIN_CAP (1u << 23)

__device__ __forceinline__ unsigned xb_ld(unsigned* p)              { return __hip_atomic_load(p, __ATOMIC_RELAXED, __HIP_MEMORY_SCOPE_AGENT); }
__device__ __forceinline__ unsigned xb_add(unsigned* p, unsigned v) { return __hip_atomic_fetch_add(p, v, __ATOMIC_RELAXED, __HIP_MEMORY_SCOPE_AGENT); }
__device__ __forceinline__ unsigned xb_xcc_id() { return (unsigned)__builtin_amdgcn_s_getreg((3 << 11) | 20) & 0xFu; }
#define XB_SPIN(cond, bar) do { unsigned _sp = 0; while (cond) { __builtin_amdgcn_s_sleep(1); \
    if ((++_sp & 255u) == 0u) { if (xb_ld(&(bar)[XB_TMO])) break; if (_sp > XB_SPIN_CAP) { atomicAdd(&(bar)[XB_TMO], 1u); break; } } } } while (0)

struct XcdBarrier {
    unsigned* bar; unsigned x;
    volatile LAS unsigned* st;
};

__device__ __forceinline__ XcdBarrier xcd_barrier_post(unsigned* bar, volatile LAS unsigned* st) {
    XcdBarrier b; b.bar = bar; b.x = xb_xcc_id(); b.st = st;
    if (my_tid() == 0) (void)xb_add(&bar[XB_XCNT(b.x)], 1u);
    return b;
}
__device__ __forceinline__ void xcd_barrier_complete(unsigned* bar, unsigned x, unsigned& nloc, unsigned& nx) {
    const unsigned G = gridDim.x * gridDim.y * gridDim.z;
    unsigned sum, cnt, mine, sp = 0u;
    for (;;) {
        sum = 0u; cnt = 0u; mine = 0u;
#pragma unroll
        for (unsigned j = 0; j < 16; ++j) { const unsigned c = xb_ld(&bar[XB_XCNT(j)]); sum += c; cnt += (c > 0u) ? 1u : 0u; mine = (j == x) ? c : mine; }
        if (sum == G) break;
        __builtin_amdgcn_s_sleep(1);
        if ((++sp & 255u) == 0u) { if (xb_ld(&bar[XB_TMO])) break; if (sp > XB_SPIN_CAP) { atomicAdd(&bar[XB_TMO], 1u); break; } }
    }
    nloc = mine > 0u ? mine : 1u; nx = cnt > 0u ? cnt : 1u;
}

__device__ __forceinline__ void xcd_barrier(const XcdBarrier& b) {
    asm volatile("s_waitcnt vmcnt(0)" ::: "memory");
    __syncthreads();
    if (my_tid() == 0) {
        unsigned* bar = b.bar;
        __builtin_amdgcn_s_waitcnt(0);
        unsigned nloc = b.st[0], nx = b.st[1];
        if (nloc == 0u) { xcd_barrier_complete(bar, b.x, nloc, nx); b.st[0] = nloc; b.st[1] = nx; }
        const unsigned old = xb_add(&bar[XB_XSUB(b.x)], 1u);
        const unsigned gen = old / nloc;
        if (old + 1u == (gen + 1u) * nloc) {
            __builtin_amdgcn_fence(__ATOMIC_RELEASE, "agent");
            asm volatile("s_waitcnt vmcnt(0)" ::: "memory");
            const unsigned og = xb_add(&bar[XB_TOP], 1u);
            const unsigned tg = og / nx;
            if (og + 1u == (tg + 1u) * nx) xb_add(&bar[XB_TOPGEN], 1u);
            else XB_SPIN(xb_ld(&bar[XB_TOPGEN]) == tg, bar);
            __builtin_amdgcn_fence(__ATOMIC_ACQUIRE, "agent");
            xb_add(&bar[XB_XGEN(b.x)], 1u);
            asm volatile("s_waitcnt vmcnt(0)" ::: "memory");
        } else {
            XB_SPIN(xb_ld(&bar[XB_XGEN(b.x)]) == gen, bar);
            __builtin_amdgcn_fence(__ATOMIC_ACQUIRE, "agent");
            asm volatile("s_waitcnt vmcnt(0)" ::: "memory");
        }
    }
    __syncthreads();
}

constexpr int NWAVES = 8, NTHR = NWAVES * 64;
constexpr int LDS_BYTES = 147456, LDSCTL_OFF = LDS_BYTES - 512, MISC_OFF = LDSCTL_OFF, RING_BYTES = LDSCTL_OFF;
static_assert(hy::L_END <= RING_BYTES && attn_body::ATTN_LDS_BYTES <= RING_BYTES && MISC_OFF + 128 <= LDS_BYTES && (33 * 64 + 2 * 64 * 64 + 64 * DHY) * 4 <= RING_BYTES && 8 * 64 * 65 * 4 <= RING_BYTES && DHY * 65 * 4 <= RING_BYTES && pg8::STAGE_BYTES <= RING_BYTES, "LDS map");
constexpr int EPI_TAB_OFF = pg8::STAGE_BYTES;
static_assert(EPI_TAB_OFF + (256 + 2048) * 4 <= LDSCTL_OFF, "epilogue tables");
constexpr int CW_BAR = 4096;

__device__ __forceinline__ long opaque_gtid() { int t = my_tid(); asm volatile("" : "+v"(t)); return (long)blockIdx.x * 512 + t; }
typedef const __attribute__((address_space(4))) Prm* KPrm;
__device__ __forceinline__ KPrm opaque_kp() { KPrm q = (KPrm)__builtin_amdgcn_kernarg_segment_ptr(); asm volatile("" : "+s"(q)); return q; }
typedef __attribute__((address_space(1))) void* GPtr;
typedef const __attribute__((address_space(4))) GPtr* KWords;
__device__ __forceinline__ void load_prm(Prm& p) {
    static_assert(sizeof(Prm) % 8 == 0, "Prm is a pack of pointers");
    KWords src = (KWords)opaque_kp(); void** dst = (void**)&p;
#pragma unroll
    for (int i = 0; i < (int)(sizeof(Prm) / 8); ++i) dst[i] = (void*)src[i];
}
#define LP() Prm p; load_prm(p)
#define GT opaque_gtid()
#define GRID_BAR() do { XcdBarrier b_; b_.bar = (unsigned*)opaque_kp()->ctl + CW_BAR; b_.x = xb_xcc_id(); b_.st = (volatile LAS unsigned*)(lds + MISC_OFF) + 8; xcd_barrier(b_); } while (0)

__device__ __forceinline__ void reduce_resgate(const Prm& p, const float* slab, int npanels, int ks, const float* src, float* dst, const float* gate, long gtid, long gsz) {
    typedef float f32x4 __attribute__((ext_vector_type(4)));
    for (long it = gtid; it < (long)npanels * (D / 256) * 16384; it += gsz) { const int tile = (int)(it >> 14), e = (int)(it & 16383), r = e >> 6, c4 = (e & 63) * 4, pm = tile / (D / 256), pn = tile % (D / 256);
        f32x4 a = (f32x4){0.f, 0.f, 0.f, 0.f};
        for (int k = 0; k < ks; ++k) a += *(const f32x4*)(slab + ((size_t)tile * ks + k) * 65536 + r * 256 + c4);
        const size_t off = (size_t)(pm * 256 + r) * D + pn * 256 + c4; const f32x4 g = *(const f32x4*)(gate + pn * 256 + c4);
        *(f32x4*)(dst + off) = *(const f32x4*)(src + off) + g * a; }
}
__device__ __forceinline__ void reduce_moedown(const Prm& p, const float* slab, int pm0, int npanels, int ks, int l, int pass, long gtid, long gsz) {
    typedef float f32x4 __attribute__((ext_vector_type(4)));
    for (long it = gtid; it < (long)npanels * (D / 256) * 16384; it += gsz) { const int tile = (int)(it >> 14), e = (int)(it & 16383), r = e >> 6, c4 = (e & 63) * 4, pm = pm0 + tile / (D / 256), pn = tile % (D / 256);
        const int tok = p.LIST[(size_t)pass * MPAD + pm * 256 + r]; if (tok < 0) continue;
        f32x4 a = (f32x4){0.f, 0.f, 0.f, 0.f};
        for (int k = 0; k < ks; ++k) a += *(const f32x4*)(slab + ((size_t)tile * ks + k) * 65536 + r * 256 + c4);
        const int col = pn * 256 + c4; const f32x4 g = *(const f32x4*)(p.MOD + ((size_t)l * 9 + tok / S) * 6 * D + 5 * D + col); const float w = p.TOPW[tok * 2 + pass] * (1.0f / (F8_SH * F8_SWD));
        typedef unsigned u32x2_ __attribute__((ext_vector_type(2)));
        u32x2_* xp = (u32x2_*)(p.XB + (size_t)tok * D + col); const u32x2_ h = *xp;
        const f32x4 v = pg8::bflo4(h.x, h.y) + g * w * a;
        if (pass == 0) *xp = (u32x2_){pg8::pkh(v.x, v.y), pg8::pkh(v.z, v.w)}; else *(f32x4*)(p.out + (size_t)tok * D + col) = v; }
}
#ifndef SPLIT_OUTPROJ
#define SPLIT_OUTPROJ 1
#endif
#ifndef SPLIT_FFN
#define SPLIT_FFN 1
#endif
#ifndef SPLIT_MOE
#define SPLIT_MOE 1
#endif
template <int L> __device__ __forceinline__ void layer_fwd(LAS unsigned char* lds, const long gsz, const int G) {
    constexpr bool first = L == 0, last = L == NL - 1; constexpr int l = L;
    constexpr int nact = last ? MX : M;
    { LP(); thin::modnorm_phase<false, false, !first>(p, l, p.x, first ? p.ctx : p.CX, p.norm_mix + l * D, 0, D, M, lds, G); }
    GRID_BAR(); SEG(1 + 12 * L + 0);
    {
        LP(); pg8::Order O; O.init(M / 256, NP / 256, G, (int)blockIdx.x, p.WinT + (size_t)l * NP * D);
        {   LAS float* T = (LAS float*)(lds + EPI_TAB_OFF);
            for (int i = my_tid(); i < 4 * 64; i += NTHR) T[i] = p.QKG[l * 4 * 64 + i];
            for (int i = my_tid(); i < 64 * 16 * 2; i += NTHR) T[256 + i] = p.ROPE[i];
            __syncthreads(); }
        pg8::EpiInProj E{p.P, (const LAS float*)(lds + EPI_TAB_OFF), (const LAS float*)(lds + EPI_TAB_OFF) + 256};
        pg8::gemm_phase<pg8::EpiInProj, true, false>(lds, p.HX, D, D, O, E);
    }
    GRID_BAR(); SEG(1 + 12 * L + 1);
    { LP(); thin::prep_hy_phase(p, l, lds, G); }
    GRID_BAR(); SEG(1 + 12 * L + 2);
    { LP(); attn_phase<0>(p, l, (char*)lds, G); }
    SEG(53);
    { LP(); hyena_phase(p, l, lds, G); }
    SEG(62);
    { LP(); attn_phase<1>(p, l, (char*)lds, G); }
    SEG(54);
    if (!last) { { LP(); attn_phase<2>(p, l, (char*)lds, G); }
        __syncthreads();
        { LP(); thin::hyena_ctx_phase(p, lds, G); } }
    SEG(63);
    GRID_BAR(); SEG(1 + 12 * L + 3);
    { LP(); thin::final_phase(p, l, nact, lds, G); }
    GRID_BAR(); SEG(1 + 12 * L + 4);
    {
        LP(); pg8::Order O; O.init((SPLIT_OUTPROJ ? MX : nact) / 256, D / 256, G, (int)blockIdx.x, p.WoutT + (size_t)l * D * D);
        pg8::EpiResB<first> E{p.x, p.XB, p.MOD + (size_t)l * 9 * 6 * D + 2 * D, 1.0f};
        pg8::gemm_phase<pg8::EpiResB<first>, true, false>(lds, p.HX, D, D, O, E);
    }
    if constexpr (!last && SPLIT_OUTPROJ) {
        constexpr int KS = 4;
        {   LP(); pg8::Order O; O.init(MC / 256, D / 256, G, (int)blockIdx.x, p.WoutT + (size_t)l * D * D); O.pm0 = MX / 256; O.ksplit = KS; O.kplen = D / KS; O.nvirt = O.nwg * KS;
            pg8::EpiPartial E{p.YC, D / 256, MX / 256, KS};
            pg8::gemm_phase<pg8::EpiPartial, true, false>(lds, p.HX, D, D / KS, O, E); }
        GRID_BAR();
        { LP(); reduce_resgate(p, p.YC, MC / 256, KS, first ? p.ctx : p.CX, p.CX, p.MOD + ((size_t)l * 9 + 8) * 6 * D + 2 * D, GT, gsz); }
    }
    GRID_BAR(); SEG(1 + 12 * L + 5);
    { LP(); thin::modnorm_phase<(L & 1) != 0, true, true>(p, l, nullptr, p.CX, p.norm_ffn + l * D, 3 * D, 4 * D, nact, lds, G); }
    GRID_BAR(); SEG(1 + 12 * L + 6);
    if constexpr ((L & 1) == 0) {
        {   LP(); pg8::Order O; O.init(nact / 256, 2 * DFF / 256, G, (int)blockIdx.x, p.WguT);
            pg8::EpiSwiGLU8 E{(unsigned char*)p.HID, DFF};
            pg8::gemm_phase<pg8::EpiSwiGLU8, true, false, true>(lds, p.HX, D / 2, D / 2, O, E); }
        GRID_BAR(); SEG(1 + 12 * L + 7);
        {   LP(); pg8::Order O; O.init(MX / 256, D / 256, G, (int)blockIdx.x, p.WdT);
            pg8::EpiResB<false> E{nullptr, p.XB, p.MOD + (size_t)l * 9 * 6 * D + 5 * D, 1.0f / (F8_SH * F8_SWD)};
            pg8::gemm_phase<pg8::EpiResB<false>, true, false, true>(lds, p.HID, DFF / 2, DFF / 2, O, E); }
        if constexpr (!last) {   LP(); pg8::Order O; O.init(MC / 256, D / 256, G, (int)blockIdx.x, p.WdT); O.pm0 = MX / 256;
            pg8::EpiResGate E{nullptr, p.CX, nullptr, p.CX, p.MOD + (size_t)l * 9 * 6 * D + 5 * D, 1.0f / (F8_SH * F8_SWD)};
            pg8::gemm_phase<pg8::EpiResGate, true, false, true>(lds, p.HID, DFF / 2, DFF / 2, O, E); }
        if constexpr (false) {
            constexpr int KS = 11; static_assert(DFF % (KS * 128) == 0 && (size_t)M * DFF * 2 + (size_t)(MC / 256) * (D / 256) * KS * 65536 * 4 <= (size_t)M * NP * 2 + (size_t)DHY * NB * S * 6, "slab space behind the dense hidden buffer");
            {   LP(); pg8::Order O; O.init(MC / 256, D / 256, G, (int)blockIdx.x, p.WdT); O.pm0 = MX / 256; O.ksplit = KS; O.kplen = DFF / KS; O.nvirt = O.nwg * KS;
                pg8::EpiPartial E{(float*)(p.HID + (size_t)M * DFF), D / 256, MX / 256, KS};
                pg8::gemm_phase<pg8::EpiPartial, true, false>(lds, p.HID, DFF, DFF / KS, O, E); }
            GRID_BAR();
            { LP(); reduce_resgate(p, (float*)(p.HID + (size_t)M * DFF), MC / 256, KS, p.CX, p.CX, p.MOD + ((size_t)l * 9 + 8) * 6 * D + 5 * D, GT, gsz); }
        }
        GRID_BAR(); SEG(1 + 12 * L + 8);
    } else {
        { LP(); thin::moe_assign_phase(p, lds, G); }
        GRID_BAR(); SEG(1 + 12 * L + 7);
#pragma unroll
        for (int pass = 0; pass < 2; ++pass) {
            {   LP(); pg8::Order O; int o = 0;
#pragma unroll
                for (int k = 0; k < 8; ++k) { o += (__builtin_amdgcn_readfirstlane(p.ctl[pass * 8 + k]) + 255) / 256; O.pend[k] = o; }
                const int npan = o; O.nM = npan; O.nN = 2 * DFE / 256; O.nwg = O.nM * O.nN; O.G = G; O.c = (int)blockIdx.x; O.Bt = p.WguTe; O.bt_group_stride = (size_t)2 * DFE * D / 2; O.rows = nullptr; O.pm0 = 0; O.ksplit = 1; O.kplen = 0; O.nvirt = O.nwg;
                pg8::EpiSwiGLU8 E{(unsigned char*)p.HID, DFE};
                pg8::gemm_phase<pg8::EpiSwiGLU8, true, false, true>(lds, p.XG + (size_t)pass * MPAD * D / 2, D / 2, D / 2, O, E); }
            GRID_BAR(); SEG(1 + 12 * L + 8 + 2 * pass);
            {   LP(); pg8::Order O; int o = 0;
#pragma unroll
                for (int k = 0; k < 8; ++k) { o += (__builtin_amdgcn_readfirstlane(p.ctl[pass * 8 + k]) + 255) / 256; O.pend[k] = o; }
                const int npan = o, nmain = (SPLIT_MOE && npan > MX / 256) ? MX / 256 : npan;
                O.nM = nmain; O.nN = D / 256; O.nwg = O.nM * O.nN; O.G = G; O.c = (int)blockIdx.x; O.Bt = p.WdTe; O.bt_group_stride = (size_t)D * DFE / 2; O.rows = nullptr; O.pm0 = 0; O.ksplit = 1; O.kplen = 0; O.nvirt = O.nwg;
                if (pass == 0) { pg8::EpiMoeDownB<false> E{p.LIST + (size_t)pass * MPAD, p.TOPW, pass, p.XB, p.out, p.MOD + (size_t)l * 9 * 6 * D + 5 * D, 1.0f / (F8_SH * F8_SWD)};
                    pg8::gemm_phase<pg8::EpiMoeDownB<false>, true, false, true>(lds, p.HID, DFE / 2, DFE / 2, O, E); }
                else { pg8::EpiMoeDownB<true> E{p.LIST + (size_t)pass * MPAD, p.TOPW, pass, p.XB, p.out, p.MOD + (size_t)l * 9 * 6 * D + 5 * D, 1.0f / (F8_SH * F8_SWD)};
                    pg8::gemm_phase<pg8::EpiMoeDownB<true>, true, false, true>(lds, p.HID, DFE / 2, DFE / 2, O, E); }
                constexpr int KS = 7; static_assert(DFE % (KS * 256) == 0 && (size_t)MPAD * DFE + (size_t)(MPAD / 256 - MX / 256) * (D / 256) * KS * 65536 * 4 <= (size_t)M * NP * 2 + (size_t)DHY * NB * S * 6, "slab space behind the (fp8) expert hidden buffer");
                if (npan > nmain) {
                    int ks = KS; asm volatile("" : "+s"(ks));
                    O.nM = npan - nmain; O.nwg = O.nM * O.nN; O.pm0 = nmain; O.ksplit = ks; O.kplen = DFE / 2 / ks; O.nvirt = O.nwg * ks;
                    pg8::EpiPartial E2{(float*)(p.HID + (size_t)MPAD * DFE / 2), D / 256, nmain, ks};
                    pg8::gemm_phase<pg8::EpiPartial, true, false, true>(lds, p.HID, DFE / 2, DFE / 2 / ks, O, E2); } }
            GRID_BAR();
            {   LP(); int o = 0;
#pragma unroll
                for (int k = 0; k < 8; ++k) o += (__builtin_amdgcn_readfirstlane(p.ctl[pass * 8 + k]) + 255) / 256;
                if (o > MX / 256) reduce_moedown(p, (float*)(p.HID + (size_t)MPAD * DFE / 2), MX / 256, o - MX / 256, 7, l, pass, GT, gsz); }
            GRID_BAR(); SEG(1 + 12 * L + 9 + 2 * pass);
        }
    }
}

__global__ void __launch_bounds__(NTHR, 2) mega_fwd(Prm p_in) {
    LAS unsigned char* lds = (LAS unsigned char*)lds_raw;
    volatile LAS unsigned* MISC = (volatile LAS unsigned*)(lds + MISC_OFF);
    const int tid = threadIdx.x;
    for (int u = tid; u < (LDS_BYTES - LDSCTL_OFF) / 4; u += NTHR) ((LAS unsigned*)(lds + LDSCTL_OFF))[u] = 0u;
    __syncthreads();
    if ((tid & 63) == 0) ((volatile LAS int*)(lds + WIDTAB_OFF))[hw_wave_slot()] = tid >> 6;
    (void)xcd_barrier_post((unsigned*)p_in.ctl + CW_BAR, MISC + 8);
#ifdef PROBE_MASK
    if (blockIdx.x == 0 && tid == 0) { volatile LAS unsigned long long* T_ = (volatile LAS unsigned long long*)(lds + MISC_OFF + 64); T_[0] = __builtin_amdgcn_s_memrealtime(); T_[1] = 0ull; }
#endif
    const int G = gridDim.x;
    const long gsz = (long)G * NTHR;
    { LP(); thin::wconv_phase(p, lds, G); }
    __syncthreads();
    SEG(60);
    { LP(); thin::rope_table(p, GT); }
    { LP(); thin::mod_phase(p, lds, G); }
    __syncthreads();
    SEG(61);
    { LP(); thin::filter_phase(p, lds, G); }
    GRID_BAR(); SEG(0);
    layer_fwd<0>(lds, gsz, G);
    layer_fwd<1>(lds, gsz, G);
#ifdef PROBE_MASK
    if (blockIdx.x == 0 && tid == 0) { volatile LAS unsigned long long* T_ = (volatile LAS unsigned long long*)(lds + MISC_OFF + 64); const unsigned long long t0_ = __builtin_amdgcn_s_memrealtime(), w_ = PROBE_MULT * T_[1];
        while (__builtin_amdgcn_s_memrealtime() - t0_ < w_) __builtin_amdgcn_s_sleep(8); }
#endif
}

extern "C" void kernel_launch(void* const* d_in, const int* in_sizes, int n_in, void* d_out, int out_size, void* d_ws, size_t ws_size, hipStream_t stream) {
    static int grid = 0;
    if (grid == 0) {
        if (n_in != 34 || out_size != MX * D || ws_size < ws_needed()) { fprintf(stderr, "kernel_launch: unexpected shapes (n_in %d out %d ws %zu need %zu)\n", n_in, out_size, ws_size, ws_needed()); grid = -1; return; }
        int dev = 0, cus = 0, per_cu = 0;
        if (hipGetDevice(&dev) != hipSuccess || hipDeviceGetAttribute(&cus, hipDeviceAttributeMultiprocessorCount, dev) != hipSuccess) { grid = -1; return; }
        if (hipFuncSetAttribute((const void*)mega_fwd, hipFuncAttributeMaxDynamicSharedMemorySize, LDS_BYTES) != hipSuccess) { fprintf(stderr, "kernel_launch: hipFuncSetAttribute failed\n"); grid = -1; return; }
        if (hipOccupancyMaxActiveBlocksPerMultiprocessor(&per_cu, (const void*)mega_fwd, NTHR, LDS_BYTES) != hipSuccess || per_cu < 1) { fprintf(stderr, "kernel_launch: occupancy query reports %d\n", per_cu); }
        (void)hipGetLastError();
        grid = cus;
    }
    if (grid < 0) return;
    (void)in_sizes;
    (void)hipMemsetAsync(d_ws, 0, CTL_BYTES, stream);
    Prm p; __builtin_memset((void*)&p, 0, sizeof(p)); build_prm(p, d_in, d_out, d_ws);
    hipLaunchKernelGGL(mega_fwd, dim3(grid), dim3(NTHR), LDS_BYTES, stream, p);
}
#else
static void forward_emu(void* const* d_in, void* d_out, void* d_ws) {
    memset(d_ws, 0, CTL_BYTES);
    Prm p; memset(&p, 0, sizeof(p)); build_prm(p, d_in, d_out, d_ws);
#define RUN(ph, l, arg) run_phase(p, (ph), (l), (arg), 0, 1)
    RUN(PH_WCONV, 0, 0); RUN(PH_MOD, 0, 0); RUN(PH_F1, 0, 0); RUN(PH_F2A, 0, 0); RUN(PH_F2B, 0, 0); RUN(PH_F3, 0, 0);
    for (int l = 0; l < NL; ++l) {
        const bool last = l == NL - 1;
        RUN(PH_MODNORM1, l, 0); RUN(PH_INPROJ, l, 0); RUN(PH_PREP_HY, l, 0); RUN(PH_PREP_QK, l, 0);
        RUN(PH_HYENA, l, 0); RUN(PH_GA, l, 0); RUN(PH_NA, l, 0); if (!last) RUN(PH_CTXATTN, l, 0);
        RUN(PH_FINAL, l, 0); RUN(PH_OUTPROJ, l, 0); RUN(PH_MODNORM2, l, 0);
        if ((l & 1) == 0) { RUN(PH_FFN_UP, l, 0); RUN(PH_FFN_DOWN, l, 0); }
        else { RUN(PH_MOE_COUNT, l, 0); RUN(PH_MOE_ASSIGN, l, 0); for (int c = 0; c < 2; ++c) { RUN(PH_MOE_UP, l, c); RUN(PH_MOE_DOWN, l, c); } }
    }
}
#endif
```

```cpp
#ifdef CPU_EMU
#include <cmath>
#include <cstdio>
#include <cstdlib>
#include <cstring>
#include <cstdint>
#define __device__
#define __global__
#define __host__
#define __forceinline__ inline
static inline int atomicAdd(int* p, int v) { int o = *p; *p += v; return o; }
#else
#include <hip/hip_runtime.h>
#include <cstdio>
#include <cstdint>
#endif

#ifdef CFG_SMALL
constexpr int D = 512, NB = 2, S = 1024, LC = 64, DFF = 256, DFE = 256;
#else
constexpr int D = 1024, NB = 8, S = 4096, LC = 256, DFF = 2816, DFE = 3584;
#endif
constexpr int NL = 2;
constexpr int DHY = 3 * D / 8, DNA = 3 * D / 8, DGA = D - DHY - DNA, NNA = DNA / 64, NGA = DGA / 64, HD = 64;
constexpr int GW = 64, ROWS = S / GW, KH = 8, KWIN = 16;
constexpr int MX = NB * S, MC = NB * LC, M = MX + MC;
constexpr int NE = 8;
constexpr int NP = 3 * D;
constexpr int PC_HY = 0, PC_NAQ = 3 * DHY, PC_NAK = PC_NAQ + DNA, PC_NAV = PC_NAK + DNA, PC_GAQ = 3 * (DHY + DNA), PC_GAK = PC_GAQ + DGA, PC_GAV = PC_GAK + DGA;
constexpr int MPAD = ((MX + NE * 255 + 255) / 256) * 256;
constexpr float EPS = 1e-6f;
constexpr float LOG2E = 1.4426950408889634f;
constexpr float QSCALE = 0.125f * LOG2E;

typedef unsigned short bf16;
__host__ __device__ __forceinline__ unsigned f2bf_u(float f) { unsigned u; __builtin_memcpy(&u, &f, 4); return (u + 0x7fffu + ((u >> 16) & 1u)) >> 16; }
__host__ __device__ __forceinline__ bf16 f2bf(float f) { return (bf16)f2bf_u(f); }
__host__ __device__ __forceinline__ float bf2f(bf16 h) { unsigned u = ((unsigned)h) << 16; float f; __builtin_memcpy(&f, &u, 4); return f; }
__host__ __device__ __forceinline__ float silu_f(float v) { return v / (1.0f + expf(-v)); }

constexpr float F8_SA = 8.0f, F8_SWU = 128.0f, F8_SH = 4.0f, F8_SWD = 256.0f, F8_MAX = 448.0f;
struct Prm {
    const float *x, *c, *ctx, *c_ctx, *w_mod, *b_mod, *norm_mix, *norm_ffn, *w_in, *hy_conv_w, *hy_conv_b, *hy_w1, *hy_b1, *hy_freq, *hy_w2, *hy_b2, *hy_w3, *hy_skip;
    const float *na_q_norm, *na_k_norm, *na_rpb, *ga_q_norm, *ga_k_norm, *out_norm_hy, *out_norm_na, *out_norm_ga, *w_out;
    const float *ffn_w_gate, *ffn_w_up, *ffn_w_down, *moe_router, *moe_w_gate, *moe_w_up, *moe_w_down;
    float* out;
    int* ctl;
    float* MOD;
    float* ROPE;
    float* QKG;
    float *FHA, *FHB;
    bf16* FT;
    bf16* FTC;
    bf16 *WinT, *WoutT;
    bf16 *WguT, *WdT;
    bf16 *WguTe, *WdTe;
    float* CX;
    int* TOPI; float* TOPW; int* LIST;
    bf16* HX;
    bf16* P;
    bf16 *VT, *VTC;
    float *YC, *YCC;
    bf16* HID;
    bf16* XG;
    bf16* XB;
    float* SW;
};

__device__ __forceinline__ void conv_T(const float* W, int K, int N, bf16* dst, long gtid, long gsz) {
    for (long i = gtid; i < (long)N * K; i += gsz) { const int n = (int)(i / K), k = (int)(i % K); dst[i] = f2bf(W[(size_t)k * N + n]); }
}
__device__ __forceinline__ void conv_gu(const float* Wg, const float* Wu, int K, int F, bf16* dst, long gtid, long gsz) {
    for (long i = gtid; i < (long)2 * F * K; i += gsz) {
        const int n = (int)(i / K), k = (int)(i % K), p = n / 256, j = n % 256;
        const float* src = j < 128 ? Wg : Wu; const int col = 128 * p + (j & 127);
        dst[i] = f2bf(src[(size_t)k * F + col]);
    }
}
__device__ __forceinline__ void ph_wconv(const Prm& p, long gtid, long gsz) {
    for (int l = 0; l < NL; ++l) {
        conv_T(p.w_in + (size_t)l * D * NP, D, NP, p.WinT + (size_t)l * NP * D, gtid, gsz);
        conv_T(p.w_out + (size_t)l * D * D, D, D, p.WoutT + (size_t)l * D * D, gtid, gsz);
    }
    conv_gu(p.ffn_w_gate, p.ffn_w_up, D, DFF, p.WguT, gtid, gsz);
    conv_T(p.ffn_w_down, DFF, D, p.WdT, gtid, gsz);
    for (int e = 0; e < NE; ++e) {
        conv_gu(p.moe_w_gate + (size_t)e * D * DFE, p.moe_w_up + (size_t)e * D * DFE, D, DFE, p.WguTe + (size_t)e * 2 * DFE * D, gtid, gsz);
        conv_T(p.moe_w_down + (size_t)e * DFE * D, DFE, D, p.WdTe + (size_t)e * D * DFE, gtid, gsz);
    }
}
__device__ __forceinline__ void ph_mod(const Prm& p, long gtid, long gsz) {
    for (long i = gtid; i < (long)NL * 9 * 6 * D; i += gsz) {
        const int n = (int)(i % (6 * D)), r = (int)((i / (6 * D)) % 9), l = (int)(i / (6 * D * 9));
        const float* cv = r < 8 ? p.c + (size_t)(r % NB) * D : p.c_ctx;
        const float* w = p.w_mod + (size_t)l * D * 6 * D;
        float acc = p.b_mod[(size_t)l * 6 * D + n];
        for (int k = 0; k < D; ++k) acc += silu_f(cv[k]) * w[(size_t)k * 6 * D + n];
        p.MOD[i] = acc;
    }
}
__device__ __forceinline__ int fset_len(int s) { return s < 2 ? S : LC; }
__device__ __forceinline__ int fset_layer(int s) { return s == 1 ? 1 : 0; }
__device__ __forceinline__ void ph_filt1(const Prm& p, long gtid, long gsz) {
    for (long i = gtid; i < (long)3 * S * 64; i += gsz) {
        const int u = (int)(i % 64), t = (int)((i / 64) % S), s = (int)(i / (64 * S));
        const int Len = fset_len(s), l = fset_layer(s);
        if (t >= Len) continue;
        const float* w1 = p.hy_w1 + (size_t)l * 33 * 64;
        const float tn = (float)t / (float)(Len - 1);
        const float ang = 6.283185307179586f * (float)t / (float)Len;
        float pre = p.hy_b1[l * 64 + u] + tn * w1[u];
        for (int j = 0; j < 16; ++j) {
            const float fr = 1e-4f + (float)j * ((15.0f - 1e-4f) / 15.0f);
            pre += cosf(fr * ang) * w1[(1 + j) * 64 + u] - sinf(fr * ang) * w1[(17 + j) * 64 + u];
        }
        p.FHA[i] = sinf(p.hy_freq[l * 64 + u] * pre);
    }
}
__device__ __forceinline__ void ph_filt2(const Prm& p, int inner, const float* src, float* dst, long gtid, long gsz) {
    for (long i = gtid; i < (long)3 * S * 64; i += gsz) {
        const int u = (int)(i % 64), t = (int)((i / 64) % S), s = (int)(i / (64 * S));
        const int Len = fset_len(s), l = fset_layer(s);
        if (t >= Len) continue;
        const float* w2 = p.hy_w2 + ((size_t)l * 2 + inner) * 64 * 64;
        const float* h = src + (i - u);
        float pre = p.hy_b2[(l * 2 + inner) * 64 + u];
        for (int k = 0; k < 64; ++k) pre += h[k] * w2[k * 64 + u];
        dst[i] = sinf(p.hy_freq[l * 64 + u] * pre);
    }
}
__device__ __forceinline__ void ph_filt3(const Prm& p, const float* src, long gtid, long gsz) {
    for (long i = gtid; i < (long)3 * S * 2 * DHY; i += gsz) {
        const int n = (int)(i % (2 * DHY)), t = (int)((i / (2 * DHY)) % S), s = (int)(i / ((long)2 * DHY * S));
        const int Len = fset_len(s), l = fset_layer(s);
        if (t >= Len) continue;
        const float* w3 = p.hy_w3 + (size_t)l * 64 * 2 * DHY;
        const float* h = src + ((size_t)s * S + t) * 64;
        float acc = 0.f;
        for (int k = 0; k < 64; ++k) acc += h[k] * w3[(size_t)k * 2 * DHY + n];
        const int cch = n % DHY;
        const float d0 = logf(1e-2f) / 1.5f, d1 = logf(1e-2f) / 0.3f;
        const float delta = fabsf(d0 + (float)cch * ((d1 - d0) / (float)(DHY - 1)));
        const float tn = (float)t / (float)(Len - 1);
        const float val = acc * expf(-tn * delta);
        bf16* ft = (s < 2 ? p.FT + (size_t)s * DHY * (2 * S + 8) : p.FTC) + (size_t)cch * (2 * Len + 8);
        if (n < DHY) ft[Len - t] = f2bf(val);
        else if (t > 0) ft[Len + t] = f2bf(val);
        else { ft[0] = 0; for (int k = 0; k < 8; ++k) ft[2 * Len + k] = 0; }
    }
}

__device__ __forceinline__ int row_modrow(int row) { return row < MX ? row / S : 8; }
__device__ __forceinline__ int row_batch(int row) { return row < MX ? row / S : (row - MX) / LC; }

__device__ __forceinline__ void ph_modnorm(const Prm& p, int l, const float* xs, const float* cs, const float* gain, int off_shift, int off_scale, int nrows, bool router, long gtid, long gsz) {
    for (long row = gtid; row < nrows; row += gsz) {
        const float* src = row < MX ? xs + (size_t)row * D : cs + (size_t)(row - MX) * D;
        const float* mod = p.MOD + ((size_t)l * 9 + row_modrow((int)row)) * 6 * D;
        float ss = 0.f;
        for (int k = 0; k < D; ++k) ss += src[k] * src[k];
        const float rstd = 1.0f / sqrtf(ss / (float)D + EPS);
        float lg[NE];
#pragma unroll
        for (int e = 0; e < NE; ++e) lg[e] = 0.f;
        for (int k = 0; k < D; ++k) {
            const float h = src[k] * rstd * gain[k] * (1.0f + mod[off_scale + k]) + mod[off_shift + k];
            p.HX[(size_t)row * D + k] = f2bf(h);
            if (router) {
#pragma unroll
                for (int e = 0; e < NE; ++e) lg[e] += h * p.moe_router[(size_t)k * NE + e]; }
        }
        if (router && row < MX) {
            float b1 = -INFINITY, b2 = -INFINITY; int i1 = 0, i2 = 0;
#pragma unroll
            for (int e = 0; e < NE; ++e) { const float v = lg[e]; if (v > b1) { b2 = b1; i2 = i1; b1 = v; i1 = e; } else if (v > b2) { b2 = v; i2 = e; } }
            const float w1 = 1.0f / (1.0f + expf(b2 - b1));
            p.TOPI[row * 2] = i1; p.TOPI[row * 2 + 1] = i2; p.TOPW[row * 2] = w1; p.TOPW[row * 2 + 1] = 1.0f - w1;
        }
    }
}
struct U4 { unsigned x, y, z, w; };
__device__ __forceinline__ float dot_bf(const bf16* a, const bf16* b, int K) {
    float acc = 0.f;
    for (int k = 0; k < K; k += 8) {
        U4 va, vb; __builtin_memcpy(&va, a + k, 16); __builtin_memcpy(&vb, b + k, 16);
        const unsigned ua[4] = {va.x, va.y, va.z, va.w}, ub[4] = {vb.x, vb.y, vb.z, vb.w};
#pragma unroll
        for (int j = 0; j < 4; ++j) acc += bf2f((bf16)(ua[j] & 0xffffu)) * bf2f((bf16)(ub[j] & 0xffffu)) + bf2f((bf16)(ua[j] >> 16)) * bf2f((bf16)(ub[j] >> 16));
    }
    return acc;
}

__device__ __forceinline__ void ph_inproj(const Prm& p, int l, long gtid, long gsz) {
    const bf16* Bt = p.WinT + (size_t)l * NP * D;
    for (long i = gtid; i < (long)M * NP; i += gsz) { const int m = (int)(i / NP), n = (int)(i % NP); p.P[i] = f2bf(dot_bf(p.HX + (size_t)m * D, Bt + (size_t)n * D, D)); }
}
__device__ __forceinline__ float sconv(const Prm& p, int l, int row, int col) {
    int t, Len; if (row < MX) { t = row % S; Len = S; } else { t = (row - MX) % LC; Len = LC; }
    const float* w = p.hy_conv_w + (size_t)l * 3 * 3 * DHY;
    float y = p.hy_conv_b[(size_t)l * 3 * DHY + col] + w[3 * DHY + col] * bf2f(p.P[(size_t)row * NP + col]);
    if (t > 0) y += w[col] * bf2f(p.P[(size_t)(row - 1) * NP + col]);
    if (t < Len - 1) y += w[2 * 3 * DHY + col] * bf2f(p.P[(size_t)(row + 1) * NP + col]);
    return y;
}
__device__ __forceinline__ void ph_prep_hy(const Prm& p, int l, long gtid, long gsz) {
    for (long i = gtid; i < (long)M * DHY; i += gsz) {
        const int row = (int)(i / DHY), c = (int)(i % DHY);
        const float v = sconv(p, l, row, 2 * DHY + c) * sconv(p, l, row, DHY + c);
        if (row < MX) p.VT[((size_t)c * NB + row / S) * S + row % S] = f2bf(v);
        else { const int rr = row - MX; p.VTC[((size_t)c * NB + rr / LC) * LC + rr % LC] = f2bf(v); }
    }
}
__device__ __forceinline__ void ph_prep_qk(const Prm& p, int l, long gtid, long gsz) {
    constexpr int NS = 2 * NNA + 2 * NGA;
    for (long i = gtid; i < (long)M * NS; i += gsz) {
        const int row = (int)(i / NS), hs = (int)(i % NS);
        int col; const float* g; bool isq, rope;
        if (hs < NNA) { col = PC_NAQ + 64 * hs; g = p.na_q_norm + l * 64; isq = true; rope = false; }
        else if (hs < 2 * NNA) { col = PC_NAK + 64 * (hs - NNA); g = p.na_k_norm + l * 64; isq = false; rope = false; }
        else if (hs < 2 * NNA + NGA) { col = PC_GAQ + 64 * (hs - 2 * NNA); g = p.ga_q_norm + l * 64; isq = true; rope = row < MX; }
        else { col = PC_GAK + 64 * (hs - 2 * NNA - NGA); g = p.ga_k_norm + l * 64; isq = false; rope = row < MX; }
        bf16* v = p.P + (size_t)row * NP + col;
        float ss = 0.f;
        for (int d = 0; d < 64; ++d) { const float a = bf2f(v[d]); ss += a * a; }
        const float rstd = 1.0f / sqrtf(ss / 64.0f + EPS), sc = isq ? QSCALE : 1.0f;
        if (!rope) { for (int d = 0; d < 64; ++d) v[d] = f2bf(bf2f(v[d]) * rstd * g[d] * sc); }
        else {
            const int t = row % S; const float pr = (float)(t / GW), pc = (float)(t % GW);
            for (int hf = 0; hf < 2; ++hf) {
                const float pos = hf == 0 ? pr : pc;
                for (int j = 0; j < 16; ++j) {
                    const float inv = powf(10000.0f, -(float)j / 16.0f), ang = pos * inv, cs = cosf(ang), sn = sinf(ang);
                    const int d1 = 32 * hf + j, d2 = d1 + 16;
                    const float a = bf2f(v[d1]) * rstd * g[d1], b = bf2f(v[d2]) * rstd * g[d2];
                    v[d1] = f2bf((a * cs - b * sn) * sc); v[d2] = f2bf((a * sn + b * cs) * sc);
                }
            }
        }
    }
}
__device__ __forceinline__ void ph_hyena_naive(const Prm& p, int l, bool with_lat, bool with_ctx, long gtid, long gsz) {
    const bf16* FTl = p.FT + (size_t)l * DHY * (2 * S + 8);
    if (with_lat) for (long i = gtid; i < (long)DHY * NB * S; i += gsz) {
        const int t = (int)(i % S), cb = (int)(i / S), c = cb / NB;
        const bf16* ft = FTl + (size_t)c * (2 * S + 8) + S - t; const bf16* v = p.VT + (size_t)cb * S;
        float acc = 0.f;
        for (int s = 0; s < S; ++s) acc += bf2f(ft[s]) * bf2f(v[s]);
        p.YC[i] = acc;
    }
    if (with_ctx) for (long i = gtid; i < (long)DHY * NB * LC; i += gsz) {
        const int t = (int)(i % LC), cb = (int)(i / LC), c = cb / NB;
        const bf16* ft = p.FTC + (size_t)c * (2 * LC + 8) + LC - t; const bf16* v = p.VTC + (size_t)cb * LC;
        float acc = 0.f;
        for (int s = 0; s < LC; ++s) acc += bf2f(ft[s]) * bf2f(v[s]);
        p.YCC[i] = acc;
    }
}
struct OnlineSm { float m, l, o[64]; };
__device__ __forceinline__ void osm_init(OnlineSm& st) { st.m = -INFINITY; st.l = 0.f;
_Pragma("unroll") for (int d = 0; d < 64; ++d) st.o[d] = 0.f; }
__device__ __forceinline__ void osm_step(OnlineSm& st, const float* q, const bf16* k, const bf16* v, float bias) {
    float sc = bias;
_Pragma("unroll") for (int d = 0; d < 64; ++d) sc += q[d] * bf2f(k[d]);
    if (sc > st.m) { const float a = exp2f(st.m - sc); st.l *= a;
_Pragma("unroll") for (int d = 0; d < 64; ++d) st.o[d] *= a;
 st.m = sc; }
    const float pe = exp2f(sc - st.m); st.l += pe;
_Pragma("unroll") for (int d = 0; d < 64; ++d) st.o[d] += pe * bf2f(v[d]);
}
__device__ __forceinline__ void ph_ga_naive(const Prm& p, long gtid, long gsz) {
    for (long i = gtid; i < (long)NB * NGA * S; i += gsz) {
        const int t = (int)(i % S), h = (int)((i / S) % NGA), b = (int)(i / ((long)S * NGA));
        bf16* qp = p.P + ((size_t)b * S + t) * NP + PC_GAQ + 64 * h;
        float q[64];
_Pragma("unroll") for (int d = 0; d < 64; ++d) q[d] = bf2f(qp[d]);
        OnlineSm st; osm_init(st);
        for (int s = 0; s < S; ++s) { const bf16* kr = p.P + ((size_t)b * S + s) * NP; osm_step(st, q, kr + PC_GAK + 64 * h, kr + PC_GAV + 64 * h, 0.f); }
        for (int s = 0; s < LC; ++s) { const bf16* kr = p.P + ((size_t)MX + b * LC + s) * NP; osm_step(st, q, kr + PC_GAK + 64 * h, kr + PC_GAV + 64 * h, 0.f); }
        const float il = 1.0f / st.l;
_Pragma("unroll") for (int d = 0; d < 64; ++d) qp[d] = f2bf(st.o[d] * il);
    }
}
__device__ __forceinline__ void ph_na_naive(const Prm& p, int l, long gtid, long gsz) {
    for (long i = gtid; i < (long)NB * NNA * S; i += gsz) {
        const int t = (int)(i % S), h = (int)((i / S) % NNA), b = (int)(i / ((long)S * NNA));
        const int r = t / GW, qc = t % GW;
        int r0 = r - KH / 2; r0 = r0 < 0 ? 0 : (r0 > ROWS - KH ? ROWS - KH : r0);
        int c0 = qc - KWIN / 2; c0 = c0 < 0 ? 0 : (c0 > GW - KWIN ? GW - KWIN : c0);
        bf16* qp = p.P + ((size_t)b * S + t) * NP + PC_NAQ + 64 * h;
        float q[64];
_Pragma("unroll") for (int d = 0; d < 64; ++d) q[d] = bf2f(qp[d]);
        const float* rpb = p.na_rpb + ((size_t)l * NNA + h) * (2 * KH - 1) * (2 * KWIN - 1);
        OnlineSm st; osm_init(st);
        for (int kr = 0; kr < KH; ++kr) for (int kc = c0; kc < c0 + KWIN; ++kc) {
            const int krow = r0 + kr, dr = krow - r + (KH - 1); int dc = kc - qc; dc = dc < -(KWIN - 1) ? -(KWIN - 1) : (dc > KWIN - 1 ? KWIN - 1 : dc); dc += KWIN - 1;
            const bf16* kp = p.P + ((size_t)b * S + krow * GW + kc) * NP;
            osm_step(st, q, kp + PC_NAK + 64 * h, kp + PC_NAV + 64 * h, rpb[dr * (2 * KWIN - 1) + dc] * LOG2E);
        }
        for (int s = 0; s < LC; ++s) { const bf16* kp = p.P + ((size_t)MX + b * LC + s) * NP; osm_step(st, q, kp + PC_NAK + 64 * h, kp + PC_NAV + 64 * h, 0.f); }
        const float il = 1.0f / st.l;
_Pragma("unroll") for (int d = 0; d < 64; ++d) qp[d] = f2bf(st.o[d] * il);
    }
}
__device__ __forceinline__ void ph_ctxattn_naive(const Prm& p, long gtid, long gsz) {
    for (long i = gtid; i < (long)NB * (NNA + NGA) * LC; i += gsz) {
        const int t = (int)(i % LC), hh = (int)((i / LC) % (NNA + NGA)), b = (int)(i / ((long)LC * (NNA + NGA)));
        const int qo = hh < NNA ? PC_NAQ + 64 * hh : PC_GAQ + 64 * (hh - NNA), ko = hh < NNA ? PC_NAK + 64 * hh : PC_GAK + 64 * (hh - NNA), vo = hh < NNA ? PC_NAV + 64 * hh : PC_GAV + 64 * (hh - NNA);
        bf16* qp = p.P + ((size_t)MX + b * LC + t) * NP + qo;
        float q[64];
_Pragma("unroll") for (int d = 0; d < 64; ++d) q[d] = bf2f(qp[d]);
        OnlineSm st; osm_init(st);
        for (int s = 0; s < LC; ++s) { const bf16* kp = p.P + ((size_t)MX + b * LC + s) * NP; osm_step(st, q, kp + ko, kp + vo, 0.f); }
        const float il = 1.0f / st.l;
_Pragma("unroll") for (int d = 0; d < 64; ++d) qp[d] = f2bf(st.o[d] * il);
    }
}
__device__ __forceinline__ void ph_final(const Prm& p, int l, int nrows, long gtid, long gsz) {
    for (long row = gtid; row < nrows; row += gsz) {
        const int r = (int)row; int b, t; const float* yc;
        if (r < MX) { b = r / S; t = r % S; } else { b = (r - MX) / LC; t = (r - MX) % LC; }
        float ss = 0.f;
        for (int pass = 0; pass < 2; ++pass) {
            const float rstd = pass ? 1.0f / sqrtf(ss / (float)DHY + EPS) : 0.f;
            for (int c = 0; c < DHY; ++c) {
                const float x0 = sconv(p, l, r, c), vp = sconv(p, l, r, 2 * DHY + c) * sconv(p, l, r, DHY + c);
                const float conv = r < MX ? p.YC[((size_t)c * NB + b) * S + t] : p.YCC[((size_t)c * NB + b) * LC + t];
                const float y = (conv + p.hy_skip[l * DHY + c] * vp) * x0;
                if (!pass) ss += y * y; else p.HX[(size_t)r * D + c] = f2bf(y * rstd * p.out_norm_hy[l * DHY + c]);
            }
        }
        { const bf16* o = p.P + (size_t)r * NP + PC_NAQ; float s2 = 0.f; for (int j = 0; j < DNA; ++j) { const float a = bf2f(o[j]); s2 += a * a; }
          const float rstd = 1.0f / sqrtf(s2 / (float)DNA + EPS); for (int j = 0; j < DNA; ++j) p.HX[(size_t)r * D + DHY + j] = f2bf(bf2f(o[j]) * rstd * p.out_norm_na[l * DNA + j]); }
        { const bf16* o = p.P + (size_t)r * NP + PC_GAQ; float s2 = 0.f; for (int j = 0; j < DGA; ++j) { const float a = bf2f(o[j]); s2 += a * a; }
          const float rstd = 1.0f / sqrtf(s2 / (float)DGA + EPS); for (int j = 0; j < DGA; ++j) p.HX[(size_t)r * D + DHY + DNA + j] = f2bf(bf2f(o[j]) * rstd * p.out_norm_ga[l * DGA + j]); }
        (void)yc;
    }
}
__device__ __forceinline__ void ph_outproj(const Prm& p, int l, const float* xs, const float* cs, int nrows, long gtid, long gsz) {
    const bf16* Bt = p.WoutT + (size_t)l * D * D;
    for (long i = gtid; i < (long)nrows * D; i += gsz) {
        const int m = (int)(i / D), n = (int)(i % D);
        const float acc = dot_bf(p.HX + (size_t)m * D, Bt + (size_t)n * D, D);
        const float gate = p.MOD[((size_t)l * 9 + row_modrow(m)) * 6 * D + 2 * D + n];
        if (m < MX) p.out[i] = xs[i] + gate * acc; else p.CX[i - (size_t)MX * D] = cs[i - (size_t)MX * D] + gate * acc;
    }
}
__device__ __forceinline__ void ph_ffn_up(const Prm& p, int nrows, long gtid, long gsz) {
    for (long i = gtid; i < (long)nrows * DFF; i += gsz) {
        const int m = (int)(i / DFF), j = (int)(i % DFF), n = 256 * (j / 128) + (j % 128);
        const float g = dot_bf(p.HX + (size_t)m * D, p.WguT + (size_t)n * D, D), u = dot_bf(p.HX + (size_t)m * D, p.WguT + (size_t)(n + 128) * D, D);
        p.HID[i] = f2bf(silu_f(g) * u);
    }
}
__device__ __forceinline__ void ph_ffn_down(const Prm& p, int l, int nrows, long gtid, long gsz) {
    for (long i = gtid; i < (long)nrows * D; i += gsz) {
        const int m = (int)(i / D), n = (int)(i % D);
        const float acc = dot_bf(p.HID + (size_t)m * DFF, p.WdT + (size_t)n * DFF, DFF);
        const float gate = p.MOD[((size_t)l * 9 + row_modrow(m)) * 6 * D + 5 * D + n];
        if (m < MX) p.out[i] += gate * acc; else p.CX[i - (size_t)MX * D] += gate * acc;
    }
}
__device__ __forceinline__ void ph_moe_count(const Prm& p, long gtid, long gsz) {
    for (long i = gtid; i < (long)2 * MPAD; i += gsz) p.LIST[i] = -1;
    for (long m = gtid; m < MX; m += gsz) { atomicAdd(p.ctl + p.TOPI[m * 2], 1); atomicAdd(p.ctl + 8 + p.TOPI[m * 2 + 1], 1); }
}
__device__ __forceinline__ int moe_off(const Prm& p, int pass, int e) {
    int o = 0;
#pragma unroll
    for (int k = 0; k < NE; ++k) if (k < e) o += (p.ctl[pass * 8 + k] + 255) / 256 * 256;
    return o;
}
__device__ __forceinline__ void ph_moe_assign(const Prm& p, long gtid, long gsz) {
    for (long m = gtid; m < MX; m += gsz) {
        for (int c = 0; c < 2; ++c) { const int e = p.TOPI[m * 2 + c]; const int slot = moe_off(p, c, e) + atomicAdd(p.ctl + 16 + c * 8 + e, 1); p.LIST[(size_t)c * MPAD + slot] = (int)m; }
    }
}
__device__ __forceinline__ int moe_slot_expert(const Prm& p, int pass, int slot) {
    int e = 0, o = 0;
#pragma unroll
    for (int k = 0; k < NE - 1; ++k) { o += (p.ctl[pass * 8 + k] + 255) / 256 * 256; if (slot >= o) e = k + 1; }
    return e;
}
__device__ __forceinline__ void ph_moe_up(const Prm& p, int pass, long gtid, long gsz) {
    const int tot = moe_off(p, pass, NE);
    for (long i = gtid; i < (long)tot * DFE; i += gsz) {
        const int slot = (int)(i / DFE), j = (int)(i % DFE), tok = p.LIST[(size_t)pass * MPAD + slot];
        if (tok < 0) continue;
        const int e = moe_slot_expert(p, pass, slot), n = 256 * (j / 128) + (j % 128);
        const bf16* W = p.WguTe + (size_t)e * 2 * DFE * D;
        const float g = dot_bf(p.HX + (size_t)tok * D, W + (size_t)n * D, D), u = dot_bf(p.HX + (size_t)tok * D, W + (size_t)(n + 128) * D, D);
        p.HID[i] = f2bf(silu_f(g) * u);
    }
}
__device__ __forceinline__ void ph_moe_down(const Prm& p, int l, int pass, long gtid, long gsz) {
    const int tot = moe_off(p, pass, NE);
    for (long i = gtid; i < (long)tot * D; i += gsz) {
        const int slot = (int)(i / D), n = (int)(i % D), tok = p.LIST[(size_t)pass * MPAD + slot];
        if (tok < 0) continue;
        const int e = moe_slot_expert(p, pass, slot);
        const float acc = dot_bf(p.HID + (size_t)slot * DFE, p.WdTe + ((size_t)e * D + n) * DFE, DFE);
        const float gate = p.MOD[((size_t)l * 9 + tok / S) * 6 * D + 5 * D + n];
        p.out[(size_t)tok * D + n] += gate * p.TOPW[tok * 2 + pass] * acc;
    }
}

enum { PH_WCONV, PH_MOD, PH_F1, PH_F2A, PH_F2B, PH_F3, PH_MODNORM1, PH_INPROJ, PH_PREP_HY, PH_PREP_QK, PH_HYENA, PH_GA, PH_NA, PH_CTXATTN, PH_FINAL, PH_OUTPROJ, PH_MODNORM2,
       PH_FFN_UP, PH_FFN_DOWN, PH_MOE_COUNT, PH_MOE_ASSIGN, PH_MOE_UP, PH_MOE_DOWN };
__device__ __forceinline__ void run_phase(const Prm& p, int ph, int l, int arg, long gtid, long gsz) {
    const bool first = l == 0, last = l == NL - 1;
    const float* xs = first ? p.x : p.out; const float* cs = first ? p.ctx : p.CX;
    const int nact = last ? MX : M;
    switch (ph) {
        case PH_WCONV: ph_wconv(p, gtid, gsz); break;
        case PH_MOD: ph_mod(p, gtid, gsz); break;
        case PH_F1: ph_filt1(p, gtid, gsz); break;
        case PH_F2A: ph_filt2(p, 0, p.FHA, p.FHB, gtid, gsz); break;
        case PH_F2B: ph_filt2(p, 1, p.FHB, p.FHA, gtid, gsz); break;
        case PH_F3: ph_filt3(p, p.FHA, gtid, gsz); break;
        case PH_MODNORM1: ph_modnorm(p, l, xs, cs, p.norm_mix + l * D, 0, D, M, false, gtid, gsz); break;
        case PH_INPROJ: ph_inproj(p, l, gtid, gsz); break;
        case PH_PREP_HY: ph_prep_hy(p, l, gtid, gsz); break;
        case PH_PREP_QK: ph_prep_qk(p, l, gtid, gsz); break;
        case PH_HYENA: ph_hyena_naive(p, l, true, !last, gtid, gsz); break;
        case PH_GA: ph_ga_naive(p, gtid, gsz); break;
        case PH_NA: ph_na_naive(p, l, gtid, gsz); break;
        case PH_CTXATTN: ph_ctxattn_naive(p, gtid, gsz); break;
        case PH_FINAL: ph_final(p, l, nact, gtid, gsz); break;
        case PH_OUTPROJ: ph_outproj(p, l, xs, cs, nact, gtid, gsz); break;
        case PH_MODNORM2: ph_modnorm(p, l, p.out, p.CX, p.norm_ffn + l * D, 3 * D, 4 * D, nact, (l & 1) != 0, gtid, gsz); break;
        case PH_FFN_UP: ph_ffn_up(p, nact, gtid, gsz); break;
        case PH_FFN_DOWN: ph_ffn_down(p, l, nact, gtid, gsz); break;
        case PH_MOE_COUNT: ph_moe_count(p, gtid, gsz); break;
        case PH_MOE_ASSIGN: ph_moe_assign(p, gtid, gsz); break;
        case PH_MOE_UP: ph_moe_up(p, arg, gtid, gsz); break;
        case PH_MOE_DOWN: ph_moe_down(p, l, arg, gtid, gsz); break;
    }
}

struct WsMap { size_t off; size_t take(size_t bytes) { const size_t o = off; off = (off + bytes + 255) & ~(size_t)255; return o; } };
constexpr size_t CTL_BYTES = 1u << 20;
static void build_prm(Prm& p, void* const* d_in, void* d_out, void* d_ws) {
    const float** f = (const float**)&p;
    for (int i = 0; i < 34; ++i) f[i] = (const float*)d_in[i];
    p.out = (float*)d_out;
    unsigned char* ws = (unsigned char*)d_ws; WsMap w{0};
    p.ctl = (int*)(ws + w.take(CTL_BYTES));
    p.MOD = (float*)(ws + w.take((size_t)NL * 9 * 6 * D * 4));
    p.ROPE = (float*)(ws + w.take((size_t)64 * 16 * 2 * 4));
    p.QKG = (float*)(ws + w.take((size_t)NL * 4 * 64 * 4));
    p.FHA = (float*)(ws + w.take((size_t)3 * S * 64 * 4)); p.FHB = (float*)(ws + w.take((size_t)3 * S * 64 * 4));
    p.FT = (bf16*)(ws + w.take((size_t)NL * DHY * (2 * S + 8) * 2)); p.FTC = (bf16*)(ws + w.take((size_t)DHY * (2 * LC + 8) * 2));
    p.WinT = (bf16*)(ws + w.take((size_t)NL * NP * D * 2)); p.WoutT = (bf16*)(ws + w.take((size_t)NL * D * D * 2));
    p.WguT = (bf16*)(ws + w.take((size_t)2 * DFF * D)); p.WdT = (bf16*)(ws + w.take((size_t)D * DFF));
    p.WguTe = (bf16*)(ws + w.take((size_t)NE * 2 * DFE * D)); p.WdTe = (bf16*)(ws + w.take((size_t)NE * D * DFE));
    p.CX = (float*)(ws + w.take((size_t)MC * D * 4));
    p.XB = (bf16*)(ws + w.take((size_t)MX * D * 2));
    p.SW = (float*)(ws + w.take((size_t)2 * MPAD * 4));
    p.TOPI = (int*)(ws + w.take((size_t)MX * 2 * 4)); p.TOPW = (float*)(ws + w.take((size_t)MX * 2 * 4)); p.LIST = (int*)(ws + w.take((size_t)2 * MPAD * 4));
    p.HX = (bf16*)(ws + w.take((size_t)M * D * 2));
    const size_t rbase = w.off;
    p.P = (bf16*)(ws + w.take((size_t)M * NP * 2));
    p.VT = (bf16*)(ws + w.take((size_t)DHY * NB * S * 2)); p.VTC = (bf16*)(ws + w.take((size_t)DHY * NB * LC * 2));
    p.YC = (float*)(ws + w.take((size_t)DHY * NB * S * 4)); p.YCC = (float*)(ws + w.take((size_t)DHY * NB * LC * 4));
    p.HID = (bf16*)(ws + rbase);
    p.XG = (bf16*)(ws + rbase + ((size_t)192 << 20));
    static_assert((size_t)MPAD * DFE + (size_t)(MPAD / 256 - MX / 256) * (D / 256) * 7 * 65536 * 4 <= ((size_t)192 << 20) && ((size_t)192 << 20) + (size_t)2 * MPAD * D <= (size_t)M * NP * 2 + (size_t)DHY * NB * S * 6, "expert buffers inside the dead projection region");
}
static size_t ws_needed() {
    const size_t hid = (size_t)M * DFF * 2 > (size_t)MPAD * DFE * 2 ? (size_t)M * DFF * 2 : (size_t)MPAD * DFE * 2;
    Prm p; unsigned char* base = (unsigned char*)0x1000; void* din[34] = {}; build_prm(p, din, nullptr, base);
    const size_t endR = (size_t)((unsigned char*)p.YCC - base) + (size_t)DHY * NB * LC * 4, endH = (size_t)((unsigned char*)p.HID - base) + hid;
    return endR > endH ? endR : endH;
}


#ifndef CPU_EMU
#define LAS __attribute__((address_space(3)))
extern __shared__ __attribute__((aligned(16))) unsigned char lds_raw[];
constexpr int WIDTAB_OFF = 147456 - 256;
__device__ __forceinline__ int hw_wave_slot() { return (int)(__builtin_amdgcn_s_getreg((5 << 11) | 4) & 63u); }
__device__ __forceinline__ int lane_id() { return (int)__builtin_amdgcn_mbcnt_hi(~0u, __builtin_amdgcn_mbcnt_lo(~0u, 0u)); }
__device__ __forceinline__ int my_tid() { const int w = __builtin_amdgcn_readfirstlane(((volatile LAS int*)((LAS unsigned char*)lds_raw + WIDTAB_OFF))[hw_wave_slot()]); return w * 64 + lane_id(); }
#ifdef PROBE_MASK
#ifndef PROBE_MULT
#define PROBE_MULT 10ull
#endif
#define SEG(id) do { if (blockIdx.x == 0 && my_tid() == 0) { const unsigned long long now_ = __builtin_amdgcn_s_memrealtime(); volatile LAS unsigned long long* T_ = (volatile LAS unsigned long long*)(lds + (147456 - 512) + 64); \
    if (((unsigned long long)(PROBE_MASK) >> (id)) & 1ull) T_[1] += now_ - T_[0]; T_[0] = now_; } } while (0)
#else
#define SEG(id) do { } while (0)
#endif
namespace pg8 {
#define PG8_LAS __attribute__((address_space(3)))
typedef unsigned short bf16_t;
typedef short bf16x8 __attribute__((ext_vector_type(8)));
typedef float f32x4 __attribute__((ext_vector_type(4)));
typedef unsigned u32x4 __attribute__((ext_vector_type(4)));
typedef unsigned u32x2 __attribute__((ext_vector_type(2)));
constexpr int BM = 256, BK = 64, HALF = 128, HTB = HALF * BK * 2  , STAGE_BYTES = 8 * HTB, NXCD = 8, WGM = 8;
__host__ __device__ __forceinline__ int lds_byte(int r, int c) { const int st = (r >> 4) * 2 + (c >> 5), rr = r & 15, cc = c & 31, ob = rr * 64 + cc * 2; return st * 1024 + (ob ^ (((ob >> 9) & 1) << 5)); }
__host__ __device__ __forceinline__ void stage_rc(int b, int& R, int& C) { const int st = b / 1024, sb = b % 1024, swz = sb ^ (((sb >> 9) & 1) << 5); R = (st >> 1) * 16 + swz / 64; C = (st & 1) * 32 + (swz % 64) / 2; }
__host__ __device__ __forceinline__ int perm32(int rho) { const int n = rho >> 4, i = rho & 15; return 8 * (i >> 2) + 4 * n + (i & 3); }
struct Unit { int pm, pn, kp; };
struct Order {
    int nM, nN, nwg, G, c;
    int pm0, ksplit, kplen, nvirt;
    const bf16_t* Bt; size_t bt_group_stride; int pend[8];
    const int* rows;
    __device__ void init(int nM_, int nN_, int G_, int c_, const bf16_t* Bt_) { nM = nM_; nN = nN_; nwg = nM * nN; G = G_; c = c_; Bt = Bt_; bt_group_stride = 0; rows = nullptr; pm0 = 0; ksplit = 1; kplen = 0; nvirt = nwg;
#pragma unroll
        for (int k = 0; k < 8; ++k) pend[k] = 0x7fffffff; }
    __device__ bool next(int i, Unit& u) const {
        const long L = (long)i * G + c; if (L >= nvirt) return false;
        int wgid = (int)L; u.kp = 0; if (ksplit > 1) { wgid = (int)L / ksplit; u.kp = (int)L % ksplit; }
        { const int q = nwg / NXCD, r = nwg % NXCD, xcd = wgid % NXCD, off = wgid / NXCD; wgid = (xcd < r ? xcd * (q + 1) : r * (q + 1) + (xcd - r) * q) + off; }
        const int nig = WGM * nN, gid = wgid / nig, fm = gid * WGM, gsz = (nM - fm) < WGM ? (nM - fm) : WGM;
        u.pm = pm0 + fm + ((wgid % nig) % gsz); u.pn = (wgid % nig) / gsz; return true;
    }
    __device__ __forceinline__ int group(int pm) const { int e = 0;
#pragma unroll
        for (int k = 0; k < 7; ++k) e += (int)((unsigned)(pend[k] - pm - 1) >> 31); return __builtin_amdgcn_readfirstlane(e); }
    __device__ __forceinline__ const bf16_t* bt(const Unit& u) const { return Bt + (size_t)group(u.pm) * bt_group_stride; }
    __device__ __forceinline__ int row(const Unit& u, int r) const { const int t = rows[(size_t)u.pm * BM + r]; return t < 0 ? 0 : t; }
};
__device__ __forceinline__ unsigned cvt_pk_bf16(float lo, float hi) { unsigned r; asm volatile("v_cvt_pk_bf16_f32 %0, %1, %2" : "=v"(r) : "v"(lo), "v"(hi)); return r; }

struct EpiBf16 {
    static constexpr bool PERM = true;
    bf16_t* O; int ldc;
    __device__ __forceinline__ void operator()(const f32x4 (&acc)[2][2][4][2], const Unit& u, int wr, int wc, int fr, int fq) const {
        const int row0 = u.pm * BM + wr * 64 + fr, col0 = u.pn * BM + wc * 32 + 8 * fq;
#pragma unroll
        for (int ai = 0; ai < 2; ++ai)
#pragma unroll
            for (int m = 0; m < 4; ++m) { bf16_t* rowp = O + (size_t)(row0 + ai * HALF + m * 16) * ldc + col0;
#pragma unroll
                for (int bj = 0; bj < 2; ++bj) { const f32x4 v0 = acc[ai][bj][m][0], v1 = acc[ai][bj][m][1];
                    u32x4 w; w.x = cvt_pk_bf16(v0[0], v0[1]); w.y = cvt_pk_bf16(v0[2], v0[3]); w.z = cvt_pk_bf16(v1[0], v1[1]); w.w = cvt_pk_bf16(v1[2], v1[3]);
                    *(u32x4*)(rowp + bj * HALF) = w; } }
    }
};
struct EpiInProj {
    static constexpr bool PERM = true;
    bf16_t* O; const PG8_LAS float* gains; const PG8_LAS float* rope;
    __device__ __forceinline__ void operator()(const f32x4 (&acc)[2][2][4][2], const Unit& u, int wr, int wc, int fr, int fq) const {
        const int c0 = u.pn * BM + 64 * wc;
        const int kind = (c0 >= PC_NAQ && c0 < PC_NAK) ? 1 : (c0 >= PC_NAK && c0 < PC_NAV) ? 2 : (c0 >= PC_GAQ && c0 < PC_GAK) ? 3 : (c0 >= PC_GAK && c0 < PC_GAV) ? 4 : 0;
        const int row0 = u.pm * BM + wr * 64 + fr;
        if (kind == 0) {
#pragma unroll
            for (int ai = 0; ai < 2; ++ai)
#pragma unroll
                for (int m = 0; m < 4; ++m) { bf16_t* rowp = O + (size_t)(row0 + ai * HALF + m * 16) * NP + c0 + 8 * fq;
#pragma unroll
                    for (int bj = 0; bj < 2; ++bj) { const f32x4 v0 = acc[ai][bj][m][0], v1 = acc[ai][bj][m][1];
                        u32x4 w; w.x = cvt_pk_bf16(v0[0], v0[1]); w.y = cvt_pk_bf16(v0[2], v0[3]); w.z = cvt_pk_bf16(v1[0], v1[1]); w.w = cvt_pk_bf16(v1[2], v1[3]);
                        *(u32x4*)(rowp + 32 * bj) = w; } }
            return;
        }
        const PG8_LAS float* gp = gains + (kind - 1) * 64;
        const float qs = (kind == 1 || kind == 3) ? QSCALE : 1.0f;
        const bool dorope = kind >= 3 && u.pm < MX / BM;
#pragma unroll
        for (int ai = 0; ai < 2; ++ai)
#pragma unroll
            for (int m = 0; m < 4; ++m) { const int row = row0 + ai * HALF + m * 16;
                f32x4 v[2][2]; float ss = 0.f;
#pragma unroll
                for (int bj = 0; bj < 2; ++bj)
#pragma unroll
                    for (int n = 0; n < 2; ++n) { v[bj][n] = acc[ai][bj][m][n]; ss += (v[bj][n][0] * v[bj][n][0] + v[bj][n][1] * v[bj][n][1]) + (v[bj][n][2] * v[bj][n][2] + v[bj][n][3] * v[bj][n][3]); }
                ss += __shfl_xor(ss, 16); ss += __shfl_xor(ss, 32);
                const float rstd = 1.0f / sqrtf(ss * (1.0f / 64.0f) + EPS);
#pragma unroll
                for (int bj = 0; bj < 2; ++bj)
#pragma unroll
                    for (int n = 0; n < 2; ++n) v[bj][n] = v[bj][n] * rstd * *(const PG8_LAS f32x4*)(gp + 32 * bj + 8 * fq + 4 * n);
                if (dorope) { const int t = row % S;
#pragma unroll
                    for (int bj = 0; bj < 2; ++bj) { const int pos = bj == 0 ? t / GW : t % GW;
#pragma unroll
                        for (int n = 0; n < 2; ++n) { const PG8_LAS float* rp = rope + (pos * 16 + 8 * (fq & 1) + 4 * n) * 2; const f32x4 a = *(const PG8_LAS f32x4*)rp, b = *(const PG8_LAS f32x4*)(rp + 4);
                            const f32x4 cs = (f32x4){a[0], a[2], b[0], b[2]}, sn = (f32x4){a[1], a[3], b[1], b[3]};
                            f32x4 o; o[0] = __shfl_xor(v[bj][n][0], 32); o[1] = __shfl_xor(v[bj][n][1], 32); o[2] = __shfl_xor(v[bj][n][2], 32); o[3] = __shfl_xor(v[bj][n][3], 32);
                            v[bj][n] = (fq & 2) ? (o * sn + v[bj][n] * cs) : (v[bj][n] * cs - o * sn); } } }
                bf16_t* rowp = O + (size_t)row * NP + c0 + 8 * fq;
#pragma unroll
                for (int bj = 0; bj < 2; ++bj) { const f32x4 v0 = v[bj][0] * qs, v1 = v[bj][1] * qs;
                    u32x4 w; w.x = cvt_pk_bf16(v0[0], v0[1]); w.y = cvt_pk_bf16(v0[2], v0[3]); w.z = cvt_pk_bf16(v1[0], v1[1]); w.w = cvt_pk_bf16(v1[2], v1[3]);
                    *(u32x4*)(rowp + 32 * bj) = w; }
                asm volatile("" ::: "memory"); }
    }
};
__device__ __forceinline__ float silu_fast(float v) { return v * __builtin_amdgcn_rcpf(1.0f + __builtin_amdgcn_exp2f(-1.4426950408889634f * v)); }
struct EpiSwiGLU {
    static constexpr bool PERM = true;
    bf16_t* H; int ldc;
    __device__ __forceinline__ void operator()(const f32x4 (&acc)[2][2][4][2], const Unit& u, int wr, int wc, int fr, int fq) const {
        const int row0 = u.pm * BM + wr * 64 + fr, col0 = u.pn * HALF + wc * 32 + 8 * fq;
#pragma unroll
        for (int ai = 0; ai < 2; ++ai)
#pragma unroll
            for (int m = 0; m < 4; ++m) { bf16_t* rowp = H + (size_t)(row0 + ai * HALF + m * 16) * ldc + col0;
                const f32x4 g0 = acc[ai][0][m][0], g1 = acc[ai][0][m][1], u0 = acc[ai][1][m][0], u1 = acc[ai][1][m][1];
                u32x4 w; w.x = cvt_pk_bf16(silu_fast(g0[0]) * u0[0], silu_fast(g0[1]) * u0[1]); w.y = cvt_pk_bf16(silu_fast(g0[2]) * u0[2], silu_fast(g0[3]) * u0[3]);
                w.z = cvt_pk_bf16(silu_fast(g1[0]) * u1[0], silu_fast(g1[1]) * u1[1]); w.w = cvt_pk_bf16(silu_fast(g1[2]) * u1[2], silu_fast(g1[3]) * u1[3]);
                *(u32x4*)rowp = w; }
    }
};
__device__ __forceinline__ unsigned pk4_fp8(float a, float b, float c, float d) {
    a = __builtin_amdgcn_fmed3f(a, -F8_MAX, F8_MAX); b = __builtin_amdgcn_fmed3f(b, -F8_MAX, F8_MAX); c = __builtin_amdgcn_fmed3f(c, -F8_MAX, F8_MAX); d = __builtin_amdgcn_fmed3f(d, -F8_MAX, F8_MAX);
    int r = __builtin_amdgcn_cvt_pk_fp8_f32(a, b, 0, false); r = __builtin_amdgcn_cvt_pk_fp8_f32(c, d, r, true); return (unsigned)r; }
struct EpiSwiGLU8 {
    static constexpr bool PERM = true;
    unsigned char* H; int ldc;
    __device__ __forceinline__ void operator()(const f32x4 (&acc)[2][2][4][2], const Unit& u, int wr, int wc, int fr, int fq) const {
        typedef float f32x2 __attribute__((ext_vector_type(2)));
        static_assert(F8_SA * F8_SWU == 1024.0f && F8_SH == 4.0f, "the folded constants below");
        const int row0 = u.pm * BM + wr * 64 + fr, col0 = u.pn * HALF + wc * 32 + 8 * fq;
        constexpr float K1 = -1.4426950408889634f / 1024.0f, C0 = 18.0f, D0 = 262144.0f;
#pragma unroll
        for (int ai = 0; ai < 2; ++ai)
#pragma unroll
            for (int m = 0; m < 4; ++m) { unsigned char* rowp = H + (size_t)(row0 + ai * HALF + m * 16) * ldc + col0;
                f32x2 o[4];
#pragma unroll
                for (int q = 0; q < 4; ++q) { const f32x4 ga = acc[ai][0][m][q >> 1], ua = acc[ai][1][m][q >> 1];
                    const f32x2 g = (q & 1) ? (f32x2){ga[2], ga[3]} : (f32x2){ga[0], ga[1]}, uu = (q & 1) ? (f32x2){ua[2], ua[3]} : (f32x2){ua[0], ua[1]};
                    const f32x2 a = g * K1 + C0; f32x2 t; t.x = __builtin_amdgcn_exp2f(a.x); t.y = __builtin_amdgcn_exp2f(a.y);
                    const f32x2 d = t + D0; f32x2 r; r.x = __builtin_amdgcn_rcpf(d.x); r.y = __builtin_amdgcn_rcpf(d.y);
                    o[q] = (g * uu) * r; }
                u32x2 w; w.x = pk4_fp8(o[0].x, o[0].y, o[1].x, o[1].y); w.y = pk4_fp8(o[2].x, o[2].y, o[3].x, o[3].y);
                *(u32x2*)rowp = w; }
    }
};
struct EpiResGate {
    static constexpr bool PERM = false;
    const float *xs, *cs; float *xd, *cd; const float* gate; float oscale;
    __device__ __forceinline__ void operator()(const f32x4 (&acc)[2][2][4][2], const Unit& u, int wr, int wc, int fr, int fq) const {
        const bool lat = u.pm < MX / BM; const int prow = (lat ? u.pm : u.pm - MX / BM) * BM + wr * 64 + fr, col0 = u.pn * BM + wc * 32 + 4 * fq;
        const float* s = lat ? xs : cs; float* d = lat ? xd : cd; const float* g = gate + (size_t)(lat ? u.pm / (S / BM) : 8) * 6 * D + col0;
        f32x4 gv[2][2];
#pragma unroll
        for (int bj = 0; bj < 2; ++bj)
#pragma unroll
            for (int n = 0; n < 2; ++n) gv[bj][n] = *(const f32x4*)(g + bj * HALF + n * 16) * oscale;
        constexpr int DEPTH = 3;
        f32x4 xb[DEPTH][2][2];
#define RG_LOAD(b) do { const size_t off_ = (size_t)(prow + ((b) >> 2) * HALF + ((b) & 3) * 16) * D + col0; \
        _Pragma("unroll") for (int bj = 0; bj < 2; ++bj) _Pragma("unroll") for (int n = 0; n < 2; ++n) xb[(b) % DEPTH][bj][n] = *(const f32x4*)(s + off_ + bj * HALF + n * 16); } while (0)
#pragma unroll
        for (int b = 0; b < DEPTH; ++b) RG_LOAD(b);
        __builtin_amdgcn_sched_barrier(0);
#pragma unroll
        for (int b = 0; b < 8; ++b) { const int ai = b >> 2, m = b & 3; const size_t off = (size_t)(prow + ai * HALF + m * 16) * D + col0;
#pragma unroll
            for (int bj = 0; bj < 2; ++bj)
#pragma unroll
                for (int n = 0; n < 2; ++n) *(f32x4*)(d + off + bj * HALF + n * 16) = xb[b % DEPTH][bj][n] + gv[bj][n] * acc[ai][bj][m][n];
            __builtin_amdgcn_sched_barrier(0);
            if (b + DEPTH < 8) { RG_LOAD(b + DEPTH); __builtin_amdgcn_sched_barrier(0); } }
#undef RG_LOAD
    }
};
typedef _Float16 hf2_t __attribute__((ext_vector_type(2))); typedef float f32x2_t __attribute__((ext_vector_type(2)));
__device__ __forceinline__ unsigned pkh(float a, float b) { const f32x2_t v = {a, b}; const hf2_t h = __builtin_convertvector(v, hf2_t); return __builtin_bit_cast(unsigned, h); }
__device__ __forceinline__ f32x4 bflo4(unsigned a, unsigned b) { const hf2_t x = __builtin_bit_cast(hf2_t, a), y = __builtin_bit_cast(hf2_t, b); return (f32x4){(float)x[0], (float)x[1], (float)y[0], (float)y[1]}; }
template <bool SRCF32> struct EpiResB {
    static constexpr bool PERM = true;
    const float* xs; bf16_t* xb; const float* gate; float oscale;
    __device__ __forceinline__ void operator()(const f32x4 (&acc)[2][2][4][2], const Unit& u, int wr, int wc, int fr, int fq) const {
        const int prow = u.pm * BM + wr * 64 + fr, col0 = u.pn * BM + wc * 32 + 8 * fq;
        const float* g = gate + (size_t)(u.pm / (S / BM)) * 6 * D + col0;
        f32x4 gv[2][2];
#pragma unroll
        for (int bj = 0; bj < 2; ++bj)
#pragma unroll
            for (int n = 0; n < 2; ++n) gv[bj][n] = *(const f32x4*)(g + bj * HALF + n * 4) * oscale;
        constexpr int DEPTH = 3;
        f32x4 xf[SRCF32 ? DEPTH : 1][2][2]; u32x4 xh[SRCF32 ? 1 : DEPTH][2];
#define RB_LOAD(b) do { const size_t off_ = (size_t)(prow + ((b) >> 2) * HALF + ((b) & 3) * 16) * D + col0; \
        _Pragma("unroll") for (int bj = 0; bj < 2; ++bj) { if constexpr (SRCF32) { xf[(b) % DEPTH][bj][0] = *(const f32x4*)(xs + off_ + bj * HALF); xf[(b) % DEPTH][bj][1] = *(const f32x4*)(xs + off_ + bj * HALF + 4); } \
            else xh[(b) % DEPTH][bj] = *(const u32x4*)(xb + off_ + bj * HALF); } } while (0)
#pragma unroll
        for (int b = 0; b < DEPTH; ++b) RB_LOAD(b);
        __builtin_amdgcn_sched_barrier(0);
#pragma unroll
        for (int b = 0; b < 8; ++b) { const int ai = b >> 2, m = b & 3; const size_t off = (size_t)(prow + ai * HALF + m * 16) * D + col0;
#pragma unroll
            for (int bj = 0; bj < 2; ++bj) { f32x4 s0, s1;
                if constexpr (SRCF32) { s0 = xf[b % DEPTH][bj][0]; s1 = xf[b % DEPTH][bj][1]; } else { const u32x4 h = xh[b % DEPTH][bj]; s0 = bflo4(h.x, h.y); s1 = bflo4(h.z, h.w); }
                const f32x4 v0 = s0 + gv[bj][0] * acc[ai][bj][m][0], v1 = s1 + gv[bj][1] * acc[ai][bj][m][1];
                u32x4 w; w.x = pkh(v0[0], v0[1]); w.y = pkh(v0[2], v0[3]); w.z = pkh(v1[0], v1[1]); w.w = pkh(v1[2], v1[3]);
                *(u32x4*)(xb + off + bj * HALF) = w; }
            __builtin_amdgcn_sched_barrier(0);
            if (b + DEPTH < 8) { RB_LOAD(b + DEPTH); __builtin_amdgcn_sched_barrier(0); } }
#undef RB_LOAD
    }
};
template <bool LAST> struct EpiMoeDownB {
    static constexpr bool PERM = true;
    const int* list; const float* sw; int pass; bf16_t* xb; float* out; const float* gate; float oscale; PG8_LAS float* gtab;
    __device__ __forceinline__ void operator()(const f32x4 (&acc)[2][2][4][2], const Unit& u, int wr, int wc, int fr, int fq) const {
        const int slot0 = u.pm * BM + wr * 64 + fr, col0 = u.pn * BM + wc * 32 + 8 * fq;
        {
            const int t_ = my_tid(); *(PG8_LAS f32x4*)(gtab + (t_ >> 6) * 256 + 4 * (t_ & 63)) = *(const f32x4*)(gate + (size_t)(t_ >> 6) * 6 * D + u.pn * BM + 4 * (t_ & 63)); }
        int tok[8]; float w[8];
#pragma unroll
        for (int b = 0; b < 8; ++b) { tok[b] = list[slot0 + (b >> 2) * HALF + (b & 3) * 16]; w[b] = sw[slot0 + (b >> 2) * HALF + (b & 3) * 16] * oscale; }
        constexpr int DEPTH = 4;
        u32x4 xh[DEPTH][2];
#define MD_LOAD(b) do { const int t_ = tok[b] < 0 ? 0 : tok[b]; const bf16_t* x_ = xb + (size_t)t_ * D + col0; \
        _Pragma("unroll") for (int bj = 0; bj < 2; ++bj) xh[(b) % DEPTH][bj] = *(const u32x4*)(x_ + bj * HALF); } while (0)
#pragma unroll
        for (int b = 0; b < DEPTH; ++b) MD_LOAD(b);
        __builtin_amdgcn_sched_barrier(0);
        asm volatile("s_waitcnt lgkmcnt(0)\n\ts_barrier" ::: "memory");
#pragma unroll
        for (int b = 0; b < 8; ++b) { const int ai = b >> 2, m = b & 3;
            if (tok[b] >= 0) { const PG8_LAS float* g_ = gtab + (tok[b] / S) * 256 + wc * 32 + 8 * fq;
#pragma unroll
                for (int bj = 0; bj < 2; ++bj) { const u32x4 h = xh[b % DEPTH][bj]; const f32x4 g0 = *(const PG8_LAS f32x4*)(g_ + bj * HALF), g1 = *(const PG8_LAS f32x4*)(g_ + bj * HALF + 4);
                    const f32x4 v0 = bflo4(h.x, h.y) + g0 * w[b] * acc[ai][bj][m][0], v1 = bflo4(h.z, h.w) + g1 * w[b] * acc[ai][bj][m][1];
                    if constexpr (LAST) { float* o = out + (size_t)tok[b] * D + col0 + bj * HALF; *(f32x4*)o = v0; *(f32x4*)(o + 4) = v1; }
                    else { u32x4 q; q.x = pkh(v0[0], v0[1]); q.y = pkh(v0[2], v0[3]); q.z = pkh(v1[0], v1[1]); q.w = pkh(v1[2], v1[3]); *(u32x4*)(xb + (size_t)tok[b] * D + col0 + bj * HALF) = q; } } }
            __builtin_amdgcn_sched_barrier(0);
            if (b + DEPTH < 8) { MD_LOAD(b + DEPTH); __builtin_amdgcn_sched_barrier(0); } }
#undef MD_LOAD
    }
};
struct EpiPartial {
    static constexpr bool PERM = false;
    float* slab; int nN, pm0, ksplit;
    __device__ __forceinline__ void operator()(const f32x4 (&acc)[2][2][4][2], const Unit& u, int wr, int wc, int fr, int fq) const {
        float* base = slab + ((size_t)((u.pm - pm0) * nN + u.pn) * ksplit + u.kp) * (BM * BM) + (size_t)(wr * 64 + fr) * BM + wc * 32 + 4 * fq;
#pragma unroll
        for (int ai = 0; ai < 2; ++ai)
#pragma unroll
            for (int m = 0; m < 4; ++m)
#pragma unroll
                for (int bj = 0; bj < 2; ++bj)
#pragma unroll
                    for (int n = 0; n < 2; ++n) *(f32x4*)(base + (size_t)(ai * HALF + m * 16) * BM + bj * HALF + n * 16) = acc[ai][bj][m][n];
    }
};
struct EpiMoeDown {
    static constexpr bool PERM = false;
    const int* list; const float* topw; int pass; float* x; const float* gate; float oscale;
    __device__ __forceinline__ void operator()(const f32x4 (&acc)[2][2][4][2], const Unit& u, int wr, int wc, int fr, int fq) const {
        const int slot0 = u.pm * BM + wr * 64 + fr, col0 = u.pn * BM + wc * 32 + 4 * fq;
#pragma unroll
        for (int ai = 0; ai < 2; ++ai)
#pragma unroll
            for (int m = 0; m < 4; ++m) { const int tok = list[slot0 + ai * HALF + m * 16];
                if (tok >= 0) { const float w = topw[tok * 2 + pass] * oscale; const float* g = gate + (size_t)(tok / S) * 6 * D + col0; float* xr = x + (size_t)tok * D + col0;
#pragma unroll
                    for (int bj = 0; bj < 2; ++bj)
#pragma unroll
                        for (int n = 0; n < 2; ++n) { const f32x4 gv = *(const f32x4*)(g + bj * HALF + n * 16); f32x4* xp = (f32x4*)(xr + bj * HALF + n * 16); *xp = *xp + gv * w * acc[ai][bj][m][n]; } } }
    }
};

__device__ __forceinline__ void glds_s(const char* sbase_, unsigned voff, unsigned m0v_) { unsigned keep;
    const unsigned long long b_ = (unsigned long long)(uintptr_t)sbase_;
    const unsigned long long sbase = (unsigned long long)(unsigned)__builtin_amdgcn_readfirstlane((int)(unsigned)b_) | ((unsigned long long)(unsigned)__builtin_amdgcn_readfirstlane((int)(unsigned)(b_ >> 32)) << 32);
    const unsigned m0v = (unsigned)__builtin_amdgcn_readfirstlane((int)m0v_);
    asm volatile("s_mov_b32 %0, m0\n\ts_mov_b32 m0, %3\n\ts_nop 0\n\tglobal_load_lds_dwordx4 %1, %2\n\ts_mov_b32 m0, %0" : "=&s"(keep) : "v"(voff), "s"(sbase), "s"(m0v) : "memory"); }
typedef int i32x4 __attribute__((ext_vector_type(4)));
typedef int i32x8 __attribute__((ext_vector_type(8)));
__device__ __forceinline__ i32x8 cat8(bf16x8 a, bf16x8 b) { const i32x4 x = __builtin_bit_cast(i32x4, a), y = __builtin_bit_cast(i32x4, b); return __builtin_shufflevector(x, y, 0, 1, 2, 3, 4, 5, 6, 7); }
__device__ __forceinline__ bf16x8 lo8(i32x8 v) { return __builtin_bit_cast(bf16x8, (i32x4)__builtin_shufflevector(v, v, 0, 1, 2, 3)); }
__device__ __forceinline__ bf16x8 hi8(i32x8 v) { return __builtin_bit_cast(bf16x8, (i32x4)__builtin_shufflevector(v, v, 4, 5, 6, 7)); }
template <class Epi, bool ALIGN_EPI, bool GATHER, bool F8 = false>
__device__ __forceinline__ void gemm_phase(PG8_LAS unsigned char* lds, const bf16_t* A, int ldk, int K, const Order& S, const Epi& E) {
    int tid_ = my_tid(); asm volatile("" : "+v"(tid_));
    const int tid = tid_, wid = __builtin_amdgcn_readfirstlane(tid >> 6), lane = tid & 63, wr = wid >> 2, wc = wid & 3, fr = lane & 15, fq = lane >> 4;
    const int nt = K / BK;
    unsigned voffB[2]; int RA[2], CA[2];
#pragma unroll
    for (int i = 0; i < 2; ++i) { int R, C; stage_rc(tid * 16 + i * 8192, R, C); const int Rb = Epi::PERM ? ((R & ~31) + perm32(R & 31)) : R; RA[i] = R; CA[i] = C; voffB[i] = (unsigned)(Rb * ldk + C) * 2u; }
    const size_t kstep = (size_t)(BK * 2);
    const size_t hstep = (size_t)HALF * ldk * 2;
    const size_t tstep = 2 * hstep;
    const unsigned ldsw = (unsigned)wid * 1024u;
    const unsigned ldsbase = (unsigned)__builtin_amdgcn_readfirstlane((int)((unsigned)(uintptr_t)lds + ldsw));
    const int aoff = lds_byte(wr * 64 + fr, fq * 8), boff = lds_byte(wc * 32 + fr, fq * 8);
#define PG8_SA(b, h) (((b) * 2 + (h)) * HTB)
#define PG8_SB(b, h) ((4 + (b) * 2 + (h)) * HTB)
#define PG8_STAGE_B(bufoff, gbase) do { _Pragma("unroll") for (int _i = 0; _i < 2; ++_i) glds_s((const char*)(gbase), voffB[_i], ldsbase + (unsigned)((bufoff) + _i * 8192)); } while (0)
#define PG8_STAGE_A(bufoff, gbase, o0, o1) do { glds_s((const char*)(gbase), (o0), ldsbase + (unsigned)(bufoff)); glds_s((const char*)(gbase), (o1), ldsbase + (unsigned)((bufoff) + 8192)); } while (0)
#define PG8_STAGE_AH(bufoff, gbase, oh0, oh1, o0, o1) do { if constexpr (GATHER) PG8_STAGE_A(bufoff, gbase, oh0, oh1); else PG8_STAGE_A(bufoff, (gbase) + hstep, o0, o1); } while (0)
#define PG8_LDA(dst, b, h) do { _Pragma("unroll") for (int m = 0; m < (F8 ? 2 : 4); ++m) _Pragma("unroll") for (int k = 0; k < 2; ++k) dst[m][k] = *(const PG8_LAS bf16x8*)(lds + PG8_SA(b, h) + aoff + m * 2048 + k * 1024); } while (0)
#define PG8_MMA8H(ai, hf) do { __builtin_amdgcn_s_setprio(1); _Pragma("unroll") for (int mm = 0; mm < 2; ++mm) _Pragma("unroll") for (int n = 0; n < 2; ++n) { \
        acc[ai][0][2 * (hf) + mm][n] = __builtin_amdgcn_mfma_scale_f32_16x16x128_f8f6f4(cat8(B0[n][0], B0[n][1]), cat8(At[mm][0], At[mm][1]), acc[ai][0][2 * (hf) + mm][n], 0, 0, 0, 0, 0, 0); \
        acc[ai][1][2 * (hf) + mm][n] = __builtin_amdgcn_mfma_scale_f32_16x16x128_f8f6f4(cat8(B1[n][0], B1[n][1]), cat8(At[mm][0], At[mm][1]), acc[ai][1][2 * (hf) + mm][n], 0, 0, 0, 0, 0, 0); } __builtin_amdgcn_s_setprio(0); } while (0)
#define PG8_CMP(ai, b, h) do { if constexpr (F8) { PG8_MMA8H(ai, 0); PG8_SCHED; \
        _Pragma("unroll") for (int m = 0; m < 2; ++m) _Pragma("unroll") for (int k = 0; k < 2; ++k) At[m][k] = *(const PG8_LAS bf16x8*)(lds + PG8_SA(b, h) + aoff + (2 + m) * 2048 + k * 1024); \
        PG8_WAIT_L(0); PG8_SCHED; PG8_MMA8H(ai, 1); } else { PG8_MMA(ai, 0, At, B0); PG8_MMA(ai, 1, At, B1); } } while (0)
#define PG8_LDB(dst, b, h) do { _Pragma("unroll") for (int n = 0; n < 2; ++n) _Pragma("unroll") for (int k = 0; k < 2; ++k) dst[n][k] = *(const PG8_LAS bf16x8*)(lds + PG8_SB(b, h) + boff + n * 2048 + k * 1024); } while (0)
#define PG8_MMA(ai, bj, At, Bt) do { __builtin_amdgcn_s_setprio(1); _Pragma("unroll") for (int m = 0; m < 4; ++m) _Pragma("unroll") for (int n = 0; n < 2; ++n) _Pragma("unroll") for (int k = 0; k < 2; ++k) \
        acc[ai][bj][m][n] = __builtin_amdgcn_mfma_f32_16x16x32_bf16(Bt[n][k], At[m][k], acc[ai][bj][m][n], 0, 0, 0); __builtin_amdgcn_s_setprio(0); } while (0)
#define PG8_WAIT_V(n) asm volatile("s_waitcnt vmcnt(" #n ")" ::: "memory")
#define PG8_WAIT_L(n) asm volatile("s_waitcnt lgkmcnt(" #n ")" ::: "memory")
#define PG8_BAR __builtin_amdgcn_s_barrier()
#define PG8_SCHED __builtin_amdgcn_sched_barrier(0)
    Unit cur, nxt; int ui = 0;
    if (!S.next(0, cur)) return;
    f32x4 acc[2][2][4][2];
#pragma unroll
    for (int a = 0; a < 2; ++a)
#pragma unroll
        for (int b = 0; b < 2; ++b)
#pragma unroll
            for (int m = 0; m < 4; ++m)
#pragma unroll
                for (int n = 0; n < 2; ++n) { acc[a][b][m][n] = (f32x4){0.f, 0.f, 0.f, 0.f}; if constexpr (F8) asm volatile("" : "+v"(acc[a][b][m][n])); }
    bf16x8 At[F8 ? 2 : 4][2], B0[2][2], B1[2][2];
    unsigned oc00, oc01, oc10, oc11, on00, on01, on10, on11;
    const size_t kpb = (size_t)S.kplen * 2;
    const char* cA; const char* cB = (const char*)S.bt(cur) + (size_t)cur.pn * tstep + cur.kp * kpb;
    bool has_next = S.next(1, nxt);
    if constexpr (GATHER) {
        cA = (const char*)A;
        oc00 = (unsigned)(S.row(cur, RA[0]) * ldk + CA[0]) * 2u; oc01 = (unsigned)(S.row(cur, RA[1]) * ldk + CA[1]) * 2u;
        oc10 = (unsigned)(S.row(cur, HALF + RA[0]) * ldk + CA[0]) * 2u; oc11 = (unsigned)(S.row(cur, HALF + RA[1]) * ldk + CA[1]) * 2u;
        on00 = oc00; on01 = oc01; on10 = oc10; on11 = oc11;
    } else {
        cA = (const char*)A + (size_t)cur.pm * tstep + cur.kp * kpb;
        oc00 = on00 = (unsigned)(RA[0] * ldk + CA[0]) * 2u; oc01 = on01 = (unsigned)(RA[1] * ldk + CA[1]) * 2u; oc10 = on10 = oc00 + (unsigned)hstep; oc11 = on11 = oc01 + (unsigned)hstep;
    }
    PG8_STAGE_B(PG8_SB(0, 0), cB); PG8_STAGE_B(PG8_SB(0, 1), cB + hstep); PG8_STAGE_A(PG8_SA(0, 0), cA, oc00, oc01); PG8_STAGE_AH(PG8_SA(0, 1), cA, oc10, oc11, oc00, oc01);
    if (wr == 1) PG8_BAR;
    PG8_WAIT_V(2); PG8_BAR;
    PG8_STAGE_B(PG8_SB(1, 0), cB + kstep); PG8_STAGE_A(PG8_SA(1, 0), cA + kstep, oc00, oc01); PG8_STAGE_B(PG8_SB(1, 1), cB + hstep + kstep);
    PG8_WAIT_V(6); PG8_BAR;
    for (;;) {
        if constexpr (GATHER) {
            if (has_next) { on00 = (unsigned)(S.row(nxt, RA[0]) * ldk + CA[0]) * 2u; on01 = (unsigned)(S.row(nxt, RA[1]) * ldk + CA[1]) * 2u;
                            on10 = (unsigned)(S.row(nxt, HALF + RA[0]) * ldk + CA[0]) * 2u; on11 = (unsigned)(S.row(nxt, HALF + RA[1]) * ldk + CA[1]) * 2u; }
        }
        const char* nA = GATHER ? cA : (has_next ? (const char*)A + (size_t)nxt.pm * tstep + nxt.kp * kpb : cA);
        const char* nB = has_next ? (const char*)S.bt(nxt) + (size_t)nxt.pn * tstep + nxt.kp * kpb : cB;
#pragma unroll 1
        for (int t = 0; t < nt; t += 2) {
            const bool last = (t == nt - 2);
            const char* a1 = cA + (size_t)(t + 1) * kstep;
            const char* a2 = last ? nA : cA + (size_t)(t + 2) * kstep; const char* b2 = last ? nB : cB + (size_t)(t + 2) * kstep;
            const char* a3 = a2 + kstep; const char* b3 = b2 + kstep;
            unsigned s00 = oc00, s01 = oc01, s10 = oc10, s11 = oc11;
            if constexpr (GATHER) { if (last) { s00 = on00; s01 = on01; s10 = on10; s11 = on11; } }
            PG8_LDB(B0, 0, 0); PG8_LDB(B1, 0, 1); PG8_SCHED; PG8_LDA(At, 0, 0); PG8_STAGE_AH(PG8_SA(1, 1), a1, oc10, oc11, oc00, oc01);
            PG8_WAIT_V(8); PG8_WAIT_L(0); PG8_BAR; PG8_CMP(0, 0, 0); PG8_BAR; PG8_SCHED;
            PG8_LDA(At, 0, 1); PG8_STAGE_B(PG8_SB(0, 0), b2); PG8_STAGE_B(PG8_SB(0, 1), b2 + hstep); PG8_STAGE_A(PG8_SA(0, 0), a2, s00, s01);
            PG8_WAIT_V(8); PG8_WAIT_L(0); PG8_BAR; PG8_CMP(1, 0, 1); PG8_BAR; PG8_SCHED;
            PG8_LDB(B0, 1, 0); PG8_LDB(B1, 1, 1); PG8_SCHED; PG8_LDA(At, 1, 0); PG8_STAGE_AH(PG8_SA(0, 1), a2, s10, s11, s00, s01);
            PG8_WAIT_V(8); PG8_WAIT_L(0); PG8_BAR; PG8_CMP(0, 1, 0); PG8_BAR; PG8_SCHED;
            PG8_LDA(At, 1, 1); PG8_STAGE_B(PG8_SB(1, 0), b3); PG8_STAGE_B(PG8_SB(1, 1), b3 + hstep); PG8_STAGE_A(PG8_SA(1, 0), a3, s00, s01);
            PG8_WAIT_V(8); PG8_WAIT_L(0); PG8_BAR; PG8_CMP(1, 1, 1); PG8_BAR; PG8_SCHED;
        }
        if constexpr (ALIGN_EPI) { if (wr == 0) PG8_BAR; }
        { int l_ = my_tid() & 63; asm volatile("" : "+v"(l_)); E(acc, cur, wr, wc, l_ & 15, l_ >> 4); }
        if (!has_next) break;
#pragma unroll
        for (int a = 0; a < 2; ++a)
#pragma unroll
            for (int b = 0; b < 2; ++b)
#pragma unroll
                for (int m = 0; m < 4; ++m)
#pragma unroll
                    for (int n = 0; n < 2; ++n) { acc[a][b][m][n] = (f32x4){0.f, 0.f, 0.f, 0.f}; if constexpr (F8) asm volatile("" : "+v"(acc[a][b][m][n])); }
        cur = nxt; cA = nA; cB = nB; ++ui;
        if constexpr (GATHER) { oc00 = on00; oc01 = on01; oc10 = on10; oc11 = on11; }
        has_next = S.next(ui + 1, nxt);
        if constexpr (ALIGN_EPI) { if (wr == 1) PG8_BAR; }
    }
    PG8_WAIT_V(0);
    if constexpr (!ALIGN_EPI) { if (wr == 0) PG8_BAR; }
    PG8_BAR;
#undef PG8_SA
#undef PG8_SB
#undef PG8_STAGE_A
#undef PG8_STAGE_B
#undef PG8_LDA
#undef PG8_MMA8H
#undef PG8_CMP
#undef PG8_STAGE_AH
#undef PG8_LDB
#undef PG8_MMA
#undef PG8_WAIT_V
#undef PG8_WAIT_L
#undef PG8_BAR
#undef PG8_SCHED
}
}


#include <hip/hip_bf16.h>
namespace attn_body {
using bf16=__hip_bfloat16;
using bf16x8=__attribute__((ext_vector_type(8)))short;
using s16x4=__attribute__((ext_vector_type(4)))short;
using f32x16=__attribute__((ext_vector_type(16)))float;
using u32x4=__attribute__((ext_vector_type(4)))unsigned;
constexpr int D=64,DM=NP;
constexpr int NW=8,QBLK=32,QB=QBLK*NW,KVBLK=64;
__device__ __forceinline__ int crow(int r,int hi){return (r&3)+8*(r>>2)+4*hi;}
#define SBAR() __builtin_amdgcn_sched_barrier(0)
constexpr int NSLOT=3, SLOTB=8192;
constexpr int LDS_K=0, LDS_V=NSLOT*SLOTB, LDS_WS=2*NSLOT*SLOTB, LDS_OST=LDS_WS+NW*64*4, LDS_TAB=LDS_OST+NW*4096, LDS_BYTES=LDS_TAB+2048;
constexpr float C2=0.125f*1.4426950408889634f;
__device__ __forceinline__ void glds16(const void*gsrc,unsigned lds_dst){unsigned keep;
  asm volatile("s_mov_b32 %0, m0\n\ts_mov_b32 m0, %2\n\ts_nop 0\n\tglobal_load_lds_dwordx4 %1, off\n\ts_mov_b32 m0, %0":"=&s"(keep):"v"(gsrc),"s"(lds_dst):"memory");}
__device__ __forceinline__ float max3f(float a,float b,float c){float r;asm("v_max3_f32 %0, %1, %2, %3":"=v"(r):"v"(a),"v"(b),"v"(c));return r;}
__device__ __forceinline__ float max2f(float a,float b){float r;asm("v_max_f32_e32 %0, %1, %2":"=v"(r):"v"(a),"v"(b));return r;}
__device__ __forceinline__ float fadd_s(float a,float b){float r;asm("v_add_f32_e32 %0, %1, %2":"=v"(r):"v"(a),"v"(b));return r;}
__device__ __forceinline__ float fsub_s(float a,float b){float r;asm("v_sub_f32_e32 %0, %1, %2":"=v"(r):"v"(a),"v"(b));return r;}
typedef float f32x2_t __attribute__((ext_vector_type(2))); typedef __bf16 bf16x2_t __attribute__((ext_vector_type(2)));
__device__ __forceinline__ unsigned cvtpk_s(float lo,float hi){f32x2_t v={lo,hi};bf16x2_t b=__builtin_convertvector(v,bf16x2_t);return __builtin_bit_cast(unsigned,b);}
#define WAIT_BAR(N) asm volatile("s_waitcnt vmcnt(" #N ") lgkmcnt(0)\n\ts_barrier":::"memory")

__device__ __forceinline__ void qkt(f32x16&p0,f32x16&p1,const char*Kslot,const bf16x8*qr,const f32x16&negm,int r32,int hi){
  const char*kb=Kslot+hi*1024+r32*16;
  #pragma unroll
  for(int d0=0;d0<4;++d0){
    const bf16x8 b0=*reinterpret_cast<const bf16x8*>(kb+d0*2048);
    const bf16x8 b1=*reinterpret_cast<const bf16x8*>(kb+d0*2048+512);
    if(d0==0){p0=__builtin_amdgcn_mfma_f32_32x32x16_bf16(b0,qr[0],negm,0,0,0);p1=__builtin_amdgcn_mfma_f32_32x32x16_bf16(b1,qr[0],negm,0,0,0);}
    else{p0=__builtin_amdgcn_mfma_f32_32x32x16_bf16(b0,qr[d0],p0,0,0,0);p1=__builtin_amdgcn_mfma_f32_32x32x16_bf16(b1,qr[d0],p1,0,0,0);}}
}
typedef __attribute__((address_space(3))) const char* lds_cptr;
typedef short v4i16_t __attribute__((ext_vector_type(4)));
__device__ __forceinline__ void kload8(bf16x8*kf,lds_cptr kp){
  kf[0]=*(const __attribute__((address_space(3))) bf16x8*)(kp);      kf[1]=*(const __attribute__((address_space(3))) bf16x8*)(kp+512);
  kf[2]=*(const __attribute__((address_space(3))) bf16x8*)(kp+2048); kf[3]=*(const __attribute__((address_space(3))) bf16x8*)(kp+2560);
  kf[4]=*(const __attribute__((address_space(3))) bf16x8*)(kp+4096); kf[5]=*(const __attribute__((address_space(3))) bf16x8*)(kp+4608);
  kf[6]=*(const __attribute__((address_space(3))) bf16x8*)(kp+6144); kf[7]=*(const __attribute__((address_space(3))) bf16x8*)(kp+6656);
}
__device__ __forceinline__ void kload2(bf16x8*kf,lds_cptr kp,int j){ kf[2*j]=*(const __attribute__((address_space(3))) bf16x8*)(kp+j*2048); kf[2*j+1]=*(const __attribute__((address_space(3))) bf16x8*)(kp+j*2048+512); }
__device__ __forceinline__ s16x4 vtr(lds_cptr p){ return __builtin_bit_cast(s16x4,__builtin_amdgcn_ds_read_tr16_b64_v4i16((__attribute__((address_space(3))) v4i16_t*)p)); }
__device__ __forceinline__ float rowmax(const f32x16&p0,const f32x16&p1){
  float a=max3f(p0[0],p0[1],p1[0]),b=max3f(p0[2],p0[3],p1[1]);a=max3f(a,p1[2],p1[3]);
  #pragma unroll
  for(int r=4;r<16;r+=4){a=max3f(a,p0[r],p0[r+1]);b=max3f(b,p0[r+2],p0[r+3]);a=max3f(a,p1[r],p1[r+1]);b=max3f(b,p1[r+2],p1[r+3]);}
  const float m=max2f(a,b);
  auto rr=__builtin_amdgcn_permlane32_swap(__float_as_uint(m),__float_as_uint(m),false,false);
  return max2f(__uint_as_float(rr[0]),__uint_as_float(rr[1]));
}
__device__ __forceinline__ void pv(f32x16*o,int vb,bf16x8 pa0,bf16x8 pa1,bf16x8 pa2,bf16x8 pa3){
  #pragma unroll
  for(int d0=0;d0<2;++d0){s16x4 lo[4],hi[4];
    #pragma unroll
    for(int ks=0;ks<4;++ks){
      asm volatile("ds_read_b64_tr_b16 %0,%1 offset:%c2":"=&v"(lo[ks]):"v"(vb),"i"(d0*4096+ks*1024):"memory");
      asm volatile("ds_read_b64_tr_b16 %0,%1 offset:%c2":"=&v"(hi[ks]):"v"(vb),"i"(d0*4096+ks*1024+512):"memory");}
    asm volatile("s_waitcnt lgkmcnt(0)":::"memory");SBAR();
    #define PK(k) (bf16x8){lo[k][0],lo[k][1],lo[k][2],lo[k][3],hi[k][0],hi[k][1],hi[k][2],hi[k][3]}
    o[d0]=__builtin_amdgcn_mfma_f32_32x32x16_bf16(pa0,PK(0),o[d0],0,0,0);
    o[d0]=__builtin_amdgcn_mfma_f32_32x32x16_bf16(pa1,PK(1),o[d0],0,0,0);
    o[d0]=__builtin_amdgcn_mfma_f32_32x32x16_bf16(pa2,PK(2),o[d0],0,0,0);
    o[d0]=__builtin_amdgcn_mfma_f32_32x32x16_bf16(pa3,PK(3),o[d0],0,0,0);
    #undef PK
  }
}

#ifndef ATTN_STORE16
#define ATTN_STORE16(p,v) (*(u32x4*)(p)=(v))
#endif
__device__ __forceinline__ void na_mask(f32x16&P0,f32x16&P1,int tl,int klo,int nlat,int wr0,int qgr,int qcol,int cs,int hi,float mhat,const float*tab){
  if(tl<0){
    #pragma unroll
    for(int r=0;r<16;++r){P0[r]-=mhat;P1[r]-=mhat;}
    return; }
  const int krow=klo+tl; const bool rv=(tl<nlat)&&(krow>=wr0)&&(krow<wr0+8);
  if(!rv){
    #pragma unroll
    for(int r=0;r<16;++r){P0[r]=-INFINITY;P1[r]=-INFINITY;}
    return; }
  int hio=hi; asm volatile("":"+v"(hio));
  const float*tb=tab+(krow-qgr+7)*31+15-qcol+4*hio; const int kb=4*hio-cs;
  #pragma unroll
  for(int r=0;r<16;++r){ const int c0=(r&3)+8*(r>>2);
    const bool v0=(unsigned)(c0+kb)<16u, v1=(unsigned)(c0+32+kb)<16u;
    const float b0=tb[c0], b1=tb[c0+32];
    P0[r]=v0?(P0[r]-mhat)+b0:-INFINITY; P1[r]=v1?(P1[r]-mhat)+b1:-INFINITY; }
}
template<int THRL,int MODE> __device__ __forceinline__ void attn_unit(const int b,const int qrow0,const int klo,const int NT,const int nlat,const bf16*Qg,const bf16*__restrict__ Kg,const bf16*__restrict__ Vg,bf16*Og,const float*rpb,char*shm){
  int tid_=my_tid(); asm volatile("":"+v"(tid_));
  const int tid=tid_,lane=tid&63,r32=lane&31,hi=lane>>5; const int wid=__builtin_amdgcn_readfirstlane(tid>>6);
  const bf16*Qw=Qg+((long)qrow0+wid*QBLK)*DM;
  #define TROW(t) ((long)(MODE==0 ? ((t)<S/64 ? (long)b*S+64*(t) : (long)MX+(long)b*LC+64*((t)-S/64)) : MODE==1 ? ((t)<LC/64 ? (long)MX+(long)b*LC+64*(t) : (long)b*S+64*(klo+((t)-LC/64<nlat?(t)-LC/64:nlat-1))) : (long)MX+(long)b*LC+64*(t)))
  const unsigned lds0=(unsigned)(uintptr_t)shm;
  float*wsf=(float*)(shm+LDS_WS)+wid*64;
  const bf16*ksrc=Kg+(long)lane*DM+wid*8;
  const bf16*vsrc=Vg+(long)(16*(wid&3)+(lane>>2))*DM+(wid>>2)*32+(lane&3)*8;
  const unsigned kdst=lds0+LDS_K+wid*1024, vdst=lds0+LDS_V+wid*1024;
  #define DMA_K(t,slot) glds16(ksrc+TROW(t)*DM,(unsigned)__builtin_amdgcn_readfirstlane(kdst+(slot)))
  #define DMA_V(t,slot) glds16(vsrc+TROW(t)*DM,(unsigned)__builtin_amdgcn_readfirstlane(vdst+(slot)))
  const int vb0=(int)(lds0+LDS_V)+((lane>>4)&1)*32+(lane&3)*8+(4*hi+((lane&15)>>2))*64;
  const char*Kbase=shm+LDS_K; bf16x8 kf[8];
  const lds_cptr shm3=(lds_cptr)shm; const lds_cptr kp0=shm3+LDS_K+hi*1024+r32*16; const lds_cptr vp0=shm3+LDS_V+((lane>>4)&1)*32+(lane&3)*8+(4*hi+((lane&15)>>2))*64;
  DMA_K(0,0);DMA_V(0,0);DMA_K(1,SLOTB);
  bf16x8 qr[4];
  #pragma unroll
  for(int d0=0;d0<4;++d0)qr[d0]=*reinterpret_cast<const bf16x8*>(&Qw[(long)r32*DM+d0*16+hi*8]);
  float mhat=0.f,l_reg=0.f;f32x16 o[2];o[0]=f32x16{};o[1]=f32x16{};f32x16 negm=f32x16{}; if(MODE!=1){asm volatile("":"+v"(negm));} const f32x16 zero16_=f32x16{};
  #define NEGM_ (MODE==1?zero16_:negm)
  const int qcol=32*(wid&1)+r32, qgr=(qrow0%S)/64+(wid>>1); int cs_=qcol-8; cs_=cs_<0?0:(cs_>48?48:cs_); int wr0_=qgr-4; wr0_=wr0_<0?0:(wr0_>S/64-8?S/64-8:wr0_);
  const float*tab=(const float*)(shm+LDS_TAB);
  if(MODE==1){ for(int i_=tid;i_<15*31;i_+=512)((float*)(shm+LDS_TAB))[i_]=rpb[i_]*1.4426950408889634f; }
  #define CMASK(P0,P1,t) do{ if(MODE==1){ na_mask(P0,P1,(t)-LC/64,klo,nlat,wr0_,qgr,qcol,cs_,hi,mhat,tab); } }while(0)
  bool resc=false;
  #define START(P0,P1) do{ const float rm=rowmax(P0,P1); resc=false; \
    { const float dl=rm; mhat=fadd_s(mhat,dl); \
      _Pragma("unroll") for(int r=0;r<16;++r){P0[r]=fsub_s(P0[r],dl);P1[r]=fsub_s(P1[r],dl);} \
      if(MODE!=1){ _Pragma("unroll") for(int r=0;r<16;++r)negm[r]=-mhat; asm volatile("":"+v"(negm)); } } \
    _Pragma("unroll") for(int r=0;r<16;++r)P0[r]=__builtin_amdgcn_exp2f(P0[r]); }while(0)
  #define RESC() do{ if(resc){ asm volatile("s_waitcnt lgkmcnt(0)":::"memory"); \
      _Pragma("unroll") for(int d_=0;d_<2;++d_) _Pragma("unroll") for(int r=0;r<16;++r)o[d_][r]*=wsf[crow(r,hi)]; } }while(0)
  f32x16 pA0,pA1,pB0,pB1;
  int sl_prev=0,sl_cur=0,sl_next=SLOTB;
  #define ROT() do{sl_prev=sl_cur;sl_cur=sl_next;sl_next=(sl_next==(NSLOT-1)*SLOTB)?0:sl_next+SLOTB;}while(0)
  DMA_K(2,2*SLOTB);
  WAIT_BAR(3);
  qkt(pA0,pA1,Kbase,qr,NEGM_,r32,hi);asm volatile("s_nop 15\n\ts_nop 7":"+v"(pA0),"+v"(pA1));CMASK(pA0,pA1,0);
  START(pA0,pA1);
  _Pragma("unroll") for(int r=0;r<16;++r)pA1[r]=__builtin_amdgcn_exp2f(pA1[r]);
  WAIT_BAR(0);
  DMA_K(3,0);DMA_V(1,SLOTB);
  ROT();
  kload8(kf,kp0+sl_cur);
  WAIT_BAR(2);
  s16x4 vlo[8],vhi[8]; u32x4 pw0,pw1,pw2,pw3;
  #define PKW(P,B) cvtpk_s(P[B],P[B+1])
  #define PAF(k) __builtin_bit_cast(bf16x8,pw##k)
  #define VFR(i) (bf16x8){vlo[i][0],vlo[i][1],vlo[i][2],vlo[i][3],vhi[i][0],vhi[i][1],vhi[i][2],vhi[i][3]}
  #define PIN(x) asm volatile("":"+v"(x))
  #define MX3(a,b,c) __builtin_fmaxf(__builtin_fmaxf((a),(b)),(c))
  #define GAPA(MF,A0,A1,A2,A3,W0,W1,PW) do{ MF; sacc+=A0; sacc+=A1; sacc+=A2; sacc+=A3; PIN(sacc); W0; W1; PIN(PW); SBAR(); }while(0)
  #define EX(v) __builtin_amdgcn_exp2f(v)
  #define GAPB(MF,X,B) do{ MF; X[B]=EX(X[B]); X[B+1]=EX(X[B+1]); X[B+2]=EX(X[B+2]); X[B+3]=EX(X[B+3]); PIN(X); SBAR(); }while(0)
  #define VRD(i) do{ vlo[i]=vtr(vp_+(((i)>>2)*4096+((i)&3)*1024)); vhi[i]=vtr(vp_+(((i)>>2)*4096+((i)&3)*1024+512)); }while(0)
  #define KRD(G,j) do{ if(G){ kload2(kf,kp0+sl_next,j); SBAR(); } }while(0)
  #define STEP(C0,C1,P0,P1,t,GK,GV,GL) do{ SBAR(); \
    const lds_cptr vp_=vp0+sl_prev; \
    VRD(0); SBAR(); float sacc=(P0[0]+P0[1]); \
    GAPA(C0=__builtin_amdgcn_mfma_f32_32x32x16_bf16(kf[0],qr[0],NEGM_,0,0,0), P0[2],P0[3],P0[4],P0[5],     pw0[0]=PKW(P0,0), pw0[1]=PKW(P0,2), pw0); \
    VRD(4); SBAR(); GAPA(C1=__builtin_amdgcn_mfma_f32_32x32x16_bf16(kf[1],qr[0],NEGM_,0,0,0), P0[6],P0[7],P0[8],P0[9],     pw0[2]=PKW(P0,4), pw0[3]=PKW(P0,6), pw0); \
    VRD(1); SBAR(); GAPA(C0=__builtin_amdgcn_mfma_f32_32x32x16_bf16(kf[2],qr[1],C0,0,0,0),   P0[10],P0[11],P0[12],P0[13], pw1[0]=PKW(P0,8), pw1[1]=PKW(P0,10), pw1); \
    VRD(5); SBAR(); GAPA(C1=__builtin_amdgcn_mfma_f32_32x32x16_bf16(kf[3],qr[1],C1,0,0,0),   P0[14],P0[15],P1[0],P1[1],   pw1[2]=PKW(P0,12),pw1[3]=PKW(P0,14), pw1); \
    VRD(2); SBAR(); GAPA(C0=__builtin_amdgcn_mfma_f32_32x32x16_bf16(kf[4],qr[2],C0,0,0,0),   P1[2],P1[3],P1[4],P1[5],     pw2[0]=PKW(P1,0), pw2[1]=PKW(P1,2), pw2); \
    VRD(6); SBAR(); GAPA(C1=__builtin_amdgcn_mfma_f32_32x32x16_bf16(kf[5],qr[2],C1,0,0,0),   P1[6],P1[7],P1[8],P1[9],     pw2[2]=PKW(P1,4), pw2[3]=PKW(P1,6), pw2); \
    VRD(3); SBAR(); GAPA(C0=__builtin_amdgcn_mfma_f32_32x32x16_bf16(kf[6],qr[3],C0,0,0,0),   P1[10],P1[11],P1[12],P1[13], pw3[0]=PKW(P1,8), pw3[1]=PKW(P1,10), pw3); \
    VRD(7); SBAR(); GAPA(C1=__builtin_amdgcn_mfma_f32_32x32x16_bf16(kf[7],qr[3],C1,0,0,0),   P1[14],P1[15],0.f,0.f,       pw3[2]=PKW(P1,12),pw3[3]=PKW(P1,14), pw3); \
    l_reg+=sacc; \
    if(GK){DMA_K((t)+3,sl_cur);} if(GV){DMA_V((t)+1,sl_next);} \
    CMASK(C0,C1,t); \
    { float a=MX3(C0[0],C0[1],C1[0]),b=MX3(C0[2],C0[3],C1[1]); a=MX3(a,C1[2],C1[3]); \
      _Pragma("unroll") for(int r=4;r<16;r+=4){a=MX3(a,C0[r],C0[r+1]);b=MX3(b,C0[r+2],C0[r+3]);a=MX3(a,C1[r],C1[r+1]);b=MX3(b,C1[r+2],C1[r+3]);} \
      float rm=__builtin_fmaxf(a,b); { auto rr=__builtin_amdgcn_permlane32_swap(__float_as_uint(rm),__float_as_uint(rm),false,false); rm=__builtin_fmaxf(__uint_as_float(rr[0]),__uint_as_float(rr[1])); } \
      resc=false; \
      if(__builtin_expect(__any(rm>(float)THRL),0)){ const float dl=__builtin_fmaxf(rm,0.f); mhat+=dl; \
        _Pragma("unroll") for(int r=0;r<16;++r){C0[r]-=dl;C1[r]-=dl;} \
        if(MODE!=1){ _Pragma("unroll") for(int r=0;r<16;++r)negm[r]=-mhat; asm volatile("":"+v"(negm)); } \
        const float f=__builtin_amdgcn_exp2f(-dl); l_reg*=f; if(hi==0)wsf[r32]=f; resc=true; } } \
    SBAR(); \
    GAPB(o[0]=__builtin_amdgcn_mfma_f32_32x32x16_bf16(PAF(0),VFR(0),o[0],0,0,0), C0,0); \
    GAPB(o[1]=__builtin_amdgcn_mfma_f32_32x32x16_bf16(PAF(0),VFR(4),o[1],0,0,0), C0,4); \
    KRD(GL,0); GAPB(o[0]=__builtin_amdgcn_mfma_f32_32x32x16_bf16(PAF(1),VFR(1),o[0],0,0,0), C0,8); \
    KRD(GL,1); GAPB(o[1]=__builtin_amdgcn_mfma_f32_32x32x16_bf16(PAF(1),VFR(5),o[1],0,0,0), C0,12); \
    KRD(GL,2); GAPB(o[0]=__builtin_amdgcn_mfma_f32_32x32x16_bf16(PAF(2),VFR(2),o[0],0,0,0), C1,0); \
    KRD(GL,3); GAPB(o[1]=__builtin_amdgcn_mfma_f32_32x32x16_bf16(PAF(2),VFR(6),o[1],0,0,0), C1,4); \
    GAPB(o[0]=__builtin_amdgcn_mfma_f32_32x32x16_bf16(PAF(3),VFR(3),o[0],0,0,0), C1,8); \
    GAPB(o[1]=__builtin_amdgcn_mfma_f32_32x32x16_bf16(PAF(3),VFR(7),o[1],0,0,0), C1,12); \
    }while(0)
  int t=1;
  #undef CMASK
  #define CMASK(P0,P1,t) do{ if(MODE==1){ na_mask(P0,P1,(t)-LC/64,klo,nlat,wr0_,qgr,qcol,cs_,hi,mhat,tab); } }while(0)
  for(;t+5<NT;t+=2){
    STEP(pB0,pB1,pA0,pA1,t,true,true,true);     WAIT_BAR(2); RESC(); ROT();
    STEP(pA0,pA1,pB0,pB1,t+1,true,true,true);   WAIT_BAR(2); RESC(); ROT();
  }
  #undef CMASK
  #define CMASK(P0,P1,t) do{ if(MODE==1){ na_mask(P0,P1,(t)-LC/64,klo,nlat,wr0_,qgr,qcol,cs_,hi,mhat,tab); } }while(0)
  #define ENDW(tt) do{ if((tt)+3<NT){WAIT_BAR(2);} else if((tt)+2<NT){WAIT_BAR(1);} else {WAIT_BAR(0);} }while(0)
  for(;t+1<NT;t+=2){
    STEP(pB0,pB1,pA0,pA1,t,(t+3<NT),(t+1<NT),(t+1<NT));       ENDW(t);   RESC(); ROT();
    STEP(pA0,pA1,pB0,pB1,t+1,(t+4<NT),(t+2<NT),(t+2<NT));     ENDW(t+1); RESC(); ROT();
  }
  STEP(pB0,pB1,pA0,pA1,NT-1,false,false,false); RESC();
  { float sacc=pB0[0]+pB0[1]; _Pragma("unroll") for(int r=2;r<16;++r)sacc+=pB0[r]; _Pragma("unroll") for(int r=0;r<16;++r)sacc+=pB1[r]; l_reg+=sacc;
    pw0=(u32x4){PKW(pB0,0),PKW(pB0,2),PKW(pB0,4),PKW(pB0,6)};pw1=(u32x4){PKW(pB0,8),PKW(pB0,10),PKW(pB0,12),PKW(pB0,14)};pw2=(u32x4){PKW(pB1,0),PKW(pB1,2),PKW(pB1,4),PKW(pB1,6)};pw3=(u32x4){PKW(pB1,8),PKW(pB1,10),PKW(pB1,12),PKW(pB1,14)};
    SBAR(); pv(o,vb0+sl_cur,PAF(0),PAF(1),PAF(2),PAF(3)); }
  #undef PKW
  #undef PAF
  #undef VFR
  #undef PIN
  #undef MX3
  #undef GAPA
  #undef GAPB
  #undef EX
  #undef VRD
  #undef KRD
  #undef STEP
  #undef ENDW
  {auto rr=__builtin_amdgcn_permlane32_swap(__float_as_uint(l_reg),__float_as_uint(l_reg),false,false);l_reg=__uint_as_float(rr[0])+__uint_as_float(rr[1]);}
  if(hi==0)wsf[32+r32]=l_reg;asm volatile("s_waitcnt lgkmcnt(0)":::"memory");
  float rli[16];
  #pragma unroll
  for(int r=0;r<16;++r)rli[r]=__builtin_amdgcn_rcpf(wsf[32+crow(r,hi)]);
  bf16*Ow=Og+((long)qrow0+wid*QBLK)*DM;
  { bf16*stg=(bf16*)(shm+LDS_OST)+wid*2048;
    #pragma unroll
    for(int r=0;r<16;++r){const int orow=crow(r,hi);
      #pragma unroll
      for(int d0=0;d0<2;++d0)stg[orow*64+d0*32+r32]=__float2bfloat16(o[d0][r]*rli[r]);}
    asm volatile("s_waitcnt lgkmcnt(0)":::"memory");
    #pragma unroll
    for(int i=0;i<4;++i){const int row=i*8+(lane>>3),ch=lane&7; const u32x4 v=*(const u32x4*)(stg+row*64+ch*8); ATTN_STORE16(Ow+(long)row*DM+ch*8,v);} }
  asm volatile("s_waitcnt lgkmcnt(0)\n\ts_barrier":::"memory");
  #undef DMA_K
  #undef NEGM_
  #undef TROW
  #undef DMA_V
  #undef CMASK
  #undef START
  #undef RESC
  #undef ROT
}
constexpr int ATTN_LDS_BYTES=LDS_BYTES;
#undef SBAR
#undef WAIT_BAR
}
__device__ __forceinline__ int pull_unit(int* ctr, LAS unsigned char* lds) {
    volatile LAS int* slot = (volatile LAS int*)(lds + (147456 - 512) + 16);
    __syncthreads();
    if (my_tid() == 0) *slot = __hip_atomic_fetch_add(ctr, 1, __ATOMIC_RELAXED, __HIP_MEMORY_SCOPE_AGENT);
    __syncthreads();
    return __builtin_amdgcn_readfirstlane(*slot);
}
template <int PART> __device__ __forceinline__ void attn_phase(const Prm& p, int l, char* shm, int G) {
    using namespace attn_body;
    const int bx = blockIdx.x, vcu = (G % 8 == 0) ? (bx % 8) * (G / 8) + bx / 8 : bx;
    const attn_body::bf16* Pb = (const attn_body::bf16*)p.P;
    constexpr int NQB = S / 256;
    if constexpr (PART == 0) for (int u = vcu * 2; u < NB * NGA * NQB; u += 2 * G) {
#pragma unroll 1
        for (int j = 0; j < 2; ++j) { const int uu = u + j; if (uu >= NB * NGA * NQB) break; const int qb = uu % NQB, h = (uu / NQB) % NGA, b = uu / (NQB * NGA);
            attn_unit<8, 0>(b, b * S + 256 * qb, 0, S / 64 + LC / 64, 0, Pb + PC_GAQ + 64 * h, Pb + PC_GAK + 64 * h, Pb + PC_GAV + 64 * h, (attn_body::bf16*)Pb + PC_GAQ + 64 * h, nullptr, shm); }
    }
    if constexpr (PART == 1) {
        for (;;) { const int uu = pull_unit(p.ctl + 32 + 2 * l + 1, (LAS unsigned char*)shm); if (uu >= NB * NNA * NQB) break; const int qb = uu % NQB, h = (uu / NQB) % NNA, b = uu / (NQB * NNA);
            const int r0 = 4 * qb; int klo = r0 - 4; klo = klo < 0 ? 0 : (klo > ROWS - 8 ? ROWS - 8 : klo); int khi = r0 + 3 - 4; khi = (khi < 0 ? 0 : (khi > ROWS - 8 ? ROWS - 8 : khi)) + 7;
            const int nlat = khi - klo + 1, NT = (LC / 64 + nlat + 1) & ~1;
            attn_unit<8, 1>(b, b * S + 256 * qb, klo, NT, nlat, Pb + PC_NAQ + 64 * h, Pb + PC_NAK + 64 * h, Pb + PC_NAV + 64 * h, (attn_body::bf16*)Pb + PC_NAQ + 64 * h, p.na_rpb + ((size_t)l * NNA + h) * 15 * 31, shm); }
    }
    if constexpr (PART == 2) {
        static_assert(LC == 256, "context unit = one 256-row query block");
        for (int u = vcu; u < NB * (NNA + NGA); u += G) { const int hh = u % (NNA + NGA), b = u / (NNA + NGA);
            const int qo = hh < NNA ? PC_NAQ + 64 * hh : PC_GAQ + 64 * (hh - NNA), ko = hh < NNA ? PC_NAK + 64 * hh : PC_GAK + 64 * (hh - NNA), vo = hh < NNA ? PC_NAV + 64 * hh : PC_GAV + 64 * (hh - NNA);
            attn_unit<8, 2>(b, MX + b * LC, 0, LC / 64, 0, Pb + qo, Pb + ko, Pb + vo, (attn_body::bf16*)Pb + qo, nullptr, shm); }
    }
}


namespace hy {
typedef short bf16x8 __attribute__((ext_vector_type(8)));
typedef short s16x4 __attribute__((ext_vector_type(4)));
typedef float f32x16 __attribute__((ext_vector_type(16)));
typedef float f32x4 __attribute__((ext_vector_type(4)));
typedef unsigned u32x4 __attribute__((ext_vector_type(4)));
constexpr int NBLK = S / 128, FTP = 2 * S + 8, L_V = 0, L_F = NB * S * 2, FCOPY = 2 * S * 2 + 64, L_END = L_F + 3 * FCOPY + 2 * S * 2;
static_assert(NBLK == 32 && NB == 8, "hyena unit geometry: 32 sequence blocks of 128, 8 batches");
__device__ __forceinline__ void hyena_unit(const bf16* vg, const bf16* fg, float* yg, LAS unsigned char* lds) {
    int tid_ = my_tid(); asm volatile("" : "+v"(tid_));
    const int tid = tid_, wid = __builtin_amdgcn_readfirstlane(tid >> 6), lane = tid & 63, n = lane & 31, hi = lane >> 5;
#pragma unroll
    for (int i = 0; i < 8; ++i) { const int q = i * 512 + tid, rowg = q >> 4, ch = q & 15, rowL = (rowg & 31) * 8 + (rowg >> 5);
        const u32x4 v = *(const u32x4*)(vg + (size_t)q * 8); *(LAS u32x4*)(lds + L_V + rowL * 256 + ((ch ^ (rowL & 15)) << 4)) = v; }
#pragma unroll
    for (int i = 0; i < 2; ++i) { const int g = i * 512 + tid; const u32x4 a = *(const u32x4*)(fg + 8 * g), b = *(const u32x4*)(fg + 8 * g + 8);
        const unsigned w[8] = {a.x, a.y, a.z, a.w, b.x, b.y, b.z, b.w};
        u32x4 c1, c3;
#pragma unroll
        for (int k = 0; k < 4; ++k) { c1[k] = __builtin_amdgcn_alignbit(w[k + 1], w[k], 16); c3[k] = __builtin_amdgcn_alignbit(w[k + 2], w[k + 1], 16); }
        *(LAS u32x4*)(lds + L_F + 0 * FCOPY + g * 16) = a; *(LAS u32x4*)(lds + L_F + 1 * FCOPY + g * 16) = c1;
        *(LAS u32x4*)(lds + L_F + 2 * FCOPY + g * 16) = (u32x4){a.y, a.z, a.w, b.x}; *(LAS u32x4*)(lds + L_F + 3 * FCOPY + g * 16) = c3; }
    __syncthreads();
    SEG(50);
    f32x16 acc[4];
#pragma unroll
    for (int m = 0; m < 4; ++m) acc[m] = f32x16{};
    const int I0 = 4 * wid, I = I0 + (n >> 3), bb = n & 7;
    if (wid >= 4) __builtin_amdgcn_s_setprio(2);
#pragma unroll 1
    for (int cs = 0; cs < NBLK; ++cs) {
        const int rowL = ((I - cs) & 31) * 8 + bb;
        bf16x8 Bf[8];
#pragma unroll
        for (int s = 0; s < 8; ++s) Bf[s] = *(const LAS bf16x8*)(lds + L_V + rowL * 256 + (((2 * s + hi) ^ (rowL & 15)) << 4));
#pragma unroll 1
        for (int pass = 0; pass < 2; ++pass) {
            const bool any = pass == 0 ? (I0 + 3 >= cs) : (I0 < cs);
            if (!any) continue;
            const bool valid = pass == 0 ? (I >= cs) : (I < cs); const int d = pass == 0 ? cs : cs - NBLK;
            const int xb = S - 128 * d - 96 - n + 8 * hi, rho = xb & 3;
            const LAS unsigned char* fa = lds + L_F + rho * FCOPY + 2 * (xb - rho);
            bf16x8 Af[14];
#pragma unroll
            for (int o = 0; o < 14; ++o) { const s16x4 lo = *(const LAS s16x4*)(fa + (13 - o) * 32), hh = *(const LAS s16x4*)(fa + (13 - o) * 32 + 8);
                Af[o] = (bf16x8){lo[0], lo[1], lo[2], lo[3], hh[0], hh[1], hh[2], hh[3]}; }
            const bool straddle = (I0 < cs) && (I0 + 3 >= cs);
            if (!straddle) {
#pragma unroll
                for (int s = 0; s < 8; ++s)
#pragma unroll
                    for (int m = 0; m < 4; ++m) acc[m] = __builtin_amdgcn_mfma_f32_32x32x16_bf16(Af[2 * m - s + 7], Bf[s], acc[m], 0, 0, 0);
            } else {
                bf16x8 Bm[8];
#pragma unroll
                for (int s = 0; s < 8; ++s) Bm[s] = valid ? Bf[s] : (bf16x8){0, 0, 0, 0, 0, 0, 0, 0};
#pragma unroll
                for (int s = 0; s < 8; ++s)
#pragma unroll
                    for (int m = 0; m < 4; ++m) acc[m] = __builtin_amdgcn_mfma_f32_32x32x16_bf16(Af[2 * m - s + 7], Bm[s], acc[m], 0, 0, 0);
            }
        }
    }
    __builtin_amdgcn_s_setprio(0);
    __syncthreads();
    SEG(51);
    LAS unsigned char* st = lds + wid * 16384;
#pragma unroll
    for (int m = 0; m < 4; ++m)
#pragma unroll
        for (int g = 0; g < 4; ++g) { const int q = 8 * m + 2 * g + hi; *(LAS f32x4*)(st + n * 512 + ((q ^ n) << 4)) = (f32x4){acc[m][4 * g], acc[m][4 * g + 1], acc[m][4 * g + 2], acc[m][4 * g + 3]}; }
    asm volatile("s_waitcnt lgkmcnt(0)" ::: "memory");
#pragma unroll
    for (int i = 0; i < 16; ++i) { const int rn = 2 * i + hi, q = n; const f32x4 v = *(const LAS f32x4*)(st + rn * 512 + ((q ^ rn) << 4));
        *(f32x4*)(yg + (size_t)(rn & 7) * S + (I0 + (rn >> 3)) * 128 + 4 * q) = v; }
    __syncthreads();
    SEG(52);
}
}
__device__ __forceinline__ void hyena_phase(const Prm& p, int l, LAS unsigned char* lds, int G) {
    (void)G;
    for (;;) { const int c = pull_unit(p.ctl + 32 + 2 * l, lds); if (c >= DHY) break;
        hy::hyena_unit(p.VT + (size_t)c * NB * S, p.FT + ((size_t)l * DHY + c) * hy::FTP, p.YC + (size_t)c * NB * S, lds); }
}


namespace thin {
typedef float f32x4 __attribute__((ext_vector_type(4)));
typedef unsigned u32x4 __attribute__((ext_vector_type(4)));
typedef unsigned u32x2 __attribute__((ext_vector_type(2)));
typedef unsigned u32x3a __attribute__((ext_vector_type(3), aligned(4)));
__device__ __forceinline__ float wave_sum(float v) {
#pragma unroll
    for (int o = 1; o < 64; o <<= 1) v += __shfl_xor(v, o);
    return v;
}
__device__ __forceinline__ unsigned pk2(float lo, float hi) { return f2bf_u(lo) | (f2bf_u(hi) << 16); }
__device__ __forceinline__ float lo16(unsigned u) { return __uint_as_float(u << 16); }
__device__ __forceinline__ float hi16(unsigned u) { return __uint_as_float(u & 0xffff0000u); }

__device__ __forceinline__ void transpose_item(const float* W, int K, int N, bf16* WT, int k0, int n0, int drow0, int drow1, LAS float* scr, int lane) {
    const int lr = lane >> 4, lc = 4 * (lane & 15);
    f32x4 v[16];
#pragma unroll
    for (int i = 0; i < 16; ++i) v[i] = __builtin_nontemporal_load((const f32x4*)(W + (size_t)(k0 + 4 * i + lr) * N + n0 + lc));
#pragma unroll
    for (int i = 0; i < 16; ++i) { LAS float* d = scr + (4 * i + lr) * 65 + lc; d[0] = v[i].x; d[1] = v[i].y; d[2] = v[i].z; d[3] = v[i].w; }
    asm volatile("s_waitcnt lgkmcnt(0)" ::: "memory");
    const int c = lane & 7;
#pragma unroll
    for (int j = 0; j < 8; ++j) { const int n = (lane >> 3) + 8 * j; const LAS float* sp = scr + (8 * c) * 65 + n;
        u32x4 o; o.x = pk2(sp[0 * 65], sp[1 * 65]); o.y = pk2(sp[2 * 65], sp[3 * 65]); o.z = pk2(sp[4 * 65], sp[5 * 65]); o.w = pk2(sp[6 * 65], sp[7 * 65]);
        *(u32x4*)(WT + (size_t)(n < 32 ? drow0 + n : drow1 + n - 32) * K + k0 + 8 * c) = o; }
    asm volatile("s_waitcnt lgkmcnt(0)" ::: "memory");
}
__device__ __forceinline__ void transpose_item8(const float* W, int K, int N, unsigned char* WT, int k0, int n0, int drow0, int drow1, float scale, LAS float* scr, int lane) {
    const int lr = lane >> 4, lc = 4 * (lane & 15);
    f32x4 v[16];
#pragma unroll
    for (int i = 0; i < 16; ++i) v[i] = __builtin_nontemporal_load((const f32x4*)(W + (size_t)(k0 + 4 * i + lr) * N + n0 + lc));
#pragma unroll
    for (int i = 0; i < 16; ++i) { LAS float* d = scr + (4 * i + lr) * 65 + lc; d[0] = v[i].x; d[1] = v[i].y; d[2] = v[i].z; d[3] = v[i].w; }
    asm volatile("s_waitcnt lgkmcnt(0)" ::: "memory");
    const int c = lane & 3;
#pragma unroll
    for (int j = 0; j < 4; ++j) { const int n = (lane >> 2) + 16 * j; const LAS float* sp = scr + (16 * c) * 65 + n;
        u32x4 o;
        o.x = pg8::pk4_fp8(sp[0 * 65] * scale, sp[1 * 65] * scale, sp[2 * 65] * scale, sp[3 * 65] * scale); o.y = pg8::pk4_fp8(sp[4 * 65] * scale, sp[5 * 65] * scale, sp[6 * 65] * scale, sp[7 * 65] * scale);
        o.z = pg8::pk4_fp8(sp[8 * 65] * scale, sp[9 * 65] * scale, sp[10 * 65] * scale, sp[11 * 65] * scale); o.w = pg8::pk4_fp8(sp[12 * 65] * scale, sp[13 * 65] * scale, sp[14 * 65] * scale, sp[15 * 65] * scale);
        *(u32x4*)(WT + (size_t)(n < 32 ? drow0 + n : drow1 + n - 32) * K + k0 + 16 * c) = o; }
    asm volatile("s_waitcnt lgkmcnt(0)" ::: "memory");
}
__device__ __forceinline__ void transpose_matrix(const float* W, int K, int N, bf16* WT, int mode, LAS float* scr, int lane, int gw, int ngw, int& rot) {
    const int nkb = K / 64, nnb = N / 64, items = nkb * nnb;
    for (int it = (gw + ngw - rot % ngw) % ngw; it < items; it += ngw) { const int kb = it / nnb, nb = it % nnb, n0 = 64 * nb;
        const int drow0 = mode == 3 ? (n0 & ~255) + 32 * ((n0 & 255) >> 6) : (mode == 0 ? n0 : 256 * (n0 / 128) + (n0 % 128) + (mode == 2 ? 128 : 0));
        transpose_item(W, K, N, WT, 64 * kb, n0, drow0, mode == 3 ? drow0 + 128 : drow0 + 32, scr, lane); }
    rot += items;
}
__device__ __forceinline__ void transpose_matrix8(const float* W, int K, int N, unsigned char* WT, int mode, float scale, LAS float* scr, int lane, int gw, int ngw, int& rot) {
    const int nkb = K / 64, nnb = N / 64, items = nkb * nnb;
    for (int it = (gw + ngw - rot % ngw) % ngw; it < items; it += ngw) { const int kb = it / nnb, nb = it % nnb, n0 = 64 * nb;
        const int drow0 = mode == 0 ? n0 : 256 * (n0 / 128) + (n0 % 128) + (mode == 2 ? 128 : 0);
        transpose_item8(W, K, N, WT, 64 * kb, n0, drow0, drow0 + 32, scale, scr, lane); }
    rot += items;
}
struct ConvItem { const float* W; void* WT; int K, N, k0, n0, drow0, drow1; float scale; bool f8; };
constexpr int CI_IN = (D / 64) * (NP / 64), CI_OUT = (D / 64) * (D / 64), CI_L = CI_IN + CI_OUT, CI_FF = (D / 64) * (DFF / 64), CI_EX = (D / 64) * (DFE / 64), CI_TOTAL = NL * CI_L + 3 * CI_FF + NE * 3 * CI_EX;
__device__ __forceinline__ void conv_decode(const Prm& p, int it, ConvItem& c) {
    c.scale = 1.0f; c.f8 = false; int mode, nnb, r;
    if (it < NL * CI_L) { const int l = it / CI_L; r = it % CI_L;
        if (r < CI_IN) { c.W = p.w_in + (size_t)l * D * NP; c.WT = p.WinT + (size_t)l * NP * D; c.K = D; c.N = NP; mode = 3; }
        else { r -= CI_IN; c.W = p.w_out + (size_t)l * D * D; c.WT = p.WoutT + (size_t)l * D * D; c.K = D; c.N = D; mode = 0; } }
    else { it -= NL * CI_L; c.f8 = true;
        if (it < 3 * CI_FF) { const int w = it / CI_FF; r = it % CI_FF;
            if (w < 2) { c.W = w == 0 ? p.ffn_w_gate : p.ffn_w_up; c.WT = p.WguT; c.K = D; c.N = DFF; mode = 1 + w; c.scale = F8_SWU; }
            else { c.W = p.ffn_w_down; c.WT = p.WdT; c.K = DFF; c.N = D; mode = 0; c.scale = F8_SWD; } }
        else { it -= 3 * CI_FF; const int e = it / (3 * CI_EX), q = it % (3 * CI_EX), w = q / CI_EX; r = q % CI_EX;
            if (w < 2) { c.W = (w == 0 ? p.moe_w_gate : p.moe_w_up) + (size_t)e * D * DFE; c.WT = (unsigned char*)p.WguTe + (size_t)e * 2 * DFE * D; c.K = D; c.N = DFE; mode = 1 + w; c.scale = F8_SWU; }
            else { c.W = p.moe_w_down + (size_t)e * DFE * D; c.WT = (unsigned char*)p.WdTe + (size_t)e * D * DFE; c.K = DFE; c.N = D; mode = 0; c.scale = F8_SWD; } } }
    nnb = c.N / 64; c.k0 = 64 * (r / nnb); c.n0 = 64 * (r % nnb);
    c.drow0 = mode == 3 ? (c.n0 & ~255) + 32 * ((c.n0 & 255) >> 6) : (mode == 0 ? c.n0 : 256 * (c.n0 / 128) + (c.n0 % 128) + (mode == 2 ? 128 : 0));
    c.drow1 = mode == 3 ? c.drow0 + 128 : c.drow0 + 32;
}
__device__ __forceinline__ void conv_load(const ConvItem& c, f32x4 (&v)[16], int lane) {
    const int lr = lane >> 4, lc = 4 * (lane & 15);
#pragma unroll
    for (int i = 0; i < 16; ++i) v[i] = __builtin_nontemporal_load((const f32x4*)(c.W + (size_t)(c.k0 + 4 * i + lr) * c.N + c.n0 + lc));
}
__device__ __forceinline__ void conv_finish(const ConvItem& c, const f32x4 (&v)[16], LAS float* scr, int lane) {
    const int lr = lane >> 4, lc = 4 * (lane & 15);
#pragma unroll
    for (int i = 0; i < 16; ++i) { LAS float* d = scr + (4 * i + lr) * 65 + lc; d[0] = v[i].x; d[1] = v[i].y; d[2] = v[i].z; d[3] = v[i].w; }
    asm volatile("s_waitcnt lgkmcnt(0)" ::: "memory");
    if (c.f8) { const int cc = lane & 3; const float scale = c.scale; unsigned char* WT = (unsigned char*)c.WT;
#pragma unroll
        for (int j = 0; j < 4; ++j) { const int n = (lane >> 2) + 16 * j; const LAS float* sp = scr + (16 * cc) * 65 + n;
            u32x4 o;
            o.x = pg8::pk4_fp8(sp[0 * 65] * scale, sp[1 * 65] * scale, sp[2 * 65] * scale, sp[3 * 65] * scale); o.y = pg8::pk4_fp8(sp[4 * 65] * scale, sp[5 * 65] * scale, sp[6 * 65] * scale, sp[7 * 65] * scale);
            o.z = pg8::pk4_fp8(sp[8 * 65] * scale, sp[9 * 65] * scale, sp[10 * 65] * scale, sp[11 * 65] * scale); o.w = pg8::pk4_fp8(sp[12 * 65] * scale, sp[13 * 65] * scale, sp[14 * 65] * scale, sp[15 * 65] * scale);
            *(u32x4*)(WT + (size_t)(n < 32 ? c.drow0 + n : c.drow1 + n - 32) * c.K + c.k0 + 16 * cc) = o; } }
    else { const int cc = lane & 7; bf16* WT = (bf16*)c.WT;
#pragma unroll
        for (int j = 0; j < 8; ++j) { const int n = (lane >> 3) + 8 * j; const LAS float* sp = scr + (8 * cc) * 65 + n;
            u32x4 o; o.x = pk2(sp[0 * 65], sp[1 * 65]); o.y = pk2(sp[2 * 65], sp[3 * 65]); o.z = pk2(sp[4 * 65], sp[5 * 65]); o.w = pk2(sp[6 * 65], sp[7 * 65]);
            *(u32x4*)(WT + (size_t)(n < 32 ? c.drow0 + n : c.drow1 + n - 32) * c.K + c.k0 + 8 * cc) = o; } }
    asm volatile("s_waitcnt lgkmcnt(0)" ::: "memory");
}
__device__ __forceinline__ void wconv_phase(const Prm& p, LAS unsigned char* lds, int bid, int G) {
    int tid_ = my_tid(); asm volatile("" : "+v"(tid_));
    const int wid = __builtin_amdgcn_readfirstlane(tid_ >> 6), lane = tid_ & 63, gw = bid * 8 + wid, ngw = G * 8;
    LAS float* scr = (LAS float*)(lds + wid * (64 * 65 * 4));
    int it = gw; if (it >= CI_TOTAL) return;
    ConvItem cur, nxt; f32x4 va[16], vb[16];
    conv_decode(p, it, cur); conv_load(cur, va, lane);
    for (;;) {
        const bool more = it + ngw < CI_TOTAL;
        if (more) { conv_decode(p, it + ngw, nxt); conv_load(nxt, vb, lane); }
        __builtin_amdgcn_sched_barrier(0);
        conv_finish(cur, va, scr, lane);
        if (!more) break;
        it += ngw;
        const bool more2 = it + ngw < CI_TOTAL;
        if (more2) { conv_decode(p, it + ngw, cur); conv_load(cur, va, lane); }
        __builtin_amdgcn_sched_barrier(0);
        conv_finish(nxt, vb, scr, lane);
        if (!more2) break;
        it += ngw;
    }
}
__device__ __forceinline__ void rope_table(const Prm& p, long gtid) {
    if (gtid < NL * 4 * 64) { const int d = (int)gtid & 63, k = ((int)gtid >> 6) & 3, l = (int)gtid >> 8; const float* src = k == 0 ? p.na_q_norm : k == 1 ? p.na_k_norm : k == 2 ? p.ga_q_norm : p.ga_k_norm; p.QKG[gtid] = src[l * 64 + d]; }
    if (gtid < 64 * 16) { const int i = (int)gtid & 15, pos = (int)gtid >> 4; const float ang = (float)pos * powf(10000.0f, -(float)i / 16.0f); p.ROPE[2 * gtid] = cosf(ang); p.ROPE[2 * gtid + 1] = sinf(ang); }
}

template <bool ROUTER, bool F8OUT = ROUTER, bool XBF16 = false>
__device__ __forceinline__ void modnorm_phase(const Prm& p, int l, const float* xs, const float* cs, const float* gain, int off_shift, int off_scale, int nrows, LAS unsigned char* lds, int G) {
    int tid_ = my_tid(); asm volatile("" : "+v"(tid_));
    const int tid = tid_, wid = __builtin_amdgcn_readfirstlane(tid >> 6), lane = tid & 63, gw = blockIdx.x * 8 + wid, ngw = G * 8;
    LAS int* hist = (LAS int*)lds;
    LAS f32x4* RW = (LAS f32x4*)(lds + 1024);
    if constexpr (ROUTER) {
        if (tid < 16) hist[tid] = 0;
        for (long i = (long)blockIdx.x * 512 + tid; i < (long)2 * MPAD; i += (long)G * 512) p.LIST[i] = -1;
        for (int q = tid; q < D * 2; q += 512) { const int k = q >> 1, h = q & 1, j = k >> 8, ln = (k & 255) >> 2, i = k & 3;
            RW[((4 * j + i) * 2 + h) * 64 + ln] = *(const f32x4*)(p.moe_router + (size_t)k * NE + 4 * h); }
        __syncthreads();
    }
    constexpr int RB = 4;
    const int nbat = (nrows + RB - 1) / RB, qb = nbat / ngw, rb_ = nbat % ngw, wv = gw;
    const int bbeg = wv * qb + (wv < rb_ ? wv : rb_), bcnt = qb + (wv < rb_ ? 1 : 0);
    const int rbeg = bbeg * RB, rend = (bbeg + bcnt) * RB < nrows ? (bbeg + bcnt) * RB : nrows;
    f32x4 gs[4], shv[4]; int curmod = -1;
    for (int row0 = rbeg; row0 < rend; row0 += RB) {
        f32x4 v[RB][4]; float ss[RB];
#pragma unroll
        for (int r = 0; r < RB; ++r) { const int row = row0 + r < rend ? row0 + r : rend - 1;
            if (XBF16 && row < MX) { const bf16* sb = p.XB + (size_t)row * D;
#pragma unroll
                for (int j = 0; j < 4; ++j) { const u32x2 h = __builtin_nontemporal_load((const u32x2*)sb + lane + 64 * j); v[r][j] = pg8::bflo4(h.x, h.y); } }
            else { const float* src = row < MX ? xs + (size_t)row * D : cs + (size_t)(row - MX) * D;
#pragma unroll
                for (int j = 0; j < 4; ++j) v[r][j] = __builtin_nontemporal_load((const f32x4*)src + lane + 64 * j); } }
#pragma unroll
        for (int r = 0; r < RB; ++r) { float a = 0.f;
#pragma unroll
            for (int j = 0; j < 4; ++j) a += (v[r][j].x * v[r][j].x + v[r][j].y * v[r][j].y) + (v[r][j].z * v[r][j].z + v[r][j].w * v[r][j].w);
            ss[r] = a; }
#pragma unroll
        for (int r = 0; r < RB; ++r) { const int row = row0 + r; if (row >= rend) break;
            const int mr = row_modrow(row);
            if (mr != curmod) { curmod = mr; const float* mod = p.MOD + ((size_t)l * 9 + mr) * 6 * D;
#pragma unroll
                for (int j = 0; j < 4; ++j) { gs[j] = ((const f32x4*)gain)[lane + 64 * j] * (((const f32x4*)(mod + off_scale))[lane + 64 * j] + 1.0f); shv[j] = ((const f32x4*)(mod + off_shift))[lane + 64 * j]; } }
            const float rstd = 1.0f / sqrtf(wave_sum(ss[r]) * (1.0f / D) + EPS);
            float lg[NE];
#pragma unroll
            for (int e = 0; e < NE; ++e) lg[e] = 0.f;
#pragma unroll
            for (int j = 0; j < 4; ++j) { const f32x4 h = v[r][j] * rstd * gs[j] + shv[j];
                if constexpr (F8OUT) *(unsigned*)((unsigned char*)p.HX + (size_t)row * D + 4 * lane + 256 * j) = pg8::pk4_fp8(h.x * F8_SA, h.y * F8_SA, h.z * F8_SA, h.w * F8_SA);
                else *(u32x2*)(p.HX + (size_t)row * D + 4 * lane + 256 * j) = (u32x2){pk2(h.x, h.y), pk2(h.z, h.w)};
                if constexpr (ROUTER) {
#pragma unroll
                    for (int i = 0; i < 4; ++i) { const f32x4 w0 = RW[((4 * j + i) * 2 + 0) * 64 + lane], w1 = RW[((4 * j + i) * 2 + 1) * 64 + lane]; const float hv = h[i];
                        lg[0] += hv * w0.x; lg[1] += hv * w0.y; lg[2] += hv * w0.z; lg[3] += hv * w0.w; lg[4] += hv * w1.x; lg[5] += hv * w1.y; lg[6] += hv * w1.z; lg[7] += hv * w1.w; } } }
            if constexpr (ROUTER) {
                if (row < MX) {
                    float b1 = -INFINITY, b2 = -INFINITY; int i1 = 0, i2 = 0;
                    float a4[4], b2_[2], c1;
#pragma unroll
                    for (int e = 0; e < 4; ++e) { const float mine = (lane & 1) ? lg[2 * e + 1] : lg[2 * e], oth = (lane & 1) ? lg[2 * e] : lg[2 * e + 1]; a4[e] = mine + __shfl_xor(oth, 1); }
#pragma unroll
                    for (int e = 0; e < 2; ++e) { const float mine = (lane & 2) ? a4[2 * e + 1] : a4[2 * e], oth = (lane & 2) ? a4[2 * e] : a4[2 * e + 1]; b2_[e] = mine + __shfl_xor(oth, 2); }
                    { const float mine = (lane & 4) ? b2_[1] : b2_[0], oth = (lane & 4) ? b2_[0] : b2_[1]; c1 = mine + __shfl_xor(oth, 4); }
                    c1 += __shfl_xor(c1, 8); c1 += __shfl_xor(c1, 16); c1 += __shfl_xor(c1, 32);
#pragma unroll
                    for (int e = 0; e < NE; ++e) { const float x = __int_as_float(__builtin_amdgcn_readlane(__float_as_int(c1), e)); if (x > b1) { b2 = b1; i2 = i1; b1 = x; i1 = e; } else if (x > b2) { b2 = x; i2 = e; } }
                    if (lane == 0) { const float w1 = 1.0f / (1.0f + expf(b2 - b1)); p.TOPI[row * 2] = i1; p.TOPI[row * 2 + 1] = i2; p.TOPW[row * 2] = w1; p.TOPW[row * 2 + 1] = 1.0f - w1;
                        __hip_atomic_fetch_add(hist + i1, 1, __ATOMIC_RELAXED, __HIP_MEMORY_SCOPE_WORKGROUP); __hip_atomic_fetch_add(hist + 8 + i2, 1, __ATOMIC_RELAXED, __HIP_MEMORY_SCOPE_WORKGROUP); }
                }
            }
        }
    }
    if constexpr (ROUTER) { __syncthreads(); if (tid < 16) atomicAdd(p.ctl + tid, hist[tid]); __syncthreads(); }
}

__device__ __forceinline__ void prep_qk_phase(const Prm& p, int l, int G) {
    static_assert(NNA == 6 && NGA == 4 && PC_NAK == PC_NAQ + 384, "pass layout of the q/k preparation");
    int tid_ = my_tid(); asm volatile("" : "+v"(tid_));
    const int tid = tid_, wid = __builtin_amdgcn_readfirstlane(tid >> 6), lane = tid & 63, gw = blockIdx.x * 8 + wid, ngw = G * 8;
    const int a = lane & 15, dd = 4 * a;
    const f32x4 gnq = *(const f32x4*)(p.na_q_norm + l * 64 + dd), gnk = *(const f32x4*)(p.na_k_norm + l * 64 + dd), ggq = *(const f32x4*)(p.ga_q_norm + l * 64 + dd), ggk = *(const f32x4*)(p.ga_k_norm + l * 64 + dd);
    const bool x2side = (a >> 2) & 1; const int rhalf = a >> 3, fi = 4 * (a & 3);
    for (int row0 = 2 * gw; row0 < M; row0 += 2 * ngw) {
        u32x2 raw[2][5];
#pragma unroll
        for (int rr = 0; rr < 2; ++rr)
#pragma unroll
            for (int ps = 0; ps < 5; ++ps) raw[rr][ps] = *(const u32x2*)(p.P + (size_t)(row0 + rr) * NP + (ps < 3 ? PC_NAQ + 256 * ps : (ps == 3 ? PC_GAQ : PC_GAK)) + 4 * lane);
#pragma unroll
        for (int rr = 0; rr < 2; ++rr) { const int row = row0 + rr; bf16* pr = p.P + (size_t)row * NP;
#pragma unroll
        for (int ps = 0; ps < 5; ++ps) {
            const int col = (ps < 3 ? PC_NAQ + 256 * ps : (ps == 3 ? PC_GAQ : PC_GAK)) + 4 * lane;
            const int hidx = ps * 4 + (lane >> 4);
            const bool isq = ps < 3 ? hidx < NNA : ps == 3;
            const f32x4 g = ps < 3 ? (hidx < NNA ? gnq : gnk) : (ps == 3 ? ggq : ggk);
            f32x4 x = (f32x4){lo16(raw[rr][ps].x), hi16(raw[rr][ps].x), lo16(raw[rr][ps].y), hi16(raw[rr][ps].y)};
            float ss = (x.x * x.x + x.y * x.y) + (x.z * x.z + x.w * x.w);
            ss += __shfl_xor(ss, 1); ss += __shfl_xor(ss, 2); ss += __shfl_xor(ss, 4); ss += __shfl_xor(ss, 8);
            const float rstd = 1.0f / sqrtf(ss * (1.0f / 64.0f) + EPS);
            x = x * rstd * g;
            if (ps >= 3 && row < MX) {
                const int t = row % S, pos = rhalf == 0 ? t / GW : t % GW;
                const f32x4 cs0 = *(const f32x4*)(p.ROPE + (size_t)(pos * 16 + fi) * 2), cs1 = *(const f32x4*)(p.ROPE + (size_t)(pos * 16 + fi) * 2 + 4);
                f32x4 o; o.x = __shfl_xor(x.x, 4); o.y = __shfl_xor(x.y, 4); o.z = __shfl_xor(x.z, 4); o.w = __shfl_xor(x.w, 4);
                const f32x4 cs = (f32x4){cs0.x, cs0.z, cs1.x, cs1.z}, sn = (f32x4){cs0.y, cs0.w, cs1.y, cs1.w};
                x = x2side ? (o * sn + x * cs) : (x * cs - o * sn);
            }
            if (isq) x = x * QSCALE;
            *(u32x2*)(pr + col) = (u32x2){pk2(x.x, x.y), pk2(x.z, x.w)};
        } }
    }
}

__device__ __forceinline__ void sconv2(const bf16* Prow, const float* w, const float* cb, int col, bool hasp, bool hasn, float& y0, float& y1) {
    const unsigned c = *(const unsigned*)(Prow + col);
    y0 = cb[col] + w[3 * DHY + col] * lo16(c); y1 = cb[col + 1] + w[3 * DHY + col + 1] * hi16(c);
    if (hasp) { const unsigned a = *(const unsigned*)(Prow - NP + col); y0 += w[col] * lo16(a); y1 += w[col + 1] * hi16(a); }
    if (hasn) { const unsigned b = *(const unsigned*)(Prow + NP + col); y0 += w[2 * 3 * DHY + col] * lo16(b); y1 += w[2 * 3 * DHY + col + 1] * hi16(b); }
}
__device__ __forceinline__ void tile_geom(int tile, int& row0, int& b, int& t0, int& Len) {
    row0 = tile * 64; if (row0 < MX) { b = row0 / S; t0 = row0 % S; Len = S; } else { const int rr = row0 - MX; b = rr / LC; t0 = rr % LC; Len = LC; }
}
template <int S0, int NS> __device__ __forceinline__ void ld_row(const bf16* Pl, bool ok, unsigned (&raw)[NS][DHY / 128]) {
    static_assert(DHY / 128 == 3, "a lane owns 6 consecutive channels = one 12-byte load per set");
#pragma unroll
    for (int s_ = 0; s_ < NS; ++s_) { u32x3a t = (u32x3a){0u, 0u, 0u}; if (ok) t = __builtin_nontemporal_load((const u32x3a*)(Pl + (S0 + s_) * DHY)); raw[s_][0] = t.x; raw[s_][1] = t.y; raw[s_][2] = t.z; }
}
template <int S0, int NS> struct ConvK {
    float wp[NS][DHY / 128][2], wc[NS][DHY / 128][2], wn[NS][DHY / 128][2], cb[NS][DHY / 128][2];
    __device__ __forceinline__ void load(const float* w, const float* b, int lane) {
#pragma unroll
        for (int s_ = 0; s_ < NS; ++s_)
#pragma unroll
            for (int j = 0; j < DHY / 128; ++j)
#pragma unroll
                for (int e = 0; e < 2; ++e) { const int col = (S0 + s_) * DHY + 6 * lane + 2 * j + e; wp[s_][j][e] = w[col]; wc[s_][j][e] = w[3 * DHY + col]; wn[s_][j][e] = w[2 * 3 * DHY + col]; cb[s_][j][e] = b[col]; }
    }
    __device__ __forceinline__ float ev(int s_, int j, int e, unsigned a, unsigned c, unsigned n) const {
        return e == 0 ? cb[s_][j][0] + wp[s_][j][0] * lo16(a) + wc[s_][j][0] * lo16(c) + wn[s_][j][0] * lo16(n) : cb[s_][j][1] + wp[s_][j][1] * hi16(a) + wc[s_][j][1] * hi16(c) + wn[s_][j][1] * hi16(n);
    }
};
__device__ __forceinline__ void prep_hy_phase(const Prm& p, int l, LAS unsigned char* lds, int G) {
    int tid_ = my_tid(); asm volatile("" : "+v"(tid_));
    const int tid = tid_, wid = __builtin_amdgcn_readfirstlane(tid >> 6), lane = tid & 63;
    constexpr int PITCH = 144, NJ = DHY / 128;
    ConvK<1, 2> K; K.load(p.hy_conv_w + (size_t)l * 3 * 3 * DHY, p.hy_conv_b + (size_t)l * 3 * DHY, lane);
    for (int tile = blockIdx.x; tile < M / 64; tile += G) {
        int row0, b, t0, Len; tile_geom(tile, row0, b, t0, Len);
        const int tt0 = 8 * wid; const bf16* Pl = p.P + (size_t)(row0 + tt0) * NP + 6 * lane;
        unsigned ra[2][NJ], rb[2][NJ], rc[2][NJ];
        ld_row<1, 2>(Pl - NP, t0 + tt0 - 1 >= 0, ra); ld_row<1, 2>(Pl, true, rb);
#pragma unroll
        for (int i = 0; i < 8; ++i) {
            ld_row<1, 2>(Pl + (size_t)(i + 1) * NP, t0 + tt0 + i + 1 < Len, rc);
#pragma unroll
            for (int j = 0; j < NJ; ++j) { const int c = 6 * lane + 2 * j;
                const float v0 = K.ev(1, j, 0, ra[1][j], rb[1][j], rc[1][j]) * K.ev(0, j, 0, ra[0][j], rb[0][j], rc[0][j]), v1 = K.ev(1, j, 1, ra[1][j], rb[1][j], rc[1][j]) * K.ev(0, j, 1, ra[0][j], rb[0][j], rc[0][j]);
                *(LAS bf16*)(lds + c * PITCH + 2 * (tt0 + i)) = f2bf(v0); *(LAS bf16*)(lds + (c + 1) * PITCH + 2 * (tt0 + i)) = f2bf(v1); }
#pragma unroll
            for (int s_ = 0; s_ < 2; ++s_)
#pragma unroll
                for (int j = 0; j < NJ; ++j) { ra[s_][j] = rb[s_][j]; rb[s_][j] = rc[s_][j]; }
        }
        __syncthreads();
        bf16* dst = row0 < MX ? p.VT : p.VTC;
        for (int idx = tid; idx < DHY * 8; idx += 512) { const int c = idx >> 3, part = idx & 7;
            *(u32x4*)(dst + ((size_t)c * NB + b) * Len + t0 + 8 * part) = *(const LAS u32x4*)(lds + c * PITCH + 16 * part); }
        __syncthreads();
    }
}
__device__ __forceinline__ void final_phase(const Prm& p, int l, int nrows, LAS unsigned char* lds, int G) {
    int tid_ = my_tid(); asm volatile("" : "+v"(tid_));
    const int tid = tid_, wid = __builtin_amdgcn_readfirstlane(tid >> 6), lane = tid & 63;
    constexpr int PITCH = 65, NJ = DHY / 128;
    LAS float* T = (LAS float*)lds;
    ConvK<0, 3> K; K.load(p.hy_conv_w + (size_t)l * 3 * 3 * DHY, p.hy_conv_b + (size_t)l * 3 * DHY, lane);
    float sk[NJ][2], gh[NJ][2], gn[DNA / 128][2], gg[DGA / 128][2];
#pragma unroll
    for (int j = 0; j < NJ; ++j)
#pragma unroll
        for (int e = 0; e < 2; ++e) { sk[j][e] = p.hy_skip[l * DHY + 6 * lane + 2 * j + e]; gh[j][e] = p.out_norm_hy[l * DHY + 6 * lane + 2 * j + e]; }
#pragma unroll
    for (int j = 0; j < DNA / 128; ++j) { gn[j][0] = p.out_norm_na[l * DNA + 6 * lane + 2 * j]; gn[j][1] = p.out_norm_na[l * DNA + 6 * lane + 2 * j + 1]; }
#pragma unroll
    for (int j = 0; j < DGA / 128; ++j) { gg[j][0] = p.out_norm_ga[l * DGA + 4 * lane + 2 * j]; gg[j][1] = p.out_norm_ga[l * DGA + 4 * lane + 2 * j + 1]; }
    for (int tile = blockIdx.x; tile < nrows / 64; tile += G) {
        int row0, b, t0, Len; tile_geom(tile, row0, b, t0, Len);
        const float* ysrc = row0 < MX ? p.YC : p.YCC;
        for (int idx = tid; idx < DHY * 16; idx += 512) { const int c = idx >> 4, part = idx & 15; const f32x4 v = __builtin_nontemporal_load((const f32x4*)(ysrc + ((size_t)c * NB + b) * Len + t0 + 4 * part));
            LAS float* d = T + c * PITCH + 4 * part; d[0] = v.x; d[1] = v.y; d[2] = v.z; d[3] = v.w; }
        __syncthreads();
        const int tt0 = 8 * wid; const bf16* Pl = p.P + (size_t)(row0 + tt0) * NP + 6 * lane;
        unsigned ra[3][NJ], rb[3][NJ], rc[3][NJ], rd[3][NJ];
        ld_row<0, 3>(Pl - NP, t0 + tt0 - 1 >= 0, ra); ld_row<0, 3>(Pl, true, rb); ld_row<0, 3>(Pl + NP, t0 + tt0 + 1 < Len, rc);
        static_assert(DNA / 128 == 3 && DGA / 128 == 2, "12- and 8-byte pieces per lane");
        u32x3a onN; u32x2 ogN;
        { const bf16* Pr0 = p.P + (size_t)(row0 + tt0) * NP; onN = __builtin_nontemporal_load((const u32x3a*)(Pr0 + PC_NAQ + 6 * lane)); ogN = __builtin_nontemporal_load((const u32x2*)(Pr0 + PC_GAQ + 4 * lane)); }
#pragma unroll 2
        for (int i = 0; i < 8; ++i) { const int tt = tt0 + i, row = row0 + tt; bf16* yrow = p.HX + (size_t)row * D;
            unsigned on[DNA / 128], og[DGA / 128];
            on[0] = onN.x; on[1] = onN.y; on[2] = onN.z; og[0] = ogN.x; og[1] = ogN.y;
            ld_row<0, 3>(Pl + (size_t)(i + 2) * NP, i + 2 <= 8 && t0 + tt + 2 < Len, rd);
            { const bf16* Prn = p.P + (size_t)(row + (i + 1 < 8 ? 1 : 0)) * NP; onN = __builtin_nontemporal_load((const u32x3a*)(Prn + PC_NAQ + 6 * lane)); ogN = __builtin_nontemporal_load((const u32x2*)(Prn + PC_GAQ + 4 * lane)); }
            float y[NJ][2]; float ss = 0.f, s2 = 0.f, s3 = 0.f;
#pragma unroll
            for (int j = 0; j < NJ; ++j)
#pragma unroll
                for (int e = 0; e < 2; ++e) { const int c = 6 * lane + 2 * j + e;
                    const float x0 = K.ev(0, j, e, ra[0][j], rb[0][j], rc[0][j]), vp = K.ev(2, j, e, ra[2][j], rb[2][j], rc[2][j]) * K.ev(1, j, e, ra[1][j], rb[1][j], rc[1][j]);
                    y[j][e] = (T[c * PITCH + tt] + sk[j][e] * vp) * x0; ss += y[j][e] * y[j][e]; }
#pragma unroll
            for (int j = 0; j < DNA / 128; ++j) s2 += lo16(on[j]) * lo16(on[j]) + hi16(on[j]) * hi16(on[j]);
#pragma unroll
            for (int j = 0; j < DGA / 128; ++j) s3 += lo16(og[j]) * lo16(og[j]) + hi16(og[j]) * hi16(og[j]);
            const float r1 = 1.0f / sqrtf(wave_sum(ss) * (1.0f / DHY) + EPS), r2 = 1.0f / sqrtf(wave_sum(s2) * (1.0f / DNA) + EPS), r3 = 1.0f / sqrtf(wave_sum(s3) * (1.0f / DGA) + EPS);
            *(u32x3a*)(yrow + 6 * lane) = (u32x3a){pk2(y[0][0] * r1 * gh[0][0], y[0][1] * r1 * gh[0][1]), pk2(y[1][0] * r1 * gh[1][0], y[1][1] * r1 * gh[1][1]), pk2(y[2][0] * r1 * gh[2][0], y[2][1] * r1 * gh[2][1])};
            *(u32x3a*)(yrow + DHY + 6 * lane) = (u32x3a){pk2(lo16(on[0]) * r2 * gn[0][0], hi16(on[0]) * r2 * gn[0][1]), pk2(lo16(on[1]) * r2 * gn[1][0], hi16(on[1]) * r2 * gn[1][1]), pk2(lo16(on[2]) * r2 * gn[2][0], hi16(on[2]) * r2 * gn[2][1])};
            *(u32x2*)(yrow + DHY + DNA + 4 * lane) = (u32x2){pk2(lo16(og[0]) * r3 * gg[0][0], hi16(og[0]) * r3 * gg[0][1]), pk2(lo16(og[1]) * r3 * gg[1][0], hi16(og[1]) * r3 * gg[1][1])};
#pragma unroll
            for (int s_ = 0; s_ < 3; ++s_)
#pragma unroll
                for (int j = 0; j < NJ; ++j) { ra[s_][j] = rb[s_][j]; rb[s_][j] = rc[s_][j]; rc[s_][j] = rd[s_][j]; }
        }
        __syncthreads();
    }
}
}
namespace thin {

__device__ __forceinline__ void mod_phase(const Prm& p, LAS unsigned char* lds) {
    int tid_ = my_tid(); asm volatile("" : "+v"(tid_));
    const int tid = tid_, wid = __builtin_amdgcn_readfirstlane(tid >> 6), lane = tid & 63;
    LAS float* sc = (LAS float*)lds;
    LAS float* red = (LAS float*)(lds + 9 * D * 4);
    for (int i = tid; i < 9 * D; i += 512) { const int r = i / D, k = i % D; sc[i] = silu_f(r < 8 ? p.c[(size_t)(r % NB) * D + k] : p.c_ctx[k]); }
    __syncthreads();
    for (;;) { const int u = pull_unit(p.ctl + 44, lds); if (u >= NL * (6 * D / 64)) break; const int l = u / (6 * D / 64), n0 = 64 * (u % (6 * D / 64));
        const float* w = p.w_mod + (size_t)l * D * 6 * D + n0 + lane;
        float acc[9];
#pragma unroll
        for (int r = 0; r < 9; ++r) acc[r] = 0.f;
#pragma unroll 1
        for (int k0 = wid * (D / 8); k0 < (wid + 1) * (D / 8); k0 += 16) { float wv[16];
#pragma unroll
            for (int j = 0; j < 16; ++j) wv[j] = __builtin_nontemporal_load(w + (size_t)(k0 + j) * 6 * D);
#pragma unroll
            for (int j = 0; j < 16; ++j)
#pragma unroll
                for (int r = 0; r < 9; ++r) acc[r] += sc[r * D + k0 + j] * wv[j]; }
#pragma unroll
        for (int r = 0; r < 9; ++r) red[(wid * 9 + r) * 64 + lane] = acc[r];
        __syncthreads();
        for (int i = tid; i < 9 * 64; i += 512) { const int r = i >> 6, j = i & 63; float t = p.b_mod[(size_t)l * 6 * D + n0 + j];
#pragma unroll
            for (int ww = 0; ww < 8; ++ww) t += red[(ww * 9 + r) * 64 + j];
            p.MOD[((size_t)l * 9 + r) * 6 * D + n0 + j] = t; }
        __syncthreads();
    }
}
__device__ __forceinline__ float rdl(float v, int i) { return __int_as_float(__builtin_amdgcn_readlane(__float_as_int(v), i)); }
__device__ __forceinline__ void filter_position(const Prm& p, int l, int half, int t, int Len, bf16* ftab, int pitch, LAS const float* W1, LAS const float* W2, LAS const float* W3, int lane_) {
    int lane = lane_; asm volatile("" : "+v"(lane));
    const float tn = (float)t / (float)(Len - 1), ang = 6.283185307179586f * (float)t / (float)Len;
    float z = 0.f;
    if (lane == 0) z = tn; else if (lane < 17) z = cosf((1e-4f + (float)(lane - 1) * ((15.0f - 1e-4f) / 15.0f)) * ang); else if (lane < 33) z = -sinf((1e-4f + (float)(lane - 17) * ((15.0f - 1e-4f) / 15.0f)) * ang);
    const float fq = p.hy_freq[l * 64 + lane];
    float pre = p.hy_b1[l * 64 + lane];
#pragma unroll 11
    for (int j = 0; j < 33; ++j) pre += rdl(z, j) * W1[j * 64 + lane];
    float h = sinf(fq * pre);
#pragma unroll 1
    for (int inner = 0; inner < 2; ++inner) { float q = p.hy_b2[(l * 2 + inner) * 64 + lane];
#pragma unroll 8
        for (int i = 0; i < 64; ++i) q += rdl(h, i) * W2[(inner * 64 + i) * 64 + lane];
        h = sinf(fq * q); }
    float o[DHY / 64];
#pragma unroll
    for (int m = 0; m < DHY / 64; ++m) o[m] = 0.f;
#pragma unroll 4
    for (int i = 0; i < 64; ++i) { const float hi_ = rdl(h, i);
#pragma unroll
        for (int m = 0; m < DHY / 64; ++m) o[m] += hi_ * W3[i * DHY + lane + 64 * m]; }
    const float d0 = logf(1e-2f) / 1.5f, d1 = logf(1e-2f) / 0.3f;
#pragma unroll
    for (int m = 0; m < DHY / 64; ++m) { const int c = lane + 64 * m; const float delta = fabsf(d0 + (float)c * ((d1 - d0) / (float)(DHY - 1)));
        const bf16 v = f2bf(o[m] * expf(-tn * delta)); bf16* ft = ftab + (size_t)c * pitch;
        if (half == 0) ft[Len - t] = v;
        else if (t > 0) ft[Len + t] = v;
        else { ft[0] = 0; for (int k = 0; k < 8; ++k) ft[2 * Len + k] = 0; } }
}
__device__ __forceinline__ void filter_phase(const Prm& p, LAS unsigned char* lds, int bid, int G) {
    int tid_ = my_tid(); asm volatile("" : "+v"(tid_));
    const int tid = tid_, wid = __builtin_amdgcn_readfirstlane(tid >> 6), lane = tid & 63;
    const int combo = bid & 3, l = combo >> 1, half = combo & 1, chunk = bid >> 2, nchunk = G >> 2;
    LAS float* W1 = (LAS float*)lds; LAS float* W2 = W1 + 33 * 64; LAS float* W3 = W2 + 2 * 64 * 64;
    for (int i = tid; i < 33 * 64; i += 512) W1[i] = p.hy_w1[(size_t)l * 33 * 64 + i];
    for (int i = tid; i < 2 * 64 * 64; i += 512) W2[i] = p.hy_w2[(size_t)l * 2 * 64 * 64 + i];
    for (int i = tid; i < 64 * DHY; i += 512) { const int k = i / DHY, c = i % DHY; W3[i] = p.hy_w3[((size_t)l * 64 + k) * 2 * DHY + half * DHY + c]; }
    __syncthreads();
    for (int t = chunk * 8 + wid; t < S; t += nchunk * 8) filter_position(p, l, half, t, S, p.FT + (size_t)l * DHY * (2 * S + 8), 2 * S + 8, W1, W2, W3, lane);
    if (l == 0) for (int t = chunk * 8 + wid; t < LC; t += nchunk * 8) filter_position(p, 0, half, t, LC, p.FTC, 2 * LC + 8, W1, W2, W3, lane);
}
__device__ __forceinline__ void moe_assign_phase(const Prm& p, LAS unsigned char* lds, int G) {
    int tid_ = my_tid(); asm volatile("" : "+v"(tid_));
    const int tid = tid_;
    LAS int* cnt = (LAS int*)lds; LAS int* base = cnt + 16;
    for (int blk = blockIdx.x; blk < MX / 128; blk += G) {
        if (tid < 16) cnt[tid] = 0;
        __syncthreads();
        const int m = blk * 128 + (tid & 127), c = (tid >> 7) & 1; int g = 0, rank = 0;
        if (tid < 256) { g = c * 8 + p.TOPI[m * 2 + c]; rank = __hip_atomic_fetch_add(cnt + g, 1, __ATOMIC_RELAXED, __HIP_MEMORY_SCOPE_WORKGROUP); }
        __syncthreads();
        if (tid < 16) base[tid] = moe_off(p, tid >> 3, tid & 7) + atomicAdd(p.ctl + 16 + tid, cnt[tid]);
        __syncthreads();
        LAS int* slots = base + 16;
        if (tid < 256) { const int sl = base[g] + rank; p.LIST[(size_t)c * MPAD + sl] = m; p.SW[(size_t)c * MPAD + sl] = p.TOPW[m * 2 + c]; slots[tid] = c * MPAD + sl; }
        __syncthreads();
        {
            const int w = tid >> 6, lane = tid & 63; const unsigned char* src = (const unsigned char*)p.HX; unsigned char* dst = (unsigned char*)p.XG;
#pragma unroll
            for (int q = 0; q < 4; ++q) { pg8::u32x4 v[8];
#pragma unroll
                for (int i = 0; i < 8; ++i) { const int r = 32 * w + 8 * q + i; v[i] = __builtin_nontemporal_load((const pg8::u32x4*)(src + (size_t)(blk * 128 + (r & 127)) * D + 16 * lane)); }
#pragma unroll
                for (int i = 0; i < 8; ++i) { const int r = 32 * w + 8 * q + i; *(pg8::u32x4*)(dst + (size_t)slots[r] * D + 16 * lane) = v[i]; } } }
        __syncthreads();
    }
}
__device__ __forceinline__ void hyena_ctx_phase(const Prm& p, LAS unsigned char* lds, int G) {
    int tid_ = my_tid(); asm volatile("" : "+v"(tid_));
    const int tid = tid_, wid = __builtin_amdgcn_readfirstlane(tid >> 6), lane = tid & 63;
    static_assert(LC == 256, "context Hyena geometry");
    LAS float* R = (LAS float*)(lds + wid * 4096);
    for (int u = blockIdx.x * 8 + wid; u < DHY * NB; u += G * 8) { const int c = u / NB;
        const bf16* ft = p.FTC + (size_t)c * (2 * LC + 8); const bf16* v = p.VTC + (size_t)u * LC;
#pragma unroll
        for (int i = 0; i < 8; ++i) R[lane + 64 * i] = bf2f(ft[lane + 64 * i]);
        float vv[4];
#pragma unroll
        for (int i = 0; i < 4; ++i) vv[i] = bf2f(v[4 * lane + i]);
        asm volatile("s_waitcnt lgkmcnt(0)" ::: "memory");
        float acc[4] = {0.f, 0.f, 0.f, 0.f};
#pragma unroll 8
        for (int s4 = 0; s4 < 64; ++s4) {
#pragma unroll
            for (int e = 0; e < 4; ++e) { const float vs = __int_as_float(__builtin_amdgcn_readlane(__float_as_int(vv[e]), s4)); const int s = 4 * s4 + e;
#pragma unroll
                for (int k = 0; k < 4; ++k) acc[k] += R[LC - (lane + 64 * k) + s] * vs; } }
#pragma unroll
        for (int k = 0; k < 4; ++k) p.YCC[(size_t)u * LC + lane + 64 * k] = acc[k];
    }
}
}

#define XB_TMO      128
#define XB_XCNT(j)  (256  + 64 * (j))
#define XB_XSUB(j)  (1280 + 64 * (j))
#define XB_XGEN(j)  (2304 + 64 * (j))
#define XB_TOP      3328
#define XB_TOPGEN   3392
#define XCD_BAR_WORDS 3456
#define XB_SPIN_CAP (1u << 23)

__device__ __forceinline__ unsigned xb_ld(unsigned* p)              { return __hip_atomic_load(p, __ATOMIC_RELAXED, __HIP_MEMORY_SCOPE_AGENT); }
__device__ __forceinline__ unsigned xb_add(unsigned* p, unsigned v) { return __hip_atomic_fetch_add(p, v, __ATOMIC_RELAXED, __HIP_MEMORY_SCOPE_AGENT); }
__device__ __forceinline__ unsigned xb_xcc_id() { return (unsigned)__builtin_amdgcn_s_getreg((3 << 11) | 20) & 0xFu; }
#define XB_SPIN(cond, bar) do { unsigned _sp = 0; while (cond) { __builtin_amdgcn_s_sleep(1); \
    if ((++_sp & 255u) == 0u) { if (xb_ld(&(bar)[XB_TMO])) break; if (_sp > XB_SPIN_CAP) { atomicAdd(&(bar)[XB_TMO], 1u); break; } } } } while (0)

struct XcdBarrier {
    unsigned* bar; unsigned x;
    volatile LAS unsigned* st;
};

__device__ __forceinline__ XcdBarrier xcd_barrier_post(unsigned* bar, volatile LAS unsigned* st) {
    XcdBarrier b; b.bar = bar; b.x = xb_xcc_id(); b.st = st;
    if (my_tid() == 0) (void)xb_add(&bar[XB_XCNT(b.x)], 1u);
    return b;
}
__device__ __forceinline__ void xcd_barrier_complete(unsigned* bar, unsigned x, unsigned& nloc, unsigned& nx) {
    const unsigned G = gridDim.x * gridDim.y * gridDim.z;
    unsigned sum, cnt, mine, sp = 0u;
    for (;;) {
        sum = 0u; cnt = 0u; mine = 0u;
#pragma unroll
        for (unsigned j = 0; j < 16; ++j) { const unsigned c = xb_ld(&bar[XB_XCNT(j)]); sum += c; cnt += (c > 0u) ? 1u : 0u; mine = (j == x) ? c : mine; }
        if (sum == G) break;
        __builtin_amdgcn_s_sleep(1);
        if ((++sp & 255u) == 0u) { if (xb_ld(&bar[XB_TMO])) break; if (sp > XB_SPIN_CAP) { atomicAdd(&bar[XB_TMO], 1u); break; } }
    }
    nloc = mine > 0u ? mine : 1u; nx = cnt > 0u ? cnt : 1u;
}

__device__ __forceinline__ void xcd_barrier(const XcdBarrier& b) {
    asm volatile("s_waitcnt vmcnt(0)" ::: "memory");
    __syncthreads();
    if (my_tid() == 0) {
        unsigned* bar = b.bar;
        __builtin_amdgcn_s_waitcnt(0);
        unsigned nloc = b.st[0], nx = b.st[1];
        if (nloc == 0u) { xcd_barrier_complete(bar, b.x, nloc, nx); b.st[0] = nloc; b.st[1] = nx; }
        const unsigned old = xb_add(&bar[XB_XSUB(b.x)], 1u);
        const unsigned gen = old / nloc;
        if (old + 1u == (gen + 1u) * nloc) {
            __builtin_amdgcn_fence(__ATOMIC_RELEASE, "agent");
            asm volatile("s_waitcnt vmcnt(0)" ::: "memory");
            const unsigned og = xb_add(&bar[XB_TOP], 1u);
            const unsigned tg = og / nx;
            if (og + 1u == (tg + 1u) * nx) xb_add(&bar[XB_TOPGEN], 1u);
            else XB_SPIN(xb_ld(&bar[XB_TOPGEN]) == tg, bar);
            __builtin_amdgcn_fence(__ATOMIC_ACQUIRE, "agent");
            xb_add(&bar[XB_XGEN(b.x)], 1u);
            asm volatile("s_waitcnt vmcnt(0)" ::: "memory");
        } else {
            XB_SPIN(xb_ld(&bar[XB_XGEN(b.x)]) == gen, bar);
            __builtin_amdgcn_fence(__ATOMIC_ACQUIRE, "agent");
            asm volatile("s_waitcnt vmcnt(0)" ::: "memory");
        }
    }
    __syncthreads();
}

constexpr int NWAVES = 8, NTHR = NWAVES * 64;
constexpr int LDS_BYTES = 147456, LDSCTL_OFF = LDS_BYTES - 512, MISC_OFF = LDSCTL_OFF, RING_BYTES = LDSCTL_OFF;
static_assert(hy::L_END <= RING_BYTES && attn_body::ATTN_LDS_BYTES <= RING_BYTES && MISC_OFF + 128 <= LDS_BYTES && (33 * 64 + 2 * 64 * 64 + 64 * DHY) * 4 <= RING_BYTES && 8 * 64 * 65 * 4 <= RING_BYTES && DHY * 65 * 4 <= RING_BYTES && pg8::STAGE_BYTES <= RING_BYTES, "LDS map");
constexpr int EPI_TAB_OFF = pg8::STAGE_BYTES;
static_assert(EPI_TAB_OFF + (256 + 2048) * 4 <= LDSCTL_OFF, "epilogue tables");
constexpr int CW_BAR = 4096;

__device__ __forceinline__ long opaque_gtid() { int t = my_tid(); asm volatile("" : "+v"(t)); return (long)blockIdx.x * 512 + t; }
typedef const __attribute__((address_space(4))) Prm* KPrm;
__device__ __forceinline__ KPrm opaque_kp() { KPrm q = (KPrm)__builtin_amdgcn_kernarg_segment_ptr(); asm volatile("" : "+s"(q)); return q; }
typedef __attribute__((address_space(1))) void* GPtr;
typedef const __attribute__((address_space(4))) GPtr* KWords;
__device__ __forceinline__ void load_prm(Prm& p) {
    static_assert(sizeof(Prm) % 8 == 0, "Prm is a pack of pointers");
    KWords src = (KWords)opaque_kp(); void** dst = (void**)&p;
#pragma unroll
    for (int i = 0; i < (int)(sizeof(Prm) / 8); ++i) dst[i] = (void*)src[i];
}
#define LP() Prm p; load_prm(p)
#define GT opaque_gtid()
#define GRID_BAR() do { XcdBarrier b_; b_.bar = (unsigned*)opaque_kp()->ctl + CW_BAR; b_.x = xb_xcc_id(); b_.st = (volatile LAS unsigned*)(lds + MISC_OFF) + 8; xcd_barrier(b_); } while (0)

__device__ __forceinline__ void reduce_resgate(const Prm& p, const float* slab, int npanels, int ks, const float* src, float* dst, const float* gate, long gtid, long gsz) {
    typedef float f32x4 __attribute__((ext_vector_type(4)));
    for (long it = gtid; it < (long)npanels * (D / 256) * 16384; it += gsz) { const int tile = (int)(it >> 14), e = (int)(it & 16383), r = e >> 6, c4 = (e & 63) * 4, pm = tile / (D / 256), pn = tile % (D / 256);
        f32x4 a = (f32x4){0.f, 0.f, 0.f, 0.f};
        for (int k = 0; k < ks; ++k) a += *(const f32x4*)(slab + ((size_t)tile * ks + k) * 65536 + r * 256 + c4);
        const size_t off = (size_t)(pm * 256 + r) * D + pn * 256 + c4; const f32x4 g = *(const f32x4*)(gate + pn * 256 + c4);
        *(f32x4*)(dst + off) = *(const f32x4*)(src + off) + g * a; }
}
__device__ __forceinline__ void reduce_moedown(const Prm& p, const float* slab, int pm0, int npanels, int ks, int l, int pass, long gtid, long gsz) {
    typedef float f32x4 __attribute__((ext_vector_type(4)));
    for (long it = gtid; it < (long)npanels * (D / 256) * 16384; it += gsz) { const int tile = (int)(it >> 14), e = (int)(it & 16383), r = e >> 6, c4 = (e & 63) * 4, pm = pm0 + tile / (D / 256), pn = tile % (D / 256);
        const int tok = p.LIST[(size_t)pass * MPAD + pm * 256 + r]; if (tok < 0) continue;
        f32x4 a = (f32x4){0.f, 0.f, 0.f, 0.f};
        for (int k = 0; k < ks; ++k) a += *(const f32x4*)(slab + ((size_t)tile * ks + k) * 65536 + r * 256 + c4);
        const int col = pn * 256 + c4; const f32x4 g = *(const f32x4*)(p.MOD + ((size_t)l * 9 + tok / S) * 6 * D + 5 * D + col); const float w = p.TOPW[tok * 2 + pass] * (1.0f / (F8_SH * F8_SWD));
        typedef unsigned u32x2_ __attribute__((ext_vector_type(2)));
        u32x2_* xp = (u32x2_*)(p.XB + (size_t)tok * D + col); const u32x2_ h = *xp;
        const f32x4 v = pg8::bflo4(h.x, h.y) + g * w * a;
        if (pass == 0) *xp = (u32x2_){pg8::pkh(v.x, v.y), pg8::pkh(v.z, v.w)}; else *(f32x4*)(p.out + (size_t)tok * D + col) = v; }
}
#ifndef SPLIT_OUTPROJ
#define SPLIT_OUTPROJ 1
#endif
#ifndef SPLIT_FFN
#define SPLIT_FFN 1
#endif
#ifndef SPLIT_MOE
#define SPLIT_MOE 1
#endif
template <int L> __device__ __forceinline__ void layer_fwd(LAS unsigned char* lds, const long gsz, const int G) {
    constexpr bool first = L == 0, last = L == NL - 1; constexpr int l = L;
    constexpr int nact = last ? MX : M;
    { LP(); thin::modnorm_phase<false, false, !first>(p, l, p.x, first ? p.ctx : p.CX, p.norm_mix + l * D, 0, D, M, lds, G); }
    GRID_BAR(); SEG(1 + 12 * L + 0);
    {
        LP(); pg8::Order O; O.init(M / 256, NP / 256, G, (int)blockIdx.x, p.WinT + (size_t)l * NP * D);
        {   LAS float* T = (LAS float*)(lds + EPI_TAB_OFF);
            for (int i = my_tid(); i < 4 * 64; i += NTHR) T[i] = p.QKG[l * 4 * 64 + i];
            for (int i = my_tid(); i < 64 * 16 * 2; i += NTHR) T[256 + i] = p.ROPE[i];
            __syncthreads(); }
        pg8::EpiInProj E{p.P, (const LAS float*)(lds + EPI_TAB_OFF), (const LAS float*)(lds + EPI_TAB_OFF) + 256};
        pg8::gemm_phase<pg8::EpiInProj, true, false>(lds, p.HX, D, D, O, E);
    }
    GRID_BAR(); SEG(1 + 12 * L + 1);
    { LP(); thin::prep_hy_phase(p, l, lds, G); }
    GRID_BAR(); SEG(1 + 12 * L + 2);
    { LP(); attn_phase<0>(p, l, (char*)lds, G); }
    SEG(53);
    { LP(); hyena_phase(p, l, lds, G); }
    SEG(62);
    if (!last) { { LP(); attn_phase<2>(p, l, (char*)lds, G); }
        __syncthreads();
        { LP(); thin::hyena_ctx_phase(p, lds, G); }
        __syncthreads(); }
    SEG(63);
    { LP(); attn_phase<1>(p, l, (char*)lds, G); }
    SEG(54);
    GRID_BAR(); SEG(1 + 12 * L + 3);
    { LP(); thin::final_phase(p, l, nact, lds, G); }
    GRID_BAR(); SEG(1 + 12 * L + 4);
    {
        LP(); pg8::Order O; O.init((SPLIT_OUTPROJ ? MX : nact) / 256, D / 256, G, (int)blockIdx.x, p.WoutT + (size_t)l * D * D);
        pg8::EpiResB<first> E{p.x, p.XB, p.MOD + (size_t)l * 9 * 6 * D + 2 * D, 1.0f};
        pg8::gemm_phase<pg8::EpiResB<first>, true, false>(lds, p.HX, D, D, O, E);
    }
    if constexpr (!last && SPLIT_OUTPROJ) {
        constexpr int KS = 4;
        {   LP(); pg8::Order O; O.init(MC / 256, D / 256, G, (int)blockIdx.x, p.WoutT + (size_t)l * D * D); O.pm0 = MX / 256; O.ksplit = KS; O.kplen = D / KS; O.nvirt = O.nwg * KS;
            pg8::EpiPartial E{p.YC, D / 256, MX / 256, KS};
            pg8::gemm_phase<pg8::EpiPartial, true, false>(lds, p.HX, D, D / KS, O, E); }
        GRID_BAR();
        { LP(); reduce_resgate(p, p.YC, MC / 256, KS, first ? p.ctx : p.CX, p.CX, p.MOD + ((size_t)l * 9 + 8) * 6 * D + 2 * D, GT, gsz); }
    }
    GRID_BAR(); SEG(1 + 12 * L + 5);
    { LP(); thin::modnorm_phase<(L & 1) != 0, true, true>(p, l, nullptr, p.CX, p.norm_ffn + l * D, 3 * D, 4 * D, nact, lds, G); }
    GRID_BAR(); SEG(1 + 12 * L + 6);
    if constexpr ((L & 1) == 0) {
        {   LP(); pg8::Order O; O.init(nact / 256, 2 * DFF / 256, G, (int)blockIdx.x, p.WguT);
            pg8::EpiSwiGLU8 E{(unsigned char*)p.HID, DFF};
            pg8::gemm_phase<pg8::EpiSwiGLU8, true, false, true>(lds, p.HX, D / 2, D / 2, O, E); }
        GRID_BAR(); SEG(1 + 12 * L + 7);
        {   LP(); pg8::Order O; O.init(MX / 256, D / 256, G, (int)blockIdx.x, p.WdT);
            pg8::EpiResB<false> E{nullptr, p.XB, p.MOD + (size_t)l * 9 * 6 * D + 5 * D, 1.0f / (F8_SH * F8_SWD)};
            pg8::gemm_phase<pg8::EpiResB<false>, true, false, true>(lds, p.HID, DFF / 2, DFF / 2, O, E); }
        if constexpr (!last) {   LP(); pg8::Order O; O.init(MC / 256, D / 256, G, (int)blockIdx.x, p.WdT); O.pm0 = MX / 256;
            pg8::EpiResGate E{nullptr, p.CX, nullptr, p.CX, p.MOD + (size_t)l * 9 * 6 * D + 5 * D, 1.0f / (F8_SH * F8_SWD)};
            pg8::gemm_phase<pg8::EpiResGate, true, false, true>(lds, p.HID, DFF / 2, DFF / 2, O, E); }
        if constexpr (false) {
            constexpr int KS = 11; static_assert(DFF % (KS * 128) == 0 && (size_t)M * DFF * 2 + (size_t)(MC / 256) * (D / 256) * KS * 65536 * 4 <= (size_t)M * NP * 2 + (size_t)DHY * NB * S * 6, "slab space behind the dense hidden buffer");
            {   LP(); pg8::Order O; O.init(MC / 256, D / 256, G, (int)blockIdx.x, p.WdT); O.pm0 = MX / 256; O.ksplit = KS; O.kplen = DFF / KS; O.nvirt = O.nwg * KS;
                pg8::EpiPartial E{(float*)(p.HID + (size_t)M * DFF), D / 256, MX / 256, KS};
                pg8::gemm_phase<pg8::EpiPartial, true, false>(lds, p.HID, DFF, DFF / KS, O, E); }
            GRID_BAR();
            { LP(); reduce_resgate(p, (float*)(p.HID + (size_t)M * DFF), MC / 256, KS, p.CX, p.CX, p.MOD + ((size_t)l * 9 + 8) * 6 * D + 5 * D, GT, gsz); }
        }
        GRID_BAR(); SEG(1 + 12 * L + 8);
    } else {
        { LP(); thin::moe_assign_phase(p, lds, G); }
        GRID_BAR(); SEG(1 + 12 * L + 7);
#pragma unroll
        for (int pass = 0; pass < 2; ++pass) {
            {   LP(); pg8::Order O; int o = 0;
#pragma unroll
                for (int k = 0; k < 8; ++k) { o += (__builtin_amdgcn_readfirstlane(p.ctl[pass * 8 + k]) + 255) / 256; O.pend[k] = o; }
                const int npan = o; O.nM = npan; O.nN = 2 * DFE / 256; O.nwg = O.nM * O.nN; O.G = G; O.c = (int)blockIdx.x; O.Bt = p.WguTe; O.bt_group_stride = (size_t)2 * DFE * D / 2; O.rows = nullptr; O.pm0 = 0; O.ksplit = 1; O.kplen = 0; O.nvirt = O.nwg;
                pg8::EpiSwiGLU8 E{(unsigned char*)p.HID, DFE};
                pg8::gemm_phase<pg8::EpiSwiGLU8, true, false, true>(lds, p.XG + (size_t)pass * MPAD * D / 2, D / 2, D / 2, O, E); }
            GRID_BAR(); SEG(1 + 12 * L + 8 + 2 * pass);
            {   LP(); pg8::Order O; int o = 0;
#pragma unroll
                for (int k = 0; k < 8; ++k) { o += (__builtin_amdgcn_readfirstlane(p.ctl[pass * 8 + k]) + 255) / 256; O.pend[k] = o; }
                const int npan = o, nmain = (SPLIT_MOE && npan > MX / 256) ? MX / 256 : npan;
                O.nM = nmain; O.nN = D / 256; O.nwg = O.nM * O.nN; O.G = G; O.c = (int)blockIdx.x; O.Bt = p.WdTe; O.bt_group_stride = (size_t)D * DFE / 2; O.rows = nullptr; O.pm0 = 0; O.ksplit = 1; O.kplen = 0; O.nvirt = O.nwg;
                if (pass == 0) { pg8::EpiMoeDownB<false> E{p.LIST + (size_t)pass * MPAD, p.SW + (size_t)pass * MPAD, pass, p.XB, p.out, p.MOD + (size_t)l * 9 * 6 * D + 5 * D, 1.0f / (F8_SH * F8_SWD), (LAS float*)(lds + EPI_TAB_OFF)};
                    pg8::gemm_phase<pg8::EpiMoeDownB<false>, true, false, true>(lds, p.HID, DFE / 2, DFE / 2, O, E); }
                else { pg8::EpiMoeDownB<true> E{p.LIST + (size_t)pass * MPAD, p.SW + (size_t)pass * MPAD, pass, p.XB, p.out, p.MOD + (size_t)l * 9 * 6 * D + 5 * D, 1.0f / (F8_SH * F8_SWD), (LAS float*)(lds + EPI_TAB_OFF)};
                    pg8::gemm_phase<pg8::EpiMoeDownB<true>, true, false, true>(lds, p.HID, DFE / 2, DFE / 2, O, E); }
                constexpr int KS = 7; static_assert(DFE % (KS * 256) == 0 && (size_t)MPAD * DFE + (size_t)(MPAD / 256 - MX / 256) * (D / 256) * KS * 65536 * 4 <= (size_t)M * NP * 2 + (size_t)DHY * NB * S * 6, "slab space behind the (fp8) expert hidden buffer");
                if (npan > nmain) {
                    int ks = KS; asm volatile("" : "+s"(ks));
                    O.nM = npan - nmain; O.nwg = O.nM * O.nN; O.pm0 = nmain; O.ksplit = ks; O.kplen = DFE / 2 / ks; O.nvirt = O.nwg * ks;
                    pg8::EpiPartial E2{(float*)(p.HID + (size_t)MPAD * DFE / 2), D / 256, nmain, ks};
                    pg8::gemm_phase<pg8::EpiPartial, true, false, true>(lds, p.HID, DFE / 2, DFE / 2 / ks, O, E2); } }
            GRID_BAR();
            {   LP(); int o = 0;
#pragma unroll
                for (int k = 0; k < 8; ++k) o += (__builtin_amdgcn_readfirstlane(p.ctl[pass * 8 + k]) + 255) / 256;
                if (o > MX / 256) reduce_moedown(p, (float*)(p.HID + (size_t)MPAD * DFE / 2), MX / 256, o - MX / 256, 7, l, pass, GT, gsz); }
            SEG(1 + 12 * L + 9 + 2 * pass);
        }
    }
}

__global__ void __launch_bounds__(NTHR, 2) mega_fwd(Prm p_in) {
    LAS unsigned char* lds = (LAS unsigned char*)lds_raw;
    volatile LAS unsigned* MISC = (volatile LAS unsigned*)(lds + MISC_OFF);
    const int tid = threadIdx.x;
    for (int u = tid; u < (LDS_BYTES - LDSCTL_OFF) / 4; u += NTHR) ((LAS unsigned*)(lds + LDSCTL_OFF))[u] = 0u;
    __syncthreads();
    if ((tid & 63) == 0) ((volatile LAS int*)(lds + WIDTAB_OFF))[hw_wave_slot()] = tid >> 6;
    (void)xcd_barrier_post((unsigned*)p_in.ctl + CW_BAR, MISC + 8);
#ifdef PROBE_MASK
    if (blockIdx.x == 0 && tid == 0) { volatile LAS unsigned long long* T_ = (volatile LAS unsigned long long*)(lds + MISC_OFF + 64); T_[0] = __builtin_amdgcn_s_memrealtime(); T_[1] = 0ull; }
#endif
    const int G = gridDim.x;
    const long gsz = (long)G * NTHR;
    { LP(); thin::rope_table(p, GT); }
    const int GF = (G / 8) * 4;
    if (GF >= 4 && (int)blockIdx.x < GF) { LP(); thin::filter_phase(p, lds, (int)blockIdx.x, GF); SEG(61); }
    else {
        const int bid = GF >= 4 ? (int)blockIdx.x - GF : (int)blockIdx.x, nb = GF >= 4 ? G - GF : G;
        { LP(); thin::wconv_phase(p, lds, bid, nb); }
        SEG(60);
        if (GF < 4) { __syncthreads(); LP(); thin::filter_phase(p, lds, (int)blockIdx.x, G); }
    }
    __syncthreads();
    { LP(); thin::mod_phase(p, lds); }
    GRID_BAR(); SEG(0);
    layer_fwd<0>(lds, gsz, G);
    layer_fwd<1>(lds, gsz, G);
#ifdef PROBE_MASK
    if (blockIdx.x == 0 && tid == 0) { volatile LAS unsigned long long* T_ = (volatile LAS unsigned long long*)(lds + MISC_OFF + 64); const unsigned long long t0_ = __builtin_amdgcn_s_memrealtime(), w_ = PROBE_MULT * T_[1];
        while (__builtin_amdgcn_s_memrealtime() - t0_ < w_) __builtin_amdgcn_s_sleep(8); }
#endif
}

extern "C" void kernel_launch(void* const* d_in, const int* in_sizes, int n_in, void* d_out, int out_size, void* d_ws, size_t ws_size, hipStream_t stream) {
    static int grid = 0;
    if (grid == 0) {
        if (n_in != 34 || out_size != MX * D || ws_size < ws_needed()) { fprintf(stderr, "kernel_launch: unexpected shapes (n_in %d out %d ws %zu need %zu)\n", n_in, out_size, ws_size, ws_needed()); grid = -1; return; }
        int dev = 0, cus = 0, per_cu = 0;
        if (hipGetDevice(&dev) != hipSuccess || hipDeviceGetAttribute(&cus, hipDeviceAttributeMultiprocessorCount, dev) != hipSuccess) { grid = -1; return; }
        if (hipFuncSetAttribute((const void*)mega_fwd, hipFuncAttributeMaxDynamicSharedMemorySize, LDS_BYTES) != hipSuccess) { fprintf(stderr, "kernel_launch: hipFuncSetAttribute failed\n"); grid = -1; return; }
        if (hipOccupancyMaxActiveBlocksPerMultiprocessor(&per_cu, (const void*)mega_fwd, NTHR, LDS_BYTES) != hipSuccess || per_cu < 1) { fprintf(stderr, "kernel_launch: occupancy query reports %d\n", per_cu); }
        (void)hipGetLastError();
        grid = cus;
    }
    if (grid < 0) return;
    (void)in_sizes;
    (void)hipMemsetAsync(d_ws, 0, CTL_BYTES, stream);
    Prm p; __builtin_memset((void*)&p, 0, sizeof(p)); build_prm(p, d_in, d_out, d_ws);
    hipLaunchKernelGGL(mega_fwd, dim3(grid), dim3(NTHR), LDS_BYTES, stream, p);
}
#else
static void forward_emu(void* const* d_in, void* d_out, void* d_ws) {
    memset(d_ws, 0, CTL_BYTES);
    Prm p; memset(&p, 0, sizeof(p)); build_prm(p, d_in, d_out, d_ws);
#define RUN(ph, l, arg) run_phase(p, (ph), (l), (arg), 0, 1)
    RUN(PH_WCONV, 0, 0); RUN(PH_MOD, 0, 0); RUN(PH_F1, 0, 0); RUN(PH_F2A, 0, 0); RUN(PH_F2B, 0, 0); RUN(PH_F3, 0, 0);
    for (int l = 0; l < NL; ++l) {
        const bool last = l == NL - 1;
        RUN(PH_MODNORM1, l, 0); RUN(PH_INPROJ, l, 0); RUN(PH_PREP_HY, l, 0); RUN(PH_PREP_QK, l, 0);
        RUN(PH_HYENA, l, 0); RUN(PH_GA, l, 0); RUN(PH_NA, l, 0); if (!last) RUN(PH_CTXATTN, l, 0);
        RUN(PH_FINAL, l, 0); RUN(PH_OUTPROJ, l, 0); RUN(PH_MODNORM2, l, 0);
        if ((l & 1) == 0) { RUN(PH_FFN_UP, l, 0); RUN(PH_FFN_DOWN, l, 0); }
        else { RUN(PH_MOE_COUNT, l, 0); RUN(PH_MOE_ASSIGN, l, 0); for (int c = 0; c < 2; ++c) { RUN(PH_MOE_UP, l, c); RUN(PH_MOE_DOWN, l, c); } }
    }
}
#endif
```
